# Optimizing an MI355X kernel written in HIP

```python
import math
import jax, jax.numpy as jnp
from jax import lax
import numpy as np

D_MODEL = 1024
BATCH = 8
SEQ = 2048
DEPTH = 2
DEC_BATCH = 128
DEC_SEQ = 4
PAST_LEN = 16384
PAGE_SIZE = 128

HEAD_DIM = 128
MIX_WIDTH = D_MODEL // 2
N_HEADS = MIX_WIDTH // HEAD_DIM
N_BRANCH = 3
CONV_W = 4
D_FF = 4 * D_MODEL
CHUNK = 64
EPS = 1e-6

_SPLIT_SIZES = [MIX_WIDTH] * 4 + [N_HEADS] * 2 \
    + [MIX_WIDTH] * 4 + [N_HEADS] * 2 \
    + [MIX_WIDTH] * 4 \
    + [D_MODEL] * N_BRANCH
IN_COLS = sum(_SPLIT_SIZES)

kernel_name = "hybrid_mlstm_gdn_hgrn2_decode_step"


def rmsnorm(x, w):
    xf = x.astype(jnp.float32)
    y = xf * lax.rsqrt(jnp.mean(xf * xf, -1, keepdims=True) + EPS)
    return (y * w.astype(jnp.float32)).astype(x.dtype)


def head_rms(x):
    return x * lax.rsqrt(jnp.mean(x * x, -1, keepdims=True) + EPS)


def l2n(x):
    return x * lax.rsqrt(jnp.sum(x * x, -1, keepdims=True) + EPS)


def heads(x):
    b, t, _ = x.shape
    return x.reshape(b, t, N_HEADS, HEAD_DIM).transpose(0, 2, 1, 3)


def unheads(x):
    b, h, t, d = x.shape
    return x.transpose(0, 2, 1, 3).reshape(b, t, h * d)


def to_chunks(x, c):
    b, h, t = x.shape[:3]
    x = x.reshape(b, h, t // c, c, *x.shape[3:])
    return jnp.moveaxis(x, 2, 0)


def from_chunks(y):
    y = jnp.moveaxis(y, 0, 2)
    return y.reshape(y.shape[0], y.shape[1], -1, *y.shape[4:])


def split_cols(proj):
    idx = [int(i) for i in np.cumsum(_SPLIT_SIZES)[:-1]]
    return jnp.split(proj, idx, axis=-1)


def mlstm_scan(q, k, v, i_log, f_log, C0, n0, m0):
    t_len = q.shape[2]
    c = math.gcd(t_len, CHUNK)
    causal = jnp.tril(jnp.ones((c, c), bool))

    def step(carry, inp):
        C, n, m = carry
        qc, kc, vc, ic, fc = inp
        b = jnp.cumsum(fc, -1)
        a = b + m[..., None]
        D = b[..., :, None] - b[..., None, :] + ic[..., None, :]
        D = jnp.where(causal, D, -jnp.inf)
        mt = jnp.maximum(a, jnp.max(D, -1))
        P = jnp.einsum('bhtd,bhsd->bhts', qc, kc) * jnp.exp(D - mt[..., None])
        w_st = jnp.exp(a - mt)
        num = jnp.einsum('bhts,bhsv->bhtv', P, vc) + w_st[..., None] * jnp.einsum('bhtk,bhkv->bhtv', qc, C)
        den = jnp.sum(P, -1) + w_st * jnp.einsum('bhtk,bhk->bht', qc, n)
        h = num / jnp.maximum(jnp.abs(den), jnp.exp(-mt))[..., None]
        m_new = mt[..., -1]
        ws = jnp.exp(D[..., -1, :] - m_new[..., None])
        wc = jnp.exp(a[..., -1] - m_new)
        C_new = wc[..., None, None] * C + jnp.einsum('bhs,bhsk,bhsv->bhkv', ws, kc, vc)
        n_new = wc[..., None] * n + jnp.einsum('bhs,bhsk->bhk', ws, kc)
        return (C_new, n_new, m_new), h

    xs = tuple(to_chunks(z, c) for z in (q, k, v, i_log, f_log))
    (C, n, m), h = lax.scan(step, (C0, n0, m0), xs)
    return from_chunks(h), C, n, m


def gdn_scan(q, k, v, beta, logg, S0):
    t_len = q.shape[2]
    dv = v.shape[-1]
    c = math.gcd(t_len, CHUNK)
    incl = jnp.tril(jnp.ones((c, c), bool))
    strict = jnp.tril(jnp.ones((c, c), bool), -1)
    eye = jnp.eye(c, dtype=jnp.float32)

    def step(S, inp):
        qc, kc, vc, bc, gc = inp
        G = jnp.cumsum(gc, -1)
        decay = jnp.exp(jnp.where(incl, G[..., :, None] - G[..., None, :], -jnp.inf))
        kk = jnp.einsum('bhtd,bhsd->bhts', kc, kc)
        A = eye + jnp.where(strict, bc[..., :, None] * kk * decay, 0.0)
        rhs = jnp.concatenate([bc[..., None] * vc, (bc * jnp.exp(G))[..., None] * kc], -1)
        sol = lax.linalg.triangular_solve(A, rhs, left_side=True, lower=True, unit_diagonal=True)
        u, w = sol[..., :dv], sol[..., dv:]
        v_new = u - jnp.einsum('bhtk,bhkv->bhtv', w, S)
        qk = jnp.einsum('bhtd,bhsd->bhts', qc, kc) * decay
        o = jnp.einsum('bhtk,bhkv->bhtv', qc * jnp.exp(G)[..., None], S) \
            + jnp.einsum('bhts,bhsv->bhtv', qk, v_new)
        GL = G[..., -1]
        S_new = jnp.exp(GL)[..., None, None] * S \
            + jnp.einsum('bhsk,bhsv->bhkv', kc * jnp.exp(GL[..., None] - G)[..., None], v_new)
        return S_new, o

    xs = tuple(to_chunks(z, c) for z in (q, k, v, beta, logg))
    S, o = lax.scan(step, S0, xs)
    return from_chunks(o), S


def hgrn_scan(q, k, v, f_log, S0):
    t_len = q.shape[2]
    c = math.gcd(t_len, CHUNK)
    incl = jnp.tril(jnp.ones((c, c), bool))

    def step(S, inp):
        qc, kc, vc, fc = inp
        Bc = jnp.cumsum(fc, 2)
        diff = Bc[:, :, :, None, :] - Bc[:, :, None, :, :]
        diff = jnp.where(incl[..., None], diff, -jnp.inf)
        A = jnp.einsum('bhtk,bhsk,bhtsk->bhts', qc, kc, jnp.exp(diff))
        o = jnp.einsum('bhtk,bhkv->bhtv', qc * jnp.exp(Bc), S) + jnp.einsum('bhts,bhsv->bhtv', A, vc)
        BL = Bc[:, :, -1]
        S_new = jnp.exp(BL)[..., None] * S \
            + jnp.einsum('bhsk,bhsv->bhkv', kc * jnp.exp(BL[:, :, None] - Bc), vc)
        return S_new, o

    xs = tuple(to_chunks(z, c) for z in (q, k, v, f_log))
    S, o = lax.scan(step, S0, xs)
    return from_chunks(o), S


def mixer(xn, p, st):
    f32 = jnp.float32
    t_len = xn.shape[1]
    proj = jnp.einsum('btd,dc->btc', xn, p['w_in']).astype(f32)
    (ml_q, ml_k, ml_v, ml_o, ml_i, ml_f,
     gd_q, gd_k, gd_v, gd_z, gd_b, gd_a,
     hg_q, hg_f, hg_i, hg_g,
     gate_a, gate_b, gate_c) = split_cols(proj)
    C0, n0, m0, S0_gd, conv0, S0_hg = st

    i_log = jnp.swapaxes(ml_i + p['ml_i_bias'].astype(f32), 1, 2)
    f_log = jnp.swapaxes(jax.nn.log_sigmoid(ml_f + p['ml_f_bias'].astype(f32)), 1, 2)
    h, C1, n1, m1 = mlstm_scan(heads(ml_q), heads(ml_k) * HEAD_DIM ** -0.5, heads(ml_v),
                               i_log, f_log, C0.astype(f32), n0.astype(f32), m0.astype(f32))
    y_ml = unheads(head_rms(h)) * p['ml_norm_w'].astype(f32) * jax.nn.sigmoid(ml_o)

    qkv = jnp.concatenate([gd_q, gd_k, gd_v], -1)
    buf = jnp.concatenate([conv0.astype(f32), qkv], 1)
    cw = p['gd_conv_w'].astype(f32)
    conv = sum(buf[:, j:j + t_len] * cw[j] for j in range(CONV_W))
    conv = jax.nn.silu(conv)
    conv1 = buf[:, t_len:]
    cq, ck, cv = jnp.split(conv, 3, axis=-1)
    beta = jnp.swapaxes(jax.nn.sigmoid(gd_b), 1, 2)
    logg = jnp.swapaxes(-jnp.exp(p['gd_A_log'].astype(f32))
                        * jax.nn.softplus(gd_a + p['gd_dt_bias'].astype(f32)), 1, 2)
    o_gd, S1_gd = gdn_scan(l2n(heads(cq)) * HEAD_DIM ** -0.5, l2n(heads(ck)), heads(cv),
                           beta, logg, S0_gd.astype(f32))
    y_gd = unheads(head_rms(o_gd) * p['gd_norm_w'].astype(f32)) * jax.nn.silu(gd_z)

    lb = p['hg_lb'].astype(f32)
    g_f = lb + (1.0 - lb) * jax.nn.sigmoid(hg_f)
    k_hg = (1.0 - lb) * jax.nn.sigmoid(-hg_f)
    o_hg, S1_hg = hgrn_scan(heads(jax.nn.silu(hg_q)), heads(k_hg), heads(hg_i),
                            heads(jnp.log(g_f)), S0_hg.astype(f32))
    y_hg = rmsnorm(unheads(o_hg), p['hg_norm_w']) * jax.nn.silu(hg_g)

    ys = jnp.stack([y_ml, y_gd, y_hg], 2)
    br = jnp.einsum('btnw,nwd->btnd', ys, p['w_branch'].astype(f32))
    gates = jax.nn.sigmoid(jnp.stack([gate_a, gate_b, gate_c], 2))
    merged = jnp.sum(gates * br, 2).astype(xn.dtype)
    out = jnp.einsum('btd,de->bte', merged, p['w_out'])
    return out, (C1, n1, m1, S1_gd, conv1, S1_hg)


def run_group(x, states, params):
    new = [[] for _ in range(len(states))]
    for l in range(DEPTH):
        p = {name: arr[l] for name, arr in params.items()}
        mix, st = mixer(rmsnorm(x, p['norm1_w']), p, tuple(s[l] for s in states))
        x = x + mix
        xn = rmsnorm(x, p['norm2_w'])
        hid = jnp.square(jax.nn.relu(xn @ p['w_up']))
        x = x + hid @ p['w_down']
        for lst, s in zip(new, st):
            lst.append(s)
    return x, tuple(jnp.stack(s) for s in new)


def setup_inputs(seed: int = 0) -> dict:
    key = jax.random.key(seed)
    ks = iter(jax.random.split(key, 32))

    def nrm(shape, s):
        return jax.random.normal(next(ks), shape, jnp.float32) * s

    W, H, Dh, D = MIX_WIDTH, N_HEADS, HEAD_DIM, D_MODEL
    dt = jnp.exp(jax.random.uniform(next(ks), (DEPTH, H), jnp.float32, math.log(1e-3), math.log(1e-1)))
    inp = {}
    inp['x_prompt'] = nrm((BATCH, SEQ, D), 1.0)
    inp['x_sample'] = nrm((DEC_BATCH, DEC_SEQ, D), 1.0)
    inp['state_mlstm_C'] = nrm((DEPTH, DEC_BATCH, H, Dh, Dh), 0.3)
    inp['state_mlstm_n'] = nrm((DEPTH, DEC_BATCH, H, Dh), 0.3)
    inp['state_mlstm_m'] = nrm((DEPTH, DEC_BATCH, H), 1.0)
    inp['state_gdn_S'] = nrm((DEPTH, DEC_BATCH, H, Dh, Dh), 0.3)
    inp['state_gdn_conv'] = nrm((DEPTH, DEC_BATCH, CONV_W - 1, 3 * W), 1.0)
    inp['state_hgrn_S'] = nrm((DEPTH, DEC_BATCH, H, Dh, Dh), 0.5)
    inp['norm1_w'] = 1.0 + nrm((DEPTH, D), 0.1)
    inp['w_in'] = nrm((DEPTH, D, IN_COLS), D ** -0.5)
    inp['ml_i_bias'] = nrm((DEPTH, H), 0.1)
    inp['ml_f_bias'] = jnp.linspace(3.0, 6.0, H, dtype=jnp.float32) + nrm((DEPTH, H), 0.1)
    inp['ml_norm_w'] = 1.0 + nrm((DEPTH, W), 0.1)
    inp['gd_conv_w'] = nrm((DEPTH, CONV_W, 3 * W), 0.5)
    inp['gd_A_log'] = jnp.log(jax.random.uniform(next(ks), (DEPTH, H), jnp.float32, 1.0, 16.0))
    inp['gd_dt_bias'] = dt + jnp.log(-jnp.expm1(-dt))
    inp['gd_norm_w'] = 1.0 + nrm((DEPTH, Dh), 0.1)
    inp['hg_lb_logits'] = nrm((DEPTH, W), 0.5)
    inp['hg_norm_w'] = 1.0 + nrm((DEPTH, W), 0.1)
    inp['w_branch'] = nrm((DEPTH, N_BRANCH, W, D), W ** -0.5)
    inp['w_out'] = nrm((DEPTH, D, D), D ** -0.5)
    inp['norm2_w'] = 1.0 + nrm((DEPTH, D), 0.1)
    inp['w_up'] = nrm((DEPTH, D, D_FF), D ** -0.5)
    inp['w_down'] = nrm((DEPTH, D_FF, D), 0.5 * D_FF ** -0.5)
    inp['final_norm_w'] = 1.0 + nrm((D,), 0.1)
    return inp


def reference(x_prompt, x_sample, state_mlstm_C, state_mlstm_n, state_mlstm_m, state_gdn_S,
              state_gdn_conv, state_hgrn_S, norm1_w, w_in, ml_i_bias, ml_f_bias, ml_norm_w,
              gd_conv_w, gd_A_log, gd_dt_bias, gd_norm_w, hg_lb_logits, hg_norm_w, w_branch,
              w_out, norm2_w, w_up, w_down, final_norm_w):
    f32 = jnp.float32
    sm = jax.nn.softmax(hg_lb_logits.astype(f32), axis=0)
    hg_lb = jnp.cumsum(sm, axis=0) - sm[0:1]
    params = dict(norm1_w=norm1_w, w_in=w_in, ml_i_bias=ml_i_bias, ml_f_bias=ml_f_bias,
                  ml_norm_w=ml_norm_w, gd_conv_w=gd_conv_w, gd_A_log=gd_A_log,
                  gd_dt_bias=gd_dt_bias, gd_norm_w=gd_norm_w, hg_lb=hg_lb, hg_norm_w=hg_norm_w,
                  w_branch=w_branch, w_out=w_out, norm2_w=norm2_w, w_up=w_up, w_down=w_down)

    bp = x_prompt.shape[0]
    zero_states = (jnp.zeros((DEPTH, bp, N_HEADS, HEAD_DIM, HEAD_DIM), f32),
                   jnp.zeros((DEPTH, bp, N_HEADS, HEAD_DIM), f32),
                   jnp.zeros((DEPTH, bp, N_HEADS), f32),
                   jnp.zeros((DEPTH, bp, N_HEADS, HEAD_DIM, HEAD_DIM), f32),
                   jnp.zeros((DEPTH, bp, CONV_W - 1, 3 * MIX_WIDTH), f32),
                   jnp.zeros((DEPTH, bp, N_HEADS, HEAD_DIM, HEAD_DIM), f32))
    hp, (p_mC, p_mn, p_mm, p_gS, p_gc, p_hS) = run_group(x_prompt, zero_states, params)
    y_prompt = rmsnorm(hp, final_norm_w)

    past = (state_mlstm_C, state_mlstm_n, state_mlstm_m, state_gdn_S, state_gdn_conv, state_hgrn_S)
    hs, (s_mC, s_mn, s_mm, s_gS, s_gc, s_hS) = run_group(x_sample, past, params)
    y_sample = rmsnorm(hs, final_norm_w)

    return (y_prompt, y_sample, p_mC, p_mn, p_mm, p_gS, p_gc, p_hS,
            s_mC, s_mn, s_mm, s_gS, s_gc, s_hS)
```

```cpp
#include <hip/hip_runtime.h>
#include <hip/hip_cooperative_groups.h>
#include <cstdio>
namespace cg = cooperative_groups;

typedef unsigned short u16;
using bf16x8 = __attribute__((ext_vector_type(8))) short;
using f32x4 = __attribute__((ext_vector_type(4))) float;
typedef float v2f __attribute__((ext_vector_type(2)));

#define DEVI __device__ __forceinline__

constexpr int D = 1024;
constexpr int MP = 16384, MS = 512, M = MP + MS;
constexpr int NPROJ = 6144, NPROJ_PAD = 6272;
constexpr int INC = 9232;
constexpr int DFF = 4096;
constexpr int NTHREADS = 512;
constexpr int LDS_BYTES = 112 * 1024;

constexpr size_t OFF_Y = 0;
constexpr size_t OFF_P_MC = (size_t)M * D;
constexpr size_t OFF_P_MN = OFF_P_MC + 2ull * 8 * 4 * 128 * 128;
constexpr size_t OFF_P_MM = OFF_P_MN + 2ull * 8 * 4 * 128;
constexpr size_t OFF_P_GS = OFF_P_MM + 2ull * 8 * 4;
constexpr size_t OFF_P_GC = OFF_P_GS + 2ull * 8 * 4 * 128 * 128;
constexpr size_t OFF_P_HS = OFF_P_GC + 2ull * 8 * 3 * 1536;
constexpr size_t OFF_S_MC = OFF_P_HS + 2ull * 8 * 4 * 128 * 128;
constexpr size_t OFF_S_MN = OFF_S_MC + 2ull * 128 * 4 * 128 * 128;
constexpr size_t OFF_S_MM = OFF_S_MN + 2ull * 128 * 4 * 128;
constexpr size_t OFF_S_GS = OFF_S_MM + 2ull * 128 * 4;
constexpr size_t OFF_S_GC = OFF_S_GS + 2ull * 128 * 4 * 128 * 128;
constexpr size_t OFF_S_HS = OFF_S_GC + 2ull * 128 * 3 * 1536;
static_assert(OFF_S_HS + 2ull * 128 * 4 * 128 * 128 == 72172608ull, "output size");

constexpr size_t WS_WT_IN = 0;
constexpr size_t WS_WT_GATE = WS_WT_IN + 2ull * NPROJ_PAD * 1024 * 2;
constexpr size_t WS_WT_BR = WS_WT_GATE + 2ull * 3072 * 1024 * 2;
constexpr size_t WS_WT_OUT = WS_WT_BR + 2ull * 3 * 1024 * 512 * 2;
constexpr size_t WS_WT_UP = WS_WT_OUT + 2ull * 1024 * 1024 * 2;
constexpr size_t WS_WT_DN = WS_WT_UP + 2ull * 4096 * 1024 * 2;
constexpr size_t WS_PROJ = WS_WT_DN + 2ull * 4096 * 1024 * 2;
constexpr size_t WS_CONV = WS_PROJ + (size_t)M * NPROJ * 2;
constexpr size_t WS_OBUF = WS_CONV + (size_t)M * 1536 * 2;
constexpr size_t WS_XN = WS_OBUF + (size_t)M * 1536 * 2;
constexpr size_t WS_SMALL = WS_XN + (size_t)M * 1024 * 2;
constexpr size_t WS_GATES = WS_SMALL + (size_t)M * 16 * 4;
constexpr size_t WS_DM = WS_GATES + (size_t)M * 16 * 4;
constexpr size_t WS_END = WS_DM + (size_t)M * 8 * 4;

struct Params {
  const float *x_prompt, *x_sample, *st_mC, *st_mn, *st_mm, *st_gS, *st_gconv, *st_hS;
  const float *norm1_w, *w_in, *ml_i_bias, *ml_f_bias, *ml_norm_w, *gd_conv_w, *gd_A_log, *gd_dt_bias,
      *gd_norm_w, *hg_lb_logits, *hg_norm_w, *w_branch, *w_out, *norm2_w, *w_up, *w_down, *final_norm_w;
  float* out;
  unsigned char* ws;
};

DEVI u16 f2bf(float f) { unsigned u = __float_as_uint(f); return (u16)((u + 0x7fffu + ((u >> 16) & 1u)) >> 16); }
DEVI unsigned pk2(float lo, float hi) { return (unsigned)f2bf(lo) | ((unsigned)f2bf(hi) << 16); }
DEVI float bflo(unsigned u) { return __uint_as_float(u << 16); }
DEVI float bfhi(unsigned u) { return __uint_as_float(u & 0xffff0000u); }
DEVI float sigm(float x) { return 1.f / (1.f + __expf(-x)); }
DEVI float silu(float x) { return x * sigm(x); }
DEVI float softplus(float x) { return fmaxf(x, 0.f) + log1pf(__expf(-fabsf(x))); }
DEVI int otid() { int t = threadIdx.x; asm volatile("" : "+v"(t)); return t; }
DEVI float wave_sum(float v) {
#pragma unroll
  for (int o = 32; o > 0; o >>= 1) v += __shfl_xor(v, o);
  return v;
}
template <int CTRL> DEVI float dpp_f(float v) {
  return __int_as_float(__builtin_amdgcn_update_dpp(0, __float_as_int(v), CTRL, 0xf, 0xf, false));
}
DEVI float row16_sum(float v) {
  v += dpp_f<0x128>(v);
  v += dpp_f<0x124>(v);
  v += dpp_f<0x122>(v);
  v += dpp_f<0x121>(v);
  return v;
}

DEVI void tr_seg(const float* __restrict__ src, int ld, int K, int ncols, u16* __restrict__ dst, float* tile, int& off) {
  const int G = gridDim.x;
  const int ntk = K >> 6, ntn = ncols >> 6, nt = ntk * ntn;
  const int start = (int)(((long)blockIdx.x + (long)G * 4096 - off) % G);
  const int tid_ = otid(); const int c = tid_ & 63, r0 = tid_ >> 6;
  for (int t = start; t < nt; t += G) {
    const int tk = t % ntk, tn = t / ntk;
    const int k0 = tk * 64, n0 = tn * 64;
#pragma unroll
    for (int i = 0; i < 8; ++i) {
      const int r = r0 + 8 * i;
      tile[r * 65 + c] = src[(size_t)(k0 + r) * ld + n0 + c];
    }
    __syncthreads();
#pragma unroll
    for (int i = 0; i < 8; ++i) {
      const int rr = r0 + 8 * i;
      dst[(size_t)(n0 + rr) * K + k0 + c] = f2bf(tile[c * 65 + rr]);
    }
    __syncthreads();
  }
  off += nt;
}

DEVI void phase_wprep(const Params& p, float* tile) {
  int off = 0;
  u16* wt_in = (u16*)(p.ws + WS_WT_IN);
  u16* wt_gate = (u16*)(p.ws + WS_WT_GATE);
  u16* wt_br = (u16*)(p.ws + WS_WT_BR);
  u16* wt_out = (u16*)(p.ws + WS_WT_OUT);
  u16* wt_up = (u16*)(p.ws + WS_WT_UP);
  u16* wt_dn = (u16*)(p.ws + WS_WT_DN);
  for (int l = 0; l < 2; ++l) {
    const float* win = p.w_in + (size_t)l * 1024 * INC;
    for (int s = 0; s < 12; ++s) {
      const int srccol = (s < 4) ? s * 512 : (s < 8 ? 2056 + (s - 4) * 512 : 4112 + (s - 8) * 512);
      tr_seg(win + srccol, INC, 1024, 512, wt_in + ((size_t)l * NPROJ_PAD + s * 512) * 1024, tile, off);
    }
    tr_seg(win + 6160, INC, 1024, 3072, wt_gate + (size_t)l * 3072 * 1024, tile, off);
    for (int b = 0; b < 3; ++b)
      tr_seg(p.w_branch + (size_t)(l * 3 + b) * 512 * 1024, 1024, 512, 1024, wt_br + (size_t)(l * 3 + b) * 1024 * 512, tile, off);
    tr_seg(p.w_out + (size_t)l * 1024 * 1024, 1024, 1024, 1024, wt_out + (size_t)l * 1024 * 1024, tile, off);
    tr_seg(p.w_up + (size_t)l * 1024 * 4096, 4096, 1024, 4096, wt_up + (size_t)l * 4096 * 1024, tile, off);
    tr_seg(p.w_down + (size_t)l * 4096 * 1024, 1024, 4096, 1024, wt_dn + (size_t)l * 1024 * 4096, tile, off);
  }
  for (int idx = blockIdx.x * NTHREADS + otid(); idx < 2 * 128 * 1024; idx += gridDim.x * NTHREADS) {
    const int l = idx >> 17, rem = idx & 131071, r = rem >> 10, k = rem & 1023;
    float v = 0.f;
    if (r < 16) {
      const int sc = (r < 8) ? 2048 + r : 4104 + (r - 8);
      v = p.w_in[(size_t)l * 1024 * INC + (size_t)k * INC + sc];
    }
    wt_in[((size_t)l * NPROJ_PAD + 6144 + r) * 1024 + k] = f2bf(v);
  }
}

DEVI void phase_norm(const float* xp, const float* xs, const float* __restrict__ w, u16* __restrict__ xn) {
  const int tid_ = otid(); const int lane = tid_ & 63, gw = blockIdx.x * 8 + (tid_ >> 6), nw = gridDim.x * 8;
  for (int m = gw; m < M; m += nw) {
    const float* xr = (m < MP) ? xp + (size_t)m * D : xs + (size_t)(m - MP) * D;
    float4 v[4];
    float ss = 0.f;
#pragma unroll
    for (int i = 0; i < 4; ++i) {
      v[i] = ((const float4*)xr)[lane + 64 * i];
      ss += v[i].x * v[i].x + v[i].y * v[i].y + v[i].z * v[i].z + v[i].w * v[i].w;
    }
    ss = wave_sum(ss);
    const float rstd = rsqrtf(ss * (1.f / 1024.f) + 1e-6f);
#pragma unroll
    for (int i = 0; i < 4; ++i) {
      const float4 wv = ((const float4*)w)[lane + 64 * i];
      uint2 o;
      o.x = pk2(v[i].x * rstd * wv.x, v[i].y * rstd * wv.y);
      o.y = pk2(v[i].z * rstd * wv.z, v[i].w * rstd * wv.w);
      ((uint2*)(xn + (size_t)m * D))[lane + 64 * i] = o;
    }
  }
}

DEVI void phase_final_norm(float* x, const float* __restrict__ w) {
  const int tid_ = otid(); const int lane = tid_ & 63, gw = blockIdx.x * 8 + (tid_ >> 6), nw = gridDim.x * 8;
  for (int m = gw; m < M; m += nw) {
    float* xr = x + (size_t)m * D;
    float4 v[4];
    float ss = 0.f;
#pragma unroll
    for (int i = 0; i < 4; ++i) {
      v[i] = ((const float4*)xr)[lane + 64 * i];
      ss += v[i].x * v[i].x + v[i].y * v[i].y + v[i].z * v[i].z + v[i].w * v[i].w;
    }
    ss = wave_sum(ss);
    const float rstd = rsqrtf(ss * (1.f / 1024.f) + 1e-6f);
#pragma unroll
    for (int i = 0; i < 4; ++i) {
      const float4 wv = ((const float4*)w)[lane + 64 * i];
      float4 o;
      o.x = v[i].x * rstd * wv.x; o.y = v[i].y * rstd * wv.y; o.z = v[i].z * rstd * wv.z; o.w = v[i].w * rstd * wv.w;
      ((float4*)xr)[lane + 64 * i] = o;
    }
  }
}

constexpr int LDS_S = 72;
template <int WMT, int WNT>
DEVI void gemm_core(const u16* __restrict__ A, int lda, const u16* __restrict__ B, int ldb, int K,
                    f32x4 (&acc)[WMT][WNT], u16* smem) {
  constexpr int BM = 64 * WMT, BN = 32 * WNT;
  constexpr int ACH = BM * 8 / NTHREADS, BCH = BN * 8 / NTHREADS;
  u16* sA = smem;
  u16* sB = smem + 2 * BM * LDS_S;
  const int tid = otid(), lane = tid & 63, w = tid >> 6, wm = w >> 1, wn = w & 1;
  const int fr = lane & 15, fq = lane >> 4;
  const int crow = tid >> 3, ckc = tid & 7;
  static_assert(BCH == 2 && (ACH == 2 || ACH == 4), "chunk counts");
  uint4 ra0, ra1, ra2, ra3, rb0, rb1;
  ra2 = uint4{0, 0, 0, 0}; ra3 = ra2;
  const u16* Ag = A + (size_t)crow * lda + ckc * 8;
  const u16* Bg = B + (size_t)crow * ldb + ckc * 8;
  const int nk = K >> 6;
#define GLOAD(KO)                                                                     \
  do {                                                                                \
    ra0 = *(const uint4*)(Ag + (KO));                                                 \
    ra1 = *(const uint4*)(Ag + (size_t)64 * lda + (KO));                              \
    if (ACH == 4) {                                                                   \
      ra2 = *(const uint4*)(Ag + (size_t)128 * lda + (KO));                           \
      ra3 = *(const uint4*)(Ag + (size_t)192 * lda + (KO));                           \
    }                                                                                 \
    rb0 = *(const uint4*)(Bg + (KO));                                                 \
    rb1 = *(const uint4*)(Bg + (size_t)64 * ldb + (KO));                              \
  } while (0)
#define SSTORE(NB)                                                                    \
  do {                                                                                \
    u16* dA = sA + ((NB) * BM + crow) * LDS_S + ckc * 8;                              \
    u16* dB = sB + ((NB) * BN + crow) * LDS_S + ckc * 8;                              \
    *(uint4*)(dA) = ra0;                                                              \
    *(uint4*)(dA + 64 * LDS_S) = ra1;                                                 \
    if (ACH == 4) {                                                                   \
      *(uint4*)(dA + 128 * LDS_S) = ra2;                                              \
      *(uint4*)(dA + 192 * LDS_S) = ra3;                                              \
    }                                                                                 \
    *(uint4*)(dB) = rb0;                                                              \
    *(uint4*)(dB + 64 * LDS_S) = rb1;                                                 \
  } while (0)
  GLOAD(0);
  SSTORE(0);
  __syncthreads();
#pragma unroll 1
  for (int kt = 0; kt < nk; ++kt) {
    const int buf = kt & 1;
    if (kt + 1 < nk) GLOAD((kt + 1) * 64);
    const u16* cA = sA + (buf * BM + wm * 16 * WMT + fr) * LDS_S + fq * 8;
    const u16* cB = sB + (buf * BN + wn * 16 * WNT + fr) * LDS_S + fq * 8;
#pragma unroll
    for (int ks = 0; ks < 2; ++ks) {
      bf16x8 af[WMT], bfr[WNT];
#pragma unroll
      for (int i = 0; i < WMT; ++i) af[i] = *(const bf16x8*)(cA + i * 16 * LDS_S + ks * 32);
#pragma unroll
      for (int j = 0; j < WNT; ++j) bfr[j] = *(const bf16x8*)(cB + j * 16 * LDS_S + ks * 32);
#pragma unroll
      for (int i = 0; i < WMT; ++i)
#pragma unroll
        for (int j = 0; j < WNT; ++j)
          acc[i][j] = __builtin_amdgcn_mfma_f32_16x16x32_bf16(bfr[j], af[i], acc[i][j], 0, 0, 0);
    }
    if (kt + 1 < nk) SSTORE(buf ^ 1);
    __syncthreads();
  }
#undef GLOAD
#undef SSTORE
}

template <int WMT, int WNT>
DEVI void zero_acc(f32x4 (&acc)[WMT][WNT]) {
#pragma unroll
  for (int i = 0; i < WMT; ++i)
#pragma unroll
    for (int j = 0; j < WNT; ++j) acc[i][j] = f32x4{0.f, 0.f, 0.f, 0.f};
}

DEVI void phase_proj(const Params& p, int l, u16* smem) {
  const u16* xn = (const u16*)(p.ws + WS_XN);
  const u16* wt = (const u16*)(p.ws + WS_WT_IN) + (size_t)l * NPROJ_PAD * 1024;
  u16* proj = (u16*)(p.ws + WS_PROJ);
  float* small = (float*)(p.ws + WS_SMALL);
  const int tid_ = otid(); const int lane = tid_ & 63, w = tid_ >> 6, wm = w >> 1, wn = w & 1, fr = lane & 15, fq = lane >> 4;
  constexpr int NT = NPROJ_PAD / 128, MT = M / 256;
  for (int t = blockIdx.x; t < MT * NT; t += gridDim.x) {
    const int mt = t / NT, nt = t - mt * NT;
    const int m0 = mt * 256, n0 = nt * 128;
    f32x4 acc[4][4];
    zero_acc(acc);
    gemm_core<4, 4>(xn + (size_t)m0 * 1024, 1024, wt + (size_t)n0 * 1024, 1024, 1024, acc, smem);
#pragma unroll
    for (int i = 0; i < 4; ++i)
#pragma unroll
      for (int j = 0; j < 4; ++j) {
        const int m = m0 + wm * 64 + i * 16 + fr, n = n0 + wn * 64 + j * 16 + fq * 4;
        if (n < NPROJ) {
          uint2 o;
          o.x = pk2(acc[i][j][0], acc[i][j][1]);
          o.y = pk2(acc[i][j][2], acc[i][j][3]);
          *(uint2*)(proj + (size_t)m * NPROJ + n) = o;
        } else if (n < NPROJ + 16) {
          *(float4*)(small + (size_t)m * 16 + (n - NPROJ)) = float4{acc[i][j][0], acc[i][j][1], acc[i][j][2], acc[i][j][3]};
        }
      }
  }
}

DEVI void phase_up(const Params& p, int l, u16* smem) {
  const u16* xn = (const u16*)(p.ws + WS_XN);
  const u16* wt = (const u16*)(p.ws + WS_WT_UP) + (size_t)l * 4096 * 1024;
  u16* hid = (u16*)(p.ws + WS_PROJ);
  const int tid_ = otid(); const int lane = tid_ & 63, w = tid_ >> 6, wm = w >> 1, wn = w & 1, fr = lane & 15, fq = lane >> 4;
  constexpr int NT = DFF / 128, MT = M / 256;
  for (int t = blockIdx.x; t < MT * NT; t += gridDim.x) {
    const int mt = t / NT, nt = t - mt * NT;
    const int m0 = mt * 256, n0 = nt * 128;
    f32x4 acc[4][4];
    zero_acc(acc);
    gemm_core<4, 4>(xn + (size_t)m0 * 1024, 1024, wt + (size_t)n0 * 1024, 1024, 1024, acc, smem);
#pragma unroll
    for (int i = 0; i < 4; ++i)
#pragma unroll
      for (int j = 0; j < 4; ++j) {
        const int m = m0 + wm * 64 + i * 16 + fr, n = n0 + wn * 64 + j * 16 + fq * 4;
        float r0 = fmaxf(acc[i][j][0], 0.f), r1 = fmaxf(acc[i][j][1], 0.f), r2 = fmaxf(acc[i][j][2], 0.f), r3 = fmaxf(acc[i][j][3], 0.f);
        uint2 o;
        o.x = pk2(r0 * r0, r1 * r1);
        o.y = pk2(r2 * r2, r3 * r3);
        *(uint2*)(hid + (size_t)m * DFF + n) = o;
      }
  }
}

DEVI void phase_merge(const Params& p, int l, u16* smem) {
  const u16* xn = (const u16*)(p.ws + WS_XN);
  const u16* y = (const u16*)(p.ws + WS_OBUF);
  const u16* wg = (const u16*)(p.ws + WS_WT_GATE) + (size_t)l * 3072 * 1024;
  const u16* wb = (const u16*)(p.ws + WS_WT_BR) + (size_t)l * 3 * 1024 * 512;
  u16* merged = (u16*)(p.ws + WS_CONV);
  const int tid_ = otid(); const int lane = tid_ & 63, w = tid_ >> 6, wm = w >> 1, wn = w & 1, fr = lane & 15, fq = lane >> 4;
  constexpr int NT = D / 128, MT = M / 128;
  for (int t = blockIdx.x; t < MT * NT; t += gridDim.x) {
    const int mt = t / NT, nt = t - mt * NT;
    const int m0 = mt * 128, n0 = nt * 128;
    f32x4 accM[2][4];
    zero_acc(accM);
#pragma unroll 1
    for (int b = 0; b < 3; ++b) {
      f32x4 accG[2][4], accB[2][4];
      zero_acc(accG);
      zero_acc(accB);
      gemm_core<2, 4>(xn + (size_t)m0 * 1024, 1024, wg + ((size_t)b * 1024 + n0) * 1024, 1024, 1024, accG, smem);
      gemm_core<2, 4>(y + (size_t)m0 * 1536 + b * 512, 1536, wb + ((size_t)b * 1024 + n0) * 512, 512, 512, accB, smem);
#pragma unroll
      for (int i = 0; i < 2; ++i)
#pragma unroll
        for (int j = 0; j < 4; ++j)
#pragma unroll
          for (int r = 0; r < 4; ++r) accM[i][j][r] += sigm(accG[i][j][r]) * accB[i][j][r];
    }
#pragma unroll
    for (int i = 0; i < 2; ++i)
#pragma unroll
      for (int j = 0; j < 4; ++j) {
        const int m = m0 + wm * 32 + i * 16 + fr, n = n0 + wn * 64 + j * 16 + fq * 4;
        uint2 o;
        o.x = pk2(accM[i][j][0], accM[i][j][1]);
        o.y = pk2(accM[i][j][2], accM[i][j][3]);
        *(uint2*)(merged + (size_t)m * D + n) = o;
      }
  }
}

DEVI void phase_resid(const u16* A, int K, const u16* wt, const float* xin_p, const float* xin_s, float* xout, u16* smem) {
  const int tid_ = otid(); const int lane = tid_ & 63, w = tid_ >> 6, wm = w >> 1, wn = w & 1, fr = lane & 15, fq = lane >> 4;
  constexpr int NT = D / 128, MT = M / 128;
  for (int t = blockIdx.x; t < MT * NT; t += gridDim.x) {
    const int mt = t / NT, nt = t - mt * NT;
    const int m0 = mt * 128, n0 = nt * 128;
    f32x4 acc[2][4];
    zero_acc(acc);
    gemm_core<2, 4>(A + (size_t)m0 * K, K, wt + (size_t)n0 * K, K, K, acc, smem);
#pragma unroll
    for (int i = 0; i < 2; ++i)
#pragma unroll
      for (int j = 0; j < 4; ++j) {
        const int m = m0 + wm * 32 + i * 16 + fr, n = n0 + wn * 64 + j * 16 + fq * 4;
        const float* xr = (m < MP) ? xin_p + (size_t)m * D : xin_s + (size_t)(m - MP) * D;
        const float4 xv = *(const float4*)(xr + n);
        float4 o;
        o.x = xv.x + acc[i][j][0]; o.y = xv.y + acc[i][j][1]; o.z = xv.z + acc[i][j][2]; o.w = xv.w + acc[i][j][3];
        *(float4*)(xout + (size_t)m * D + n) = o;
      }
  }
}

DEVI void phase_prep(const Params& p, int l) {
  const int tid_ = otid(); const int lane = tid_ & 63, gw = blockIdx.x * 8 + (tid_ >> 6), nw = gridDim.x * 8;
  u16* proj = (u16*)(p.ws + WS_PROJ);
  u16* conv = (u16*)(p.ws + WS_CONV);
  const float* small = (const float*)(p.ws + WS_SMALL);
  float* gates = (float*)(p.ws + WS_GATES);
  constexpr int NTASK = (M / 4) * 21;
  for (int task = gw; task < NTASK; task += nw) {
    const int tg = task / 21, k = task - tg * 21;
    const int m0 = tg * 4;
    const bool samp = m0 >= MP;
    int b, t0;
    if (!samp) { b = m0 >> 11; t0 = m0 & 2047; } else { b = (m0 - MP) >> 2; t0 = 0; }
    if (k < 12) {
      const int pp = k >> 2, hh = k & 3;
      const int ch = pp * 512 + hh * 128 + lane * 2;
      const u16* src = proj + 2048 + ch;
      float rx[7], ry[7];
#pragma unroll
      for (int j = 0; j < 7; ++j) {
        const int t = t0 - 3 + j;
        if (t >= 0) {
          const unsigned u = *(const unsigned*)(src + (size_t)(m0 - 3 + j) * NPROJ);
          rx[j] = bflo(u); ry[j] = bfhi(u);
        } else if (samp) {
          const float2 cs = *(const float2*)(p.st_gconv + ((size_t)(l * 128 + b) * 3 + j) * 1536 + ch);
          rx[j] = cs.x; ry[j] = cs.y;
        } else { rx[j] = 0.f; ry[j] = 0.f; }
      }
      float cwx[4], cwy[4];
#pragma unroll
      for (int j = 0; j < 4; ++j) {
        const float2 c2 = *(const float2*)(p.gd_conv_w + (size_t)(l * 4 + j) * 1536 + ch);
        cwx[j] = c2.x; cwy[j] = c2.y;
      }
#pragma unroll
      for (int tt = 0; tt < 4; ++tt) {
        float ax = 0.f, ay = 0.f;
#pragma unroll
        for (int j = 0; j < 4; ++j) { ax += cwx[j] * rx[tt + j]; ay += cwy[j] * ry[tt + j]; }
        ax = silu(ax); ay = silu(ay);
        if (pp < 2) {
          float ss = wave_sum(ax * ax + ay * ay);
          float sc = rsqrtf(ss + 1e-6f);
          if (pp == 0) sc *= 0.08838834764831845f;
          ax *= sc; ay *= sc;
        }
        *(unsigned*)(conv + (size_t)(m0 + tt) * 1536 + ch) = pk2(ax, ay);
      }
      const bool last = samp || (t0 == 2044);
      if (last) {
        float* co = p.out + (samp ? OFF_S_GC + (size_t)(l * 128 + b) * 3 * 1536 : OFF_P_GC + (size_t)(l * 8 + b) * 3 * 1536) + ch;
#pragma unroll
        for (int j = 0; j < 3; ++j) *(float2*)(co + j * 1536) = float2{rx[4 + j], ry[4 + j]};
      }
    } else if (k < 20) {
      const int kk = k - 12, part = kk >> 2, hh = kk & 3;
      const int wch = hh * 128 + lane * 2;
      u16* col = proj + 4096 + part * 512 + wch;
      float lb0 = 0.f, lb1 = 0.f;
      if (part == 1 && l == 1) {
        lb0 = sigm(p.hg_lb_logits[512 + wch] - p.hg_lb_logits[wch]);
        lb1 = sigm(p.hg_lb_logits[512 + wch + 1] - p.hg_lb_logits[wch + 1]);
      }
      unsigned u[4];
#pragma unroll
      for (int tt = 0; tt < 4; ++tt) u[tt] = *(const unsigned*)(col + (size_t)(m0 + tt) * NPROJ);
#pragma unroll
      for (int tt = 0; tt < 4; ++tt) {
        float a = bflo(u[tt]), c = bfhi(u[tt]);
        if (part == 0) { a = silu(a); c = silu(c); }
        else { a = (1.f - lb0) * sigm(-a); c = (1.f - lb1) * sigm(-c); }
        *(unsigned*)(col + (size_t)(m0 + tt) * NPROJ) = pk2(a, c);
      }
    } else {
      const int tt = lane >> 4, g = lane & 15, hh = g & 3;
      const float v = small[(size_t)(m0 + tt) * 16 + g];
      float r;
      if (g < 4) r = v + p.ml_i_bias[l * 4 + hh];
      else if (g < 8) { const float x = v + p.ml_f_bias[l * 4 + hh]; r = -softplus(-x); }
      else if (g < 12) r = sigm(v);
      else { const float x = v + p.gd_dt_bias[l * 4 + hh]; r = __expf(-__expf(p.gd_A_log[l * 4 + hh]) * softplus(x)); }
      gates[(size_t)(m0 + tt) * 16 + g] = r;
    }
  }
}

template <int KIND>
DEVI void scan_unit(const Params& p, int l, bool samp, int b, int h, int colbase, float* smem) {
  constexpr int CPL = (KIND == 1) ? 1 : 2;
  constexpr int UC = 32 * CPL;
  constexpr int VCH = UC / 8;
  const int tid = otid(), lane = tid & 63, w = tid >> 6, kg = lane & 15, cl = lane >> 4;
  const int T = samp ? 4 : 2048;
  const int rowbase = samp ? (MP + b * 4) : b * 2048;
  const int NB = samp ? 128 : 8;
  const u16* proj = (const u16*)(p.ws + WS_PROJ);
  const u16* conv = (const u16*)(p.ws + WS_CONV);
  u16* obuf = (u16*)(p.ws + WS_OBUF);
  const float* gates = (const float*)(p.ws + WS_GATES);
  float* dm = (float*)(p.ws + WS_DM);
  const u16 *qsrc, *ksrc, *vsrc;
  int ld, ocol;
  const float* Sin;
  float* Sout;
  const size_t sidx_in = ((size_t)(l * 128 + b) * 4 + h) * 16384;
  const size_t sidx_out = ((size_t)(l * NB + b) * 4 + h) * 16384;
  if (KIND == 0) {
    qsrc = proj + h * 128; ksrc = proj + 512 + h * 128; vsrc = proj + 1024 + h * 128 + colbase; ld = NPROJ; ocol = 0;
    Sin = p.st_mC + sidx_in; Sout = p.out + (samp ? OFF_S_MC : OFF_P_MC) + sidx_out;
  } else if (KIND == 1) {
    qsrc = conv + h * 128; ksrc = conv + 512 + h * 128; vsrc = conv + 1024 + h * 128 + colbase; ld = 1536; ocol = 512;
    Sin = p.st_gS + sidx_in; Sout = p.out + (samp ? OFF_S_GS : OFF_P_GS) + sidx_out;
  } else {
    qsrc = proj + 4096 + h * 128; ksrc = proj + 4608 + h * 128; vsrc = proj + 5120 + h * 128 + colbase; ld = NPROJ; ocol = 1024;
    Sin = p.st_hS + sidx_in; Sout = p.out + (samp ? OFF_S_HS : OFF_P_HS) + sidx_out;
  }
  float* qk = smem;
  float* vl = smem + 2 * 32 * 256;
  float* gl = vl + 2 * 32 * 64;

  const int wc = w * 4 * CPL + cl * CPL;
  const int col0 = colbase + wc;
  v2f S[CPL][4];
  v2f nv[4];
#pragma unroll
  for (int c = 0; c < CPL; ++c)
#pragma unroll
    for (int i = 0; i < 4; ++i) {
      if (samp) { S[c][i].x = Sin[(size_t)(kg * 8 + 2 * i) * 128 + col0 + c]; S[c][i].y = Sin[(size_t)(kg * 8 + 2 * i + 1) * 128 + col0 + c]; }
      else { S[c][i].x = 0.f; S[c][i].y = 0.f; }
    }
  float mstart = 0.f;
  if (KIND == 0) {
    const size_t nidx = ((size_t)(l * 128 + b) * 4 + h) * 128;
#pragma unroll
    for (int i = 0; i < 4; ++i) {
      if (samp) { nv[i].x = p.st_mn[nidx + kg * 8 + 2 * i]; nv[i].y = p.st_mn[nidx + kg * 8 + 2 * i + 1]; }
      else { nv[i].x = 0.f; nv[i].y = 0.f; }
    }
    if (samp) mstart = p.st_mm[(size_t)(l * 128 + b) * 4 + h];
  }

  uint4 rq, rk, rv;
  float g0 = 0.f, g1 = 0.f;
  const int sr = tid >> 4, sc = tid & 15;
  const int vr = tid / VCH, vc = tid % VCH;
  auto prefetch = [&](int j) {
    const int t = j * 32 + sr;
    rq = uint4{0, 0, 0, 0}; rk = uint4{0, 0, 0, 0}; rv = uint4{0, 0, 0, 0};
    if (t < T) {
      rq = *(const uint4*)(qsrc + (size_t)(rowbase + t) * ld + sc * 8);
      rk = *(const uint4*)(ksrc + (size_t)(rowbase + t) * ld + sc * 8);
    }
    if (tid < 32 * VCH) {
      const int tv = j * 32 + vr;
      if (tv < T) rv = *(const uint4*)(vsrc + (size_t)(rowbase + tv) * ld + vc * 8);
    }
    if (KIND != 2) {
      g0 = (KIND == 0) ? -1e30f : 0.f; g1 = 0.f;
      if (tid < 32) {
        const int tg = j * 32 + tid;
        if (tg < T) {
          if (KIND == 0) { g0 = gates[(size_t)(rowbase + tg) * 16 + h]; g1 = gates[(size_t)(rowbase + tg) * 16 + 4 + h]; }
          else { g0 = gates[(size_t)(rowbase + tg) * 16 + 8 + h]; g1 = gates[(size_t)(rowbase + tg) * 16 + 12 + h]; }
        }
      }
    }
  };
  auto stage = [&](int j, int buf) {
    float* qd = qk + (buf * 32 + sr) * 256 + sc * 8;
    *(float4*)(qd) = float4{bflo(rq.x), bfhi(rq.x), bflo(rq.y), bfhi(rq.y)};
    *(float4*)(qd + 4) = float4{bflo(rq.z), bfhi(rq.z), bflo(rq.w), bfhi(rq.w)};
    *(float4*)(qd + 128) = float4{bflo(rk.x), bfhi(rk.x), bflo(rk.y), bfhi(rk.y)};
    *(float4*)(qd + 132) = float4{bflo(rk.z), bfhi(rk.z), bflo(rk.w), bfhi(rk.w)};
    if (tid < 32 * VCH) {
      float* vd = vl + (buf * 32 + vr) * 64 + vc * 8;
      *(float4*)(vd) = float4{bflo(rv.x), bfhi(rv.x), bflo(rv.y), bfhi(rv.y)};
      *(float4*)(vd + 4) = float4{bflo(rv.z), bfhi(rv.z), bflo(rv.w), bfhi(rv.w)};
    }
    if (KIND == 0) {
      if (w == 0) {
        float bs = g1;
#pragma unroll
        for (int d = 1; d < 32; d <<= 1) { const float o = __shfl_up(bs, d); if (lane >= d) bs += o; }
        float R = g0 - bs;
#pragma unroll
        for (int d = 1; d < 32; d <<= 1) { const float o = __shfl_up(R, d); if (lane >= d) R = fmaxf(R, o); }
        const float mt = bs + fmaxf(mstart, R);
        float mprev = __shfl_up(mt, 1);
        if (lane == 0) mprev = mstart;
        const float fw = __expf(g1 + mprev - mt);
        const float iw = __expf(g0 - mt) * 0.08838834764831845f;
        if (lane < 32) {
          float* gd = gl + (buf * 32 + lane) * 4;
          gd[0] = fw; gd[1] = iw; gd[2] = mt;
        }
        int lastv = T - j * 32 - 1;
        if (lastv > 31) lastv = 31;
        mstart = __shfl(mt, lastv);
      }
    } else if (KIND == 1) {
      if (tid < 32) {
        float* gd = gl + (buf * 32 + tid) * 4;
        gd[0] = g0; gd[1] = g1;
      }
    }
  };

  const int nblk = (T + 31) >> 5;
  prefetch(0);
  stage(0, 0);
  __syncthreads();
  for (int j = 0; j < nblk; ++j) {
    const int buf = j & 1;
    if (j + 1 < nblk) prefetch(j + 1);
    int steps = T - j * 32;
    if (steps > 32) steps = 32;
    for (int t = 0; t < steps; ++t) {
      const float* qp = qk + (buf * 32 + t) * 256 + kg * 8;
      const float4 qa = *(const float4*)(qp), qb = *(const float4*)(qp + 4);
      const float4 ka = *(const float4*)(qp + 128), kb = *(const float4*)(qp + 132);
      const v2f q2[4] = {v2f{qa.x, qa.y}, v2f{qa.z, qa.w}, v2f{qb.x, qb.y}, v2f{qb.z, qb.w}};
      const v2f k2[4] = {v2f{ka.x, ka.y}, v2f{ka.z, ka.w}, v2f{kb.x, kb.y}, v2f{kb.z, kb.w}};
      const float* vp = vl + (buf * 32 + t) * 64 + wc;
      const float* gp = gl + (buf * 32 + t) * 4;
      const size_t orow = (size_t)(rowbase + j * 32 + t);
      if (KIND == 0) {
        const float fw = gp[0], iw = gp[1];
        const v2f fw2 = v2f{fw, fw};
        const float2 vv = *(const float2*)vp;
        const float va[2] = {vv.x * iw, vv.y * iw};
        float num[2];
#pragma unroll
        for (int c = 0; c < 2; ++c) {
          const v2f vc2 = v2f{va[c], va[c]};
          v2f a = v2f{0.f, 0.f};
#pragma unroll
          for (int i = 0; i < 4; ++i) {
            S[c][i] = fw2 * S[c][i] + k2[i] * vc2;
            a += q2[i] * S[c][i];
          }
          num[c] = row16_sum(a.x + a.y);
        }
        const v2f iw2 = v2f{iw, iw};
        v2f a = v2f{0.f, 0.f};
#pragma unroll
        for (int i = 0; i < 4; ++i) {
          nv[i] = fw2 * nv[i] + k2[i] * iw2;
          a += q2[i] * nv[i];
        }
        const float den = row16_sum(a.x + a.y);
        if (kg == 0) *(unsigned*)(obuf + orow * 1536 + ocol + h * 128 + col0) = pk2(num[0], num[1]);
        if (colbase == 0 && tid == 0) { dm[orow * 8 + h] = den; dm[orow * 8 + 4 + h] = gp[2]; }
      } else if (KIND == 1) {
        const float beta = gp[0], g = gp[1];
        const float v = vp[0];
        v2f a = v2f{0.f, 0.f};
#pragma unroll
        for (int i = 0; i < 4; ++i) a += k2[i] * S[0][i];
        const float kS = row16_sum(a.x + a.y);
        const float vn = beta * (v - g * kS);
        const v2f g2 = v2f{g, g}, vn2 = v2f{vn, vn};
        v2f o2 = v2f{0.f, 0.f};
#pragma unroll
        for (int i = 0; i < 4; ++i) {
          S[0][i] = g2 * S[0][i] + k2[i] * vn2;
          o2 += q2[i] * S[0][i];
        }
        const float o = row16_sum(o2.x + o2.y);
        if (kg == 0) obuf[orow * 1536 + ocol + h * 128 + col0] = f2bf(o);
      } else {
        const float2 vv = *(const float2*)vp;
        const float va[2] = {vv.x, vv.y};
        float num[2];
#pragma unroll
        for (int c = 0; c < 2; ++c) {
          const v2f vc2 = v2f{va[c], va[c]};
          v2f a = v2f{0.f, 0.f};
#pragma unroll
          for (int i = 0; i < 4; ++i) {
            S[c][i] = S[c][i] + k2[i] * (vc2 - S[c][i]);
            a += q2[i] * S[c][i];
          }
          num[c] = row16_sum(a.x + a.y);
        }
        if (kg == 0) *(unsigned*)(obuf + orow * 1536 + ocol + h * 128 + col0) = pk2(num[0], num[1]);
      }
    }
    if (j + 1 < nblk) stage(j + 1, buf ^ 1);
    __syncthreads();
  }
#pragma unroll
  for (int c = 0; c < CPL; ++c)
#pragma unroll
    for (int i = 0; i < 4; ++i) {
      Sout[(size_t)(kg * 8 + 2 * i) * 128 + col0 + c] = S[c][i].x;
      Sout[(size_t)(kg * 8 + 2 * i + 1) * 128 + col0 + c] = S[c][i].y;
    }
  if (KIND == 0 && colbase == 0 && w == 0) {
    if (cl == 0) {
      float* no = p.out + (samp ? OFF_S_MN : OFF_P_MN) + ((size_t)(l * NB + b) * 4 + h) * 128 + kg * 8;
#pragma unroll
      for (int i = 0; i < 4; ++i) { no[2 * i] = nv[i].x; no[2 * i + 1] = nv[i].y; }
    }
    if (lane == 0) p.out[(samp ? OFF_S_MM : OFF_P_MM) + (size_t)(l * NB + b) * 4 + h] = mstart;
  }
  __syncthreads();
}

DEVI void phase_scan(const Params& p, int l, float* smem) {
  constexpr int NU = 256 + 4096;
  for (int u = blockIdx.x; u < NU; u += gridDim.x) {
    if (u < 128) {
      const int seq = u >> 2;
      scan_unit<1>(p, l, false, seq >> 2, seq & 3, (u & 3) * 32, smem);
    } else if (u < 192) {
      const int uu = u - 128, seq = uu >> 1;
      scan_unit<0>(p, l, false, seq >> 2, seq & 3, (uu & 1) * 64, smem);
    } else if (u < 256) {
      const int uu = u - 192, seq = uu >> 1;
      scan_unit<2>(p, l, false, seq >> 2, seq & 3, (uu & 1) * 64, smem);
    } else {
      const int s = u - 256, s4 = s & 3;
      if (s4 < 2) {
        const int idx = (s >> 2) * 2 + (s & 1), seq = idx >> 2;
        scan_unit<1>(p, l, true, seq >> 2, seq & 3, (idx & 3) * 32, smem);
      } else {
        const int idx = s >> 2, seq = idx >> 1;
        if (s4 == 2) scan_unit<0>(p, l, true, seq >> 2, seq & 3, (idx & 1) * 64, smem);
        else scan_unit<2>(p, l, true, seq >> 2, seq & 3, (idx & 1) * 64, smem);
      }
    }
  }
}

DEVI void phase_post(const Params& p, int l) {
  const int tid_ = otid(); const int lane = tid_ & 63, gw = blockIdx.x * 8 + (tid_ >> 6), nw = gridDim.x * 8;
  const u16* proj = (const u16*)(p.ws + WS_PROJ);
  u16* obuf = (u16*)(p.ws + WS_OBUF);
  const float* dm = (const float*)(p.ws + WS_DM);
  constexpr int NTASK = (M / 4) * 9;
  for (int task = gw; task < NTASK; task += nw) {
    const int tg = task / 9, k = task - tg * 9;
    const int m0 = tg * 4;
    if (k < 4) {
      const int hh = k, c = hh * 128 + lane * 2;
      const float2 nw2 = *(const float2*)(p.ml_norm_w + l * 512 + c);
#pragma unroll
      for (int tt = 0; tt < 4; ++tt) {
        const size_t m = m0 + tt;
        const unsigned u = *(const unsigned*)(obuf + m * 1536 + c);
        const unsigned og = *(const unsigned*)(proj + m * NPROJ + 1536 + c);
        const float den = dm[m * 8 + hh], mt = dm[m * 8 + 4 + hh];
        const float dd = fmaxf(fabsf(den), __expf(-mt));
        const float h0 = bflo(u) / dd, h1 = bfhi(u) / dd;
        const float ss = wave_sum(h0 * h0 + h1 * h1);
        const float sc = rsqrtf(ss * (1.f / 128.f) + 1e-6f);
        *(unsigned*)(obuf + m * 1536 + c) = pk2(h0 * sc * nw2.x * sigm(bflo(og)), h1 * sc * nw2.y * sigm(bfhi(og)));
      }
    } else if (k < 8) {
      const int hh = k - 4, cc = lane * 2, c = hh * 128 + cc;
      const float2 nw2 = *(const float2*)(p.gd_norm_w + l * 128 + cc);
#pragma unroll
      for (int tt = 0; tt < 4; ++tt) {
        const size_t m = m0 + tt;
        const unsigned u = *(const unsigned*)(obuf + m * 1536 + 512 + c);
        const unsigned z = *(const unsigned*)(proj + m * NPROJ + 3584 + c);
        const float o0 = bflo(u), o1 = bfhi(u);
        const float ss = wave_sum(o0 * o0 + o1 * o1);
        const float sc = rsqrtf(ss * (1.f / 128.f) + 1e-6f);
        *(unsigned*)(obuf + m * 1536 + 512 + c) = pk2(o0 * sc * nw2.x * silu(bflo(z)), o1 * sc * nw2.y * silu(bfhi(z)));
      }
    } else {
      const int c = lane * 8;
      const float4 wa = *(const float4*)(p.hg_norm_w + l * 512 + c), wb = *(const float4*)(p.hg_norm_w + l * 512 + c + 4);
#pragma unroll
      for (int tt = 0; tt < 4; ++tt) {
        const size_t m = m0 + tt;
        const uint4 ov = *(const uint4*)(obuf + m * 1536 + 1024 + c);
        const uint4 gv = *(const uint4*)(proj + m * NPROJ + 5632 + c);
        float o[8] = {bflo(ov.x), bfhi(ov.x), bflo(ov.y), bfhi(ov.y), bflo(ov.z), bfhi(ov.z), bflo(ov.w), bfhi(ov.w)};
        const float g[8] = {bflo(gv.x), bfhi(gv.x), bflo(gv.y), bfhi(gv.y), bflo(gv.z), bfhi(gv.z), bflo(gv.w), bfhi(gv.w)};
        const float wv[8] = {wa.x, wa.y, wa.z, wa.w, wb.x, wb.y, wb.z, wb.w};
        float ss = 0.f;
#pragma unroll
        for (int i = 0; i < 8; ++i) ss += o[i] * o[i];
        ss = wave_sum(ss);
        const float sc = rsqrtf(ss * (1.f / 512.f) + 1e-6f);
#pragma unroll
        for (int i = 0; i < 8; ++i) o[i] = o[i] * sc * wv[i] * silu(g[i]);
        uint4 r;
        r.x = pk2(o[0], o[1]); r.y = pk2(o[2], o[3]); r.z = pk2(o[4], o[5]); r.w = pk2(o[6], o[7]);
        *(uint4*)(obuf + m * 1536 + 1024 + c) = r;
      }
    }
  }
}

__global__ void __launch_bounds__(NTHREADS) mega_fwd(Params p) {
  extern __shared__ __attribute__((aligned(16))) unsigned char smem_raw[];
  cg::grid_group grid = cg::this_grid();
  float* smf = (float*)smem_raw;
  u16* smh = (u16*)smem_raw;
  u16* xn = (u16*)(p.ws + WS_XN);
  float* x = p.out;

  phase_wprep(p, smf);
  phase_norm(p.x_prompt, p.x_sample, p.norm1_w, xn);
  grid.sync();
#pragma unroll 1
  for (int l = 0; l < 2; ++l) {
    phase_proj(p, l, smh);
    grid.sync();
    phase_prep(p, l);
    grid.sync();
    phase_scan(p, l, smf);
    grid.sync();
    phase_post(p, l);
    grid.sync();
    phase_merge(p, l, smh);
    grid.sync();
    if (l == 0)
      phase_resid((const u16*)(p.ws + WS_CONV), 1024, (const u16*)(p.ws + WS_WT_OUT), p.x_prompt, p.x_sample, x, smh);
    else
      phase_resid((const u16*)(p.ws + WS_CONV), 1024, (const u16*)(p.ws + WS_WT_OUT) + (size_t)1024 * 1024, x, x + (size_t)MP * D, x, smh);
    grid.sync();
    phase_norm(x, x + (size_t)MP * D, p.norm2_w + l * D, xn);
    grid.sync();
    phase_up(p, l, smh);
    grid.sync();
    phase_resid((const u16*)(p.ws + WS_PROJ), 4096, (const u16*)(p.ws + WS_WT_DN) + (size_t)l * 1024 * 4096, x, x + (size_t)MP * D, x, smh);
    grid.sync();
    if (l == 0) {
      phase_norm(x, x + (size_t)MP * D, p.norm1_w + D, xn);
      grid.sync();
    }
  }
  phase_final_norm(x, p.final_norm_w);
}

extern "C" void kernel_launch(void* const* d_in, const int* in_sizes, int n_in, void* d_out, int out_size, void* d_ws,
                              size_t ws_size, hipStream_t stream) {
  static int grid_blocks = 0;
  if (!grid_blocks) {
    int dev = 0, cus = 0, per_cu = 0;
    hipGetDevice(&dev);
    hipDeviceGetAttribute(&cus, hipDeviceAttributeMultiprocessorCount, dev);
    hipFuncSetAttribute((const void*)mega_fwd, hipFuncAttributeMaxDynamicSharedMemorySize, LDS_BYTES);
    hipOccupancyMaxActiveBlocksPerMultiprocessor(&per_cu, (const void*)mega_fwd, NTHREADS, LDS_BYTES);
    if (per_cu < 1) { fprintf(stderr, "occupancy query returned %d\n", per_cu); per_cu = 1; }
    grid_blocks = cus;
    if (ws_size < WS_END) fprintf(stderr, "workspace too small: %zu < %zu\n", ws_size, (size_t)WS_END);
  }
  Params p{};
  p.x_prompt = (const float*)d_in[0]; p.x_sample = (const float*)d_in[1];
  p.st_mC = (const float*)d_in[2]; p.st_mn = (const float*)d_in[3]; p.st_mm = (const float*)d_in[4];
  p.st_gS = (const float*)d_in[5]; p.st_gconv = (const float*)d_in[6]; p.st_hS = (const float*)d_in[7];
  p.norm1_w = (const float*)d_in[8]; p.w_in = (const float*)d_in[9]; p.ml_i_bias = (const float*)d_in[10];
  p.ml_f_bias = (const float*)d_in[11]; p.ml_norm_w = (const float*)d_in[12]; p.gd_conv_w = (const float*)d_in[13];
  p.gd_A_log = (const float*)d_in[14]; p.gd_dt_bias = (const float*)d_in[15]; p.gd_norm_w = (const float*)d_in[16];
  p.hg_lb_logits = (const float*)d_in[17]; p.hg_norm_w = (const float*)d_in[18]; p.w_branch = (const float*)d_in[19];
  p.w_out = (const float*)d_in[20]; p.norm2_w = (const float*)d_in[21]; p.w_up = (const float*)d_in[22];
  p.w_down = (const float*)d_in[23]; p.final_norm_w = (const float*)d_in[24];
  p.out = (float*)d_out;
  p.ws = (unsigned char*)d_ws;
  void* args[] = {&p};
  hipError_t e = hipLaunchCooperativeKernel((const void*)mega_fwd, dim3(grid_blocks), dim3(NTHREADS), args, LDS_BYTES, stream);
  if (e != hipSuccess) fprintf(stderr, "cooperative launch failed: %s (grid %d)\n", hipGetErrorString(e), grid_blocks);
}
```

```cpp
#include <hip/hip_runtime.h>
#include <hip/hip_cooperative_groups.h>
#include <cstdio>
namespace cg = cooperative_groups;

typedef unsigned short u16;
using bf16x8 = __attribute__((ext_vector_type(8))) short;
using f32x4 = __attribute__((ext_vector_type(4))) float;
typedef float v2f __attribute__((ext_vector_type(2)));

#define DEVI __device__ __forceinline__

constexpr int D = 1024;
constexpr int MP = 16384, MS = 512, M = MP + MS;
constexpr int NPROJ = 6144, NPROJ_PAD = 6272;
constexpr int INC = 9232;
constexpr int DFF = 4096;
constexpr int NTHREADS = 512;
constexpr int LDS_BYTES = 112 * 1024;

constexpr size_t OFF_Y = 0;
constexpr size_t OFF_P_MC = (size_t)M * D;
constexpr size_t OFF_P_MN = OFF_P_MC + 2ull * 8 * 4 * 128 * 128;
constexpr size_t OFF_P_MM = OFF_P_MN + 2ull * 8 * 4 * 128;
constexpr size_t OFF_P_GS = OFF_P_MM + 2ull * 8 * 4;
constexpr size_t OFF_P_GC = OFF_P_GS + 2ull * 8 * 4 * 128 * 128;
constexpr size_t OFF_P_HS = OFF_P_GC + 2ull * 8 * 3 * 1536;
constexpr size_t OFF_S_MC = OFF_P_HS + 2ull * 8 * 4 * 128 * 128;
constexpr size_t OFF_S_MN = OFF_S_MC + 2ull * 128 * 4 * 128 * 128;
constexpr size_t OFF_S_MM = OFF_S_MN + 2ull * 128 * 4 * 128;
constexpr size_t OFF_S_GS = OFF_S_MM + 2ull * 128 * 4;
constexpr size_t OFF_S_GC = OFF_S_GS + 2ull * 128 * 4 * 128 * 128;
constexpr size_t OFF_S_HS = OFF_S_GC + 2ull * 128 * 3 * 1536;
static_assert(OFF_S_HS + 2ull * 128 * 4 * 128 * 128 == 72172608ull, "output size");

constexpr size_t WS_WT_IN = 0;
constexpr size_t WS_WT_GATE = WS_WT_IN + 2ull * NPROJ_PAD * 1024 * 2;
constexpr size_t WS_WT_BR = WS_WT_GATE + 2ull * 3072 * 1024 * 2;
constexpr size_t WS_WT_OUT = WS_WT_BR + 2ull * 3 * 1024 * 512 * 2;
constexpr size_t WS_WT_UP = WS_WT_OUT + 2ull * 1024 * 1024 * 2;
constexpr size_t WS_WT_DN = WS_WT_UP + 2ull * 4096 * 1024 * 2;
constexpr size_t WS_PROJ = WS_WT_DN + 2ull * 4096 * 1024 * 2;
constexpr size_t WS_CONV = WS_PROJ + (size_t)M * NPROJ * 2;
constexpr size_t WS_OBUF = WS_CONV + (size_t)M * 1536 * 2;
constexpr size_t WS_XN = WS_OBUF + (size_t)M * 1536 * 2;
constexpr size_t WS_SMALL = WS_XN + (size_t)M * 1024 * 2;
constexpr size_t WS_GATES = WS_SMALL + (size_t)M * 16 * 4;
constexpr size_t WS_DM = WS_GATES + (size_t)M * 16 * 4;
constexpr size_t WS_END = WS_DM + (size_t)M * 8 * 4;

struct Params {
  const float *x_prompt, *x_sample, *st_mC, *st_mn, *st_mm, *st_gS, *st_gconv, *st_hS;
  const float *norm1_w, *w_in, *ml_i_bias, *ml_f_bias, *ml_norm_w, *gd_conv_w, *gd_A_log, *gd_dt_bias,
      *gd_norm_w, *hg_lb_logits, *hg_norm_w, *w_branch, *w_out, *norm2_w, *w_up, *w_down, *final_norm_w;
  float* out;
  unsigned char* ws;
};

DEVI u16 f2bf(float f) { unsigned u = __float_as_uint(f); return (u16)((u + 0x7fffu + ((u >> 16) & 1u)) >> 16); }
DEVI unsigned pk2(float lo, float hi) { return (unsigned)f2bf(lo) | ((unsigned)f2bf(hi) << 16); }
DEVI float bflo(unsigned u) { return __uint_as_float(u << 16); }
DEVI float bfhi(unsigned u) { return __uint_as_float(u & 0xffff0000u); }
DEVI float sigm(float x) { return 1.f / (1.f + __expf(-x)); }
DEVI float silu(float x) { return x * sigm(x); }
DEVI float softplus(float x) { return fmaxf(x, 0.f) + log1pf(__expf(-fabsf(x))); }
DEVI int otid() { int t = threadIdx.x; asm volatile("" : "+v"(t)); return t; }
DEVI float wave_sum(float v) {
#pragma unroll
  for (int o = 32; o > 0; o >>= 1) v += __shfl_xor(v, o);
  return v;
}
template <int CTRL> DEVI float dpp_f(float v) {
  return __int_as_float(__builtin_amdgcn_update_dpp(0, __float_as_int(v), CTRL, 0xf, 0xf, false));
}
DEVI float row16_sum(float v) {
  v += dpp_f<0x128>(v);
  v += dpp_f<0x124>(v);
  v += dpp_f<0x122>(v);
  v += dpp_f<0x121>(v);
  return v;
}

DEVI void tr_seg(const float* __restrict__ src, int ld, int K, int ncols, u16* __restrict__ dst, float* tile, int& off) {
  const int G = gridDim.x;
  const int ntk = K >> 6, ntn = ncols >> 6, nt = ntk * ntn;
  const int start = (int)(((long)blockIdx.x + (long)G * 4096 - off) % G);
  const int tid_ = otid(); const int c = tid_ & 63, r0 = tid_ >> 6;
  for (int t = start; t < nt; t += G) {
    const int tk = t % ntk, tn = t / ntk;
    const int k0 = tk * 64, n0 = tn * 64;
#pragma unroll
    for (int i = 0; i < 8; ++i) {
      const int r = r0 + 8 * i;
      tile[r * 65 + c] = src[(size_t)(k0 + r) * ld + n0 + c];
    }
    __syncthreads();
#pragma unroll
    for (int i = 0; i < 8; ++i) {
      const int rr = r0 + 8 * i;
      dst[(size_t)(n0 + rr) * K + k0 + c] = f2bf(tile[c * 65 + rr]);
    }
    __syncthreads();
  }
  off += nt;
}

DEVI void phase_wprep(const Params& p, float* tile) {
  int off = 0;
  u16* wt_in = (u16*)(p.ws + WS_WT_IN);
  u16* wt_gate = (u16*)(p.ws + WS_WT_GATE);
  u16* wt_br = (u16*)(p.ws + WS_WT_BR);
  u16* wt_out = (u16*)(p.ws + WS_WT_OUT);
  u16* wt_up = (u16*)(p.ws + WS_WT_UP);
  u16* wt_dn = (u16*)(p.ws + WS_WT_DN);
  for (int l = 0; l < 2; ++l) {
    const float* win = p.w_in + (size_t)l * 1024 * INC;
    for (int s = 0; s < 12; ++s) {
      const int srccol = (s < 4) ? s * 512 : (s < 8 ? 2056 + (s - 4) * 512 : 4112 + (s - 8) * 512);
      tr_seg(win + srccol, INC, 1024, 512, wt_in + ((size_t)l * NPROJ_PAD + s * 512) * 1024, tile, off);
    }
    tr_seg(win + 6160, INC, 1024, 3072, wt_gate + (size_t)l * 3072 * 1024, tile, off);
    for (int b = 0; b < 3; ++b)
      tr_seg(p.w_branch + (size_t)(l * 3 + b) * 512 * 1024, 1024, 512, 1024, wt_br + (size_t)(l * 3 + b) * 1024 * 512, tile, off);
    tr_seg(p.w_out + (size_t)l * 1024 * 1024, 1024, 1024, 1024, wt_out + (size_t)l * 1024 * 1024, tile, off);
    tr_seg(p.w_up + (size_t)l * 1024 * 4096, 4096, 1024, 4096, wt_up + (size_t)l * 4096 * 1024, tile, off);
    tr_seg(p.w_down + (size_t)l * 4096 * 1024, 1024, 4096, 1024, wt_dn + (size_t)l * 1024 * 4096, tile, off);
  }
  for (int idx = blockIdx.x * NTHREADS + otid(); idx < 2 * 128 * 1024; idx += gridDim.x * NTHREADS) {
    const int l = idx >> 17, rem = idx & 131071, r = rem >> 10, k = rem & 1023;
    float v = 0.f;
    if (r < 16) {
      const int sc = (r < 8) ? 2048 + r : 4104 + (r - 8);
      v = p.w_in[(size_t)l * 1024 * INC + (size_t)k * INC + sc];
    }
    wt_in[((size_t)l * NPROJ_PAD + 6144 + r) * 1024 + k] = f2bf(v);
  }
}

DEVI void phase_norm(const float* xp, const float* xs, const float* __restrict__ w, u16* __restrict__ xn) {
  const int tid_ = otid(); const int lane = tid_ & 63, gw = blockIdx.x * 8 + (tid_ >> 6), nw = gridDim.x * 8;
  for (int m = gw; m < M; m += nw) {
    const float* xr = (m < MP) ? xp + (size_t)m * D : xs + (size_t)(m - MP) * D;
    float4 v[4];
    float ss = 0.f;
#pragma unroll
    for (int i = 0; i < 4; ++i) {
      v[i] = ((const float4*)xr)[lane + 64 * i];
      ss += v[i].x * v[i].x + v[i].y * v[i].y + v[i].z * v[i].z + v[i].w * v[i].w;
    }
    ss = wave_sum(ss);
    const float rstd = rsqrtf(ss * (1.f / 1024.f) + 1e-6f);
#pragma unroll
    for (int i = 0; i < 4; ++i) {
      const float4 wv = ((const float4*)w)[lane + 64 * i];
      uint2 o;
      o.x = pk2(v[i].x * rstd * wv.x, v[i].y * rstd * wv.y);
      o.y = pk2(v[i].z * rstd * wv.z, v[i].w * rstd * wv.w);
      ((uint2*)(xn + (size_t)m * D))[lane + 64 * i] = o;
    }
  }
}

DEVI void phase_final_norm(float* x, const float* __restrict__ w) {
  const int tid_ = otid(); const int lane = tid_ & 63, gw = blockIdx.x * 8 + (tid_ >> 6), nw = gridDim.x * 8;
  for (int m = gw; m < M; m += nw) {
    float* xr = x + (size_t)m * D;
    float4 v[4];
    float ss = 0.f;
#pragma unroll
    for (int i = 0; i < 4; ++i) {
      v[i] = ((const float4*)xr)[lane + 64 * i];
      ss += v[i].x * v[i].x + v[i].y * v[i].y + v[i].z * v[i].z + v[i].w * v[i].w;
    }
    ss = wave_sum(ss);
    const float rstd = rsqrtf(ss * (1.f / 1024.f) + 1e-6f);
#pragma unroll
    for (int i = 0; i < 4; ++i) {
      const float4 wv = ((const float4*)w)[lane + 64 * i];
      float4 o;
      o.x = v[i].x * rstd * wv.x; o.y = v[i].y * rstd * wv.y; o.z = v[i].z * rstd * wv.z; o.w = v[i].w * rstd * wv.w;
      ((float4*)xr)[lane + 64 * i] = o;
    }
  }
}

constexpr int LDS_S = 72;
template <int WMT, int WNT>
DEVI void gemm_core(const u16* __restrict__ A, int lda, const u16* __restrict__ B, int ldb, int K,
                    f32x4 (&acc)[WMT][WNT], u16* smem) {
  constexpr int BM = 64 * WMT, BN = 32 * WNT;
  constexpr int ACH = BM * 8 / NTHREADS, BCH = BN * 8 / NTHREADS;
  u16* sA = smem;
  u16* sB = smem + 2 * BM * LDS_S;
  const int tid = otid(), lane = tid & 63, w = tid >> 6, wm = w >> 1, wn = w & 1;
  const int fr = lane & 15, fq = lane >> 4;
  const int crow = tid >> 3, ckc = tid & 7;
  static_assert(BCH == 2 && (ACH == 2 || ACH == 4), "chunk counts");
  uint4 pa0, pa1, pa2, pa3, pb0, pb1, qa0, qa1, qa2, qa3, qb0, qb1;
  pa2 = uint4{0, 0, 0, 0}; pa3 = pa2; qa2 = pa2; qa3 = pa2;
  const u16* Ag = A + (size_t)crow * lda + ckc * 8;
  const u16* Bg = B + (size_t)crow * ldb + ckc * 8;
  const int nk = K >> 6;
#define GLOAD(S, KO)                                                                  \
  do {                                                                                \
    S##a0 = *(const uint4*)(Ag + (KO));                                               \
    S##a1 = *(const uint4*)(Ag + (size_t)64 * lda + (KO));                            \
    if (ACH == 4) {                                                                   \
      S##a2 = *(const uint4*)(Ag + (size_t)128 * lda + (KO));                         \
      S##a3 = *(const uint4*)(Ag + (size_t)192 * lda + (KO));                         \
    }                                                                                 \
    S##b0 = *(const uint4*)(Bg + (KO));                                               \
    S##b1 = *(const uint4*)(Bg + (size_t)64 * ldb + (KO));                            \
  } while (0)
#define SSTORE(S, NB)                                                                 \
  do {                                                                                \
    u16* dA = sA + ((NB) * BM + crow) * LDS_S + ckc * 8;                              \
    u16* dB = sB + ((NB) * BN + crow) * LDS_S + ckc * 8;                              \
    *(uint4*)(dA) = S##a0;                                                            \
    *(uint4*)(dA + 64 * LDS_S) = S##a1;                                               \
    if (ACH == 4) {                                                                   \
      *(uint4*)(dA + 128 * LDS_S) = S##a2;                                            \
      *(uint4*)(dA + 192 * LDS_S) = S##a3;                                            \
    }                                                                                 \
    *(uint4*)(dB) = S##b0;                                                            \
    *(uint4*)(dB + 64 * LDS_S) = S##b1;                                               \
  } while (0)
#define COMPUTE(BUF)                                                                  \
  do {                                                                                \
    const u16* cA = sA + ((BUF) * BM + wm * 16 * WMT + fr) * LDS_S + fq * 8;          \
    const u16* cB = sB + ((BUF) * BN + wn * 16 * WNT + fr) * LDS_S + fq * 8;          \
    bf16x8 af[2][WMT], bfr[2][WNT];                                                   \
    _Pragma("unroll") for (int ks = 0; ks < 2; ++ks) {                                \
      _Pragma("unroll") for (int i = 0; i < WMT; ++i) af[ks][i] = *(const bf16x8*)(cA + i * 16 * LDS_S + ks * 32);  \
      _Pragma("unroll") for (int j = 0; j < WNT; ++j) bfr[ks][j] = *(const bf16x8*)(cB + j * 16 * LDS_S + ks * 32); \
    }                                                                                 \
    __builtin_amdgcn_sched_barrier(0);                                                \
    _Pragma("unroll") for (int ks = 0; ks < 2; ++ks)                                  \
      _Pragma("unroll") for (int i = 0; i < WMT; ++i)                                 \
        _Pragma("unroll") for (int j = 0; j < WNT; ++j)                               \
          acc[i][j] = __builtin_amdgcn_mfma_f32_16x16x32_bf16(bfr[ks][j], af[ks][i], acc[i][j], 0, 0, 0);  \
    __builtin_amdgcn_sched_barrier(0);                                                \
  } while (0)
  GLOAD(p, 0);
  GLOAD(q, 64);
  SSTORE(p, 0);
  __syncthreads();
#pragma unroll 1
  for (int kt = 0; kt < nk; kt += 2) {
    const int k2 = (kt + 2 < nk) ? kt + 2 : nk - 1;
    GLOAD(p, k2 * 64);
    COMPUTE(0);
    SSTORE(q, 1);
    __syncthreads();
    const int k3 = (kt + 3 < nk) ? kt + 3 : nk - 1;
    GLOAD(q, k3 * 64);
    COMPUTE(1);
    SSTORE(p, 0);
    __syncthreads();
  }
#undef GLOAD
#undef SSTORE
#undef COMPUTE
}

DEVI bool tile_map(int it, int MT, int NT, int& mt, int& nt) {
  const int G = gridDim.x, per = G >> 3;
  const int t = it * G + (blockIdx.x & 7) * per + (blockIdx.x >> 3);
  if (t >= MT * NT) return false;
  constexpr int GM = 4;
  const int gsize = GM * NT;
  const int g = t / gsize, tl = t - g * gsize;
  int gsz = MT - g * GM;
  if (gsz > GM) gsz = GM;
  mt = g * GM + (tl % gsz);
  nt = tl / gsz;
  return true;
}

template <int WMT, int WNT>
DEVI void zero_acc(f32x4 (&acc)[WMT][WNT]) {
#pragma unroll
  for (int i = 0; i < WMT; ++i)
#pragma unroll
    for (int j = 0; j < WNT; ++j) acc[i][j] = f32x4{0.f, 0.f, 0.f, 0.f};
}

DEVI void phase_proj(const Params& p, int l, u16* smem) {
  const u16* xn = (const u16*)(p.ws + WS_XN);
  const u16* wt = (const u16*)(p.ws + WS_WT_IN) + (size_t)l * NPROJ_PAD * 1024;
  u16* proj = (u16*)(p.ws + WS_PROJ);
  float* small = (float*)(p.ws + WS_SMALL);
  const int tid_ = otid(); const int lane = tid_ & 63, w = tid_ >> 6, wm = w >> 1, wn = w & 1, fr = lane & 15, fq = lane >> 4;
  constexpr int NT = NPROJ_PAD / 128, MT = M / 256;
  for (int it = 0; it * (int)gridDim.x < MT * NT; ++it) {
    int mt, nt;
    if (!tile_map(it, MT, NT, mt, nt)) break;
    const int m0 = mt * 256, n0 = nt * 128;
    f32x4 acc[4][4];
    zero_acc(acc);
    gemm_core<4, 4>(xn + (size_t)m0 * 1024, 1024, wt + (size_t)n0 * 1024, 1024, 1024, acc, smem);
#pragma unroll
    for (int i = 0; i < 4; ++i)
#pragma unroll
      for (int j = 0; j < 4; ++j) {
        const int m = m0 + wm * 64 + i * 16 + fr, n = n0 + wn * 64 + j * 16 + fq * 4;
        if (n < NPROJ) {
          uint2 o;
          o.x = pk2(acc[i][j][0], acc[i][j][1]);
          o.y = pk2(acc[i][j][2], acc[i][j][3]);
          *(uint2*)(proj + (size_t)m * NPROJ + n) = o;
        } else if (n < NPROJ + 16) {
          *(float4*)(small + (size_t)m * 16 + (n - NPROJ)) = float4{acc[i][j][0], acc[i][j][1], acc[i][j][2], acc[i][j][3]};
        }
      }
  }
}

DEVI void phase_up(const Params& p, int l, u16* smem) {
  const u16* xn = (const u16*)(p.ws + WS_XN);
  const u16* wt = (const u16*)(p.ws + WS_WT_UP) + (size_t)l * 4096 * 1024;
  u16* hid = (u16*)(p.ws + WS_PROJ);
  const int tid_ = otid(); const int lane = tid_ & 63, w = tid_ >> 6, wm = w >> 1, wn = w & 1, fr = lane & 15, fq = lane >> 4;
  constexpr int NT = DFF / 128, MT = M / 256;
  for (int it = 0; it * (int)gridDim.x < MT * NT; ++it) {
    int mt, nt;
    if (!tile_map(it, MT, NT, mt, nt)) break;
    const int m0 = mt * 256, n0 = nt * 128;
    f32x4 acc[4][4];
    zero_acc(acc);
    gemm_core<4, 4>(xn + (size_t)m0 * 1024, 1024, wt + (size_t)n0 * 1024, 1024, 1024, acc, smem);
#pragma unroll
    for (int i = 0; i < 4; ++i)
#pragma unroll
      for (int j = 0; j < 4; ++j) {
        const int m = m0 + wm * 64 + i * 16 + fr, n = n0 + wn * 64 + j * 16 + fq * 4;
        float r0 = fmaxf(acc[i][j][0], 0.f), r1 = fmaxf(acc[i][j][1], 0.f), r2 = fmaxf(acc[i][j][2], 0.f), r3 = fmaxf(acc[i][j][3], 0.f);
        uint2 o;
        o.x = pk2(r0 * r0, r1 * r1);
        o.y = pk2(r2 * r2, r3 * r3);
        *(uint2*)(hid + (size_t)m * DFF + n) = o;
      }
  }
}

DEVI void phase_merge(const Params& p, int l, u16* smem) {
  const u16* xn = (const u16*)(p.ws + WS_XN);
  const u16* y = (const u16*)(p.ws + WS_OBUF);
  const u16* wg = (const u16*)(p.ws + WS_WT_GATE) + (size_t)l * 3072 * 1024;
  const u16* wb = (const u16*)(p.ws + WS_WT_BR) + (size_t)l * 3 * 1024 * 512;
  u16* merged = (u16*)(p.ws + WS_CONV);
  const int tid_ = otid(); const int lane = tid_ & 63, w = tid_ >> 6, wm = w >> 1, wn = w & 1, fr = lane & 15, fq = lane >> 4;
  constexpr int NT = D / 128, MT = M / 128;
  for (int it = 0; it * (int)gridDim.x < MT * NT; ++it) {
    int mt, nt;
    if (!tile_map(it, MT, NT, mt, nt)) break;
    const int m0 = mt * 128, n0 = nt * 128;
    f32x4 accM[2][4];
    zero_acc(accM);
#pragma unroll 1
    for (int b = 0; b < 3; ++b) {
      f32x4 accG[2][4], accB[2][4];
      zero_acc(accG);
      zero_acc(accB);
      gemm_core<2, 4>(xn + (size_t)m0 * 1024, 1024, wg + ((size_t)b * 1024 + n0) * 1024, 1024, 1024, accG, smem);
      gemm_core<2, 4>(y + (size_t)m0 * 1536 + b * 512, 1536, wb + ((size_t)b * 1024 + n0) * 512, 512, 512, accB, smem);
#pragma unroll
      for (int i = 0; i < 2; ++i)
#pragma unroll
        for (int j = 0; j < 4; ++j)
#pragma unroll
          for (int r = 0; r < 4; ++r) accM[i][j][r] += sigm(accG[i][j][r]) * accB[i][j][r];
    }
#pragma unroll
    for (int i = 0; i < 2; ++i)
#pragma unroll
      for (int j = 0; j < 4; ++j) {
        const int m = m0 + wm * 32 + i * 16 + fr, n = n0 + wn * 64 + j * 16 + fq * 4;
        uint2 o;
        o.x = pk2(accM[i][j][0], accM[i][j][1]);
        o.y = pk2(accM[i][j][2], accM[i][j][3]);
        *(uint2*)(merged + (size_t)m * D + n) = o;
      }
  }
}

DEVI void phase_resid(const u16* A, int K, const u16* wt, const float* xin_p, const float* xin_s, float* xout, u16* smem) {
  const int tid_ = otid(); const int lane = tid_ & 63, w = tid_ >> 6, wm = w >> 1, wn = w & 1, fr = lane & 15, fq = lane >> 4;
  constexpr int NT = D / 128, MT = M / 128;
  for (int it = 0; it * (int)gridDim.x < MT * NT; ++it) {
    int mt, nt;
    if (!tile_map(it, MT, NT, mt, nt)) break;
    const int m0 = mt * 128, n0 = nt * 128;
    f32x4 acc[2][4];
    zero_acc(acc);
    gemm_core<2, 4>(A + (size_t)m0 * K, K, wt + (size_t)n0 * K, K, K, acc, smem);
#pragma unroll
    for (int i = 0; i < 2; ++i)
#pragma unroll
      for (int j = 0; j < 4; ++j) {
        const int m = m0 + wm * 32 + i * 16 + fr, n = n0 + wn * 64 + j * 16 + fq * 4;
        const float* xr = (m < MP) ? xin_p + (size_t)m * D : xin_s + (size_t)(m - MP) * D;
        const float4 xv = *(const float4*)(xr + n);
        float4 o;
        o.x = xv.x + acc[i][j][0]; o.y = xv.y + acc[i][j][1]; o.z = xv.z + acc[i][j][2]; o.w = xv.w + acc[i][j][3];
        *(float4*)(xout + (size_t)m * D + n) = o;
      }
  }
}

DEVI void phase_prep(const Params& p, int l) {
  const int tid_ = otid(); const int lane = tid_ & 63, gw = blockIdx.x * 8 + (tid_ >> 6), nw = gridDim.x * 8;
  u16* proj = (u16*)(p.ws + WS_PROJ);
  u16* conv = (u16*)(p.ws + WS_CONV);
  const float* small = (const float*)(p.ws + WS_SMALL);
  float* gates = (float*)(p.ws + WS_GATES);
  constexpr int NTASK = (M / 4) * 21;
  for (int task = gw; task < NTASK; task += nw) {
    const int tg = task / 21, k = task - tg * 21;
    const int m0 = tg * 4;
    const bool samp = m0 >= MP;
    int b, t0;
    if (!samp) { b = m0 >> 11; t0 = m0 & 2047; } else { b = (m0 - MP) >> 2; t0 = 0; }
    if (k < 12) {
      const int pp = k >> 2, hh = k & 3;
      const int ch = pp * 512 + hh * 128 + lane * 2;
      const u16* src = proj + 2048 + ch;
      float rx[7], ry[7];
#pragma unroll
      for (int j = 0; j < 7; ++j) {
        const int t = t0 - 3 + j;
        if (t >= 0) {
          const unsigned u = *(const unsigned*)(src + (size_t)(m0 - 3 + j) * NPROJ);
          rx[j] = bflo(u); ry[j] = bfhi(u);
        } else if (samp) {
          const float2 cs = *(const float2*)(p.st_gconv + ((size_t)(l * 128 + b) * 3 + j) * 1536 + ch);
          rx[j] = cs.x; ry[j] = cs.y;
        } else { rx[j] = 0.f; ry[j] = 0.f; }
      }
      float cwx[4], cwy[4];
#pragma unroll
      for (int j = 0; j < 4; ++j) {
        const float2 c2 = *(const float2*)(p.gd_conv_w + (size_t)(l * 4 + j) * 1536 + ch);
        cwx[j] = c2.x; cwy[j] = c2.y;
      }
#pragma unroll
      for (int tt = 0; tt < 4; ++tt) {
        float ax = 0.f, ay = 0.f;
#pragma unroll
        for (int j = 0; j < 4; ++j) { ax += cwx[j] * rx[tt + j]; ay += cwy[j] * ry[tt + j]; }
        ax = silu(ax); ay = silu(ay);
        if (pp < 2) {
          float ss = wave_sum(ax * ax + ay * ay);
          float sc = rsqrtf(ss + 1e-6f);
          if (pp == 0) sc *= 0.08838834764831845f;
          ax *= sc; ay *= sc;
        }
        *(unsigned*)(conv + (size_t)(m0 + tt) * 1536 + ch) = pk2(ax, ay);
      }
      const bool last = samp || (t0 == 2044);
      if (last) {
        float* co = p.out + (samp ? OFF_S_GC + (size_t)(l * 128 + b) * 3 * 1536 : OFF_P_GC + (size_t)(l * 8 + b) * 3 * 1536) + ch;
#pragma unroll
        for (int j = 0; j < 3; ++j) *(float2*)(co + j * 1536) = float2{rx[4 + j], ry[4 + j]};
      }
    } else if (k < 20) {
      const int kk = k - 12, part = kk >> 2, hh = kk & 3;
      const int wch = hh * 128 + lane * 2;
      u16* col = proj + 4096 + part * 512 + wch;
      float lb0 = 0.f, lb1 = 0.f;
      if (part == 1 && l == 1) {
        lb0 = sigm(p.hg_lb_logits[512 + wch] - p.hg_lb_logits[wch]);
        lb1 = sigm(p.hg_lb_logits[512 + wch + 1] - p.hg_lb_logits[wch + 1]);
      }
      unsigned u[4];
#pragma unroll
      for (int tt = 0; tt < 4; ++tt) u[tt] = *(const unsigned*)(col + (size_t)(m0 + tt) * NPROJ);
#pragma unroll
      for (int tt = 0; tt < 4; ++tt) {
        float a = bflo(u[tt]), c = bfhi(u[tt]);
        if (part == 0) { a = silu(a); c = silu(c); }
        else { a = (1.f - lb0) * sigm(-a); c = (1.f - lb1) * sigm(-c); }
        *(unsigned*)(col + (size_t)(m0 + tt) * NPROJ) = pk2(a, c);
      }
    } else {
      const int tt = lane >> 4, g = lane & 15, hh = g & 3;
      const float v = small[(size_t)(m0 + tt) * 16 + g];
      float r;
      if (g < 4) r = v + p.ml_i_bias[l * 4 + hh];
      else if (g < 8) { const float x = v + p.ml_f_bias[l * 4 + hh]; r = -softplus(-x); }
      else if (g < 12) r = sigm(v);
      else { const float x = v + p.gd_dt_bias[l * 4 + hh]; r = __expf(-__expf(p.gd_A_log[l * 4 + hh]) * softplus(x)); }
      gates[(size_t)(m0 + tt) * 16 + g] = r;
    }
  }
}

template <int KIND>
DEVI void scan_unit(const Params& p, int l, bool samp, int b, int h, int colbase, float* smem) {
  constexpr int CPL = (KIND == 1) ? 1 : 2;
  constexpr int UC = 32 * CPL;
  constexpr int VCH = UC / 8;
  const int tid = otid(), lane = tid & 63, w = tid >> 6, kg = lane & 15, cl = lane >> 4;
  const int T = samp ? 4 : 2048;
  const int rowbase = samp ? (MP + b * 4) : b * 2048;
  const int NB = samp ? 128 : 8;
  const u16* proj = (const u16*)(p.ws + WS_PROJ);
  const u16* conv = (const u16*)(p.ws + WS_CONV);
  u16* obuf = (u16*)(p.ws + WS_OBUF);
  const float* gates = (const float*)(p.ws + WS_GATES);
  float* dm = (float*)(p.ws + WS_DM);
  const u16 *qsrc, *ksrc, *vsrc;
  int ld, ocol;
  const float* Sin;
  float* Sout;
  const size_t sidx_in = ((size_t)(l * 128 + b) * 4 + h) * 16384;
  const size_t sidx_out = ((size_t)(l * NB + b) * 4 + h) * 16384;
  if (KIND == 0) {
    qsrc = proj + h * 128; ksrc = proj + 512 + h * 128; vsrc = proj + 1024 + h * 128 + colbase; ld = NPROJ; ocol = 0;
    Sin = p.st_mC + sidx_in; Sout = p.out + (samp ? OFF_S_MC : OFF_P_MC) + sidx_out;
  } else if (KIND == 1) {
    qsrc = conv + h * 128; ksrc = conv + 512 + h * 128; vsrc = conv + 1024 + h * 128 + colbase; ld = 1536; ocol = 512;
    Sin = p.st_gS + sidx_in; Sout = p.out + (samp ? OFF_S_GS : OFF_P_GS) + sidx_out;
  } else {
    qsrc = proj + 4096 + h * 128; ksrc = proj + 4608 + h * 128; vsrc = proj + 5120 + h * 128 + colbase; ld = NPROJ; ocol = 1024;
    Sin = p.st_hS + sidx_in; Sout = p.out + (samp ? OFF_S_HS : OFF_P_HS) + sidx_out;
  }
  float* qk = smem;
  float* vl = smem + 2 * 32 * 256;
  float* gl = vl + 2 * 32 * 64;

  const int wc = w * 4 * CPL + cl * CPL;
  const int col0 = colbase + wc;
  v2f S[CPL][4];
  v2f nv[4];
#pragma unroll
  for (int c = 0; c < CPL; ++c)
#pragma unroll
    for (int i = 0; i < 4; ++i) {
      if (samp) { S[c][i].x = Sin[(size_t)(kg * 8 + 2 * i) * 128 + col0 + c]; S[c][i].y = Sin[(size_t)(kg * 8 + 2 * i + 1) * 128 + col0 + c]; }
      else { S[c][i].x = 0.f; S[c][i].y = 0.f; }
    }
  float mstart = 0.f;
  if (KIND == 0) {
    const size_t nidx = ((size_t)(l * 128 + b) * 4 + h) * 128;
#pragma unroll
    for (int i = 0; i < 4; ++i) {
      if (samp) { nv[i].x = p.st_mn[nidx + kg * 8 + 2 * i]; nv[i].y = p.st_mn[nidx + kg * 8 + 2 * i + 1]; }
      else { nv[i].x = 0.f; nv[i].y = 0.f; }
    }
    if (samp) mstart = p.st_mm[(size_t)(l * 128 + b) * 4 + h];
  }

  uint4 rq, rk, rv;
  float g0 = 0.f, g1 = 0.f;
  const int sr = tid >> 4, sc = tid & 15;
  const int vr = tid / VCH, vc = tid % VCH;
  auto prefetch = [&](int j) {
    const int t = j * 32 + sr;
    rq = uint4{0, 0, 0, 0}; rk = uint4{0, 0, 0, 0}; rv = uint4{0, 0, 0, 0};
    if (t < T) {
      rq = *(const uint4*)(qsrc + (size_t)(rowbase + t) * ld + sc * 8);
      rk = *(const uint4*)(ksrc + (size_t)(rowbase + t) * ld + sc * 8);
    }
    if (tid < 32 * VCH) {
      const int tv = j * 32 + vr;
      if (tv < T) rv = *(const uint4*)(vsrc + (size_t)(rowbase + tv) * ld + vc * 8);
    }
    if (KIND != 2) {
      g0 = (KIND == 0) ? -1e30f : 0.f; g1 = 0.f;
      if (tid < 32) {
        const int tg = j * 32 + tid;
        if (tg < T) {
          if (KIND == 0) { g0 = gates[(size_t)(rowbase + tg) * 16 + h]; g1 = gates[(size_t)(rowbase + tg) * 16 + 4 + h]; }
          else { g0 = gates[(size_t)(rowbase + tg) * 16 + 8 + h]; g1 = gates[(size_t)(rowbase + tg) * 16 + 12 + h]; }
        }
      }
    }
  };
  auto stage = [&](int j, int buf) {
    float* qd = qk + (buf * 32 + sr) * 256 + sc * 8;
    *(float4*)(qd) = float4{bflo(rq.x), bfhi(rq.x), bflo(rq.y), bfhi(rq.y)};
    *(float4*)(qd + 4) = float4{bflo(rq.z), bfhi(rq.z), bflo(rq.w), bfhi(rq.w)};
    *(float4*)(qd + 128) = float4{bflo(rk.x), bfhi(rk.x), bflo(rk.y), bfhi(rk.y)};
    *(float4*)(qd + 132) = float4{bflo(rk.z), bfhi(rk.z), bflo(rk.w), bfhi(rk.w)};
    if (tid < 32 * VCH) {
      float* vd = vl + (buf * 32 + vr) * 64 + vc * 8;
      *(float4*)(vd) = float4{bflo(rv.x), bfhi(rv.x), bflo(rv.y), bfhi(rv.y)};
      *(float4*)(vd + 4) = float4{bflo(rv.z), bfhi(rv.z), bflo(rv.w), bfhi(rv.w)};
    }
    if (KIND == 0) {
      if (w == 0) {
        float bs = g1;
#pragma unroll
        for (int d = 1; d < 32; d <<= 1) { const float o = __shfl_up(bs, d); if (lane >= d) bs += o; }
        float R = g0 - bs;
#pragma unroll
        for (int d = 1; d < 32; d <<= 1) { const float o = __shfl_up(R, d); if (lane >= d) R = fmaxf(R, o); }
        const float mt = bs + fmaxf(mstart, R);
        float mprev = __shfl_up(mt, 1);
        if (lane == 0) mprev = mstart;
        const float fw = __expf(g1 + mprev - mt);
        const float iw = __expf(g0 - mt) * 0.08838834764831845f;
        if (lane < 32) {
          float* gd = gl + (buf * 32 + lane) * 4;
          gd[0] = fw; gd[1] = iw; gd[2] = mt;
        }
        int lastv = T - j * 32 - 1;
        if (lastv > 31) lastv = 31;
        mstart = __shfl(mt, lastv);
      }
    } else if (KIND == 1) {
      if (tid < 32) {
        float* gd = gl + (buf * 32 + tid) * 4;
        gd[0] = g0; gd[1] = g1;
      }
    }
  };

  const bool do_n = (KIND == 0) && (colbase == 0) && (w == 0);
  const int nblk = (T + 31) >> 5;
  prefetch(0);
  stage(0, 0);
  __syncthreads();
  for (int j = 0; j < nblk; ++j) {
    const int buf = j & 1;
    if (j + 1 < nblk) prefetch(j + 1);
    int steps = T - j * 32;
    if (steps > 32) steps = 32;
    u16* const obase = obuf + (size_t)(rowbase + j * 32) * 1536 + ocol + h * 128 + col0;
    float* const dmbase = dm + (size_t)(rowbase + j * 32) * 8 + h;
#pragma unroll 4
    for (int t = 0; t < steps; ++t) {
      const float* qp = qk + (buf * 32 + t) * 256 + kg * 8;
      const float4 qa = *(const float4*)(qp), qb = *(const float4*)(qp + 4);
      const float4 ka = *(const float4*)(qp + 128), kb = *(const float4*)(qp + 132);
      const v2f q2[4] = {v2f{qa.x, qa.y}, v2f{qa.z, qa.w}, v2f{qb.x, qb.y}, v2f{qb.z, qb.w}};
      const v2f k2[4] = {v2f{ka.x, ka.y}, v2f{ka.z, ka.w}, v2f{kb.x, kb.y}, v2f{kb.z, kb.w}};
      const float* vp = vl + (buf * 32 + t) * 64 + wc;
      const float* gp = gl + (buf * 32 + t) * 4;
      if (KIND == 0) {
        const float fw = gp[0], iw = gp[1];
        const v2f fw2 = v2f{fw, fw};
        const float2 vv = *(const float2*)vp;
        const float va[2] = {vv.x * iw, vv.y * iw};
        float num[2];
#pragma unroll
        for (int c = 0; c < 2; ++c) {
          const v2f vc2 = v2f{va[c], va[c]};
          v2f a = v2f{0.f, 0.f};
#pragma unroll
          for (int i = 0; i < 4; ++i) {
            S[c][i] = fw2 * S[c][i] + k2[i] * vc2;
            a += q2[i] * S[c][i];
          }
          num[c] = row16_sum(a.x + a.y);
        }
        if (kg == 0) *(unsigned*)(obase + t * 1536) = pk2(num[0], num[1]);
        if (do_n) {
          const v2f iw2 = v2f{iw, iw};
          v2f a = v2f{0.f, 0.f};
#pragma unroll
          for (int i = 0; i < 4; ++i) {
            nv[i] = fw2 * nv[i] + k2[i] * iw2;
            a += q2[i] * nv[i];
          }
          const float den = row16_sum(a.x + a.y);
          if (lane == 0) { dmbase[t * 8] = den; dmbase[t * 8 + 4] = gp[2]; }
        }
      } else if (KIND == 1) {
        const float beta = gp[0], g = gp[1];
        const float v = vp[0];
        v2f a = v2f{0.f, 0.f};
#pragma unroll
        for (int i = 0; i < 4; ++i) a += k2[i] * S[0][i];
        const float kS = row16_sum(a.x + a.y);
        const float vn = beta * (v - g * kS);
        const v2f g2 = v2f{g, g}, vn2 = v2f{vn, vn};
        v2f o2 = v2f{0.f, 0.f};
#pragma unroll
        for (int i = 0; i < 4; ++i) {
          S[0][i] = g2 * S[0][i] + k2[i] * vn2;
          o2 += q2[i] * S[0][i];
        }
        const float o = row16_sum(o2.x + o2.y);
        if (kg == 0) obase[t * 1536] = f2bf(o);
      } else {
        const float2 vv = *(const float2*)vp;
        const float va[2] = {vv.x, vv.y};
        float num[2];
#pragma unroll
        for (int c = 0; c < 2; ++c) {
          const v2f vc2 = v2f{va[c], va[c]};
          v2f a = v2f{0.f, 0.f};
#pragma unroll
          for (int i = 0; i < 4; ++i) {
            S[c][i] = S[c][i] + k2[i] * (vc2 - S[c][i]);
            a += q2[i] * S[c][i];
          }
          num[c] = row16_sum(a.x + a.y);
        }
        if (kg == 0) *(unsigned*)(obase + t * 1536) = pk2(num[0], num[1]);
      }
    }
    if (j + 1 < nblk) stage(j + 1, buf ^ 1);
    __syncthreads();
  }
#pragma unroll
  for (int c = 0; c < CPL; ++c)
#pragma unroll
    for (int i = 0; i < 4; ++i) {
      Sout[(size_t)(kg * 8 + 2 * i) * 128 + col0 + c] = S[c][i].x;
      Sout[(size_t)(kg * 8 + 2 * i + 1) * 128 + col0 + c] = S[c][i].y;
    }
  if (KIND == 0 && colbase == 0 && w == 0) {
    if (cl == 0) {
      float* no = p.out + (samp ? OFF_S_MN : OFF_P_MN) + ((size_t)(l * NB + b) * 4 + h) * 128 + kg * 8;
#pragma unroll
      for (int i = 0; i < 4; ++i) { no[2 * i] = nv[i].x; no[2 * i + 1] = nv[i].y; }
    }
    if (lane == 0) p.out[(samp ? OFF_S_MM : OFF_P_MM) + (size_t)(l * NB + b) * 4 + h] = mstart;
  }
  __syncthreads();
}

DEVI void phase_scan(const Params& p, int l, float* smem) {
  constexpr int NU = 256 + 4096;
  for (int u = blockIdx.x; u < NU; u += gridDim.x) {
    if (u < 128) {
      const int seq = u >> 2;
      scan_unit<1>(p, l, false, seq >> 2, seq & 3, (u & 3) * 32, smem);
    } else if (u < 192) {
      const int uu = u - 128, seq = uu >> 1;
      scan_unit<0>(p, l, false, seq >> 2, seq & 3, (uu & 1) * 64, smem);
    } else if (u < 256) {
      const int uu = u - 192, seq = uu >> 1;
      scan_unit<2>(p, l, false, seq >> 2, seq & 3, (uu & 1) * 64, smem);
    } else {
      const int s = u - 256, s4 = s & 3;
      if (s4 < 2) {
        const int idx = (s >> 2) * 2 + (s & 1), seq = idx >> 2;
        scan_unit<1>(p, l, true, seq >> 2, seq & 3, (idx & 3) * 32, smem);
      } else {
        const int idx = s >> 2, seq = idx >> 1;
        if (s4 == 2) scan_unit<0>(p, l, true, seq >> 2, seq & 3, (idx & 1) * 64, smem);
        else scan_unit<2>(p, l, true, seq >> 2, seq & 3, (idx & 1) * 64, smem);
      }
    }
  }
}

DEVI void phase_post(const Params& p, int l) {
  const int tid_ = otid(); const int lane = tid_ & 63, gw = blockIdx.x * 8 + (tid_ >> 6), nw = gridDim.x * 8;
  const u16* proj = (const u16*)(p.ws + WS_PROJ);
  u16* obuf = (u16*)(p.ws + WS_OBUF);
  const float* dm = (const float*)(p.ws + WS_DM);
  constexpr int NTASK = (M / 4) * 9;
  for (int task = gw; task < NTASK; task += nw) {
    const int tg = task / 9, k = task - tg * 9;
    const int m0 = tg * 4;
    if (k < 4) {
      const int hh = k, c = hh * 128 + lane * 2;
      const float2 nw2 = *(const float2*)(p.ml_norm_w + l * 512 + c);
#pragma unroll
      for (int tt = 0; tt < 4; ++tt) {
        const size_t m = m0 + tt;
        const unsigned u = *(const unsigned*)(obuf + m * 1536 + c);
        const unsigned og = *(const unsigned*)(proj + m * NPROJ + 1536 + c);
        const float den = dm[m * 8 + hh], mt = dm[m * 8 + 4 + hh];
        const float dd = fmaxf(fabsf(den), __expf(-mt));
        const float h0 = bflo(u) / dd, h1 = bfhi(u) / dd;
        const float ss = wave_sum(h0 * h0 + h1 * h1);
        const float sc = rsqrtf(ss * (1.f / 128.f) + 1e-6f);
        *(unsigned*)(obuf + m * 1536 + c) = pk2(h0 * sc * nw2.x * sigm(bflo(og)), h1 * sc * nw2.y * sigm(bfhi(og)));
      }
    } else if (k < 8) {
      const int hh = k - 4, cc = lane * 2, c = hh * 128 + cc;
      const float2 nw2 = *(const float2*)(p.gd_norm_w + l * 128 + cc);
#pragma unroll
      for (int tt = 0; tt < 4; ++tt) {
        const size_t m = m0 + tt;
        const unsigned u = *(const unsigned*)(obuf + m * 1536 + 512 + c);
        const unsigned z = *(const unsigned*)(proj + m * NPROJ + 3584 + c);
        const float o0 = bflo(u), o1 = bfhi(u);
        const float ss = wave_sum(o0 * o0 + o1 * o1);
        const float sc = rsqrtf(ss * (1.f / 128.f) + 1e-6f);
        *(unsigned*)(obuf + m * 1536 + 512 + c) = pk2(o0 * sc * nw2.x * silu(bflo(z)), o1 * sc * nw2.y * silu(bfhi(z)));
      }
    } else {
      const int c = lane * 8;
      const float4 wa = *(const float4*)(p.hg_norm_w + l * 512 + c), wb = *(const float4*)(p.hg_norm_w + l * 512 + c + 4);
#pragma unroll
      for (int tt = 0; tt < 4; ++tt) {
        const size_t m = m0 + tt;
        const uint4 ov = *(const uint4*)(obuf + m * 1536 + 1024 + c);
        const uint4 gv = *(const uint4*)(proj + m * NPROJ + 5632 + c);
        float o[8] = {bflo(ov.x), bfhi(ov.x), bflo(ov.y), bfhi(ov.y), bflo(ov.z), bfhi(ov.z), bflo(ov.w), bfhi(ov.w)};
        const float g[8] = {bflo(gv.x), bfhi(gv.x), bflo(gv.y), bfhi(gv.y), bflo(gv.z), bfhi(gv.z), bflo(gv.w), bfhi(gv.w)};
        const float wv[8] = {wa.x, wa.y, wa.z, wa.w, wb.x, wb.y, wb.z, wb.w};
        float ss = 0.f;
#pragma unroll
        for (int i = 0; i < 8; ++i) ss += o[i] * o[i];
        ss = wave_sum(ss);
        const float sc = rsqrtf(ss * (1.f / 512.f) + 1e-6f);
#pragma unroll
        for (int i = 0; i < 8; ++i) o[i] = o[i] * sc * wv[i] * silu(g[i]);
        uint4 r;
        r.x = pk2(o[0], o[1]); r.y = pk2(o[2], o[3]); r.z = pk2(o[4], o[5]); r.w = pk2(o[6], o[7]);
        *(uint4*)(obuf + m * 1536 + 1024 + c) = r;
      }
    }
  }
}

__global__ void __launch_bounds__(NTHREADS) mega_fwd(Params p) {
  extern __shared__ __attribute__((aligned(16))) unsigned char smem_raw[];
  cg::grid_group grid = cg::this_grid();
  float* smf = (float*)smem_raw;
  u16* smh = (u16*)smem_raw;
  u16* xn = (u16*)(p.ws + WS_XN);
  float* x = p.out;

  phase_wprep(p, smf);
  phase_norm(p.x_prompt, p.x_sample, p.norm1_w, xn);
  grid.sync();
#pragma unroll 1
  for (int l = 0; l < 2; ++l) {
    phase_proj(p, l, smh);
    grid.sync();
    phase_prep(p, l);
    grid.sync();
    phase_scan(p, l, smf);
    grid.sync();
    phase_post(p, l);
    grid.sync();
    phase_merge(p, l, smh);
    grid.sync();
    if (l == 0)
      phase_resid((const u16*)(p.ws + WS_CONV), 1024, (const u16*)(p.ws + WS_WT_OUT), p.x_prompt, p.x_sample, x, smh);
    else
      phase_resid((const u16*)(p.ws + WS_CONV), 1024, (const u16*)(p.ws + WS_WT_OUT) + (size_t)1024 * 1024, x, x + (size_t)MP * D, x, smh);
    grid.sync();
    phase_norm(x, x + (size_t)MP * D, p.norm2_w + l * D, xn);
    grid.sync();
    phase_up(p, l, smh);
    grid.sync();
    phase_resid((const u16*)(p.ws + WS_PROJ), 4096, (const u16*)(p.ws + WS_WT_DN) + (size_t)l * 1024 * 4096, x, x + (size_t)MP * D, x, smh);
    grid.sync();
    if (l == 0) {
      phase_norm(x, x + (size_t)MP * D, p.norm1_w + D, xn);
      grid.sync();
    }
  }
  phase_final_norm(x, p.final_norm_w);
}

extern "C" void kernel_launch(void* const* d_in, const int* in_sizes, int n_in, void* d_out, int out_size, void* d_ws,
                              size_t ws_size, hipStream_t stream) {
  static int grid_blocks = 0;
  if (!grid_blocks) {
    int dev = 0, cus = 0, per_cu = 0;
    hipGetDevice(&dev);
    hipDeviceGetAttribute(&cus, hipDeviceAttributeMultiprocessorCount, dev);
    hipFuncSetAttribute((const void*)mega_fwd, hipFuncAttributeMaxDynamicSharedMemorySize, LDS_BYTES);
    hipOccupancyMaxActiveBlocksPerMultiprocessor(&per_cu, (const void*)mega_fwd, NTHREADS, LDS_BYTES);
    if (per_cu < 1) { fprintf(stderr, "occupancy query returned %d\n", per_cu); per_cu = 1; }
    grid_blocks = cus;
    if (ws_size < WS_END) fprintf(stderr, "workspace too small: %zu < %zu\n", ws_size, (size_t)WS_END);
  }
  Params p{};
  p.x_prompt = (const float*)d_in[0]; p.x_sample = (const float*)d_in[1];
  p.st_mC = (const float*)d_in[2]; p.st_mn = (const float*)d_in[3]; p.st_mm = (const float*)d_in[4];
  p.st_gS = (const float*)d_in[5]; p.st_gconv = (const float*)d_in[6]; p.st_hS = (const float*)d_in[7];
  p.norm1_w = (const float*)d_in[8]; p.w_in = (const float*)d_in[9]; p.ml_i_bias = (const float*)d_in[10];
  p.ml_f_bias = (const float*)d_in[11]; p.ml_norm_w = (const float*)d_in[12]; p.gd_conv_w = (const float*)d_in[13];
  p.gd_A_log = (const float*)d_in[14]; p.gd_dt_bias = (const float*)d_in[15]; p.gd_norm_w = (const float*)d_in[16];
  p.hg_lb_logits = (const float*)d_in[17]; p.hg_norm_w = (const float*)d_in[18]; p.w_branch = (const float*)d_in[19];
  p.w_out = (const float*)d_in[20]; p.norm2_w = (const float*)d_in[21]; p.w_up = (const float*)d_in[22];
  p.w_down = (const float*)d_in[23]; p.final_norm_w = (const float*)d_in[24];
  p.out = (float*)d_out;
  p.ws = (unsigned char*)d_ws;
  void* args[] = {&p};
  hipError_t e = hipLaunchCooperativeKernel((const void*)mega_fwd, dim3(grid_blocks), dim3(NTHREADS), args, LDS_BYTES, stream);
  if (e != hipSuccess) fprintf(stderr, "cooperative launch failed: %s (grid %d)\n", hipGetErrorString(e), grid_blocks);
}
```

```cpp
#include <hip/hip_runtime.h>
#include <hip/hip_cooperative_groups.h>
#include <cstdio>
namespace cg = cooperative_groups;

typedef unsigned short u16;
using bf16x8 = __attribute__((ext_vector_type(8))) short;
using f32x4 = __attribute__((ext_vector_type(4))) float;
typedef float v2f __attribute__((ext_vector_type(2)));

#define DEVI __device__ __forceinline__

constexpr int D = 1024;
constexpr int MP = 16384, MS = 512, M = MP + MS;
constexpr int NPROJ = 6144, NPROJ_PAD = 6272;
constexpr int INC = 9232;
constexpr int DFF = 4096;
constexpr int NTHREADS = 512;
constexpr int LDS_BYTES = 112 * 1024;
constexpr int LDX = 1088, LDH = 4160, LDY = 1600, LDW1 = 1088, LDWB = 576, LDWD = 4160;

constexpr size_t OFF_Y = 0;
constexpr size_t OFF_P_MC = (size_t)M * D;
constexpr size_t OFF_P_MN = OFF_P_MC + 2ull * 8 * 4 * 128 * 128;
constexpr size_t OFF_P_MM = OFF_P_MN + 2ull * 8 * 4 * 128;
constexpr size_t OFF_P_GS = OFF_P_MM + 2ull * 8 * 4;
constexpr size_t OFF_P_GC = OFF_P_GS + 2ull * 8 * 4 * 128 * 128;
constexpr size_t OFF_P_HS = OFF_P_GC + 2ull * 8 * 3 * 1536;
constexpr size_t OFF_S_MC = OFF_P_HS + 2ull * 8 * 4 * 128 * 128;
constexpr size_t OFF_S_MN = OFF_S_MC + 2ull * 128 * 4 * 128 * 128;
constexpr size_t OFF_S_MM = OFF_S_MN + 2ull * 128 * 4 * 128;
constexpr size_t OFF_S_GS = OFF_S_MM + 2ull * 128 * 4;
constexpr size_t OFF_S_GC = OFF_S_GS + 2ull * 128 * 4 * 128 * 128;
constexpr size_t OFF_S_HS = OFF_S_GC + 2ull * 128 * 3 * 1536;
static_assert(OFF_S_HS + 2ull * 128 * 4 * 128 * 128 == 72172608ull, "output size");

constexpr size_t WS_WT_IN = 0;
constexpr size_t WS_WT_GATE = WS_WT_IN + 2ull * NPROJ_PAD * LDW1 * 2;
constexpr size_t WS_WT_BR = WS_WT_GATE + 2ull * 3072 * LDW1 * 2;
constexpr size_t WS_WT_OUT = WS_WT_BR + 2ull * 3 * 1024 * LDWB * 2;
constexpr size_t WS_WT_UP = WS_WT_OUT + 2ull * 1024 * LDW1 * 2;
constexpr size_t WS_WT_DN = WS_WT_UP + 2ull * 4096 * LDW1 * 2;
constexpr size_t WS_PROJ = WS_WT_DN + 2ull * 1024 * LDWD * 2;
constexpr size_t WS_CONV = WS_PROJ + (size_t)M * NPROJ * 2;
constexpr size_t WS_OBUF = WS_CONV + (size_t)M * 1536 * 2;
constexpr size_t WS_XN = WS_OBUF + (size_t)M * LDY * 2;
constexpr size_t WS_SMALL = WS_XN + (size_t)M * LDX * 2;
constexpr size_t WS_GATES = WS_SMALL;
constexpr size_t WS_DM = WS_GATES + (size_t)M * 16 * 4;
constexpr size_t WS_BAR = WS_DM + (size_t)M * 8 * 4;
constexpr size_t WS_BAR_BYTES = 16384;
constexpr size_t WS_END = WS_BAR + WS_BAR_BYTES;
static_assert(WS_END <= 439571584ull, "workspace budget");
static_assert((size_t)M * LDH * 2 <= (size_t)M * NPROJ * 2 && (size_t)M * LDX * 2 <= (size_t)M * 1536 * 2, "aliases fit");

struct Params {
  const float *x_prompt, *x_sample, *st_mC, *st_mn, *st_mm, *st_gS, *st_gconv, *st_hS;
  const float *norm1_w, *w_in, *ml_i_bias, *ml_f_bias, *ml_norm_w, *gd_conv_w, *gd_A_log, *gd_dt_bias,
      *gd_norm_w, *hg_lb_logits, *hg_norm_w, *w_branch, *w_out, *norm2_w, *w_up, *w_down, *final_norm_w;
  float* out;
  unsigned char* ws;
};

DEVI u16 f2bf(float f) { unsigned u = __float_as_uint(f); return (u16)((u + 0x7fffu + ((u >> 16) & 1u)) >> 16); }
DEVI unsigned pk2(float lo, float hi) { return (unsigned)f2bf(lo) | ((unsigned)f2bf(hi) << 16); }
DEVI float bflo(unsigned u) { return __uint_as_float(u << 16); }
DEVI float bfhi(unsigned u) { return __uint_as_float(u & 0xffff0000u); }
DEVI float sigm(float x) { return 1.f / (1.f + __expf(-x)); }
DEVI float silu(float x) { return x * sigm(x); }
DEVI float softplus(float x) { return fmaxf(x, 0.f) + log1pf(__expf(-fabsf(x))); }
DEVI int otid() { int t = threadIdx.x; asm volatile("" : "+v"(t)); return t; }
DEVI float wave_sum(float v) {
#pragma unroll
  for (int o = 32; o > 0; o >>= 1) v += __shfl_xor(v, o);
  return v;
}
template <int CTRL> DEVI float dpp_f(float v) {
  return __int_as_float(__builtin_amdgcn_update_dpp(0, __float_as_int(v), CTRL, 0xf, 0xf, false));
}
DEVI float row16_sum(float v) {
  v += dpp_f<0x128>(v);
  v += dpp_f<0x124>(v);
  v += dpp_f<0x122>(v);
  v += dpp_f<0x121>(v);
  return v;
}

DEVI void tr_seg(const float* __restrict__ src, int ld, int K, int ncols, u16* __restrict__ dst, int dld, float* tile, int& off) {
  const int G = gridDim.x;
  const int ntk = K >> 6, ntn = ncols >> 6, nt = ntk * ntn;
  const int start = (int)(((long)blockIdx.x + (long)G * 4096 - off) % G);
  const int tid_ = otid(); const int c = tid_ & 63, r0 = tid_ >> 6;
  for (int t = start; t < nt; t += G) {
    const int tk = t % ntk, tn = t / ntk;
    const int k0 = tk * 64, n0 = tn * 64;
#pragma unroll
    for (int i = 0; i < 8; ++i) {
      const int r = r0 + 8 * i;
      tile[r * 65 + c] = src[(size_t)(k0 + r) * ld + n0 + c];
    }
    __syncthreads();
#pragma unroll
    for (int i = 0; i < 8; ++i) {
      const int rr = r0 + 8 * i;
      dst[(size_t)(n0 + rr) * dld + k0 + c] = f2bf(tile[c * 65 + rr]);
    }
    __syncthreads();
  }
  off += nt;
}

DEVI void phase_wprep(const Params& p, float* tile) {
  int off = 0;
  u16* wt_in = (u16*)(p.ws + WS_WT_IN);
  u16* wt_gate = (u16*)(p.ws + WS_WT_GATE);
  u16* wt_br = (u16*)(p.ws + WS_WT_BR);
  u16* wt_out = (u16*)(p.ws + WS_WT_OUT);
  u16* wt_up = (u16*)(p.ws + WS_WT_UP);
  u16* wt_dn = (u16*)(p.ws + WS_WT_DN);
  for (int l = 0; l < 2; ++l) {
    const float* win = p.w_in + (size_t)l * 1024 * INC;
    for (int s = 0; s < 12; ++s) {
      const int srccol = (s < 4) ? s * 512 : (s < 8 ? 2056 + (s - 4) * 512 : 4112 + (s - 8) * 512);
      tr_seg(win + srccol, INC, 1024, 512, wt_in + ((size_t)l * NPROJ_PAD + s * 512) * LDW1, LDW1, tile, off);
    }
    tr_seg(win + 6160, INC, 1024, 3072, wt_gate + (size_t)l * 3072 * LDW1, LDW1, tile, off);
    for (int b = 0; b < 3; ++b)
      tr_seg(p.w_branch + (size_t)(l * 3 + b) * 512 * 1024, 1024, 512, 1024, wt_br + (size_t)(l * 3 + b) * 1024 * LDWB, LDWB, tile, off);
    tr_seg(p.w_out + (size_t)l * 1024 * 1024, 1024, 1024, 1024, wt_out + (size_t)l * 1024 * LDW1, LDW1, tile, off);
    tr_seg(p.w_up + (size_t)l * 1024 * 4096, 4096, 1024, 4096, wt_up + (size_t)l * 4096 * LDW1, LDW1, tile, off);
    tr_seg(p.w_down + (size_t)l * 4096 * 1024, 1024, 4096, 1024, wt_dn + (size_t)l * 1024 * LDWD, LDWD, tile, off);
  }
  for (int idx = blockIdx.x * NTHREADS + otid(); idx < 2 * 128 * 1024; idx += gridDim.x * NTHREADS) {
    const int l = idx >> 17, rem = idx & 131071, r = rem >> 10, k = rem & 1023;
    float v = 0.f;
    if (r < 16) {
      const int sc = (r < 8) ? 2048 + r : 4104 + (r - 8);
      v = p.w_in[(size_t)l * 1024 * INC + (size_t)k * INC + sc];
    }
    wt_in[((size_t)l * NPROJ_PAD + 6144 + r) * LDW1 + k] = f2bf(v);
  }
}

DEVI void phase_norm(const float* xp, const float* xs, const float* __restrict__ w, u16* __restrict__ xn) {
  const int tid_ = otid(); const int lane = tid_ & 63, gw = blockIdx.x * 8 + (tid_ >> 6), nw = gridDim.x * 8;
  for (int m = gw; m < M; m += nw) {
    const float* xr = (m < MP) ? xp + (size_t)m * D : xs + (size_t)(m - MP) * D;
    float4 v[4];
    float ss = 0.f;
#pragma unroll
    for (int i = 0; i < 4; ++i) {
      v[i] = ((const float4*)xr)[lane + 64 * i];
      ss += v[i].x * v[i].x + v[i].y * v[i].y + v[i].z * v[i].z + v[i].w * v[i].w;
    }
    ss = wave_sum(ss);
    const float rstd = rsqrtf(ss * (1.f / 1024.f) + 1e-6f);
#pragma unroll
    for (int i = 0; i < 4; ++i) {
      const float4 wv = ((const float4*)w)[lane + 64 * i];
      uint2 o;
      o.x = pk2(v[i].x * rstd * wv.x, v[i].y * rstd * wv.y);
      o.y = pk2(v[i].z * rstd * wv.z, v[i].w * rstd * wv.w);
      ((uint2*)(xn + (size_t)m * LDX))[lane + 64 * i] = o;
    }
  }
}

DEVI void phase_final_norm(float* x, const float* __restrict__ w) {
  const int tid_ = otid(); const int lane = tid_ & 63, gw = blockIdx.x * 8 + (tid_ >> 6), nw = gridDim.x * 8;
  for (int m = gw; m < M; m += nw) {
    float* xr = x + (size_t)m * D;
    float4 v[4];
    float ss = 0.f;
#pragma unroll
    for (int i = 0; i < 4; ++i) {
      v[i] = ((const float4*)xr)[lane + 64 * i];
      ss += v[i].x * v[i].x + v[i].y * v[i].y + v[i].z * v[i].z + v[i].w * v[i].w;
    }
    ss = wave_sum(ss);
    const float rstd = rsqrtf(ss * (1.f / 1024.f) + 1e-6f);
#pragma unroll
    for (int i = 0; i < 4; ++i) {
      const float4 wv = ((const float4*)w)[lane + 64 * i];
      float4 o;
      o.x = v[i].x * rstd * wv.x; o.y = v[i].y * rstd * wv.y; o.z = v[i].z * rstd * wv.z; o.w = v[i].w * rstd * wv.w;
      ((float4*)xr)[lane + 64 * i] = o;
    }
  }
}

constexpr int LDS_S = 64;
template <int WMT, int WNT>
DEVI void gemm_core(const u16* __restrict__ A, int lda, const u16* __restrict__ B, int ldb, int K,
                    f32x4 (&acc)[WMT][WNT], u16* smem) {
  constexpr int BM = 64 * WMT, BN = 32 * WNT;
  constexpr int ACH = BM * 8 / NTHREADS, BCH = BN * 8 / NTHREADS;
  u16* sA = smem;
  u16* sB = smem + 2 * BM * LDS_S;
  const int tid = otid(), lane = tid & 63, w = tid >> 6, wm = w >> 1, wn = w & 1;
  const int fr = lane & 15, fq = lane >> 4;
  const int crow = tid >> 3, ckc = tid & 7;
  const int wsw = (ckc ^ (crow & 7)) * 8;
  const int rsw0 = (fq ^ (fr & 7)) * 8;
  static_assert(BCH == 2 && (ACH == 2 || ACH == 4), "chunk counts");
  uint4 pa0, pa1, pa2, pa3, pb0, pb1, qa0, qa1, qa2, qa3, qb0, qb1;
  pa2 = uint4{0, 0, 0, 0}; pa3 = pa2; qa2 = pa2; qa3 = pa2;
  const u16* Ag = A + (size_t)crow * lda + ckc * 8;
  const u16* Bg = B + (size_t)crow * ldb + ckc * 8;
  const int nk = K >> 6;
#define GLOAD(S, KO)                                                                  \
  do {                                                                                \
    S##a0 = *(const uint4*)(Ag + (KO));                                               \
    S##a1 = *(const uint4*)(Ag + (size_t)64 * lda + (KO));                            \
    if (ACH == 4) {                                                                   \
      S##a2 = *(const uint4*)(Ag + (size_t)128 * lda + (KO));                         \
      S##a3 = *(const uint4*)(Ag + (size_t)192 * lda + (KO));                         \
    }                                                                                 \
    S##b0 = *(const uint4*)(Bg + (KO));                                               \
    S##b1 = *(const uint4*)(Bg + (size_t)64 * ldb + (KO));                            \
  } while (0)
#define SSTORE(S, NB)                                                                 \
  do {                                                                                \
    u16* dA = sA + ((NB) * BM + crow) * LDS_S + wsw;                                  \
    u16* dB = sB + ((NB) * BN + crow) * LDS_S + wsw;                                  \
    *(uint4*)(dA) = S##a0;                                                            \
    *(uint4*)(dA + 64 * LDS_S) = S##a1;                                               \
    if (ACH == 4) {                                                                   \
      *(uint4*)(dA + 128 * LDS_S) = S##a2;                                            \
      *(uint4*)(dA + 192 * LDS_S) = S##a3;                                            \
    }                                                                                 \
    *(uint4*)(dB) = S##b0;                                                            \
    *(uint4*)(dB + 64 * LDS_S) = S##b1;                                               \
  } while (0)
#define LOADFR(BUF)                                                                   \
  do {                                                                                \
    const u16* cA = sA + ((BUF) * BM + wm * 16 * WMT + fr) * LDS_S;                   \
    const u16* cB = sB + ((BUF) * BN + wn * 16 * WNT + fr) * LDS_S;                   \
    _Pragma("unroll") for (int ks = 0; ks < 2; ++ks) {                                \
      const int so = rsw0 ^ (ks * 32);                                                \
      _Pragma("unroll") for (int i = 0; i < WMT; ++i) af[ks][i] = *(const bf16x8*)(cA + i * 16 * LDS_S + so);  \
      _Pragma("unroll") for (int j = 0; j < WNT; ++j) bfr[ks][j] = *(const bf16x8*)(cB + j * 16 * LDS_S + so); \
    }                                                                                 \
  } while (0)
#define MFMAS()                                                                       \
  do {                                                                                \
    _Pragma("unroll") for (int ks = 0; ks < 2; ++ks)                                  \
      _Pragma("unroll") for (int i = 0; i < WMT; ++i)                                 \
        _Pragma("unroll") for (int j = 0; j < WNT; ++j)                               \
          acc[i][j] = __builtin_amdgcn_mfma_f32_16x16x32_bf16(bfr[ks][j], af[ks][i], acc[i][j], 0, 0, 0);  \
  } while (0)
  bf16x8 af[2][WMT], bfr[2][WNT];
  GLOAD(p, 0);
  SSTORE(p, 0);
  __builtin_amdgcn_sched_barrier(0);
  GLOAD(q, 64);
  __builtin_amdgcn_sched_barrier(0);
  GLOAD(p, 128);
  __builtin_amdgcn_sched_barrier(0);
  __syncthreads();
#pragma unroll 1
  for (int kt = 0; kt < nk; kt += 2) {
    LOADFR(0);
    __builtin_amdgcn_sched_barrier(0);
    SSTORE(q, 1);
    const int k3 = (kt + 3 < nk) ? kt + 3 : nk - 1;
    GLOAD(q, k3 * 64);
    __builtin_amdgcn_sched_barrier(0);
    MFMAS();
    __builtin_amdgcn_sched_barrier(0);
    __syncthreads();
    LOADFR(1);
    __builtin_amdgcn_sched_barrier(0);
    SSTORE(p, 0);
    const int k4 = (kt + 4 < nk) ? kt + 4 : nk - 1;
    GLOAD(p, k4 * 64);
    __builtin_amdgcn_sched_barrier(0);
    MFMAS();
    __builtin_amdgcn_sched_barrier(0);
    __syncthreads();
  }
#undef GLOAD
#undef SSTORE
#undef LOADFR
#undef MFMAS
}

DEVI bool tile_map(int it, int MT, int NT, int& mt, int& nt) {
  const int G = gridDim.x, per = G >> 3;
  const int t = it * G + (blockIdx.x & 7) * per + (blockIdx.x >> 3);
  if (t >= MT * NT) return false;
  constexpr int GM = 4;
  const int gsize = GM * NT;
  const int g = t / gsize, tl = t - g * gsize;
  int gsz = MT - g * GM;
  if (gsz > GM) gsz = GM;
  mt = g * GM + (tl % gsz);
  nt = tl / gsz;
  return true;
}

template <int WMT, int WNT>
DEVI void zero_acc(f32x4 (&acc)[WMT][WNT]) {
#pragma unroll
  for (int i = 0; i < WMT; ++i)
#pragma unroll
    for (int j = 0; j < WNT; ++j) acc[i][j] = f32x4{0.f, 0.f, 0.f, 0.f};
}

DEVI void phase_proj(const Params& p, int l, u16* smem) {
  const u16* xn = (const u16*)(p.ws + WS_XN);
  const u16* wt = (const u16*)(p.ws + WS_WT_IN) + (size_t)l * NPROJ_PAD * LDW1;
  u16* proj = (u16*)(p.ws + WS_PROJ);
  float* small = (float*)(p.ws + WS_SMALL);
  const int tid_ = otid(); const int lane = tid_ & 63, w = tid_ >> 6, wm = w >> 1, wn = w & 1, fr = lane & 15, fq = lane >> 4;
  constexpr int NT = NPROJ_PAD / 128, MT = M / 256;
  for (int it = 0; it * (int)gridDim.x < MT * NT; ++it) {
    int mt, nt;
    if (!tile_map(it, MT, NT, mt, nt)) break;
    const int m0 = mt * 256, n0 = nt * 128;
    f32x4 acc[4][4];
    zero_acc(acc);
    gemm_core<4, 4>(xn + (size_t)m0 * LDX, LDX, wt + (size_t)n0 * LDW1, LDW1, 1024, acc, smem);
#pragma unroll
    for (int i = 0; i < 4; ++i)
#pragma unroll
      for (int j = 0; j < 4; ++j) {
        const int m = m0 + wm * 64 + i * 16 + fr, n = n0 + wn * 64 + j * 16 + fq * 4;
        if (n < NPROJ) {
          uint2 o;
          o.x = pk2(acc[i][j][0], acc[i][j][1]);
          o.y = pk2(acc[i][j][2], acc[i][j][3]);
          *(uint2*)(proj + (size_t)m * NPROJ + n) = o;
        } else if (n < NPROJ + 16) {
          *(float4*)(small + (size_t)m * 16 + (n - NPROJ)) = float4{acc[i][j][0], acc[i][j][1], acc[i][j][2], acc[i][j][3]};
        }
      }
  }
}

DEVI void phase_up(const Params& p, int l, u16* smem) {
  const u16* xn = (const u16*)(p.ws + WS_XN);
  const u16* wt = (const u16*)(p.ws + WS_WT_UP) + (size_t)l * 4096 * LDW1;
  u16* hid = (u16*)(p.ws + WS_PROJ);
  const int tid_ = otid(); const int lane = tid_ & 63, w = tid_ >> 6, wm = w >> 1, wn = w & 1, fr = lane & 15, fq = lane >> 4;
  constexpr int NT = DFF / 128, MT = M / 256;
  for (int it = 0; it * (int)gridDim.x < MT * NT; ++it) {
    int mt, nt;
    if (!tile_map(it, MT, NT, mt, nt)) break;
    const int m0 = mt * 256, n0 = nt * 128;
    f32x4 acc[4][4];
    zero_acc(acc);
    gemm_core<4, 4>(xn + (size_t)m0 * LDX, LDX, wt + (size_t)n0 * LDW1, LDW1, 1024, acc, smem);
#pragma unroll
    for (int i = 0; i < 4; ++i)
#pragma unroll
      for (int j = 0; j < 4; ++j) {
        const int m = m0 + wm * 64 + i * 16 + fr, n = n0 + wn * 64 + j * 16 + fq * 4;
        float r0 = fmaxf(acc[i][j][0], 0.f), r1 = fmaxf(acc[i][j][1], 0.f), r2 = fmaxf(acc[i][j][2], 0.f), r3 = fmaxf(acc[i][j][3], 0.f);
        uint2 o;
        o.x = pk2(r0 * r0, r1 * r1);
        o.y = pk2(r2 * r2, r3 * r3);
        *(uint2*)(hid + (size_t)m * LDH + n) = o;
      }
  }
}

DEVI void phase_merge(const Params& p, int l, u16* smem) {
  const u16* xn = (const u16*)(p.ws + WS_XN);
  const u16* y = (const u16*)(p.ws + WS_OBUF);
  const u16* wg = (const u16*)(p.ws + WS_WT_GATE) + (size_t)l * 3072 * LDW1;
  const u16* wb = (const u16*)(p.ws + WS_WT_BR) + (size_t)l * 3 * 1024 * LDWB;
  u16* merged = (u16*)(p.ws + WS_CONV);
  const int tid_ = otid(); const int lane = tid_ & 63, w = tid_ >> 6, wm = w >> 1, wn = w & 1, fr = lane & 15, fq = lane >> 4;
  constexpr int NT = D / 128, MT = M / 128;
  for (int it = 0; it * (int)gridDim.x < MT * NT; ++it) {
    int mt, nt;
    if (!tile_map(it, MT, NT, mt, nt)) break;
    const int m0 = mt * 128, n0 = nt * 128;
    f32x4 accM[2][4];
    zero_acc(accM);
#pragma unroll 1
    for (int b = 0; b < 3; ++b) {
      f32x4 accG[2][4], accB[2][4];
      zero_acc(accG);
      zero_acc(accB);
      gemm_core<2, 4>(xn + (size_t)m0 * LDX, LDX, wg + ((size_t)b * 1024 + n0) * LDW1, LDW1, 1024, accG, smem);
      gemm_core<2, 4>(y + (size_t)m0 * LDY + b * 512, LDY, wb + ((size_t)b * 1024 + n0) * LDWB, LDWB, 512, accB, smem);
#pragma unroll
      for (int i = 0; i < 2; ++i)
#pragma unroll
        for (int j = 0; j < 4; ++j)
#pragma unroll
          for (int r = 0; r < 4; ++r) accM[i][j][r] += sigm(accG[i][j][r]) * accB[i][j][r];
    }
#pragma unroll
    for (int i = 0; i < 2; ++i)
#pragma unroll
      for (int j = 0; j < 4; ++j) {
        const int m = m0 + wm * 32 + i * 16 + fr, n = n0 + wn * 64 + j * 16 + fq * 4;
        uint2 o;
        o.x = pk2(accM[i][j][0], accM[i][j][1]);
        o.y = pk2(accM[i][j][2], accM[i][j][3]);
        *(uint2*)(merged + (size_t)m * LDX + n) = o;
      }
  }
}

DEVI void phase_resid(const u16* A, int lda, int K, const u16* wt, int ldb, const float* xin_p, const float* xin_s, float* xout, u16* smem) {
  const int tid_ = otid(); const int lane = tid_ & 63, w = tid_ >> 6, wm = w >> 1, wn = w & 1, fr = lane & 15, fq = lane >> 4;
  constexpr int NT = D / 128, MT = M / 128;
  for (int it = 0; it * (int)gridDim.x < MT * NT; ++it) {
    int mt, nt;
    if (!tile_map(it, MT, NT, mt, nt)) break;
    const int m0 = mt * 128, n0 = nt * 128;
    f32x4 acc[2][4];
    zero_acc(acc);
    gemm_core<2, 4>(A + (size_t)m0 * lda, lda, wt + (size_t)n0 * ldb, ldb, K, acc, smem);
#pragma unroll
    for (int i = 0; i < 2; ++i)
#pragma unroll
      for (int j = 0; j < 4; ++j) {
        const int m = m0 + wm * 32 + i * 16 + fr, n = n0 + wn * 64 + j * 16 + fq * 4;
        const float* xr = (m < MP) ? xin_p + (size_t)m * D : xin_s + (size_t)(m - MP) * D;
        const float4 xv = *(const float4*)(xr + n);
        float4 o;
        o.x = xv.x + acc[i][j][0]; o.y = xv.y + acc[i][j][1]; o.z = xv.z + acc[i][j][2]; o.w = xv.w + acc[i][j][3];
        *(float4*)(xout + (size_t)m * D + n) = o;
      }
  }
}

DEVI void phase_prep(const Params& p, int l) {
  const int tid_ = otid(); const int lane = tid_ & 63, gw = blockIdx.x * 8 + (tid_ >> 6), nw = gridDim.x * 8;
  u16* proj = (u16*)(p.ws + WS_PROJ);
  u16* conv = (u16*)(p.ws + WS_CONV);
  const float* small = (const float*)(p.ws + WS_SMALL);
  float* gates = (float*)(p.ws + WS_GATES);
  constexpr int NTASK = (M / 4) * 21;
  for (int task = gw; task < NTASK; task += nw) {
    const int tg = task / 21, k = task - tg * 21;
    const int m0 = tg * 4;
    const bool samp = m0 >= MP;
    int b, t0;
    if (!samp) { b = m0 >> 11; t0 = m0 & 2047; } else { b = (m0 - MP) >> 2; t0 = 0; }
    if (k < 12) {
      const int pp = k >> 2, hh = k & 3;
      const int ch = pp * 512 + hh * 128 + lane * 2;
      const u16* src = proj + 2048 + ch;
      float rx[7], ry[7];
#pragma unroll
      for (int j = 0; j < 7; ++j) {
        const int t = t0 - 3 + j;
        if (t >= 0) {
          const unsigned u = *(const unsigned*)(src + (size_t)(m0 - 3 + j) * NPROJ);
          rx[j] = bflo(u); ry[j] = bfhi(u);
        } else if (samp) {
          const float2 cs = *(const float2*)(p.st_gconv + ((size_t)(l * 128 + b) * 3 + j) * 1536 + ch);
          rx[j] = cs.x; ry[j] = cs.y;
        } else { rx[j] = 0.f; ry[j] = 0.f; }
      }
      float cwx[4], cwy[4];
#pragma unroll
      for (int j = 0; j < 4; ++j) {
        const float2 c2 = *(const float2*)(p.gd_conv_w + (size_t)(l * 4 + j) * 1536 + ch);
        cwx[j] = c2.x; cwy[j] = c2.y;
      }
#pragma unroll
      for (int tt = 0; tt < 4; ++tt) {
        float ax = 0.f, ay = 0.f;
#pragma unroll
        for (int j = 0; j < 4; ++j) { ax += cwx[j] * rx[tt + j]; ay += cwy[j] * ry[tt + j]; }
        ax = silu(ax); ay = silu(ay);
        if (pp < 2) {
          float ss = wave_sum(ax * ax + ay * ay);
          float sc = rsqrtf(ss + 1e-6f);
          if (pp == 0) sc *= 0.08838834764831845f;
          ax *= sc; ay *= sc;
        }
        *(unsigned*)(conv + (size_t)(m0 + tt) * 1536 + ch) = pk2(ax, ay);
      }
      const bool last = samp || (t0 == 2044);
      if (last) {
        float* co = p.out + (samp ? OFF_S_GC + (size_t)(l * 128 + b) * 3 * 1536 : OFF_P_GC + (size_t)(l * 8 + b) * 3 * 1536) + ch;
#pragma unroll
        for (int j = 0; j < 3; ++j) *(float2*)(co + j * 1536) = float2{rx[4 + j], ry[4 + j]};
      }
    } else if (k < 20) {
      const int kk = k - 12, part = kk >> 2, hh = kk & 3;
      const int wch = hh * 128 + lane * 2;
      u16* col = proj + 4096 + part * 512 + wch;
      float lb0 = 0.f, lb1 = 0.f;
      if (part == 1 && l == 1) {
        lb0 = sigm(p.hg_lb_logits[512 + wch] - p.hg_lb_logits[wch]);
        lb1 = sigm(p.hg_lb_logits[512 + wch + 1] - p.hg_lb_logits[wch + 1]);
      }
      unsigned u[4];
#pragma unroll
      for (int tt = 0; tt < 4; ++tt) u[tt] = *(const unsigned*)(col + (size_t)(m0 + tt) * NPROJ);
#pragma unroll
      for (int tt = 0; tt < 4; ++tt) {
        float a = bflo(u[tt]), c = bfhi(u[tt]);
        if (part == 0) { a = silu(a); c = silu(c); }
        else { a = (1.f - lb0) * sigm(-a); c = (1.f - lb1) * sigm(-c); }
        *(unsigned*)(col + (size_t)(m0 + tt) * NPROJ) = pk2(a, c);
      }
    } else {
      const int tt = lane >> 4, g = lane & 15, hh = g & 3;
      const float v = small[(size_t)(m0 + tt) * 16 + g];
      float r;
      if (g < 4) r = v + p.ml_i_bias[l * 4 + hh];
      else if (g < 8) { const float x = v + p.ml_f_bias[l * 4 + hh]; r = -softplus(-x); }
      else if (g < 12) r = sigm(v);
      else { const float x = v + p.gd_dt_bias[l * 4 + hh]; r = __expf(-__expf(p.gd_A_log[l * 4 + hh]) * softplus(x)); }
      gates[(size_t)(m0 + tt) * 16 + g] = r;
    }
  }
}

template <int KIND>
DEVI void scan_unit(const Params& p, int l, bool samp, int b, int h, int colbase, float* smem) {
  constexpr int CPL = (KIND == 1) ? 1 : 2;
  constexpr int UC = 32 * CPL;
  constexpr int VCH = UC / 8;
  const int tid = otid(), lane = tid & 63, w = tid >> 6, kg = lane & 15, cl = lane >> 4;
  const int T = samp ? 4 : 2048;
  const int rowbase = samp ? (MP + b * 4) : b * 2048;
  const int NB = samp ? 128 : 8;
  const u16* proj = (const u16*)(p.ws + WS_PROJ);
  const u16* conv = (const u16*)(p.ws + WS_CONV);
  u16* obuf = (u16*)(p.ws + WS_OBUF);
  const float* gates = (const float*)(p.ws + WS_GATES);
  float* dm = (float*)(p.ws + WS_DM);
  const u16 *qsrc, *ksrc, *vsrc;
  int ld, ocol;
  const float* Sin;
  float* Sout;
  const size_t sidx_in = ((size_t)(l * 128 + b) * 4 + h) * 16384;
  const size_t sidx_out = ((size_t)(l * NB + b) * 4 + h) * 16384;
  if (KIND == 0) {
    qsrc = proj + h * 128; ksrc = proj + 512 + h * 128; vsrc = proj + 1024 + h * 128 + colbase; ld = NPROJ; ocol = 0;
    Sin = p.st_mC + sidx_in; Sout = p.out + (samp ? OFF_S_MC : OFF_P_MC) + sidx_out;
  } else if (KIND == 1) {
    qsrc = conv + h * 128; ksrc = conv + 512 + h * 128; vsrc = conv + 1024 + h * 128 + colbase; ld = 1536; ocol = 512;
    Sin = p.st_gS + sidx_in; Sout = p.out + (samp ? OFF_S_GS : OFF_P_GS) + sidx_out;
  } else {
    qsrc = proj + 4096 + h * 128; ksrc = proj + 4608 + h * 128; vsrc = proj + 5120 + h * 128 + colbase; ld = NPROJ; ocol = 1024;
    Sin = p.st_hS + sidx_in; Sout = p.out + (samp ? OFF_S_HS : OFF_P_HS) + sidx_out;
  }
  float* qk = smem;
  float* vl = smem + 2 * 32 * 256;
  float* gl = vl + 2 * 32 * 64;

  const int wc = w * 4 * CPL + cl * CPL;
  const int col0 = colbase + wc;
  v2f S[CPL][4];
  v2f nv[4];
#pragma unroll
  for (int c = 0; c < CPL; ++c)
#pragma unroll
    for (int i = 0; i < 4; ++i) {
      if (samp) { S[c][i].x = Sin[(size_t)(kg * 8 + 2 * i) * 128 + col0 + c]; S[c][i].y = Sin[(size_t)(kg * 8 + 2 * i + 1) * 128 + col0 + c]; }
      else { S[c][i].x = 0.f; S[c][i].y = 0.f; }
    }
  float mstart = 0.f;
  if (KIND == 0) {
    const size_t nidx = ((size_t)(l * 128 + b) * 4 + h) * 128;
#pragma unroll
    for (int i = 0; i < 4; ++i) {
      if (samp) { nv[i].x = p.st_mn[nidx + kg * 8 + 2 * i]; nv[i].y = p.st_mn[nidx + kg * 8 + 2 * i + 1]; }
      else { nv[i].x = 0.f; nv[i].y = 0.f; }
    }
    if (samp) mstart = p.st_mm[(size_t)(l * 128 + b) * 4 + h];
  }

  uint4 rq, rk, rv;
  float g0 = 0.f, g1 = 0.f;
  const int sr = tid >> 4, sc = tid & 15;
  const int vr = tid / VCH, vc = tid % VCH;
  auto prefetch = [&](int j) {
    const int t = j * 32 + sr;
    rq = uint4{0, 0, 0, 0}; rk = uint4{0, 0, 0, 0}; rv = uint4{0, 0, 0, 0};
    if (t < T) {
      rq = *(const uint4*)(qsrc + (size_t)(rowbase + t) * ld + sc * 8);
      rk = *(const uint4*)(ksrc + (size_t)(rowbase + t) * ld + sc * 8);
    }
    if (tid < 32 * VCH) {
      const int tv = j * 32 + vr;
      if (tv < T) rv = *(const uint4*)(vsrc + (size_t)(rowbase + tv) * ld + vc * 8);
    }
    if (KIND != 2) {
      g0 = (KIND == 0) ? -1e30f : 0.f; g1 = 0.f;
      if (tid < 32) {
        const int tg = j * 32 + tid;
        if (tg < T) {
          if (KIND == 0) { g0 = gates[(size_t)(rowbase + tg) * 16 + h]; g1 = gates[(size_t)(rowbase + tg) * 16 + 4 + h]; }
          else { g0 = gates[(size_t)(rowbase + tg) * 16 + 8 + h]; g1 = gates[(size_t)(rowbase + tg) * 16 + 12 + h]; }
        }
      }
    }
  };
  auto stage = [&](int j, int buf) {
    float* qd = qk + (buf * 32 + sr) * 256 + sc * 8;
    *(float4*)(qd) = float4{bflo(rq.x), bfhi(rq.x), bflo(rq.y), bfhi(rq.y)};
    *(float4*)(qd + 4) = float4{bflo(rq.z), bfhi(rq.z), bflo(rq.w), bfhi(rq.w)};
    *(float4*)(qd + 128) = float4{bflo(rk.x), bfhi(rk.x), bflo(rk.y), bfhi(rk.y)};
    *(float4*)(qd + 132) = float4{bflo(rk.z), bfhi(rk.z), bflo(rk.w), bfhi(rk.w)};
    if (tid < 32 * VCH) {
      float* vd = vl + (buf * 32 + vr) * 64 + vc * 8;
      *(float4*)(vd) = float4{bflo(rv.x), bfhi(rv.x), bflo(rv.y), bfhi(rv.y)};
      *(float4*)(vd + 4) = float4{bflo(rv.z), bfhi(rv.z), bflo(rv.w), bfhi(rv.w)};
    }
    if (KIND == 0) {
      if (w == 0) {
        float bs = g1;
#pragma unroll
        for (int d = 1; d < 32; d <<= 1) { const float o = __shfl_up(bs, d); if (lane >= d) bs += o; }
        float R = g0 - bs;
#pragma unroll
        for (int d = 1; d < 32; d <<= 1) { const float o = __shfl_up(R, d); if (lane >= d) R = fmaxf(R, o); }
        const float mt = bs + fmaxf(mstart, R);
        float mprev = __shfl_up(mt, 1);
        if (lane == 0) mprev = mstart;
        const float fw = __expf(g1 + mprev - mt);
        const float iw = __expf(g0 - mt) * 0.08838834764831845f;
        if (lane < 32) {
          float* gd = gl + (buf * 32 + lane) * 4;
          gd[0] = fw; gd[1] = iw; gd[2] = mt;
        }
        int lastv = T - j * 32 - 1;
        if (lastv > 31) lastv = 31;
        mstart = __shfl(mt, lastv);
      }
    } else if (KIND == 1) {
      if (tid < 32) {
        float* gd = gl + (buf * 32 + tid) * 4;
        gd[0] = g0; gd[1] = g1;
      }
    }
  };

  const bool do_n = (KIND == 0) && (colbase == 0) && (w == 0);
  const int nblk = (T + 31) >> 5;
  prefetch(0);
  stage(0, 0);
  __syncthreads();
  for (int j = 0; j < nblk; ++j) {
    const int buf = j & 1;
    if (j + 1 < nblk) prefetch(j + 1);
    int steps = T - j * 32;
    if (steps > 32) steps = 32;
    u16* const obase = obuf + (size_t)(rowbase + j * 32) * LDY + ocol + h * 128 + col0;
    float* const dmbase = dm + (size_t)(rowbase + j * 32) * 8 + h;
#pragma unroll 4
    for (int t = 0; t < steps; ++t) {
      const float* qp = qk + (buf * 32 + t) * 256 + kg * 8;
      const float4 qa = *(const float4*)(qp), qb = *(const float4*)(qp + 4);
      const float4 ka = *(const float4*)(qp + 128), kb = *(const float4*)(qp + 132);
      const v2f q2[4] = {v2f{qa.x, qa.y}, v2f{qa.z, qa.w}, v2f{qb.x, qb.y}, v2f{qb.z, qb.w}};
      const v2f k2[4] = {v2f{ka.x, ka.y}, v2f{ka.z, ka.w}, v2f{kb.x, kb.y}, v2f{kb.z, kb.w}};
      const float* vp = vl + (buf * 32 + t) * 64 + wc;
      const float* gp = gl + (buf * 32 + t) * 4;
      if (KIND == 0) {
        const float fw = gp[0], iw = gp[1];
        const v2f fw2 = v2f{fw, fw};
        const float2 vv = *(const float2*)vp;
        const float va[2] = {vv.x * iw, vv.y * iw};
        float num[2];
#pragma unroll
        for (int c = 0; c < 2; ++c) {
          const v2f vc2 = v2f{va[c], va[c]};
          v2f a = v2f{0.f, 0.f};
#pragma unroll
          for (int i = 0; i < 4; ++i) {
            S[c][i] = fw2 * S[c][i] + k2[i] * vc2;
            a += q2[i] * S[c][i];
          }
          num[c] = row16_sum(a.x + a.y);
        }
        if (kg == 0) *(unsigned*)(obase + t * LDY) = pk2(num[0], num[1]);
        if (do_n) {
          const v2f iw2 = v2f{iw, iw};
          v2f a = v2f{0.f, 0.f};
#pragma unroll
          for (int i = 0; i < 4; ++i) {
            nv[i] = fw2 * nv[i] + k2[i] * iw2;
            a += q2[i] * nv[i];
          }
          const float den = row16_sum(a.x + a.y);
          if (lane == 0) { dmbase[t * 8] = den; dmbase[t * 8 + 4] = gp[2]; }
        }
      } else if (KIND == 1) {
        const float beta = gp[0], g = gp[1];
        const float v = vp[0];
        v2f a = v2f{0.f, 0.f};
#pragma unroll
        for (int i = 0; i < 4; ++i) a += k2[i] * S[0][i];
        const float kS = row16_sum(a.x + a.y);
        const float vn = beta * (v - g * kS);
        const v2f g2 = v2f{g, g}, vn2 = v2f{vn, vn};
        v2f o2 = v2f{0.f, 0.f};
#pragma unroll
        for (int i = 0; i < 4; ++i) {
          S[0][i] = g2 * S[0][i] + k2[i] * vn2;
          o2 += q2[i] * S[0][i];
        }
        const float o = row16_sum(o2.x + o2.y);
        if (kg == 0) obase[t * LDY] = f2bf(o);
      } else {
        const float2 vv = *(const float2*)vp;
        const float va[2] = {vv.x, vv.y};
        float num[2];
#pragma unroll
        for (int c = 0; c < 2; ++c) {
          const v2f vc2 = v2f{va[c], va[c]};
          v2f a = v2f{0.f, 0.f};
#pragma unroll
          for (int i = 0; i < 4; ++i) {
            S[c][i] = S[c][i] + k2[i] * (vc2 - S[c][i]);
            a += q2[i] * S[c][i];
          }
          num[c] = row16_sum(a.x + a.y);
        }
        if (kg == 0) *(unsigned*)(obase + t * LDY) = pk2(num[0], num[1]);
      }
    }
    if (j + 1 < nblk) stage(j + 1, buf ^ 1);
    __syncthreads();
  }
#pragma unroll
  for (int c = 0; c < CPL; ++c)
#pragma unroll
    for (int i = 0; i < 4; ++i) {
      Sout[(size_t)(kg * 8 + 2 * i) * 128 + col0 + c] = S[c][i].x;
      Sout[(size_t)(kg * 8 + 2 * i + 1) * 128 + col0 + c] = S[c][i].y;
    }
  if (KIND == 0 && colbase == 0 && w == 0) {
    if (cl == 0) {
      float* no = p.out + (samp ? OFF_S_MN : OFF_P_MN) + ((size_t)(l * NB + b) * 4 + h) * 128 + kg * 8;
#pragma unroll
      for (int i = 0; i < 4; ++i) { no[2 * i] = nv[i].x; no[2 * i + 1] = nv[i].y; }
    }
    if (lane == 0) p.out[(samp ? OFF_S_MM : OFF_P_MM) + (size_t)(l * NB + b) * 4 + h] = mstart;
  }
  __syncthreads();
}

DEVI void phase_scan(const Params& p, int l, float* smem) {
  constexpr int NU = 256 + 4096;
  for (int u = blockIdx.x; u < NU; u += gridDim.x) {
    if (u < 128) {
      const int seq = u >> 2;
      scan_unit<1>(p, l, false, seq >> 2, seq & 3, (u & 3) * 32, smem);
    } else if (u < 192) {
      const int uu = u - 128, seq = uu >> 1;
      scan_unit<0>(p, l, false, seq >> 2, seq & 3, (uu & 1) * 64, smem);
    } else if (u < 256) {
      const int uu = u - 192, seq = uu >> 1;
      scan_unit<2>(p, l, false, seq >> 2, seq & 3, (uu & 1) * 64, smem);
    } else {
      const int s = u - 256, s4 = s & 3;
      if (s4 < 2) {
        const int idx = (s >> 2) * 2 + (s & 1), seq = idx >> 2;
        scan_unit<1>(p, l, true, seq >> 2, seq & 3, (idx & 3) * 32, smem);
      } else {
        const int idx = s >> 2, seq = idx >> 1;
        if (s4 == 2) scan_unit<0>(p, l, true, seq >> 2, seq & 3, (idx & 1) * 64, smem);
        else scan_unit<2>(p, l, true, seq >> 2, seq & 3, (idx & 1) * 64, smem);
      }
    }
  }
}

DEVI void phase_post(const Params& p, int l) {
  const int tid_ = otid(); const int lane = tid_ & 63, gw = blockIdx.x * 8 + (tid_ >> 6), nw = gridDim.x * 8;
  const u16* proj = (const u16*)(p.ws + WS_PROJ);
  u16* obuf = (u16*)(p.ws + WS_OBUF);
  const float* dm = (const float*)(p.ws + WS_DM);
  constexpr int NTASK = (M / 4) * 9;
  for (int task = gw; task < NTASK; task += nw) {
    const int tg = task / 9, k = task - tg * 9;
    const int m0 = tg * 4;
    if (k < 4) {
      const int hh = k, c = hh * 128 + lane * 2;
      const float2 nw2 = *(const float2*)(p.ml_norm_w + l * 512 + c);
#pragma unroll
      for (int tt = 0; tt < 4; ++tt) {
        const size_t m = m0 + tt;
        const unsigned u = *(const unsigned*)(obuf + m * LDY + c);
        const unsigned og = *(const unsigned*)(proj + m * NPROJ + 1536 + c);
        const float den = dm[m * 8 + hh], mt = dm[m * 8 + 4 + hh];
        const float dd = fmaxf(fabsf(den), __expf(-mt));
        const float h0 = bflo(u) / dd, h1 = bfhi(u) / dd;
        const float ss = wave_sum(h0 * h0 + h1 * h1);
        const float sc = rsqrtf(ss * (1.f / 128.f) + 1e-6f);
        *(unsigned*)(obuf + m * LDY + c) = pk2(h0 * sc * nw2.x * sigm(bflo(og)), h1 * sc * nw2.y * sigm(bfhi(og)));
      }
    } else if (k < 8) {
      const int hh = k - 4, cc = lane * 2, c = hh * 128 + cc;
      const float2 nw2 = *(const float2*)(p.gd_norm_w + l * 128 + cc);
#pragma unroll
      for (int tt = 0; tt < 4; ++tt) {
        const size_t m = m0 + tt;
        const unsigned u = *(const unsigned*)(obuf + m * LDY + 512 + c);
        const unsigned z = *(const unsigned*)(proj + m * NPROJ + 3584 + c);
        const float o0 = bflo(u), o1 = bfhi(u);
        const float ss = wave_sum(o0 * o0 + o1 * o1);
        const float sc = rsqrtf(ss * (1.f / 128.f) + 1e-6f);
        *(unsigned*)(obuf + m * LDY + 512 + c) = pk2(o0 * sc * nw2.x * silu(bflo(z)), o1 * sc * nw2.y * silu(bfhi(z)));
      }
    } else {
      const int c = lane * 8;
      const float4 wa = *(const float4*)(p.hg_norm_w + l * 512 + c), wb = *(const float4*)(p.hg_norm_w + l * 512 + c + 4);
#pragma unroll
      for (int tt = 0; tt < 4; ++tt) {
        const size_t m = m0 + tt;
        const uint4 ov = *(const uint4*)(obuf + m * LDY + 1024 + c);
        const uint4 gv = *(const uint4*)(proj + m * NPROJ + 5632 + c);
        float o[8] = {bflo(ov.x), bfhi(ov.x), bflo(ov.y), bfhi(ov.y), bflo(ov.z), bfhi(ov.z), bflo(ov.w), bfhi(ov.w)};
        const float g[8] = {bflo(gv.x), bfhi(gv.x), bflo(gv.y), bfhi(gv.y), bflo(gv.z), bfhi(gv.z), bflo(gv.w), bfhi(gv.w)};
        const float wv[8] = {wa.x, wa.y, wa.z, wa.w, wb.x, wb.y, wb.z, wb.w};
        float ss = 0.f;
#pragma unroll
        for (int i = 0; i < 8; ++i) ss += o[i] * o[i];
        ss = wave_sum(ss);
        const float sc = rsqrtf(ss * (1.f / 512.f) + 1e-6f);
#pragma unroll
        for (int i = 0; i < 8; ++i) o[i] = o[i] * sc * wv[i] * silu(g[i]);
        uint4 r;
        r.x = pk2(o[0], o[1]); r.y = pk2(o[2], o[3]); r.z = pk2(o[4], o[5]); r.w = pk2(o[6], o[7]);
        *(uint4*)(obuf + m * LDY + 1024 + c) = r;
      }
    }
  }
}

#define LAS __attribute__((address_space(3)))
#define XB_TMO      128
#define XB_XCNT(j)  (256  + 64 * (j))
#define XB_XSUB(j)  (1280 + 64 * (j))
#define XB_XGEN(j)  (2304 + 64 * (j))
#define XB_TOP      3328
#define XB_TOPGEN   3392
#define XCD_BAR_WORDS 3456
#define XB_SPIN_CAP (1u << 18)

__device__ __forceinline__ unsigned xb_ld(unsigned* p)              { return __hip_atomic_load(p, __ATOMIC_RELAXED, __HIP_MEMORY_SCOPE_AGENT); }
__device__ __forceinline__ unsigned xb_add(unsigned* p, unsigned v) { return __hip_atomic_fetch_add(p, v, __ATOMIC_RELAXED, __HIP_MEMORY_SCOPE_AGENT); }
__device__ __forceinline__ unsigned xb_xcc_id() { return (unsigned)__builtin_amdgcn_s_getreg((3 << 11) | 20) & 0xFu; }
#define XB_SPIN(cond, bar) do { unsigned _sp = 0; while (cond) { __builtin_amdgcn_s_sleep(1); \
    if ((++_sp & 255u) == 0u) { if (xb_ld(&(bar)[XB_TMO])) break; if (_sp > XB_SPIN_CAP) { atomicAdd(&(bar)[XB_TMO], 1u); break; } } } } while (0)

struct XcdBarrier {
    unsigned* bar; unsigned x;
    volatile LAS unsigned* st;
};

__device__ __forceinline__ XcdBarrier xcd_barrier_post(unsigned* bar, volatile LAS unsigned* st) {
    XcdBarrier b; b.bar = bar; b.x = xb_xcc_id(); b.st = st;
    if (threadIdx.x == 0) (void)xb_add(&bar[XB_XCNT(b.x)], 1u);
    return b;
}
__device__ __forceinline__ void xcd_barrier_complete(unsigned* bar, unsigned x, unsigned& nloc, unsigned& nx) {
    const unsigned G = gridDim.x * gridDim.y * gridDim.z;
    unsigned sum, cnt, mine, sp = 0u;
    for (;;) {
        sum = 0u; cnt = 0u; mine = 0u;
#pragma unroll
        for (unsigned j = 0; j < 16; ++j) { const unsigned c = xb_ld(&bar[XB_XCNT(j)]); sum += c; cnt += (c > 0u) ? 1u : 0u; mine = (j == x) ? c : mine; }
        if (sum == G) break;
        __builtin_amdgcn_s_sleep(1);
        if ((++sp & 255u) == 0u) { if (xb_ld(&bar[XB_TMO])) break; if (sp > XB_SPIN_CAP) { atomicAdd(&bar[XB_TMO], 1u); break; } }
    }
    nloc = mine > 0u ? mine : 1u; nx = cnt > 0u ? cnt : 1u;
}

__device__ __forceinline__ void xcd_barrier(const XcdBarrier& b) {
    asm volatile("s_waitcnt vmcnt(0)" ::: "memory");
    __syncthreads();
    if (threadIdx.x == 0) {
        unsigned* bar = b.bar;
        __builtin_amdgcn_s_waitcnt(0);
        unsigned nloc = b.st[0], nx = b.st[1];
        if (nloc == 0u) { xcd_barrier_complete(bar, b.x, nloc, nx); b.st[0] = nloc; b.st[1] = nx; }
        const unsigned old = xb_add(&bar[XB_XSUB(b.x)], 1u);
        const unsigned gen = old / nloc;
        if (old + 1u == (gen + 1u) * nloc) {
            __builtin_amdgcn_fence(__ATOMIC_RELEASE, "agent");
            asm volatile("s_waitcnt vmcnt(0)" ::: "memory");
            const unsigned og = xb_add(&bar[XB_TOP], 1u);
            const unsigned tg = og / nx;
            if (og + 1u == (tg + 1u) * nx) xb_add(&bar[XB_TOPGEN], 1u);
            else XB_SPIN(xb_ld(&bar[XB_TOPGEN]) == tg, bar);
            __builtin_amdgcn_fence(__ATOMIC_ACQUIRE, "agent");
            xb_add(&bar[XB_XGEN(b.x)], 1u);
            asm volatile("s_waitcnt vmcnt(0)" ::: "memory");
        } else {
            XB_SPIN(xb_ld(&bar[XB_XGEN(b.x)]) == gen, bar);
            __builtin_amdgcn_fence(__ATOMIC_ACQUIRE, "agent");
            asm volatile("s_waitcnt vmcnt(0)" ::: "memory");
        }
    }
    __syncthreads();
}


__global__ void __launch_bounds__(NTHREADS) mega_fwd(Params p) {
  extern __shared__ __attribute__((aligned(16))) unsigned char smem_raw[];
  cg::grid_group grid = cg::this_grid();
  float* smf = (float*)smem_raw;
  u16* smh = (u16*)smem_raw;
  u16* xn = (u16*)(p.ws + WS_XN);
  float* x = p.out;

  volatile LAS unsigned* bst = (volatile LAS unsigned*)(smem_raw + LDS_BYTES - 16);
  if (threadIdx.x < 2) bst[threadIdx.x] = 0u;
  __syncthreads();
  const XcdBarrier xbar = xcd_barrier_post((unsigned*)(p.ws + WS_BAR), bst);
  phase_wprep(p, smf);
  phase_norm(p.x_prompt, p.x_sample, p.norm1_w, xn);
  grid.sync();
#pragma unroll 1
  for (int l = 0; l < 2; ++l) {
    phase_proj(p, l, smh);
    xcd_barrier(xbar);
    phase_prep(p, l);
    xcd_barrier(xbar);
    phase_scan(p, l, smf);
    xcd_barrier(xbar);
    phase_post(p, l);
    xcd_barrier(xbar);
    phase_merge(p, l, smh);
    xcd_barrier(xbar);
    if (l == 0)
      phase_resid((const u16*)(p.ws + WS_CONV), LDX, 1024, (const u16*)(p.ws + WS_WT_OUT), LDW1, p.x_prompt, p.x_sample, x, smh);
    else
      phase_resid((const u16*)(p.ws + WS_CONV), LDX, 1024, (const u16*)(p.ws + WS_WT_OUT) + (size_t)1024 * LDW1, LDW1, x, x + (size_t)MP * D, x, smh);
    xcd_barrier(xbar);
    phase_norm(x, x + (size_t)MP * D, p.norm2_w + l * D, xn);
    xcd_barrier(xbar);
    phase_up(p, l, smh);
    xcd_barrier(xbar);
    phase_resid((const u16*)(p.ws + WS_PROJ), LDH, 4096, (const u16*)(p.ws + WS_WT_DN) + (size_t)l * 1024 * LDWD, LDWD, x, x + (size_t)MP * D, x, smh);
    xcd_barrier(xbar);
    if (l == 0) {
      phase_norm(x, x + (size_t)MP * D, p.norm1_w + D, xn);
      xcd_barrier(xbar);
    }
  }
  phase_final_norm(x, p.final_norm_w);
}

extern "C" void kernel_launch(void* const* d_in, const int* in_sizes, int n_in, void* d_out, int out_size, void* d_ws,
                              size_t ws_size, hipStream_t stream) {
  static int grid_blocks = 0;
  if (!grid_blocks) {
    int dev = 0, cus = 0, per_cu = 0;
    hipGetDevice(&dev);
    hipDeviceGetAttribute(&cus, hipDeviceAttributeMultiprocessorCount, dev);
    hipFuncSetAttribute((const void*)mega_fwd, hipFuncAttributeMaxDynamicSharedMemorySize, LDS_BYTES);
    hipOccupancyMaxActiveBlocksPerMultiprocessor(&per_cu, (const void*)mega_fwd, NTHREADS, LDS_BYTES);
    if (per_cu < 1) { fprintf(stderr, "occupancy query returned %d\n", per_cu); per_cu = 1; }
    grid_blocks = cus;
    if (ws_size < WS_END) fprintf(stderr, "workspace too small: %zu < %zu\n", ws_size, (size_t)WS_END);
  }
  Params p{};
  p.x_prompt = (const float*)d_in[0]; p.x_sample = (const float*)d_in[1];
  p.st_mC = (const float*)d_in[2]; p.st_mn = (const float*)d_in[3]; p.st_mm = (const float*)d_in[4];
  p.st_gS = (const float*)d_in[5]; p.st_gconv = (const float*)d_in[6]; p.st_hS = (const float*)d_in[7];
  p.norm1_w = (const float*)d_in[8]; p.w_in = (const float*)d_in[9]; p.ml_i_bias = (const float*)d_in[10];
  p.ml_f_bias = (const float*)d_in[11]; p.ml_norm_w = (const float*)d_in[12]; p.gd_conv_w = (const float*)d_in[13];
  p.gd_A_log = (const float*)d_in[14]; p.gd_dt_bias = (const float*)d_in[15]; p.gd_norm_w = (const float*)d_in[16];
  p.hg_lb_logits = (const float*)d_in[17]; p.hg_norm_w = (const float*)d_in[18]; p.w_branch = (const float*)d_in[19];
  p.w_out = (const float*)d_in[20]; p.norm2_w = (const float*)d_in[21]; p.w_up = (const float*)d_in[22];
  p.w_down = (const float*)d_in[23]; p.final_norm_w = (const float*)d_in[24];
  p.out = (float*)d_out;
  p.ws = (unsigned char*)d_ws;
  hipMemsetAsync((char*)d_ws + WS_BAR, 0, WS_BAR_BYTES, stream);
  void* args[] = {&p};
  hipError_t e = hipLaunchCooperativeKernel((const void*)mega_fwd, dim3(grid_blocks), dim3(NTHREADS), args, LDS_BYTES, stream);
  if (e != hipSuccess) fprintf(stderr, "cooperative launch failed: %s (grid %d)\n", hipGetErrorString(e), grid_blocks);
}
```

```cpp
#include <hip/hip_runtime.h>
#include <hip/hip_cooperative_groups.h>
#include <cstdio>
namespace cg = cooperative_groups;

typedef unsigned short u16;
using bf16x8 = __attribute__((ext_vector_type(8))) short;
using f32x4 = __attribute__((ext_vector_type(4))) float;
typedef float v2f __attribute__((ext_vector_type(2)));

#define DEVI __device__ __forceinline__

constexpr int D = 1024;
constexpr int MP = 16384, MS = 512, M = MP + MS;
constexpr int NPROJ = 6144, NPROJ_PAD = 6272;
constexpr int INC = 9232;
constexpr int DFF = 4096;
constexpr int NTHREADS = 512;
constexpr int LDS_BYTES = 132 * 1024;
constexpr int LDX = 1088, LDH = 4160, LDY = 1600, LDW1 = 1088, LDWB = 576, LDWD = 4160;

constexpr size_t OFF_Y = 0;
constexpr size_t OFF_P_MC = (size_t)M * D;
constexpr size_t OFF_P_MN = OFF_P_MC + 2ull * 8 * 4 * 128 * 128;
constexpr size_t OFF_P_MM = OFF_P_MN + 2ull * 8 * 4 * 128;
constexpr size_t OFF_P_GS = OFF_P_MM + 2ull * 8 * 4;
constexpr size_t OFF_P_GC = OFF_P_GS + 2ull * 8 * 4 * 128 * 128;
constexpr size_t OFF_P_HS = OFF_P_GC + 2ull * 8 * 3 * 1536;
constexpr size_t OFF_S_MC = OFF_P_HS + 2ull * 8 * 4 * 128 * 128;
constexpr size_t OFF_S_MN = OFF_S_MC + 2ull * 128 * 4 * 128 * 128;
constexpr size_t OFF_S_MM = OFF_S_MN + 2ull * 128 * 4 * 128;
constexpr size_t OFF_S_GS = OFF_S_MM + 2ull * 128 * 4;
constexpr size_t OFF_S_GC = OFF_S_GS + 2ull * 128 * 4 * 128 * 128;
constexpr size_t OFF_S_HS = OFF_S_GC + 2ull * 128 * 3 * 1536;
static_assert(OFF_S_HS + 2ull * 128 * 4 * 128 * 128 == 72172608ull, "output size");

constexpr size_t WS_WT_IN = 0;
constexpr size_t WS_WT_GATE = WS_WT_IN + 2ull * NPROJ_PAD * LDW1 * 2;
constexpr size_t WS_WT_BR = WS_WT_GATE + 2ull * 3072 * LDW1 * 2;
constexpr size_t WS_WT_OUT = WS_WT_BR + 2ull * 3 * 1024 * LDWB * 2;
constexpr size_t WS_WT_UP = WS_WT_OUT + 2ull * 1024 * LDW1 * 2;
constexpr size_t WS_WT_DN = WS_WT_UP + 2ull * 4096 * LDW1 * 2;
constexpr size_t WS_PROJ = WS_WT_DN + 2ull * 1024 * LDWD * 2;
constexpr size_t WS_CONV = WS_PROJ + (size_t)M * NPROJ * 2;
constexpr size_t WS_OBUF = WS_CONV + (size_t)M * 1536 * 2;
constexpr size_t WS_XN = WS_OBUF + (size_t)M * LDY * 2;
constexpr size_t WS_SMALL = WS_XN + (size_t)M * LDX * 2;
constexpr size_t WS_GATES = WS_SMALL;
constexpr size_t WS_DM = WS_GATES + (size_t)M * 16 * 4;
constexpr size_t WS_BAR = WS_DM + (size_t)M * 8 * 4;
constexpr size_t WS_BAR_BYTES = 16384;
constexpr size_t WS_END = WS_BAR + WS_BAR_BYTES;
static_assert(WS_END <= 439571584ull, "workspace budget");
static_assert((size_t)M * LDH * 2 <= (size_t)M * NPROJ * 2 && (size_t)M * LDX * 2 <= (size_t)M * 1536 * 2, "aliases fit");

struct Params {
  const float *x_prompt, *x_sample, *st_mC, *st_mn, *st_mm, *st_gS, *st_gconv, *st_hS;
  const float *norm1_w, *w_in, *ml_i_bias, *ml_f_bias, *ml_norm_w, *gd_conv_w, *gd_A_log, *gd_dt_bias,
      *gd_norm_w, *hg_lb_logits, *hg_norm_w, *w_branch, *w_out, *norm2_w, *w_up, *w_down, *final_norm_w;
  float* out;
  unsigned char* ws;
};

DEVI u16 f2bf(float f) { unsigned u = __float_as_uint(f); return (u16)((u + 0x7fffu + ((u >> 16) & 1u)) >> 16); }
DEVI unsigned pk2(float lo, float hi) { return (unsigned)f2bf(lo) | ((unsigned)f2bf(hi) << 16); }
DEVI float bflo(unsigned u) { return __uint_as_float(u << 16); }
DEVI float bfhi(unsigned u) { return __uint_as_float(u & 0xffff0000u); }
DEVI float sigm(float x) { return 1.f / (1.f + __expf(-x)); }
DEVI float silu(float x) { return x * sigm(x); }
DEVI float softplus(float x) { return fmaxf(x, 0.f) + log1pf(__expf(-fabsf(x))); }
DEVI int otid() { int t = threadIdx.x; asm volatile("" : "+v"(t)); return t; }
DEVI float wave_sum(float v) {
#pragma unroll
  for (int o = 32; o > 0; o >>= 1) v += __shfl_xor(v, o);
  return v;
}
template <int CTRL> DEVI float dpp_f(float v) {
  return __int_as_float(__builtin_amdgcn_update_dpp(0, __float_as_int(v), CTRL, 0xf, 0xf, false));
}
DEVI float row16_sum(float v) {
  float r;
  asm("s_nop 1\n\tv_add_f32_dpp %0, %1, %1 row_ror:8 row_mask:0xf bank_mask:0xf" : "=v"(r) : "v"(v));
  asm("s_nop 1\n\tv_add_f32_dpp %0, %1, %1 row_ror:4 row_mask:0xf bank_mask:0xf" : "=v"(v) : "v"(r));
  asm("s_nop 1\n\tv_add_f32_dpp %0, %1, %1 row_ror:2 row_mask:0xf bank_mask:0xf" : "=v"(r) : "v"(v));
  asm("s_nop 1\n\tv_add_f32_dpp %0, %1, %1 row_ror:1 row_mask:0xf bank_mask:0xf" : "=v"(v) : "v"(r));
  return v;
}

DEVI void tr_seg(const float* __restrict__ src, int ld, int K, int ncols, u16* __restrict__ dst, int dld, float* tile, int& off) {
  const int tid_ = otid();
  const int lane = tid_ & 63, gw = blockIdx.x * 8 + (tid_ >> 6), nw = gridDim.x * 8;
  const int nkb = K >> 4, nnb = ncols >> 6, nt = nkb * nnb;
  const int start = (int)(((long)gw + (long)nw * 4096 - off) % nw);
  for (int t = start; t < nt; t += nw) {
    const int kb = t % nkb, nb = t / nkb;
    const float* sp = src + (size_t)(kb * 16) * ld + nb * 64 + lane;
    float v[16];
#pragma unroll
    for (int i = 0; i < 16; ++i) v[i] = sp[(size_t)i * ld];
    uint4 o0, o1;
    o0.x = pk2(v[0], v[1]); o0.y = pk2(v[2], v[3]); o0.z = pk2(v[4], v[5]); o0.w = pk2(v[6], v[7]);
    o1.x = pk2(v[8], v[9]); o1.y = pk2(v[10], v[11]); o1.z = pk2(v[12], v[13]); o1.w = pk2(v[14], v[15]);
    u16* dp = dst + (size_t)(nb * 64 + lane) * dld + kb * 16;
    *(uint4*)dp = o0;
    *(uint4*)(dp + 8) = o1;
  }
  off += nt;
}

DEVI void phase_wprep(const Params& p, float* tile) {
  int off = 0;
  u16* wt_in = (u16*)(p.ws + WS_WT_IN);
  u16* wt_gate = (u16*)(p.ws + WS_WT_GATE);
  u16* wt_br = (u16*)(p.ws + WS_WT_BR);
  u16* wt_out = (u16*)(p.ws + WS_WT_OUT);
  u16* wt_up = (u16*)(p.ws + WS_WT_UP);
  u16* wt_dn = (u16*)(p.ws + WS_WT_DN);
  for (int l = 0; l < 2; ++l) {
    const float* win = p.w_in + (size_t)l * 1024 * INC;
    for (int s = 0; s < 12; ++s) {
      const int srccol = (s < 4) ? s * 512 : (s < 8 ? 2056 + (s - 4) * 512 : 4112 + (s - 8) * 512);
      tr_seg(win + srccol, INC, 1024, 512, wt_in + ((size_t)l * NPROJ_PAD + s * 512) * LDW1, LDW1, tile, off);
    }
    tr_seg(win + 6160, INC, 1024, 3072, wt_gate + (size_t)l * 3072 * LDW1, LDW1, tile, off);
    for (int b = 0; b < 3; ++b)
      tr_seg(p.w_branch + (size_t)(l * 3 + b) * 512 * 1024, 1024, 512, 1024, wt_br + (size_t)(l * 3 + b) * 1024 * LDWB, LDWB, tile, off);
    tr_seg(p.w_out + (size_t)l * 1024 * 1024, 1024, 1024, 1024, wt_out + (size_t)l * 1024 * LDW1, LDW1, tile, off);
    tr_seg(p.w_up + (size_t)l * 1024 * 4096, 4096, 1024, 4096, wt_up + (size_t)l * 4096 * LDW1, LDW1, tile, off);
    tr_seg(p.w_down + (size_t)l * 4096 * 1024, 1024, 4096, 1024, wt_dn + (size_t)l * 1024 * LDWD, LDWD, tile, off);
  }
  for (int idx = blockIdx.x * NTHREADS + otid(); idx < 2 * 128 * 1024; idx += gridDim.x * NTHREADS) {
    const int l = idx >> 17, rem = idx & 131071, r = rem >> 10, k = rem & 1023;
    float v = 0.f;
    if (r < 16) {
      const int sc = (r < 8) ? 2048 + r : 4104 + (r - 8);
      v = p.w_in[(size_t)l * 1024 * INC + (size_t)k * INC + sc];
    }
    wt_in[((size_t)l * NPROJ_PAD + 6144 + r) * LDW1 + k] = f2bf(v);
  }
}

DEVI void phase_norm(const float* xp, const float* xs, const float* __restrict__ w, u16* __restrict__ xn) {
  const int tid_ = otid(); const int lane = tid_ & 63, gw = blockIdx.x * 8 + (tid_ >> 6), nw = gridDim.x * 8;
  for (int m = gw; m < M; m += nw) {
    const float* xr = (m < MP) ? xp + (size_t)m * D : xs + (size_t)(m - MP) * D;
    float4 v[4];
    float ss = 0.f;
#pragma unroll
    for (int i = 0; i < 4; ++i) {
      v[i] = ((const float4*)xr)[lane + 64 * i];
      ss += v[i].x * v[i].x + v[i].y * v[i].y + v[i].z * v[i].z + v[i].w * v[i].w;
    }
    ss = wave_sum(ss);
    const float rstd = rsqrtf(ss * (1.f / 1024.f) + 1e-6f);
#pragma unroll
    for (int i = 0; i < 4; ++i) {
      const float4 wv = ((const float4*)w)[lane + 64 * i];
      uint2 o;
      o.x = pk2(v[i].x * rstd * wv.x, v[i].y * rstd * wv.y);
      o.y = pk2(v[i].z * rstd * wv.z, v[i].w * rstd * wv.w);
      ((uint2*)(xn + (size_t)m * LDX))[lane + 64 * i] = o;
    }
  }
}

DEVI void phase_final_norm(float* x, const float* __restrict__ w) {
  const int tid_ = otid(); const int lane = tid_ & 63, gw = blockIdx.x * 8 + (tid_ >> 6), nw = gridDim.x * 8;
  for (int m = gw; m < M; m += nw) {
    float* xr = x + (size_t)m * D;
    float4 v[4];
    float ss = 0.f;
#pragma unroll
    for (int i = 0; i < 4; ++i) {
      v[i] = ((const float4*)xr)[lane + 64 * i];
      ss += v[i].x * v[i].x + v[i].y * v[i].y + v[i].z * v[i].z + v[i].w * v[i].w;
    }
    ss = wave_sum(ss);
    const float rstd = rsqrtf(ss * (1.f / 1024.f) + 1e-6f);
#pragma unroll
    for (int i = 0; i < 4; ++i) {
      const float4 wv = ((const float4*)w)[lane + 64 * i];
      float4 o;
      o.x = v[i].x * rstd * wv.x; o.y = v[i].y * rstd * wv.y; o.z = v[i].z * rstd * wv.z; o.w = v[i].w * rstd * wv.w;
      ((float4*)xr)[lane + 64 * i] = o;
    }
  }
}

constexpr int LDS_S = 64;
template <int WMT, int WNT>
DEVI void gemm_core(const u16* __restrict__ A, int lda, const u16* __restrict__ B, int ldb, int K,
                    f32x4 (&acc)[WMT][WNT], u16* smem) {
  constexpr int BM = 64 * WMT, BN = 32 * WNT;
  constexpr int ACH = BM * 8 / NTHREADS, BCH = BN * 8 / NTHREADS;
  u16* sA = smem;
  u16* sB = smem + 2 * BM * LDS_S;
  const int tid = otid(), lane = tid & 63, w = tid >> 6, wm = w >> 1, wn = w & 1;
  const int fr = lane & 15, fq = lane >> 4;
  const int crow = tid >> 3, ckc = tid & 7;
  const int wsw = (ckc ^ (crow & 7)) * 8;
  const int rsw0 = (fq ^ (fr & 7)) * 8;
  static_assert(BCH == 2 && (ACH == 2 || ACH == 4), "chunk counts");
  uint4 pa0, pa1, pa2, pa3, pb0, pb1, qa0, qa1, qa2, qa3, qb0, qb1;
  pa2 = uint4{0, 0, 0, 0}; pa3 = pa2; qa2 = pa2; qa3 = pa2;
  const u16* Ag = A + (size_t)crow * lda + ckc * 8;
  const u16* Bg = B + (size_t)crow * ldb + ckc * 8;
  const int nk = K >> 6;
#define GLOAD(S, KO)                                                                  \
  do {                                                                                \
    S##a0 = *(const uint4*)(Ag + (KO));                                               \
    S##a1 = *(const uint4*)(Ag + (size_t)64 * lda + (KO));                            \
    if (ACH == 4) {                                                                   \
      S##a2 = *(const uint4*)(Ag + (size_t)128 * lda + (KO));                         \
      S##a3 = *(const uint4*)(Ag + (size_t)192 * lda + (KO));                         \
    }                                                                                 \
    S##b0 = *(const uint4*)(Bg + (KO));                                               \
    S##b1 = *(const uint4*)(Bg + (size_t)64 * ldb + (KO));                            \
  } while (0)
#define SSTORE(S, NB)                                                                 \
  do {                                                                                \
    u16* dA = sA + ((NB) * BM + crow) * LDS_S + wsw;                                  \
    u16* dB = sB + ((NB) * BN + crow) * LDS_S + wsw;                                  \
    *(uint4*)(dA) = S##a0;                                                            \
    *(uint4*)(dA + 64 * LDS_S) = S##a1;                                               \
    if (ACH == 4) {                                                                   \
      *(uint4*)(dA + 128 * LDS_S) = S##a2;                                            \
      *(uint4*)(dA + 192 * LDS_S) = S##a3;                                            \
    }                                                                                 \
    *(uint4*)(dB) = S##b0;                                                            \
    *(uint4*)(dB + 64 * LDS_S) = S##b1;                                               \
  } while (0)
#define LOADFR(BUF)                                                                   \
  do {                                                                                \
    const u16* cA = sA + ((BUF) * BM + wm * 16 * WMT + fr) * LDS_S;                   \
    const u16* cB = sB + ((BUF) * BN + wn * 16 * WNT + fr) * LDS_S;                   \
    _Pragma("unroll") for (int ks = 0; ks < 2; ++ks) {                                \
      const int so = rsw0 ^ (ks * 32);                                                \
      _Pragma("unroll") for (int i = 0; i < WMT; ++i) af[ks][i] = *(const bf16x8*)(cA + i * 16 * LDS_S + so);  \
      _Pragma("unroll") for (int j = 0; j < WNT; ++j) bfr[ks][j] = *(const bf16x8*)(cB + j * 16 * LDS_S + so); \
    }                                                                                 \
  } while (0)
#define MFMAS()                                                                       \
  do {                                                                                \
    _Pragma("unroll") for (int ks = 0; ks < 2; ++ks)                                  \
      _Pragma("unroll") for (int i = 0; i < WMT; ++i)                                 \
        _Pragma("unroll") for (int j = 0; j < WNT; ++j)                               \
          acc[i][j] = __builtin_amdgcn_mfma_f32_16x16x32_bf16(bfr[ks][j], af[ks][i], acc[i][j], 0, 0, 0);  \
  } while (0)
  bf16x8 af[2][WMT], bfr[2][WNT];
  GLOAD(p, 0);
  SSTORE(p, 0);
  __builtin_amdgcn_sched_barrier(0);
  GLOAD(q, 64);
  __builtin_amdgcn_sched_barrier(0);
  GLOAD(p, 128);
  __builtin_amdgcn_sched_barrier(0);
  __syncthreads();
#pragma unroll 1
  for (int kt = 0; kt < nk; kt += 2) {
    LOADFR(0);
    __builtin_amdgcn_sched_barrier(0);
    SSTORE(q, 1);
    const int k3 = (kt + 3 < nk) ? kt + 3 : nk - 1;
    GLOAD(q, k3 * 64);
    __builtin_amdgcn_sched_barrier(0);
    MFMAS();
    __builtin_amdgcn_sched_barrier(0);
    __syncthreads();
    LOADFR(1);
    __builtin_amdgcn_sched_barrier(0);
    SSTORE(p, 0);
    const int k4 = (kt + 4 < nk) ? kt + 4 : nk - 1;
    GLOAD(p, k4 * 64);
    __builtin_amdgcn_sched_barrier(0);
    MFMAS();
    __builtin_amdgcn_sched_barrier(0);
    __syncthreads();
  }
#undef GLOAD
#undef SSTORE
#undef LOADFR
#undef MFMAS
}

DEVI bool tile_map(int it, int vcu, int MT, int NT, int& mt, int& nt) {
  const int G = gridDim.x;
  const int t = it * G + vcu;
  if (t >= MT * NT) return false;
  constexpr int GM = 4;
  const int gsize = GM * NT;
  const int g = t / gsize, tl = t - g * gsize;
  int gsz = MT - g * GM;
  if (gsz > GM) gsz = GM;
  mt = g * GM + (tl % gsz);
  nt = tl / gsz;
  return true;
}

template <int WMT, int WNT>
DEVI void zero_acc(f32x4 (&acc)[WMT][WNT]) {
#pragma unroll
  for (int i = 0; i < WMT; ++i)
#pragma unroll
    for (int j = 0; j < WNT; ++j) acc[i][j] = f32x4{0.f, 0.f, 0.f, 0.f};
}


DEVI void gemm_core_big(const u16* __restrict__ A, int lda, const u16* __restrict__ B, int ldb, int K,
                        f32x4 (&acc)[4][8], u16* smem) {
  u16* sA = smem;
  u16* sB = smem + 2 * 256 * LDS_S;
  const int tid = otid(), lane = tid & 63, w = tid >> 6, wm = w >> 1, wn = w & 1;
  const int fr = lane & 15, fq = lane >> 4;
  const int crow = tid >> 3, ckc = tid & 7;
  const int wsw = (ckc ^ (crow & 7)) * 8;
  const int rsw0 = (fq ^ (fr & 7)) * 8;
  uint4 pa0, pa1, pa2, pa3, pb0, pb1, pb2, pb3;
  const u16* Ag = A + (size_t)crow * lda + ckc * 8;
  const u16* Bg = B + (size_t)crow * ldb + ckc * 8;
  const int nk = K >> 6;
#define BGLOAD(KO)                                                                    \
  do {                                                                                \
    pa0 = *(const uint4*)(Ag + (KO));                                                 \
    pa1 = *(const uint4*)(Ag + (size_t)64 * lda + (KO));                              \
    pa2 = *(const uint4*)(Ag + (size_t)128 * lda + (KO));                             \
    pa3 = *(const uint4*)(Ag + (size_t)192 * lda + (KO));                             \
    pb0 = *(const uint4*)(Bg + (KO));                                                 \
    pb1 = *(const uint4*)(Bg + (size_t)64 * ldb + (KO));                              \
    pb2 = *(const uint4*)(Bg + (size_t)128 * ldb + (KO));                             \
    pb3 = *(const uint4*)(Bg + (size_t)192 * ldb + (KO));                             \
  } while (0)
#define BSSTORE(NB)                                                                   \
  do {                                                                                \
    u16* dA = sA + ((NB) * 256 + crow) * LDS_S + wsw;                                 \
    u16* dB = sB + ((NB) * 256 + crow) * LDS_S + wsw;                                 \
    *(uint4*)(dA) = pa0;                                                              \
    *(uint4*)(dA + 64 * LDS_S) = pa1;                                                 \
    *(uint4*)(dA + 128 * LDS_S) = pa2;                                                \
    *(uint4*)(dA + 192 * LDS_S) = pa3;                                                \
    *(uint4*)(dB) = pb0;                                                              \
    *(uint4*)(dB + 64 * LDS_S) = pb1;                                                 \
    *(uint4*)(dB + 128 * LDS_S) = pb2;                                                \
    *(uint4*)(dB + 192 * LDS_S) = pb3;                                                \
  } while (0)
#define BLOADFR(BUF, KS)                                                              \
  do {                                                                                \
    const u16* cA = sA + ((BUF) * 256 + wm * 64 + fr) * LDS_S + (rsw0 ^ ((KS) * 32)); \
    const u16* cB = sB + ((BUF) * 256 + wn * 128 + fr) * LDS_S + (rsw0 ^ ((KS) * 32)); \
    _Pragma("unroll") for (int i = 0; i < 4; ++i) af[i] = *(const bf16x8*)(cA + i * 16 * LDS_S);  \
    _Pragma("unroll") for (int j = 0; j < 8; ++j) bfr[j] = *(const bf16x8*)(cB + j * 16 * LDS_S); \
  } while (0)
#define BMFMAS()                                                                      \
  do {                                                                                \
    _Pragma("unroll") for (int i = 0; i < 4; ++i)                                     \
      _Pragma("unroll") for (int j = 0; j < 8; ++j)                                   \
        acc[i][j] = __builtin_amdgcn_mfma_f32_16x16x32_bf16(bfr[j], af[i], acc[i][j], 0, 0, 0);  \
  } while (0)
#define BHALF(BUF, KNEXT)                                                             \
  do {                                                                                \
    BLOADFR(BUF, 0);                                                                  \
    __builtin_amdgcn_sched_barrier(0);                                                \
    BSSTORE((BUF) ^ 1);                                                               \
    BGLOAD((KNEXT) * 64);                                                             \
    __builtin_amdgcn_sched_barrier(0);                                                \
    BMFMAS();                                                                         \
    __builtin_amdgcn_sched_barrier(0);                                                \
    BLOADFR(BUF, 1);                                                                  \
    __builtin_amdgcn_sched_barrier(0);                                                \
    BMFMAS();                                                                         \
    __builtin_amdgcn_sched_barrier(0);                                                \
    __syncthreads();                                                                  \
  } while (0)
  bf16x8 af[4], bfr[8];
  BGLOAD(0);
  BSSTORE(0);
  __builtin_amdgcn_sched_barrier(0);
  BGLOAD(64);
  __builtin_amdgcn_sched_barrier(0);
  __syncthreads();
#pragma unroll 1
  for (int kt = 0; kt < nk; kt += 2) {
    const int k2 = (kt + 2 < nk) ? kt + 2 : nk - 1;
    BHALF(0, k2);
    const int k3 = (kt + 3 < nk) ? kt + 3 : nk - 1;
    BHALF(1, k3);
  }
#undef BGLOAD
#undef BSSTORE
#undef BLOADFR
#undef BMFMAS
#undef BHALF
}

DEVI void phase_proj(const Params& p, int l, int vcu, u16* smem) {
  const u16* xn = (const u16*)(p.ws + WS_XN);
  const u16* wt = (const u16*)(p.ws + WS_WT_IN) + (size_t)l * NPROJ_PAD * LDW1;
  u16* proj = (u16*)(p.ws + WS_PROJ);
  float* small = (float*)(p.ws + WS_SMALL);
  const int tid_ = otid(); const int lane = tid_ & 63, w = tid_ >> 6, wm = w >> 1, wn = w & 1, fr = lane & 15, fq = lane >> 4;
  constexpr int NT = 25, MT = M / 256;
  for (int it = 0; it * (int)gridDim.x < MT * NT; ++it) {
    int mt, nt;
    if (!tile_map(it, vcu, MT, NT, mt, nt)) break;
    const int m0 = mt * 256, n0 = nt * 256;
    f32x4 acc[4][8];
    zero_acc(acc);
    gemm_core_big(xn + (size_t)m0 * LDX, LDX, wt + (size_t)n0 * LDW1, LDW1, 1024, acc, smem);
#pragma unroll
    for (int i = 0; i < 4; ++i)
#pragma unroll
      for (int j = 0; j < 8; ++j) {
        const int m = m0 + wm * 64 + i * 16 + fr, n = n0 + wn * 128 + j * 16 + fq * 4;
        if (n < NPROJ) {
          uint2 o;
          o.x = pk2(acc[i][j][0], acc[i][j][1]);
          o.y = pk2(acc[i][j][2], acc[i][j][3]);
          *(uint2*)(proj + (size_t)m * NPROJ + n) = o;
        } else if (n < NPROJ + 16) {
          *(float4*)(small + (size_t)m * 16 + (n - NPROJ)) = float4{acc[i][j][0], acc[i][j][1], acc[i][j][2], acc[i][j][3]};
        }
      }
  }
}

DEVI void phase_up(const Params& p, int l, int vcu, u16* smem) {
  const u16* xn = (const u16*)(p.ws + WS_XN);
  const u16* wt = (const u16*)(p.ws + WS_WT_UP) + (size_t)l * 4096 * LDW1;
  u16* hid = (u16*)(p.ws + WS_PROJ);
  const int tid_ = otid(); const int lane = tid_ & 63, w = tid_ >> 6, wm = w >> 1, wn = w & 1, fr = lane & 15, fq = lane >> 4;
  constexpr int NT = DFF / 256, MT = M / 256;
  for (int it = 0; it * (int)gridDim.x < MT * NT; ++it) {
    int mt, nt;
    if (!tile_map(it, vcu, MT, NT, mt, nt)) break;
    const int m0 = mt * 256, n0 = nt * 256;
    f32x4 acc[4][8];
    zero_acc(acc);
    gemm_core_big(xn + (size_t)m0 * LDX, LDX, wt + (size_t)n0 * LDW1, LDW1, 1024, acc, smem);
#pragma unroll
    for (int i = 0; i < 4; ++i)
#pragma unroll
      for (int j = 0; j < 8; ++j) {
        const int m = m0 + wm * 64 + i * 16 + fr, n = n0 + wn * 128 + j * 16 + fq * 4;
        float r0 = fmaxf(acc[i][j][0], 0.f), r1 = fmaxf(acc[i][j][1], 0.f), r2 = fmaxf(acc[i][j][2], 0.f), r3 = fmaxf(acc[i][j][3], 0.f);
        uint2 o;
        o.x = pk2(r0 * r0, r1 * r1);
        o.y = pk2(r2 * r2, r3 * r3);
        *(uint2*)(hid + (size_t)m * LDH + n) = o;
      }
  }
}

DEVI void phase_merge(const Params& p, int l, int vcu, u16* smem) {
  const u16* xn = (const u16*)(p.ws + WS_XN);
  const u16* y = (const u16*)(p.ws + WS_OBUF);
  const u16* wg = (const u16*)(p.ws + WS_WT_GATE) + (size_t)l * 3072 * LDW1;
  const u16* wb = (const u16*)(p.ws + WS_WT_BR) + (size_t)l * 3 * 1024 * LDWB;
  u16* merged = (u16*)(p.ws + WS_CONV);
  const int tid_ = otid(); const int lane = tid_ & 63, w = tid_ >> 6, wm = w >> 1, wn = w & 1, fr = lane & 15, fq = lane >> 4;
  constexpr int NT = D / 128, MT = M / 128;
  for (int it = 0; it * (int)gridDim.x < MT * NT; ++it) {
    int mt, nt;
    if (!tile_map(it, vcu, MT, NT, mt, nt)) break;
    const int m0 = mt * 128, n0 = nt * 128;
    f32x4 accM[2][4];
    zero_acc(accM);
#pragma unroll 1
    for (int b = 0; b < 3; ++b) {
      f32x4 accG[2][4], accB[2][4];
      zero_acc(accG);
      zero_acc(accB);
      gemm_core<2, 4>(xn + (size_t)m0 * LDX, LDX, wg + ((size_t)b * 1024 + n0) * LDW1, LDW1, 1024, accG, smem);
      gemm_core<2, 4>(y + (size_t)m0 * LDY + b * 512, LDY, wb + ((size_t)b * 1024 + n0) * LDWB, LDWB, 512, accB, smem);
#pragma unroll
      for (int i = 0; i < 2; ++i)
#pragma unroll
        for (int j = 0; j < 4; ++j)
#pragma unroll
          for (int r = 0; r < 4; ++r) accM[i][j][r] += sigm(accG[i][j][r]) * accB[i][j][r];
    }
#pragma unroll
    for (int i = 0; i < 2; ++i)
#pragma unroll
      for (int j = 0; j < 4; ++j) {
        const int m = m0 + wm * 32 + i * 16 + fr, n = n0 + wn * 64 + j * 16 + fq * 4;
        uint2 o;
        o.x = pk2(accM[i][j][0], accM[i][j][1]);
        o.y = pk2(accM[i][j][2], accM[i][j][3]);
        *(uint2*)(merged + (size_t)m * LDX + n) = o;
      }
  }
}

DEVI void phase_resid(const u16* A, int lda, int K, const u16* wt, int ldb, const float* xin_p, const float* xin_s, float* xout, int vcu, u16* smem) {
  const int tid_ = otid(); const int lane = tid_ & 63, w = tid_ >> 6, wm = w >> 1, wn = w & 1, fr = lane & 15, fq = lane >> 4;
  constexpr int NT = D / 128, MT = M / 128;
  for (int it = 0; it * (int)gridDim.x < MT * NT; ++it) {
    int mt, nt;
    if (!tile_map(it, vcu, MT, NT, mt, nt)) break;
    const int m0 = mt * 128, n0 = nt * 128;
    f32x4 acc[2][4];
    zero_acc(acc);
    gemm_core<2, 4>(A + (size_t)m0 * lda, lda, wt + (size_t)n0 * ldb, ldb, K, acc, smem);
#pragma unroll
    for (int i = 0; i < 2; ++i)
#pragma unroll
      for (int j = 0; j < 4; ++j) {
        const int m = m0 + wm * 32 + i * 16 + fr, n = n0 + wn * 64 + j * 16 + fq * 4;
        const float* xr = (m < MP) ? xin_p + (size_t)m * D : xin_s + (size_t)(m - MP) * D;
        const float4 xv = *(const float4*)(xr + n);
        float4 o;
        o.x = xv.x + acc[i][j][0]; o.y = xv.y + acc[i][j][1]; o.z = xv.z + acc[i][j][2]; o.w = xv.w + acc[i][j][3];
        *(float4*)(xout + (size_t)m * D + n) = o;
      }
  }
}

DEVI void phase_prep(const Params& p, int l) {
  const int tid_ = otid(); const int lane = tid_ & 63, gw = blockIdx.x * 8 + (tid_ >> 6), nw = gridDim.x * 8;
  u16* proj = (u16*)(p.ws + WS_PROJ);
  u16* conv = (u16*)(p.ws + WS_CONV);
  const float* small = (const float*)(p.ws + WS_SMALL);
  float* gates = (float*)(p.ws + WS_GATES);
  constexpr int NTASK = (M / 4) * 21;
  for (int task = gw; task < NTASK; task += nw) {
    const int tg = task / 21, k = task - tg * 21;
    const int m0 = tg * 4;
    const bool samp = m0 >= MP;
    int b, t0;
    if (!samp) { b = m0 >> 11; t0 = m0 & 2047; } else { b = (m0 - MP) >> 2; t0 = 0; }
    if (k < 12) {
      const int pp = k >> 2, hh = k & 3;
      const int ch = pp * 512 + hh * 128 + lane * 2;
      const u16* src = proj + 2048 + ch;
      float rx[7], ry[7];
#pragma unroll
      for (int j = 0; j < 7; ++j) {
        const int t = t0 - 3 + j;
        if (t >= 0) {
          const unsigned u = *(const unsigned*)(src + (size_t)(m0 - 3 + j) * NPROJ);
          rx[j] = bflo(u); ry[j] = bfhi(u);
        } else if (samp) {
          const float2 cs = *(const float2*)(p.st_gconv + ((size_t)(l * 128 + b) * 3 + j) * 1536 + ch);
          rx[j] = cs.x; ry[j] = cs.y;
        } else { rx[j] = 0.f; ry[j] = 0.f; }
      }
      float cwx[4], cwy[4];
#pragma unroll
      for (int j = 0; j < 4; ++j) {
        const float2 c2 = *(const float2*)(p.gd_conv_w + (size_t)(l * 4 + j) * 1536 + ch);
        cwx[j] = c2.x; cwy[j] = c2.y;
      }
#pragma unroll
      for (int tt = 0; tt < 4; ++tt) {
        float ax = 0.f, ay = 0.f;
#pragma unroll
        for (int j = 0; j < 4; ++j) { ax += cwx[j] * rx[tt + j]; ay += cwy[j] * ry[tt + j]; }
        ax = silu(ax); ay = silu(ay);
        if (pp < 2) {
          float ss = wave_sum(ax * ax + ay * ay);
          float sc = rsqrtf(ss + 1e-6f);
          if (pp == 0) sc *= 0.08838834764831845f;
          ax *= sc; ay *= sc;
        }
        *(unsigned*)(conv + (size_t)(m0 + tt) * 1536 + ch) = pk2(ax, ay);
      }
      const bool last = samp || (t0 == 2044);
      if (last) {
        float* co = p.out + (samp ? OFF_S_GC + (size_t)(l * 128 + b) * 3 * 1536 : OFF_P_GC + (size_t)(l * 8 + b) * 3 * 1536) + ch;
#pragma unroll
        for (int j = 0; j < 3; ++j) *(float2*)(co + j * 1536) = float2{rx[4 + j], ry[4 + j]};
      }
    } else if (k < 20) {
      const int kk = k - 12, part = kk >> 2, hh = kk & 3;
      const int wch = hh * 128 + lane * 2;
      u16* col = proj + 4096 + part * 512 + wch;
      float lb0 = 0.f, lb1 = 0.f;
      if (part == 1 && l == 1) {
        lb0 = sigm(p.hg_lb_logits[512 + wch] - p.hg_lb_logits[wch]);
        lb1 = sigm(p.hg_lb_logits[512 + wch + 1] - p.hg_lb_logits[wch + 1]);
      }
      unsigned u[4];
#pragma unroll
      for (int tt = 0; tt < 4; ++tt) u[tt] = *(const unsigned*)(col + (size_t)(m0 + tt) * NPROJ);
#pragma unroll
      for (int tt = 0; tt < 4; ++tt) {
        float a = bflo(u[tt]), c = bfhi(u[tt]);
        if (part == 0) { a = silu(a); c = silu(c); }
        else { a = (1.f - lb0) * sigm(-a); c = (1.f - lb1) * sigm(-c); }
        *(unsigned*)(col + (size_t)(m0 + tt) * NPROJ) = pk2(a, c);
      }
    } else {
      const int tt = lane >> 4, g = lane & 15, hh = g & 3;
      const float v = small[(size_t)(m0 + tt) * 16 + g];
      float r;
      if (g < 4) r = v + p.ml_i_bias[l * 4 + hh];
      else if (g < 8) { const float x = v + p.ml_f_bias[l * 4 + hh]; r = -softplus(-x); }
      else if (g < 12) r = sigm(v);
      else { const float x = v + p.gd_dt_bias[l * 4 + hh]; r = __expf(-__expf(p.gd_A_log[l * 4 + hh]) * softplus(x)); }
      gates[(size_t)(m0 + tt) * 16 + g] = r;
    }
  }
}

template <int KIND>
DEVI void scan_unit(const Params& p, int l, bool samp, int b, int h, int colbase, float* smem) {
  constexpr int CPL = (KIND == 1) ? 1 : 2;
  constexpr int UC = 32 * CPL;
  constexpr int VCH = UC / 8;
  const int tid = otid(), lane = tid & 63, w = tid >> 6, kg = lane & 15, cl = lane >> 4;
  const int T = samp ? 4 : 2048;
  const int rowbase = samp ? (MP + b * 4) : b * 2048;
  const int NB = samp ? 128 : 8;
  const u16* proj = (const u16*)(p.ws + WS_PROJ);
  const u16* conv = (const u16*)(p.ws + WS_CONV);
  u16* obuf = (u16*)(p.ws + WS_OBUF);
  const float* gates = (const float*)(p.ws + WS_GATES);
  float* dm = (float*)(p.ws + WS_DM);
  const u16 *qsrc, *ksrc, *vsrc;
  int ld, ocol;
  const float* Sin;
  float* Sout;
  const size_t sidx_in = ((size_t)(l * 128 + b) * 4 + h) * 16384;
  const size_t sidx_out = ((size_t)(l * NB + b) * 4 + h) * 16384;
  if (KIND == 0) {
    qsrc = proj + h * 128; ksrc = proj + 512 + h * 128; vsrc = proj + 1024 + h * 128 + colbase; ld = NPROJ; ocol = 0;
    Sin = p.st_mC + sidx_in; Sout = p.out + (samp ? OFF_S_MC : OFF_P_MC) + sidx_out;
  } else if (KIND == 1) {
    qsrc = conv + h * 128; ksrc = conv + 512 + h * 128; vsrc = conv + 1024 + h * 128 + colbase; ld = 1536; ocol = 512;
    Sin = p.st_gS + sidx_in; Sout = p.out + (samp ? OFF_S_GS : OFF_P_GS) + sidx_out;
  } else {
    qsrc = proj + 4096 + h * 128; ksrc = proj + 4608 + h * 128; vsrc = proj + 5120 + h * 128 + colbase; ld = NPROJ; ocol = 1024;
    Sin = p.st_hS + sidx_in; Sout = p.out + (samp ? OFF_S_HS : OFF_P_HS) + sidx_out;
  }
  float* qk = smem;
  float* vl = smem + 2 * 32 * 256;
  float* gl = vl + 2 * 32 * 64;

  const int wc = w * 4 * CPL + cl * CPL;
  const int col0 = colbase + wc;
  v2f S[CPL][4];
  v2f nv[4];
#pragma unroll
  for (int c = 0; c < CPL; ++c)
#pragma unroll
    for (int i = 0; i < 4; ++i) {
      if (samp) { S[c][i].x = Sin[(size_t)(kg * 8 + 2 * i) * 128 + col0 + c]; S[c][i].y = Sin[(size_t)(kg * 8 + 2 * i + 1) * 128 + col0 + c]; }
      else { S[c][i].x = 0.f; S[c][i].y = 0.f; }
    }
  float mstart = 0.f;
  if (KIND == 0) {
    const size_t nidx = ((size_t)(l * 128 + b) * 4 + h) * 128;
#pragma unroll
    for (int i = 0; i < 4; ++i) {
      if (samp) { nv[i].x = p.st_mn[nidx + kg * 8 + 2 * i]; nv[i].y = p.st_mn[nidx + kg * 8 + 2 * i + 1]; }
      else { nv[i].x = 0.f; nv[i].y = 0.f; }
    }
    if (samp) mstart = p.st_mm[(size_t)(l * 128 + b) * 4 + h];
  }

  uint4 rq, rk, rv;
  float g0 = 0.f, g1 = 0.f;
  const int sr = tid >> 4, sc = tid & 15;
  const int vr = tid / VCH, vc = tid % VCH;
  auto prefetch = [&](int j) {
    const int t = j * 32 + sr;
    rq = uint4{0, 0, 0, 0}; rk = uint4{0, 0, 0, 0}; rv = uint4{0, 0, 0, 0};
    if (t < T) {
      rq = *(const uint4*)(qsrc + (size_t)(rowbase + t) * ld + sc * 8);
      rk = *(const uint4*)(ksrc + (size_t)(rowbase + t) * ld + sc * 8);
    }
    if (tid < 32 * VCH) {
      const int tv = j * 32 + vr;
      if (tv < T) rv = *(const uint4*)(vsrc + (size_t)(rowbase + tv) * ld + vc * 8);
    }
    if (KIND != 2) {
      g0 = (KIND == 0) ? -1e30f : 0.f; g1 = 0.f;
      if (tid < 32) {
        const int tg = j * 32 + tid;
        if (tg < T) {
          if (KIND == 0) { g0 = gates[(size_t)(rowbase + tg) * 16 + h]; g1 = gates[(size_t)(rowbase + tg) * 16 + 4 + h]; }
          else { g0 = gates[(size_t)(rowbase + tg) * 16 + 8 + h]; g1 = gates[(size_t)(rowbase + tg) * 16 + 12 + h]; }
        }
      }
    }
  };
  auto stage = [&](int j, int buf) {
    float* qd = qk + (buf * 32 + sr) * 256 + sc * 8;
    *(float4*)(qd) = float4{bflo(rq.x), bfhi(rq.x), bflo(rq.y), bfhi(rq.y)};
    *(float4*)(qd + 4) = float4{bflo(rq.z), bfhi(rq.z), bflo(rq.w), bfhi(rq.w)};
    *(float4*)(qd + 128) = float4{bflo(rk.x), bfhi(rk.x), bflo(rk.y), bfhi(rk.y)};
    *(float4*)(qd + 132) = float4{bflo(rk.z), bfhi(rk.z), bflo(rk.w), bfhi(rk.w)};
    if (tid < 32 * VCH) {
      float* vd = vl + (buf * 32 + vr) * 64 + vc * 8;
      *(float4*)(vd) = float4{bflo(rv.x), bfhi(rv.x), bflo(rv.y), bfhi(rv.y)};
      *(float4*)(vd + 4) = float4{bflo(rv.z), bfhi(rv.z), bflo(rv.w), bfhi(rv.w)};
    }
    if (KIND == 0) {
      if (w == 0) {
        float bs = g1;
#pragma unroll
        for (int d = 1; d < 32; d <<= 1) { const float o = __shfl_up(bs, d); if (lane >= d) bs += o; }
        float R = g0 - bs;
#pragma unroll
        for (int d = 1; d < 32; d <<= 1) { const float o = __shfl_up(R, d); if (lane >= d) R = fmaxf(R, o); }
        const float mt = bs + fmaxf(mstart, R);
        float mprev = __shfl_up(mt, 1);
        if (lane == 0) mprev = mstart;
        const float fw = __expf(g1 + mprev - mt);
        const float iw = __expf(g0 - mt) * 0.08838834764831845f;
        if (lane < 32) {
          float* gd = gl + (buf * 32 + lane) * 4;
          gd[0] = fw; gd[1] = iw; gd[2] = mt;
        }
        int lastv = T - j * 32 - 1;
        if (lastv > 31) lastv = 31;
        mstart = __shfl(mt, lastv);
      }
    } else if (KIND == 1) {
      if (tid < 32) {
        float* gd = gl + (buf * 32 + tid) * 4;
        gd[0] = g0; gd[1] = g1;
      }
    }
  };

  const bool do_n = (KIND == 0) && (colbase == 0) && (w == 0);
  const int nblk = (T + 31) >> 5;
  prefetch(0);
  stage(0, 0);
  __syncthreads();
  for (int j = 0; j < nblk; ++j) {
    const int buf = j & 1;
    if (j + 1 < nblk) prefetch(j + 1);
    int steps = T - j * 32;
    if (steps > 32) steps = 32;
    u16* const obase = obuf + (size_t)(rowbase + j * 32) * LDY + ocol + h * 128 + col0;
    float* const dmbase = dm + (size_t)(rowbase + j * 32) * 8 + h;
    for (int t0 = 0; t0 < steps; t0 += 16) {
      int ns = steps - t0;
      if (ns > 16) ns = 16;
      float keep0 = 0.f, keep1 = 0.f, keepd = 0.f, keepm = 0.f;
#pragma unroll 4
      for (int tt = 0; tt < ns; ++tt) {
        const int t = t0 + tt;
        const float* qp = qk + (buf * 32 + t) * 256 + kg * 8;
        const float4 qa = *(const float4*)(qp), qb = *(const float4*)(qp + 4);
        const float4 ka = *(const float4*)(qp + 128), kb = *(const float4*)(qp + 132);
        const v2f q2[4] = {v2f{qa.x, qa.y}, v2f{qa.z, qa.w}, v2f{qb.x, qb.y}, v2f{qb.z, qb.w}};
        const v2f k2[4] = {v2f{ka.x, ka.y}, v2f{ka.z, ka.w}, v2f{kb.x, kb.y}, v2f{kb.z, kb.w}};
        const float* vp = vl + (buf * 32 + t) * 64 + wc;
        const float* gp = gl + (buf * 32 + t) * 4;
        const bool mine = (kg == tt);
        if (KIND == 0) {
          const float fw = gp[0], iw = gp[1];
          const v2f fw2 = v2f{fw, fw};
          const float2 vv = *(const float2*)vp;
          const float va[2] = {vv.x * iw, vv.y * iw};
          float num[2];
#pragma unroll
          for (int c = 0; c < 2; ++c) {
            const v2f vc2 = v2f{va[c], va[c]};
            v2f a = v2f{0.f, 0.f};
#pragma unroll
            for (int i = 0; i < 4; ++i) {
              S[c][i] = fw2 * S[c][i] + k2[i] * vc2;
              a += q2[i] * S[c][i];
            }
            num[c] = row16_sum(a.x + a.y);
          }
          keep0 = mine ? num[0] : keep0;
          keep1 = mine ? num[1] : keep1;
          if (do_n) {
            const v2f iw2 = v2f{iw, iw};
            v2f a = v2f{0.f, 0.f};
#pragma unroll
            for (int i = 0; i < 4; ++i) {
              nv[i] = fw2 * nv[i] + k2[i] * iw2;
              a += q2[i] * nv[i];
            }
            const float den = row16_sum(a.x + a.y);
            keepd = mine ? den : keepd;
            keepm = mine ? gp[2] : keepm;
          }
        } else if (KIND == 1) {
          const float beta = gp[0], g = gp[1];
          const float v = vp[0];
          v2f a = v2f{0.f, 0.f};
#pragma unroll
          for (int i = 0; i < 4; ++i) a += k2[i] * S[0][i];
          const float kS = row16_sum(a.x + a.y);
          const float vn = beta * (v - g * kS);
          const v2f g2 = v2f{g, g}, vn2 = v2f{vn, vn};
          v2f o2 = v2f{0.f, 0.f};
#pragma unroll
          for (int i = 0; i < 4; ++i) {
            S[0][i] = g2 * S[0][i] + k2[i] * vn2;
            o2 += q2[i] * S[0][i];
          }
          const float o = row16_sum(o2.x + o2.y);
          keep0 = mine ? o : keep0;
        } else {
          const float2 vv = *(const float2*)vp;
          const float va[2] = {vv.x, vv.y};
          float num[2];
#pragma unroll
          for (int c = 0; c < 2; ++c) {
            const v2f vc2 = v2f{va[c], va[c]};
            v2f a = v2f{0.f, 0.f};
#pragma unroll
            for (int i = 0; i < 4; ++i) {
              S[c][i] = S[c][i] + k2[i] * (vc2 - S[c][i]);
              a += q2[i] * S[c][i];
            }
            num[c] = row16_sum(a.x + a.y);
          }
          keep0 = mine ? num[0] : keep0;
          keep1 = mine ? num[1] : keep1;
        }
      }
      if (kg < ns) {
        if (KIND == 1) obase[(size_t)(t0 + kg) * LDY] = f2bf(keep0);
        else *(unsigned*)(obase + (size_t)(t0 + kg) * LDY) = pk2(keep0, keep1);
        if (do_n && cl == 0) { dmbase[(t0 + kg) * 8] = keepd; dmbase[(t0 + kg) * 8 + 4] = keepm; }
      }
    }
    if (j + 1 < nblk) stage(j + 1, buf ^ 1);
    __syncthreads();
  }
#pragma unroll
  for (int c = 0; c < CPL; ++c)
#pragma unroll
    for (int i = 0; i < 4; ++i) {
      Sout[(size_t)(kg * 8 + 2 * i) * 128 + col0 + c] = S[c][i].x;
      Sout[(size_t)(kg * 8 + 2 * i + 1) * 128 + col0 + c] = S[c][i].y;
    }
  if (KIND == 0 && colbase == 0 && w == 0) {
    if (cl == 0) {
      float* no = p.out + (samp ? OFF_S_MN : OFF_P_MN) + ((size_t)(l * NB + b) * 4 + h) * 128 + kg * 8;
#pragma unroll
      for (int i = 0; i < 4; ++i) { no[2 * i] = nv[i].x; no[2 * i + 1] = nv[i].y; }
    }
    if (lane == 0) p.out[(samp ? OFF_S_MM : OFF_P_MM) + (size_t)(l * NB + b) * 4 + h] = mstart;
  }
  __syncthreads();
}

DEVI void phase_scan(const Params& p, int l, float* smem) {
  constexpr int NU = 256 + 4096;
  for (int u = blockIdx.x; u < NU; u += gridDim.x) {
    if (u < 128) {
      const int seq = u >> 2;
      scan_unit<1>(p, l, false, seq >> 2, seq & 3, (u & 3) * 32, smem);
    } else if (u < 192) {
      const int uu = u - 128, seq = uu >> 1;
      scan_unit<0>(p, l, false, seq >> 2, seq & 3, (uu & 1) * 64, smem);
    } else if (u < 256) {
      const int uu = u - 192, seq = uu >> 1;
      scan_unit<2>(p, l, false, seq >> 2, seq & 3, (uu & 1) * 64, smem);
    } else {
      const int s = u - 256, s4 = s & 3;
      if (s4 < 2) {
        const int idx = (s >> 2) * 2 + (s & 1), seq = idx >> 2;
        scan_unit<1>(p, l, true, seq >> 2, seq & 3, (idx & 3) * 32, smem);
      } else {
        const int idx = s >> 2, seq = idx >> 1;
        if (s4 == 2) scan_unit<0>(p, l, true, seq >> 2, seq & 3, (idx & 1) * 64, smem);
        else scan_unit<2>(p, l, true, seq >> 2, seq & 3, (idx & 1) * 64, smem);
      }
    }
  }
}

DEVI void phase_post(const Params& p, int l) {
  const int tid_ = otid(); const int lane = tid_ & 63, gw = blockIdx.x * 8 + (tid_ >> 6), nw = gridDim.x * 8;
  const u16* proj = (const u16*)(p.ws + WS_PROJ);
  u16* obuf = (u16*)(p.ws + WS_OBUF);
  const float* dm = (const float*)(p.ws + WS_DM);
  constexpr int NTASK = (M / 4) * 9;
  for (int task = gw; task < NTASK; task += nw) {
    const int tg = task / 9, k = task - tg * 9;
    const int m0 = tg * 4;
    if (k < 4) {
      const int hh = k, c = hh * 128 + lane * 2;
      const float2 nw2 = *(const float2*)(p.ml_norm_w + l * 512 + c);
#pragma unroll
      for (int tt = 0; tt < 4; ++tt) {
        const size_t m = m0 + tt;
        const unsigned u = *(const unsigned*)(obuf + m * LDY + c);
        const unsigned og = *(const unsigned*)(proj + m * NPROJ + 1536 + c);
        const float den = dm[m * 8 + hh], mt = dm[m * 8 + 4 + hh];
        const float dd = fmaxf(fabsf(den), __expf(-mt));
        const float h0 = bflo(u) / dd, h1 = bfhi(u) / dd;
        const float ss = wave_sum(h0 * h0 + h1 * h1);
        const float sc = rsqrtf(ss * (1.f / 128.f) + 1e-6f);
        *(unsigned*)(obuf + m * LDY + c) = pk2(h0 * sc * nw2.x * sigm(bflo(og)), h1 * sc * nw2.y * sigm(bfhi(og)));
      }
    } else if (k < 8) {
      const int hh = k - 4, cc = lane * 2, c = hh * 128 + cc;
      const float2 nw2 = *(const float2*)(p.gd_norm_w + l * 128 + cc);
#pragma unroll
      for (int tt = 0; tt < 4; ++tt) {
        const size_t m = m0 + tt;
        const unsigned u = *(const unsigned*)(obuf + m * LDY + 512 + c);
        const unsigned z = *(const unsigned*)(proj + m * NPROJ + 3584 + c);
        const float o0 = bflo(u), o1 = bfhi(u);
        const float ss = wave_sum(o0 * o0 + o1 * o1);
        const float sc = rsqrtf(ss * (1.f / 128.f) + 1e-6f);
        *(unsigned*)(obuf + m * LDY + 512 + c) = pk2(o0 * sc * nw2.x * silu(bflo(z)), o1 * sc * nw2.y * silu(bfhi(z)));
      }
    } else {
      const int c = lane * 8;
      const float4 wa = *(const float4*)(p.hg_norm_w + l * 512 + c), wb = *(const float4*)(p.hg_norm_w + l * 512 + c + 4);
#pragma unroll
      for (int tt = 0; tt < 4; ++tt) {
        const size_t m = m0 + tt;
        const uint4 ov = *(const uint4*)(obuf + m * LDY + 1024 + c);
        const uint4 gv = *(const uint4*)(proj + m * NPROJ + 5632 + c);
        float o[8] = {bflo(ov.x), bfhi(ov.x), bflo(ov.y), bfhi(ov.y), bflo(ov.z), bfhi(ov.z), bflo(ov.w), bfhi(ov.w)};
        const float g[8] = {bflo(gv.x), bfhi(gv.x), bflo(gv.y), bfhi(gv.y), bflo(gv.z), bfhi(gv.z), bflo(gv.w), bfhi(gv.w)};
        const float wv[8] = {wa.x, wa.y, wa.z, wa.w, wb.x, wb.y, wb.z, wb.w};
        float ss = 0.f;
#pragma unroll
        for (int i = 0; i < 8; ++i) ss += o[i] * o[i];
        ss = wave_sum(ss);
        const float sc = rsqrtf(ss * (1.f / 512.f) + 1e-6f);
#pragma unroll
        for (int i = 0; i < 8; ++i) o[i] = o[i] * sc * wv[i] * silu(g[i]);
        uint4 r;
        r.x = pk2(o[0], o[1]); r.y = pk2(o[2], o[3]); r.z = pk2(o[4], o[5]); r.w = pk2(o[6], o[7]);
        *(uint4*)(obuf + m * LDY + 1024 + c) = r;
      }
    }
  }
}

#define LAS __attribute__((address_space(3)))
#define XB_TMO      128
#define XB_XCNT(j)  (256  + 64 * (j))
#define XB_XSUB(j)  (1280 + 64 * (j))
#define XB_XGEN(j)  (2304 + 64 * (j))
#define XB_TOP      3328
#define XB_TOPGEN   3392
#define XCD_BAR_WORDS 3456
#define XB_SPIN_CAP (1u << 18)

__device__ __forceinline__ unsigned xb_ld(unsigned* p)              { return __hip_atomic_load(p, __ATOMIC_RELAXED, __HIP_MEMORY_SCOPE_AGENT); }
__device__ __forceinline__ unsigned xb_add(unsigned* p, unsigned v) { return __hip_atomic_fetch_add(p, v, __ATOMIC_RELAXED, __HIP_MEMORY_SCOPE_AGENT); }
__device__ __forceinline__ unsigned xb_xcc_id() { return (unsigned)__builtin_amdgcn_s_getreg((3 << 11) | 20) & 0xFu; }
#define XB_SPIN(cond, bar) do { unsigned _sp = 0; while (cond) { __builtin_amdgcn_s_sleep(1); \
    if ((++_sp & 255u) == 0u) { if (xb_ld(&(bar)[XB_TMO])) break; if (_sp > XB_SPIN_CAP) { atomicAdd(&(bar)[XB_TMO], 1u); break; } } } } while (0)

struct XcdBarrier {
    unsigned* bar; unsigned x;
    volatile LAS unsigned* st;
};

__device__ __forceinline__ XcdBarrier xcd_barrier_post(unsigned* bar, volatile LAS unsigned* st) {
    XcdBarrier b; b.bar = bar; b.x = xb_xcc_id(); b.st = st;
    if (threadIdx.x == 0) (void)xb_add(&bar[XB_XCNT(b.x)], 1u);
    return b;
}
__device__ __forceinline__ void xcd_barrier_complete(unsigned* bar, unsigned x, unsigned& nloc, unsigned& nx) {
    const unsigned G = gridDim.x * gridDim.y * gridDim.z;
    unsigned sum, cnt, mine, sp = 0u;
    for (;;) {
        sum = 0u; cnt = 0u; mine = 0u;
#pragma unroll
        for (unsigned j = 0; j < 16; ++j) { const unsigned c = xb_ld(&bar[XB_XCNT(j)]); sum += c; cnt += (c > 0u) ? 1u : 0u; mine = (j == x) ? c : mine; }
        if (sum == G) break;
        __builtin_amdgcn_s_sleep(1);
        if ((++sp & 255u) == 0u) { if (xb_ld(&bar[XB_TMO])) break; if (sp > XB_SPIN_CAP) { atomicAdd(&bar[XB_TMO], 1u); break; } }
    }
    nloc = mine > 0u ? mine : 1u; nx = cnt > 0u ? cnt : 1u;
}

__device__ __forceinline__ void xcd_barrier(const XcdBarrier& b) {
    asm volatile("s_waitcnt vmcnt(0)" ::: "memory");
    __syncthreads();
    if (threadIdx.x == 0) {
        unsigned* bar = b.bar;
        __builtin_amdgcn_s_waitcnt(0);
        unsigned nloc = b.st[0], nx = b.st[1];
        if (nloc == 0u) { xcd_barrier_complete(bar, b.x, nloc, nx); b.st[0] = nloc; b.st[1] = nx; }
        const unsigned old = xb_add(&bar[XB_XSUB(b.x)], 1u);
        const unsigned gen = old / nloc;
        if (old + 1u == (gen + 1u) * nloc) {
            __builtin_amdgcn_fence(__ATOMIC_RELEASE, "agent");
            asm volatile("s_waitcnt vmcnt(0)" ::: "memory");
            const unsigned og = xb_add(&bar[XB_TOP], 1u);
            const unsigned tg = og / nx;
            if (og + 1u == (tg + 1u) * nx) xb_add(&bar[XB_TOPGEN], 1u);
            else XB_SPIN(xb_ld(&bar[XB_TOPGEN]) == tg, bar);
            __builtin_amdgcn_fence(__ATOMIC_ACQUIRE, "agent");
            xb_add(&bar[XB_XGEN(b.x)], 1u);
            asm volatile("s_waitcnt vmcnt(0)" ::: "memory");
        } else {
            XB_SPIN(xb_ld(&bar[XB_XGEN(b.x)]) == gen, bar);
            __builtin_amdgcn_fence(__ATOMIC_ACQUIRE, "agent");
            asm volatile("s_waitcnt vmcnt(0)" ::: "memory");
        }
    }
    __syncthreads();
}


__global__ void __launch_bounds__(NTHREADS) mega_fwd(Params p) {
  extern __shared__ __attribute__((aligned(16))) unsigned char smem_raw[];
  cg::grid_group grid = cg::this_grid();
  float* smf = (float*)smem_raw;
  u16* smh = (u16*)smem_raw;
  u16* xn = (u16*)(p.ws + WS_XN);
  float* x = p.out;

  volatile LAS unsigned* bst = (volatile LAS unsigned*)(smem_raw + LDS_BYTES - 16);
  if (threadIdx.x < 2) bst[threadIdx.x] = 0u;
  __syncthreads();
  XcdBarrier xbar; xbar.bar = (unsigned*)(p.ws + WS_BAR); xbar.x = xb_xcc_id(); xbar.st = bst;
  if (threadIdx.x == 0) bst[2] = xb_add(&xbar.bar[XB_XCNT(xbar.x)], 1u);
  phase_wprep(p, smf);
  phase_norm(p.x_prompt, p.x_sample, p.norm1_w, xn);
  grid.sync();
  if (threadIdx.x == 0) {
    const unsigned per = gridDim.x >> 3;
    bool ok = (gridDim.x & 7u) == 0u && xbar.x < 8u;
    for (unsigned j = 0; j < 8; ++j) ok = ok && (xb_ld(&xbar.bar[XB_XCNT(j)]) == per);
    const unsigned rank = bst[2];
    bst[3] = (ok && rank < per) ? xbar.x * per + rank : (blockIdx.x & 7u) * per + (blockIdx.x >> 3);
  }
  __syncthreads();
  const int vcu = (int)bst[3];
#pragma unroll 1
  for (int l = 0; l < 2; ++l) {
    phase_proj(p, l, vcu, smh);
    xcd_barrier(xbar);
    phase_prep(p, l);
    xcd_barrier(xbar);
    phase_scan(p, l, smf);
    xcd_barrier(xbar);
    phase_post(p, l);
    xcd_barrier(xbar);
    phase_merge(p, l, vcu, smh);
    xcd_barrier(xbar);
    if (l == 0)
      phase_resid((const u16*)(p.ws + WS_CONV), LDX, 1024, (const u16*)(p.ws + WS_WT_OUT), LDW1, p.x_prompt, p.x_sample, x, vcu, smh);
    else
      phase_resid((const u16*)(p.ws + WS_CONV), LDX, 1024, (const u16*)(p.ws + WS_WT_OUT) + (size_t)1024 * LDW1, LDW1, x, x + (size_t)MP * D, x, vcu, smh);
    xcd_barrier(xbar);
    phase_norm(x, x + (size_t)MP * D, p.norm2_w + l * D, xn);
    xcd_barrier(xbar);
    phase_up(p, l, vcu, smh);
    xcd_barrier(xbar);
    phase_resid((const u16*)(p.ws + WS_PROJ), LDH, 4096, (const u16*)(p.ws + WS_WT_DN) + (size_t)l * 1024 * LDWD, LDWD, x, x + (size_t)MP * D, x, vcu, smh);
    xcd_barrier(xbar);
    if (l == 0) {
      phase_norm(x, x + (size_t)MP * D, p.norm1_w + D, xn);
      xcd_barrier(xbar);
    }
  }
  phase_final_norm(x, p.final_norm_w);
}

extern "C" void kernel_launch(void* const* d_in, const int* in_sizes, int n_in, void* d_out, int out_size, void* d_ws,
                              size_t ws_size, hipStream_t stream) {
  static int grid_blocks = 0;
  if (!grid_blocks) {
    int dev = 0, cus = 0, per_cu = 0;
    hipGetDevice(&dev);
    hipDeviceGetAttribute(&cus, hipDeviceAttributeMultiprocessorCount, dev);
    hipFuncSetAttribute((const void*)mega_fwd, hipFuncAttributeMaxDynamicSharedMemorySize, LDS_BYTES);
    hipOccupancyMaxActiveBlocksPerMultiprocessor(&per_cu, (const void*)mega_fwd, NTHREADS, LDS_BYTES);
    if (per_cu < 1) { fprintf(stderr, "occupancy query returned %d\n", per_cu); per_cu = 1; }
    grid_blocks = cus;
    if (ws_size < WS_END) fprintf(stderr, "workspace too small: %zu < %zu\n", ws_size, (size_t)WS_END);
  }
  Params p{};
  p.x_prompt = (const float*)d_in[0]; p.x_sample = (const float*)d_in[1];
  p.st_mC = (const float*)d_in[2]; p.st_mn = (const float*)d_in[3]; p.st_mm = (const float*)d_in[4];
  p.st_gS = (const float*)d_in[5]; p.st_gconv = (const float*)d_in[6]; p.st_hS = (const float*)d_in[7];
  p.norm1_w = (const float*)d_in[8]; p.w_in = (const float*)d_in[9]; p.ml_i_bias = (const float*)d_in[10];
  p.ml_f_bias = (const float*)d_in[11]; p.ml_norm_w = (const float*)d_in[12]; p.gd_conv_w = (const float*)d_in[13];
  p.gd_A_log = (const float*)d_in[14]; p.gd_dt_bias = (const float*)d_in[15]; p.gd_norm_w = (const float*)d_in[16];
  p.hg_lb_logits = (const float*)d_in[17]; p.hg_norm_w = (const float*)d_in[18]; p.w_branch = (const float*)d_in[19];
  p.w_out = (const float*)d_in[20]; p.norm2_w = (const float*)d_in[21]; p.w_up = (const float*)d_in[22];
  p.w_down = (const float*)d_in[23]; p.final_norm_w = (const float*)d_in[24];
  p.out = (float*)d_out;
  p.ws = (unsigned char*)d_ws;
  hipMemsetAsync((char*)d_ws + WS_BAR, 0, WS_BAR_BYTES, stream);
  void* args[] = {&p};
  hipError_t e = hipLaunchCooperativeKernel((const void*)mega_fwd, dim3(grid_blocks), dim3(NTHREADS), args, LDS_BYTES, stream);
  if (e != hipSuccess) fprintf(stderr, "cooperative launch failed: %s (grid %d)\n", hipGetErrorString(e), grid_blocks);
}
```

```cpp
#include <hip/hip_runtime.h>
#include <hip/hip_cooperative_groups.h>
#include <cstdio>
namespace cg = cooperative_groups;

typedef unsigned short u16;
using bf16x8 = __attribute__((ext_vector_type(8))) short;
using f32x4 = __attribute__((ext_vector_type(4))) float;
typedef float v2f __attribute__((ext_vector_type(2)));

#define DEVI __device__ __forceinline__

constexpr int D = 1024;
constexpr int MP = 16384, MS = 512, M = MP + MS;
constexpr int NPROJ = 6144, NPROJ_PAD = 6272;
constexpr int INC = 9232;
constexpr int DFF = 4096;
constexpr int NTHREADS = 512;
constexpr int LDS_BYTES = 132 * 1024;
constexpr int LDX = 1088, LDH = 4160, LDY = 1600, LDW1 = 1088, LDWB = 576, LDWD = 4160;

constexpr size_t OFF_Y = 0;
constexpr size_t OFF_P_MC = (size_t)M * D;
constexpr size_t OFF_P_MN = OFF_P_MC + 2ull * 8 * 4 * 128 * 128;
constexpr size_t OFF_P_MM = OFF_P_MN + 2ull * 8 * 4 * 128;
constexpr size_t OFF_P_GS = OFF_P_MM + 2ull * 8 * 4;
constexpr size_t OFF_P_GC = OFF_P_GS + 2ull * 8 * 4 * 128 * 128;
constexpr size_t OFF_P_HS = OFF_P_GC + 2ull * 8 * 3 * 1536;
constexpr size_t OFF_S_MC = OFF_P_HS + 2ull * 8 * 4 * 128 * 128;
constexpr size_t OFF_S_MN = OFF_S_MC + 2ull * 128 * 4 * 128 * 128;
constexpr size_t OFF_S_MM = OFF_S_MN + 2ull * 128 * 4 * 128;
constexpr size_t OFF_S_GS = OFF_S_MM + 2ull * 128 * 4;
constexpr size_t OFF_S_GC = OFF_S_GS + 2ull * 128 * 4 * 128 * 128;
constexpr size_t OFF_S_HS = OFF_S_GC + 2ull * 128 * 3 * 1536;
static_assert(OFF_S_HS + 2ull * 128 * 4 * 128 * 128 == 72172608ull, "output size");

constexpr size_t WS_WT_IN = 0;
constexpr size_t WS_WT_GATE = WS_WT_IN + 2ull * NPROJ_PAD * LDW1 * 2;
constexpr size_t WS_WT_BR = WS_WT_GATE + 2ull * 3072 * LDW1 * 2;
constexpr size_t WS_WT_OUT = WS_WT_BR + 2ull * 3 * 1024 * LDWB * 2;
constexpr size_t WS_WT_UP = WS_WT_OUT + 2ull * 1024 * LDW1 * 2;
constexpr size_t WS_WT_DN = WS_WT_UP + 2ull * 4096 * LDW1 * 2;
constexpr size_t WS_PROJ = WS_WT_DN + 2ull * 1024 * LDWD * 2;
constexpr size_t WS_CONV = WS_PROJ + (size_t)M * NPROJ * 2;
constexpr size_t WS_OBUF = WS_CONV + (size_t)M * 1536 * 2;
constexpr size_t WS_XN = WS_OBUF + (size_t)M * LDY * 2;
constexpr size_t WS_SMALL = WS_XN + (size_t)M * LDX * 2;
constexpr size_t WS_GATES = WS_SMALL;
constexpr size_t WS_DM = WS_GATES + (size_t)M * 16 * 4;
constexpr size_t WS_BAR = WS_DM + (size_t)M * 8 * 4;
constexpr size_t WS_BAR_BYTES = 16384;
constexpr size_t WS_END = WS_BAR + WS_BAR_BYTES;
static_assert(WS_END <= 439571584ull, "workspace budget");
static_assert((size_t)M * LDH * 2 <= (size_t)M * NPROJ * 2 && (size_t)M * LDX * 2 <= (size_t)M * 1536 * 2, "aliases fit");

struct Params {
  const float *x_prompt, *x_sample, *st_mC, *st_mn, *st_mm, *st_gS, *st_gconv, *st_hS;
  const float *norm1_w, *w_in, *ml_i_bias, *ml_f_bias, *ml_norm_w, *gd_conv_w, *gd_A_log, *gd_dt_bias,
      *gd_norm_w, *hg_lb_logits, *hg_norm_w, *w_branch, *w_out, *norm2_w, *w_up, *w_down, *final_norm_w;
  float* out;
  unsigned char* ws;
};

DEVI u16 f2bf(float f) { unsigned u = __float_as_uint(f); return (u16)((u + 0x7fffu + ((u >> 16) & 1u)) >> 16); }
DEVI unsigned pk2(float lo, float hi) { return (unsigned)f2bf(lo) | ((unsigned)f2bf(hi) << 16); }
DEVI float bflo(unsigned u) { return __uint_as_float(u << 16); }
DEVI float bfhi(unsigned u) { return __uint_as_float(u & 0xffff0000u); }
DEVI float sigm(float x) { return 1.f / (1.f + __expf(-x)); }
DEVI float silu(float x) { return x * sigm(x); }
DEVI float softplus(float x) { return fmaxf(x, 0.f) + log1pf(__expf(-fabsf(x))); }
DEVI int otid() { int t = threadIdx.x; asm volatile("" : "+v"(t)); return t; }
DEVI float wave_sum(float v) {
#pragma unroll
  for (int o = 32; o > 0; o >>= 1) v += __shfl_xor(v, o);
  return v;
}
template <int CTRL> DEVI float dpp_f(float v) {
  return __int_as_float(__builtin_amdgcn_update_dpp(0, __float_as_int(v), CTRL, 0xf, 0xf, false));
}
DEVI float row16_sum(float v) {
  float r;
  asm("s_nop 1\n\tv_add_f32_dpp %0, %1, %1 row_ror:8 row_mask:0xf bank_mask:0xf" : "=v"(r) : "v"(v));
  asm("s_nop 1\n\tv_add_f32_dpp %0, %1, %1 row_ror:4 row_mask:0xf bank_mask:0xf" : "=v"(v) : "v"(r));
  asm("s_nop 1\n\tv_add_f32_dpp %0, %1, %1 row_ror:2 row_mask:0xf bank_mask:0xf" : "=v"(r) : "v"(v));
  asm("s_nop 1\n\tv_add_f32_dpp %0, %1, %1 row_ror:1 row_mask:0xf bank_mask:0xf" : "=v"(v) : "v"(r));
  return v;
}

DEVI void tr_seg(const float* __restrict__ src, int ld, int K, int ncols, u16* __restrict__ dst, int dld, float* tile, int& off) {
  const int tid_ = otid();
  const int lane = tid_ & 63, gw = blockIdx.x * 8 + (tid_ >> 6), nw = gridDim.x * 8;
  const int nkb = K >> 4, nnb = ncols >> 6, nt = nkb * nnb;
  const int start = (int)(((long)gw + (long)nw * 4096 - off) % nw);
  for (int t = start; t < nt; t += nw) {
    const int kb = t % nkb, nb = t / nkb;
    const float* sp = src + (size_t)(kb * 16) * ld + nb * 64 + lane;
    float v[16];
#pragma unroll
    for (int i = 0; i < 16; ++i) v[i] = sp[(size_t)i * ld];
    uint4 o0, o1;
    o0.x = pk2(v[0], v[1]); o0.y = pk2(v[2], v[3]); o0.z = pk2(v[4], v[5]); o0.w = pk2(v[6], v[7]);
    o1.x = pk2(v[8], v[9]); o1.y = pk2(v[10], v[11]); o1.z = pk2(v[12], v[13]); o1.w = pk2(v[14], v[15]);
    u16* dp = dst + (size_t)(nb * 64 + lane) * dld + kb * 16;
    *(uint4*)dp = o0;
    *(uint4*)(dp + 8) = o1;
  }
  off += nt;
}

DEVI void phase_wprep(const Params& p, float* tile) {
  int off = 0;
  u16* wt_in = (u16*)(p.ws + WS_WT_IN);
  u16* wt_gate = (u16*)(p.ws + WS_WT_GATE);
  u16* wt_br = (u16*)(p.ws + WS_WT_BR);
  u16* wt_out = (u16*)(p.ws + WS_WT_OUT);
  u16* wt_up = (u16*)(p.ws + WS_WT_UP);
  u16* wt_dn = (u16*)(p.ws + WS_WT_DN);
  for (int l = 0; l < 2; ++l) {
    const float* win = p.w_in + (size_t)l * 1024 * INC;
    for (int s = 0; s < 12; ++s) {
      const int srccol = (s < 4) ? s * 512 : (s < 8 ? 2056 + (s - 4) * 512 : 4112 + (s - 8) * 512);
      tr_seg(win + srccol, INC, 1024, 512, wt_in + ((size_t)l * NPROJ_PAD + s * 512) * LDW1, LDW1, tile, off);
    }
    tr_seg(win + 6160, INC, 1024, 3072, wt_gate + (size_t)l * 3072 * LDW1, LDW1, tile, off);
    for (int b = 0; b < 3; ++b)
      tr_seg(p.w_branch + (size_t)(l * 3 + b) * 512 * 1024, 1024, 512, 1024, wt_br + (size_t)(l * 3 + b) * 1024 * LDWB, LDWB, tile, off);
    tr_seg(p.w_out + (size_t)l * 1024 * 1024, 1024, 1024, 1024, wt_out + (size_t)l * 1024 * LDW1, LDW1, tile, off);
    tr_seg(p.w_up + (size_t)l * 1024 * 4096, 4096, 1024, 4096, wt_up + (size_t)l * 4096 * LDW1, LDW1, tile, off);
    tr_seg(p.w_down + (size_t)l * 4096 * 1024, 1024, 4096, 1024, wt_dn + (size_t)l * 1024 * LDWD, LDWD, tile, off);
  }
  for (int idx = blockIdx.x * NTHREADS + otid(); idx < 2 * 128 * 1024; idx += gridDim.x * NTHREADS) {
    const int l = idx >> 17, rem = idx & 131071, r = rem >> 10, k = rem & 1023;
    float v = 0.f;
    if (r < 16) {
      const int sc = (r < 8) ? 2048 + r : 4104 + (r - 8);
      v = p.w_in[(size_t)l * 1024 * INC + (size_t)k * INC + sc];
    }
    wt_in[((size_t)l * NPROJ_PAD + 6144 + r) * LDW1 + k] = f2bf(v);
  }
}

DEVI void phase_norm(const float* xp, const float* xs, const float* __restrict__ w, u16* __restrict__ xn) {
  const int tid_ = otid(); const int lane = tid_ & 63, gw = blockIdx.x * 8 + (tid_ >> 6), nw = gridDim.x * 8;
  for (int m = gw; m < M; m += nw) {
    const float* xr = (m < MP) ? xp + (size_t)m * D : xs + (size_t)(m - MP) * D;
    float4 v[4];
    float ss = 0.f;
#pragma unroll
    for (int i = 0; i < 4; ++i) {
      v[i] = ((const float4*)xr)[lane + 64 * i];
      ss += v[i].x * v[i].x + v[i].y * v[i].y + v[i].z * v[i].z + v[i].w * v[i].w;
    }
    ss = wave_sum(ss);
    const float rstd = rsqrtf(ss * (1.f / 1024.f) + 1e-6f);
#pragma unroll
    for (int i = 0; i < 4; ++i) {
      const float4 wv = ((const float4*)w)[lane + 64 * i];
      uint2 o;
      o.x = pk2(v[i].x * rstd * wv.x, v[i].y * rstd * wv.y);
      o.y = pk2(v[i].z * rstd * wv.z, v[i].w * rstd * wv.w);
      ((uint2*)(xn + (size_t)m * LDX))[lane + 64 * i] = o;
    }
  }
}

DEVI void phase_final_norm(float* x, const float* __restrict__ w) {
  const int tid_ = otid(); const int lane = tid_ & 63, gw = blockIdx.x * 8 + (tid_ >> 6), nw = gridDim.x * 8;
  for (int m = gw; m < M; m += nw) {
    float* xr = x + (size_t)m * D;
    float4 v[4];
    float ss = 0.f;
#pragma unroll
    for (int i = 0; i < 4; ++i) {
      v[i] = ((const float4*)xr)[lane + 64 * i];
      ss += v[i].x * v[i].x + v[i].y * v[i].y + v[i].z * v[i].z + v[i].w * v[i].w;
    }
    ss = wave_sum(ss);
    const float rstd = rsqrtf(ss * (1.f / 1024.f) + 1e-6f);
#pragma unroll
    for (int i = 0; i < 4; ++i) {
      const float4 wv = ((const float4*)w)[lane + 64 * i];
      float4 o;
      o.x = v[i].x * rstd * wv.x; o.y = v[i].y * rstd * wv.y; o.z = v[i].z * rstd * wv.z; o.w = v[i].w * rstd * wv.w;
      ((float4*)xr)[lane + 64 * i] = o;
    }
  }
}

constexpr int LDS_S = 64;
template <int WMT, int WNT>
DEVI void gemm_core(const u16* __restrict__ A, int lda, const u16* __restrict__ B, int ldb, int K,
                    f32x4 (&acc)[WMT][WNT], u16* smem) {
  constexpr int BM = 64 * WMT, BN = 32 * WNT;
  constexpr int ACH = BM * 8 / NTHREADS, BCH = BN * 8 / NTHREADS;
  u16* sA = smem;
  u16* sB = smem + 2 * BM * LDS_S;
  const int tid = otid(), lane = tid & 63, w = tid >> 6, wm = w >> 1, wn = w & 1;
  const int fr = lane & 15, fq = lane >> 4;
  const int crow = tid >> 3, ckc = tid & 7;
  const int wsw = (ckc ^ (crow & 7)) * 8;
  const int rsw0 = (fq ^ (fr & 7)) * 8;
  static_assert(BCH == 2 && (ACH == 2 || ACH == 4), "chunk counts");
  uint4 pa0, pa1, pa2, pa3, pb0, pb1, qa0, qa1, qa2, qa3, qb0, qb1;
  pa2 = uint4{0, 0, 0, 0}; pa3 = pa2; qa2 = pa2; qa3 = pa2;
  const u16* Ag = A + (size_t)crow * lda + ckc * 8;
  const u16* Bg = B + (size_t)crow * ldb + ckc * 8;
  const int nk = K >> 6;
#define GLOAD(S, KO)                                                                  \
  do {                                                                                \
    S##a0 = *(const uint4*)(Ag + (KO));                                               \
    S##a1 = *(const uint4*)(Ag + (size_t)64 * lda + (KO));                            \
    if (ACH == 4) {                                                                   \
      S##a2 = *(const uint4*)(Ag + (size_t)128 * lda + (KO));                         \
      S##a3 = *(const uint4*)(Ag + (size_t)192 * lda + (KO));                         \
    }                                                                                 \
    S##b0 = *(const uint4*)(Bg + (KO));                                               \
    S##b1 = *(const uint4*)(Bg + (size_t)64 * ldb + (KO));                            \
  } while (0)
#define SSTORE(S, NB)                                                                 \
  do {                                                                                \
    u16* dA = sA + ((NB) * BM + crow) * LDS_S + wsw;                                  \
    u16* dB = sB + ((NB) * BN + crow) * LDS_S + wsw;                                  \
    *(uint4*)(dA) = S##a0;                                                            \
    *(uint4*)(dA + 64 * LDS_S) = S##a1;                                               \
    if (ACH == 4) {                                                                   \
      *(uint4*)(dA + 128 * LDS_S) = S##a2;                                            \
      *(uint4*)(dA + 192 * LDS_S) = S##a3;                                            \
    }                                                                                 \
    *(uint4*)(dB) = S##b0;                                                            \
    *(uint4*)(dB + 64 * LDS_S) = S##b1;                                               \
  } while (0)
#define LOADFR(BUF)                                                                   \
  do {                                                                                \
    const u16* cA = sA + ((BUF) * BM + wm * 16 * WMT + fr) * LDS_S;                   \
    const u16* cB = sB + ((BUF) * BN + wn * 16 * WNT + fr) * LDS_S;                   \
    _Pragma("unroll") for (int ks = 0; ks < 2; ++ks) {                                \
      const int so = rsw0 ^ (ks * 32);                                                \
      _Pragma("unroll") for (int i = 0; i < WMT; ++i) af[ks][i] = *(const bf16x8*)(cA + i * 16 * LDS_S + so);  \
      _Pragma("unroll") for (int j = 0; j < WNT; ++j) bfr[ks][j] = *(const bf16x8*)(cB + j * 16 * LDS_S + so); \
    }                                                                                 \
  } while (0)
#define MFMAS()                                                                       \
  do {                                                                                \
    _Pragma("unroll") for (int ks = 0; ks < 2; ++ks)                                  \
      _Pragma("unroll") for (int i = 0; i < WMT; ++i)                                 \
        _Pragma("unroll") for (int j = 0; j < WNT; ++j)                               \
          acc[i][j] = __builtin_amdgcn_mfma_f32_16x16x32_bf16(bfr[ks][j], af[ks][i], acc[i][j], 0, 0, 0);  \
  } while (0)
  bf16x8 af[2][WMT], bfr[2][WNT];
  GLOAD(p, 0);
  SSTORE(p, 0);
  __builtin_amdgcn_sched_barrier(0);
  GLOAD(q, 64);
  __builtin_amdgcn_sched_barrier(0);
  GLOAD(p, 128);
  __builtin_amdgcn_sched_barrier(0);
  __syncthreads();
#pragma unroll 1
  for (int kt = 0; kt < nk; kt += 2) {
    LOADFR(0);
    __builtin_amdgcn_sched_barrier(0);
    SSTORE(q, 1);
    const int k3 = (kt + 3 < nk) ? kt + 3 : nk - 1;
    GLOAD(q, k3 * 64);
    __builtin_amdgcn_sched_barrier(0);
    MFMAS();
    __builtin_amdgcn_sched_barrier(0);
    __syncthreads();
    LOADFR(1);
    __builtin_amdgcn_sched_barrier(0);
    SSTORE(p, 0);
    const int k4 = (kt + 4 < nk) ? kt + 4 : nk - 1;
    GLOAD(p, k4 * 64);
    __builtin_amdgcn_sched_barrier(0);
    MFMAS();
    __builtin_amdgcn_sched_barrier(0);
    __syncthreads();
  }
#undef GLOAD
#undef SSTORE
#undef LOADFR
#undef MFMAS
}

DEVI bool tile_map(int it, int vcu, int MT, int NT, int& mt, int& nt) {
  const int G = gridDim.x;
  const int t = it * G + vcu;
  if (t >= MT * NT) return false;
  constexpr int GM = 4;
  const int gsize = GM * NT;
  const int g = t / gsize, tl = t - g * gsize;
  int gsz = MT - g * GM;
  if (gsz > GM) gsz = GM;
  mt = g * GM + (tl % gsz);
  nt = tl / gsz;
  return true;
}

template <int WMT, int WNT>
DEVI void zero_acc(f32x4 (&acc)[WMT][WNT]) {
#pragma unroll
  for (int i = 0; i < WMT; ++i)
#pragma unroll
    for (int j = 0; j < WNT; ++j) acc[i][j] = f32x4{0.f, 0.f, 0.f, 0.f};
}


DEVI void gemm_core_big(const u16* __restrict__ A, int lda, const u16* __restrict__ B, int ldb, int K,
                        f32x4 (&acc)[4][8], u16* smem) {
  u16* sA = smem;
  u16* sB = smem + 2 * 256 * LDS_S;
  const int tid = otid(), lane = tid & 63, w = tid >> 6, wm = w >> 1, wn = w & 1;
  const int fr = lane & 15, fq = lane >> 4;
  const int crow = tid >> 3, ckc = tid & 7;
  const int wsw = (ckc ^ (crow & 7)) * 8;
  const int rsw0 = (fq ^ (fr & 7)) * 8;
  uint4 pa0, pa1, pa2, pa3, pb0, pb1, pb2, pb3;
  const u16* Ag = A + (size_t)crow * lda + ckc * 8;
  const u16* Bg = B + (size_t)crow * ldb + ckc * 8;
  const int nk = K >> 6;
#define BGLOAD(KO)                                                                    \
  do {                                                                                \
    pa0 = *(const uint4*)(Ag + (KO));                                                 \
    pa1 = *(const uint4*)(Ag + (size_t)64 * lda + (KO));                              \
    pa2 = *(const uint4*)(Ag + (size_t)128 * lda + (KO));                             \
    pa3 = *(const uint4*)(Ag + (size_t)192 * lda + (KO));                             \
    pb0 = *(const uint4*)(Bg + (KO));                                                 \
    pb1 = *(const uint4*)(Bg + (size_t)64 * ldb + (KO));                              \
    pb2 = *(const uint4*)(Bg + (size_t)128 * ldb + (KO));                             \
    pb3 = *(const uint4*)(Bg + (size_t)192 * ldb + (KO));                             \
  } while (0)
#define BSSTORE(NB)                                                                   \
  do {                                                                                \
    u16* dA = sA + ((NB) * 256 + crow) * LDS_S + wsw;                                 \
    u16* dB = sB + ((NB) * 256 + crow) * LDS_S + wsw;                                 \
    *(uint4*)(dA) = pa0;                                                              \
    *(uint4*)(dA + 64 * LDS_S) = pa1;                                                 \
    *(uint4*)(dA + 128 * LDS_S) = pa2;                                                \
    *(uint4*)(dA + 192 * LDS_S) = pa3;                                                \
    *(uint4*)(dB) = pb0;                                                              \
    *(uint4*)(dB + 64 * LDS_S) = pb1;                                                 \
    *(uint4*)(dB + 128 * LDS_S) = pb2;                                                \
    *(uint4*)(dB + 192 * LDS_S) = pb3;                                                \
  } while (0)
#define BLOADFR(BUF, KS)                                                              \
  do {                                                                                \
    const u16* cA = sA + ((BUF) * 256 + wm * 64 + fr) * LDS_S + (rsw0 ^ ((KS) * 32)); \
    const u16* cB = sB + ((BUF) * 256 + wn * 128 + fr) * LDS_S + (rsw0 ^ ((KS) * 32)); \
    _Pragma("unroll") for (int i = 0; i < 4; ++i) af[i] = *(const bf16x8*)(cA + i * 16 * LDS_S);  \
    _Pragma("unroll") for (int j = 0; j < 8; ++j) bfr[j] = *(const bf16x8*)(cB + j * 16 * LDS_S); \
  } while (0)
#define BMFMAS()                                                                      \
  do {                                                                                \
    _Pragma("unroll") for (int i = 0; i < 4; ++i)                                     \
      _Pragma("unroll") for (int j = 0; j < 8; ++j)                                   \
        acc[i][j] = __builtin_amdgcn_mfma_f32_16x16x32_bf16(bfr[j], af[i], acc[i][j], 0, 0, 0);  \
  } while (0)
#define BHALF(BUF, KNEXT)                                                             \
  do {                                                                                \
    BLOADFR(BUF, 0);                                                                  \
    __builtin_amdgcn_sched_barrier(0);                                                \
    BSSTORE((BUF) ^ 1);                                                               \
    BGLOAD((KNEXT) * 64);                                                             \
    __builtin_amdgcn_sched_barrier(0);                                                \
    BMFMAS();                                                                         \
    __builtin_amdgcn_sched_barrier(0);                                                \
    BLOADFR(BUF, 1);                                                                  \
    __builtin_amdgcn_sched_barrier(0);                                                \
    BMFMAS();                                                                         \
    __builtin_amdgcn_sched_barrier(0);                                                \
    __syncthreads();                                                                  \
  } while (0)
  bf16x8 af[4], bfr[8];
  BGLOAD(0);
  BSSTORE(0);
  __builtin_amdgcn_sched_barrier(0);
  BGLOAD(64);
  __builtin_amdgcn_sched_barrier(0);
  __syncthreads();
#pragma unroll 1
  for (int kt = 0; kt < nk; kt += 2) {
    const int k2 = (kt + 2 < nk) ? kt + 2 : nk - 1;
    BHALF(0, k2);
    const int k3 = (kt + 3 < nk) ? kt + 3 : nk - 1;
    BHALF(1, k3);
  }
#undef BGLOAD
#undef BSSTORE
#undef BLOADFR
#undef BMFMAS
#undef BHALF
}

DEVI void phase_proj(const Params& p, int l, int vcu, u16* smem) {
  const u16* xn = (const u16*)(p.ws + WS_XN);
  const u16* wt = (const u16*)(p.ws + WS_WT_IN) + (size_t)l * NPROJ_PAD * LDW1;
  u16* proj = (u16*)(p.ws + WS_PROJ);
  float* small = (float*)(p.ws + WS_SMALL);
  const int tid_ = otid(); const int lane = tid_ & 63, w = tid_ >> 6, wm = w >> 1, wn = w & 1, fr = lane & 15, fq = lane >> 4;
  constexpr int NT = 25, MT = M / 256;
  for (int it = 0; it * (int)gridDim.x < MT * NT; ++it) {
    int mt, nt;
    if (!tile_map(it, vcu, MT, NT, mt, nt)) break;
    const int m0 = mt * 256, n0 = nt * 256;
    f32x4 acc[4][8];
    zero_acc(acc);
    gemm_core_big(xn + (size_t)m0 * LDX, LDX, wt + (size_t)n0 * LDW1, LDW1, 1024, acc, smem);
#pragma unroll
    for (int i = 0; i < 4; ++i)
#pragma unroll
      for (int j = 0; j < 8; ++j) {
        const int m = m0 + wm * 64 + i * 16 + fr, n = n0 + wn * 128 + j * 16 + fq * 4;
        if (n < NPROJ) {
          uint2 o;
          o.x = pk2(acc[i][j][0], acc[i][j][1]);
          o.y = pk2(acc[i][j][2], acc[i][j][3]);
          *(uint2*)(proj + (size_t)m * NPROJ + n) = o;
        } else if (n < NPROJ + 16) {
          *(float4*)(small + (size_t)m * 16 + (n - NPROJ)) = float4{acc[i][j][0], acc[i][j][1], acc[i][j][2], acc[i][j][3]};
        }
      }
  }
}

DEVI void phase_up(const Params& p, int l, int vcu, u16* smem) {
  const u16* xn = (const u16*)(p.ws + WS_XN);
  const u16* wt = (const u16*)(p.ws + WS_WT_UP) + (size_t)l * 4096 * LDW1;
  u16* hid = (u16*)(p.ws + WS_PROJ);
  const int tid_ = otid(); const int lane = tid_ & 63, w = tid_ >> 6, wm = w >> 1, wn = w & 1, fr = lane & 15, fq = lane >> 4;
  constexpr int NT = DFF / 256, MT = M / 256;
  for (int it = 0; it * (int)gridDim.x < MT * NT; ++it) {
    int mt, nt;
    if (!tile_map(it, vcu, MT, NT, mt, nt)) break;
    const int m0 = mt * 256, n0 = nt * 256;
    f32x4 acc[4][8];
    zero_acc(acc);
    gemm_core_big(xn + (size_t)m0 * LDX, LDX, wt + (size_t)n0 * LDW1, LDW1, 1024, acc, smem);
#pragma unroll
    for (int i = 0; i < 4; ++i)
#pragma unroll
      for (int j = 0; j < 8; ++j) {
        const int m = m0 + wm * 64 + i * 16 + fr, n = n0 + wn * 128 + j * 16 + fq * 4;
        float r0 = fmaxf(acc[i][j][0], 0.f), r1 = fmaxf(acc[i][j][1], 0.f), r2 = fmaxf(acc[i][j][2], 0.f), r3 = fmaxf(acc[i][j][3], 0.f);
        uint2 o;
        o.x = pk2(r0 * r0, r1 * r1);
        o.y = pk2(r2 * r2, r3 * r3);
        *(uint2*)(hid + (size_t)m * LDH + n) = o;
      }
  }
}

DEVI void phase_merge(const Params& p, int l, int vcu, u16* smem) {
  const u16* xn = (const u16*)(p.ws + WS_XN);
  const u16* y = (const u16*)(p.ws + WS_OBUF);
  const u16* wg = (const u16*)(p.ws + WS_WT_GATE) + (size_t)l * 3072 * LDW1;
  const u16* wb = (const u16*)(p.ws + WS_WT_BR) + (size_t)l * 3 * 1024 * LDWB;
  u16* merged = (u16*)(p.ws + WS_CONV);
  const int tid_ = otid(); const int lane = tid_ & 63, w = tid_ >> 6, wm = w >> 1, wn = w & 1, fr = lane & 15, fq = lane >> 4;
  constexpr int NT = D / 128, MT = M / 128;
  for (int it = 0; it * (int)gridDim.x < MT * NT; ++it) {
    int mt, nt;
    if (!tile_map(it, vcu, MT, NT, mt, nt)) break;
    const int m0 = mt * 128, n0 = nt * 128;
    f32x4 accM[2][4];
    zero_acc(accM);
#pragma unroll 1
    for (int b = 0; b < 3; ++b) {
      f32x4 accG[2][4], accB[2][4];
      zero_acc(accG);
      zero_acc(accB);
      gemm_core<2, 4>(xn + (size_t)m0 * LDX, LDX, wg + ((size_t)b * 1024 + n0) * LDW1, LDW1, 1024, accG, smem);
      gemm_core<2, 4>(y + (size_t)m0 * LDY + b * 512, LDY, wb + ((size_t)b * 1024 + n0) * LDWB, LDWB, 512, accB, smem);
#pragma unroll
      for (int i = 0; i < 2; ++i)
#pragma unroll
        for (int j = 0; j < 4; ++j)
#pragma unroll
          for (int r = 0; r < 4; ++r) accM[i][j][r] += sigm(accG[i][j][r]) * accB[i][j][r];
    }
#pragma unroll
    for (int i = 0; i < 2; ++i)
#pragma unroll
      for (int j = 0; j < 4; ++j) {
        const int m = m0 + wm * 32 + i * 16 + fr, n = n0 + wn * 64 + j * 16 + fq * 4;
        uint2 o;
        o.x = pk2(accM[i][j][0], accM[i][j][1]);
        o.y = pk2(accM[i][j][2], accM[i][j][3]);
        *(uint2*)(merged + (size_t)m * LDX + n) = o;
      }
  }
}

DEVI void phase_resid(const u16* A, int lda, int K, const u16* wt, int ldb, const float* xin_p, const float* xin_s, float* xout, int vcu, u16* smem) {
  const int tid_ = otid(); const int lane = tid_ & 63, w = tid_ >> 6, wm = w >> 1, wn = w & 1, fr = lane & 15, fq = lane >> 4;
  constexpr int NT = D / 128, MT = M / 128;
  for (int it = 0; it * (int)gridDim.x < MT * NT; ++it) {
    int mt, nt;
    if (!tile_map(it, vcu, MT, NT, mt, nt)) break;
    const int m0 = mt * 128, n0 = nt * 128;
    f32x4 acc[2][4];
    zero_acc(acc);
    gemm_core<2, 4>(A + (size_t)m0 * lda, lda, wt + (size_t)n0 * ldb, ldb, K, acc, smem);
#pragma unroll
    for (int i = 0; i < 2; ++i)
#pragma unroll
      for (int j = 0; j < 4; ++j) {
        const int m = m0 + wm * 32 + i * 16 + fr, n = n0 + wn * 64 + j * 16 + fq * 4;
        const float* xr = (m < MP) ? xin_p + (size_t)m * D : xin_s + (size_t)(m - MP) * D;
        const float4 xv = *(const float4*)(xr + n);
        float4 o;
        o.x = xv.x + acc[i][j][0]; o.y = xv.y + acc[i][j][1]; o.z = xv.z + acc[i][j][2]; o.w = xv.w + acc[i][j][3];
        *(float4*)(xout + (size_t)m * D + n) = o;
      }
  }
}

DEVI void phase_prep(const Params& p, int l) {
  const int tid_ = otid(); const int lane = tid_ & 63, gw = blockIdx.x * 8 + (tid_ >> 6), nw = gridDim.x * 8;
  u16* proj = (u16*)(p.ws + WS_PROJ);
  u16* conv = (u16*)(p.ws + WS_CONV);
  const float* small = (const float*)(p.ws + WS_SMALL);
  float* gates = (float*)(p.ws + WS_GATES);
  constexpr int NTASK = (M / 4) * 21;
  for (int task = gw; task < NTASK; task += nw) {
    const int tg = task / 21, k = task - tg * 21;
    const int m0 = tg * 4;
    const bool samp = m0 >= MP;
    int b, t0;
    if (!samp) { b = m0 >> 11; t0 = m0 & 2047; } else { b = (m0 - MP) >> 2; t0 = 0; }
    if (k < 12) {
      const int pp = k >> 2, hh = k & 3;
      const int ch = pp * 512 + hh * 128 + lane * 2;
      const u16* src = proj + 2048 + ch;
      float rx[7], ry[7];
#pragma unroll
      for (int j = 0; j < 7; ++j) {
        const int t = t0 - 3 + j;
        if (t >= 0) {
          const unsigned u = *(const unsigned*)(src + (size_t)(m0 - 3 + j) * NPROJ);
          rx[j] = bflo(u); ry[j] = bfhi(u);
        } else if (samp) {
          const float2 cs = *(const float2*)(p.st_gconv + ((size_t)(l * 128 + b) * 3 + j) * 1536 + ch);
          rx[j] = cs.x; ry[j] = cs.y;
        } else { rx[j] = 0.f; ry[j] = 0.f; }
      }
      float cwx[4], cwy[4];
#pragma unroll
      for (int j = 0; j < 4; ++j) {
        const float2 c2 = *(const float2*)(p.gd_conv_w + (size_t)(l * 4 + j) * 1536 + ch);
        cwx[j] = c2.x; cwy[j] = c2.y;
      }
#pragma unroll
      for (int tt = 0; tt < 4; ++tt) {
        float ax = 0.f, ay = 0.f;
#pragma unroll
        for (int j = 0; j < 4; ++j) { ax += cwx[j] * rx[tt + j]; ay += cwy[j] * ry[tt + j]; }
        ax = silu(ax); ay = silu(ay);
        if (pp < 2) {
          float ss = wave_sum(ax * ax + ay * ay);
          float sc = rsqrtf(ss + 1e-6f);
          if (pp == 0) sc *= 0.08838834764831845f;
          ax *= sc; ay *= sc;
        }
        *(unsigned*)(conv + (size_t)(m0 + tt) * 1536 + ch) = pk2(ax, ay);
      }
      const bool last = samp || (t0 == 2044);
      if (last) {
        float* co = p.out + (samp ? OFF_S_GC + (size_t)(l * 128 + b) * 3 * 1536 : OFF_P_GC + (size_t)(l * 8 + b) * 3 * 1536) + ch;
#pragma unroll
        for (int j = 0; j < 3; ++j) *(float2*)(co + j * 1536) = float2{rx[4 + j], ry[4 + j]};
      }
    } else if (k < 20) {
      const int kk = k - 12, part = kk >> 2, hh = kk & 3;
      const int wch = hh * 128 + lane * 2;
      u16* col = proj + 4096 + part * 512 + wch;
      float lb0 = 0.f, lb1 = 0.f;
      if (part == 1 && l == 1) {
        lb0 = sigm(p.hg_lb_logits[512 + wch] - p.hg_lb_logits[wch]);
        lb1 = sigm(p.hg_lb_logits[512 + wch + 1] - p.hg_lb_logits[wch + 1]);
      }
      unsigned u[4];
#pragma unroll
      for (int tt = 0; tt < 4; ++tt) u[tt] = *(const unsigned*)(col + (size_t)(m0 + tt) * NPROJ);
#pragma unroll
      for (int tt = 0; tt < 4; ++tt) {
        float a = bflo(u[tt]), c = bfhi(u[tt]);
        if (part == 0) { a = silu(a); c = silu(c); }
        else { a = (1.f - lb0) * sigm(-a); c = (1.f - lb1) * sigm(-c); }
        *(unsigned*)(col + (size_t)(m0 + tt) * NPROJ) = pk2(a, c);
      }
    } else {
      const int tt = lane >> 4, g = lane & 15, hh = g & 3;
      const float v = small[(size_t)(m0 + tt) * 16 + g];
      float r;
      if (g < 4) r = v + p.ml_i_bias[l * 4 + hh];
      else if (g < 8) { const float x = v + p.ml_f_bias[l * 4 + hh]; r = -softplus(-x); }
      else if (g < 12) r = sigm(v);
      else { const float x = v + p.gd_dt_bias[l * 4 + hh]; r = __expf(-__expf(p.gd_A_log[l * 4 + hh]) * softplus(x)); }
      gates[(size_t)(m0 + tt) * 16 + g] = r;
    }
  }
}

template <int KIND>
DEVI void scan_unit(const Params& p, int l, bool samp, int b, int h, int colbase, float* smem) {
  constexpr int CPL = (KIND == 1) ? 1 : 2;
  constexpr int UC = 32 * CPL;
  constexpr int VCH = UC / 8;
  const int tid = otid(), lane = tid & 63, w = tid >> 6, kg = lane & 15, cl = lane >> 4;
  const int T = samp ? 4 : 2048;
  const int rowbase = samp ? (MP + b * 4) : b * 2048;
  const int NB = samp ? 128 : 8;
  const u16* proj = (const u16*)(p.ws + WS_PROJ);
  const u16* conv = (const u16*)(p.ws + WS_CONV);
  u16* obuf = (u16*)(p.ws + WS_OBUF);
  const float* gates = (const float*)(p.ws + WS_GATES);
  float* dm = (float*)(p.ws + WS_DM);
  const u16 *qsrc, *ksrc, *vsrc;
  int ld, ocol;
  const float* Sin;
  float* Sout;
  const size_t sidx_in = ((size_t)(l * 128 + b) * 4 + h) * 16384;
  const size_t sidx_out = ((size_t)(l * NB + b) * 4 + h) * 16384;
  if (KIND == 0) {
    qsrc = proj + h * 128; ksrc = proj + 512 + h * 128; vsrc = proj + 1024 + h * 128 + colbase; ld = NPROJ; ocol = 0;
    Sin = p.st_mC + sidx_in; Sout = p.out + (samp ? OFF_S_MC : OFF_P_MC) + sidx_out;
  } else if (KIND == 1) {
    qsrc = conv + h * 128; ksrc = conv + 512 + h * 128; vsrc = conv + 1024 + h * 128 + colbase; ld = 1536; ocol = 512;
    Sin = p.st_gS + sidx_in; Sout = p.out + (samp ? OFF_S_GS : OFF_P_GS) + sidx_out;
  } else {
    qsrc = proj + 4096 + h * 128; ksrc = proj + 4608 + h * 128; vsrc = proj + 5120 + h * 128 + colbase; ld = NPROJ; ocol = 1024;
    Sin = p.st_hS + sidx_in; Sout = p.out + (samp ? OFF_S_HS : OFF_P_HS) + sidx_out;
  }
  float* qk = smem;
  float* vl = smem + 2 * 32 * 256;
  float* gl = vl + 2 * 32 * 64;

  const int wc = w * 4 * CPL + cl * CPL;
  const int col0 = colbase + wc;
  v2f S[CPL][4];
  v2f nv[4];
#pragma unroll
  for (int c = 0; c < CPL; ++c)
#pragma unroll
    for (int i = 0; i < 4; ++i) {
      if (samp) { S[c][i].x = Sin[(size_t)(kg * 8 + 2 * i) * 128 + col0 + c]; S[c][i].y = Sin[(size_t)(kg * 8 + 2 * i + 1) * 128 + col0 + c]; }
      else { S[c][i].x = 0.f; S[c][i].y = 0.f; }
    }
  float mstart = 0.f;
  if (KIND == 0) {
    const size_t nidx = ((size_t)(l * 128 + b) * 4 + h) * 128;
#pragma unroll
    for (int i = 0; i < 4; ++i) {
      if (samp) { nv[i].x = p.st_mn[nidx + kg * 8 + 2 * i]; nv[i].y = p.st_mn[nidx + kg * 8 + 2 * i + 1]; }
      else { nv[i].x = 0.f; nv[i].y = 0.f; }
    }
    if (samp) mstart = p.st_mm[(size_t)(l * 128 + b) * 4 + h];
  }

  uint4 rq, rk, rv;
  float g0 = 0.f, g1 = 0.f;
  const int sr = tid >> 4, sc = tid & 15;
  const int vr = tid / VCH, vc = tid % VCH;
  auto prefetch = [&](int j) {
    const int t = j * 32 + sr;
    rq = uint4{0, 0, 0, 0}; rk = uint4{0, 0, 0, 0}; rv = uint4{0, 0, 0, 0};
    if (t < T) {
      rq = *(const uint4*)(qsrc + (size_t)(rowbase + t) * ld + sc * 8);
      rk = *(const uint4*)(ksrc + (size_t)(rowbase + t) * ld + sc * 8);
    }
    if (tid < 32 * VCH) {
      const int tv = j * 32 + vr;
      if (tv < T) rv = *(const uint4*)(vsrc + (size_t)(rowbase + tv) * ld + vc * 8);
    }
    if (KIND != 2) {
      g0 = (KIND == 0) ? -1e30f : 0.f; g1 = 0.f;
      if (tid < 32) {
        const int tg = j * 32 + tid;
        if (tg < T) {
          if (KIND == 0) { g0 = gates[(size_t)(rowbase + tg) * 16 + h]; g1 = gates[(size_t)(rowbase + tg) * 16 + 4 + h]; }
          else { g0 = gates[(size_t)(rowbase + tg) * 16 + 8 + h]; g1 = gates[(size_t)(rowbase + tg) * 16 + 12 + h]; }
        }
      }
    }
  };
  auto stage = [&](int j, int buf) {
    float* qd = qk + (buf * 32 + sr) * 256 + sc * 8;
    *(float4*)(qd) = float4{bflo(rq.x), bfhi(rq.x), bflo(rq.y), bfhi(rq.y)};
    *(float4*)(qd + 4) = float4{bflo(rq.z), bfhi(rq.z), bflo(rq.w), bfhi(rq.w)};
    *(float4*)(qd + 128) = float4{bflo(rk.x), bfhi(rk.x), bflo(rk.y), bfhi(rk.y)};
    *(float4*)(qd + 132) = float4{bflo(rk.z), bfhi(rk.z), bflo(rk.w), bfhi(rk.w)};
    if (tid < 32 * VCH) {
      float* vd = vl + (buf * 32 + vr) * 64 + vc * 8;
      *(float4*)(vd) = float4{bflo(rv.x), bfhi(rv.x), bflo(rv.y), bfhi(rv.y)};
      *(float4*)(vd + 4) = float4{bflo(rv.z), bfhi(rv.z), bflo(rv.w), bfhi(rv.w)};
    }
    if (KIND == 0) {
      if (w == 0) {
        float bs = g1;
#pragma unroll
        for (int d = 1; d < 32; d <<= 1) { const float o = __shfl_up(bs, d); if (lane >= d) bs += o; }
        float R = g0 - bs;
#pragma unroll
        for (int d = 1; d < 32; d <<= 1) { const float o = __shfl_up(R, d); if (lane >= d) R = fmaxf(R, o); }
        const float mt = bs + fmaxf(mstart, R);
        float mprev = __shfl_up(mt, 1);
        if (lane == 0) mprev = mstart;
        const float fw = __expf(g1 + mprev - mt);
        const float iw = __expf(g0 - mt) * 0.08838834764831845f;
        if (lane < 32) {
          float* gd = gl + (buf * 32 + lane) * 4;
          gd[0] = fw; gd[1] = iw; gd[2] = mt;
        }
        int lastv = T - j * 32 - 1;
        if (lastv > 31) lastv = 31;
        mstart = __shfl(mt, lastv);
      }
    } else if (KIND == 1) {
      if (tid < 32) {
        float* gd = gl + (buf * 32 + tid) * 4;
        gd[0] = g0; gd[1] = g1;
      }
    }
  };

  const bool do_n = (KIND == 0) && (colbase == 0) && (w == 0);
  const int nblk = (T + 31) >> 5;
  prefetch(0);
  stage(0, 0);
  __syncthreads();
  for (int j = 0; j < nblk; ++j) {
    const int buf = j & 1;
    if (j + 1 < nblk) prefetch(j + 1);
    int steps = T - j * 32;
    if (steps > 32) steps = 32;
    u16* const obase = obuf + (size_t)(rowbase + j * 32) * LDY + ocol + h * 128 + col0;
    float* const dmbase = dm + (size_t)(rowbase + j * 32) * 8 + h;
    for (int t0 = 0; t0 < steps; t0 += 16) {
      int ns = steps - t0;
      if (ns > 16) ns = 16;
      float keep0 = 0.f, keep1 = 0.f, keepd = 0.f, keepm = 0.f;
#pragma unroll 4
      for (int tt = 0; tt < ns; ++tt) {
        const int t = t0 + tt;
        const float* qp = qk + (buf * 32 + t) * 256 + kg * 8;
        const float4 qa = *(const float4*)(qp), qb = *(const float4*)(qp + 4);
        const float4 ka = *(const float4*)(qp + 128), kb = *(const float4*)(qp + 132);
        const v2f q2[4] = {v2f{qa.x, qa.y}, v2f{qa.z, qa.w}, v2f{qb.x, qb.y}, v2f{qb.z, qb.w}};
        const v2f k2[4] = {v2f{ka.x, ka.y}, v2f{ka.z, ka.w}, v2f{kb.x, kb.y}, v2f{kb.z, kb.w}};
        const float* vp = vl + (buf * 32 + t) * 64 + wc;
        const float* gp = gl + (buf * 32 + t) * 4;
        const bool mine = (kg == tt);
        if (KIND == 0) {
          const float fw = gp[0], iw = gp[1];
          const v2f fw2 = v2f{fw, fw};
          const float2 vv = *(const float2*)vp;
          const float va[2] = {vv.x * iw, vv.y * iw};
          float num[2];
#pragma unroll
          for (int c = 0; c < 2; ++c) {
            const v2f vc2 = v2f{va[c], va[c]};
            v2f a = v2f{0.f, 0.f};
#pragma unroll
            for (int i = 0; i < 4; ++i) {
              S[c][i] = fw2 * S[c][i] + k2[i] * vc2;
              a += q2[i] * S[c][i];
            }
            num[c] = row16_sum(a.x + a.y);
          }
          keep0 = mine ? num[0] : keep0;
          keep1 = mine ? num[1] : keep1;
          if (do_n) {
            const v2f iw2 = v2f{iw, iw};
            v2f a = v2f{0.f, 0.f};
#pragma unroll
            for (int i = 0; i < 4; ++i) {
              nv[i] = fw2 * nv[i] + k2[i] * iw2;
              a += q2[i] * nv[i];
            }
            const float den = row16_sum(a.x + a.y);
            keepd = mine ? den : keepd;
            keepm = mine ? gp[2] : keepm;
          }
        } else if (KIND == 1) {
          const float beta = gp[0], g = gp[1];
          const float v = vp[0];
          v2f a = v2f{0.f, 0.f};
#pragma unroll
          for (int i = 0; i < 4; ++i) a += k2[i] * S[0][i];
          const float kS = row16_sum(a.x + a.y);
          const float vn = beta * (v - g * kS);
          const v2f g2 = v2f{g, g}, vn2 = v2f{vn, vn};
          v2f o2 = v2f{0.f, 0.f};
#pragma unroll
          for (int i = 0; i < 4; ++i) {
            S[0][i] = g2 * S[0][i] + k2[i] * vn2;
            o2 += q2[i] * S[0][i];
          }
          const float o = row16_sum(o2.x + o2.y);
          keep0 = mine ? o : keep0;
        } else {
          const float2 vv = *(const float2*)vp;
          const float va[2] = {vv.x, vv.y};
          float num[2];
#pragma unroll
          for (int c = 0; c < 2; ++c) {
            const v2f vc2 = v2f{va[c], va[c]};
            v2f a = v2f{0.f, 0.f};
#pragma unroll
            for (int i = 0; i < 4; ++i) {
              S[c][i] = S[c][i] + k2[i] * (vc2 - S[c][i]);
              a += q2[i] * S[c][i];
            }
            num[c] = row16_sum(a.x + a.y);
          }
          keep0 = mine ? num[0] : keep0;
          keep1 = mine ? num[1] : keep1;
        }
      }
      if (kg < ns) {
        if (KIND == 1) obase[(size_t)(t0 + kg) * LDY] = f2bf(keep0);
        else *(unsigned*)(obase + (size_t)(t0 + kg) * LDY) = pk2(keep0, keep1);
        if (do_n && cl == 0) { dmbase[(t0 + kg) * 8] = keepd; dmbase[(t0 + kg) * 8 + 4] = keepm; }
      }
    }
    if (j + 1 < nblk) stage(j + 1, buf ^ 1);
    __syncthreads();
  }
#pragma unroll
  for (int c = 0; c < CPL; ++c)
#pragma unroll
    for (int i = 0; i < 4; ++i) {
      Sout[(size_t)(kg * 8 + 2 * i) * 128 + col0 + c] = S[c][i].x;
      Sout[(size_t)(kg * 8 + 2 * i + 1) * 128 + col0 + c] = S[c][i].y;
    }
  if (KIND == 0 && colbase == 0 && w == 0) {
    if (cl == 0) {
      float* no = p.out + (samp ? OFF_S_MN : OFF_P_MN) + ((size_t)(l * NB + b) * 4 + h) * 128 + kg * 8;
#pragma unroll
      for (int i = 0; i < 4; ++i) { no[2 * i] = nv[i].x; no[2 * i + 1] = nv[i].y; }
    }
    if (lane == 0) p.out[(samp ? OFF_S_MM : OFF_P_MM) + (size_t)(l * NB + b) * 4 + h] = mstart;
  }
  __syncthreads();
}

DEVI void scan_sample_unit(const Params& p, int l, int s, float* smem) {
  const int s4 = s & 3;
  if (s4 < 2) {
    const int idx = (s >> 2) * 2 + (s & 1), seq = idx >> 2;
    scan_unit<1>(p, l, true, seq >> 2, seq & 3, (idx & 3) * 32, smem);
  } else {
    const int idx = s >> 2, seq = idx >> 1;
    if (s4 == 2) scan_unit<0>(p, l, true, seq >> 2, seq & 3, (idx & 1) * 64, smem);
    else scan_unit<2>(p, l, true, seq >> 2, seq & 3, (idx & 1) * 64, smem);
  }
}

DEVI void phase_scan(const Params& p, int l, float* smem) {
  for (int u = blockIdx.x; u < 256; u += gridDim.x) {
    if (u < 128) {
      const int seq = u >> 2;
      scan_unit<1>(p, l, false, seq >> 2, seq & 3, (u & 3) * 32, smem);
    } else if (u < 192) {
      const int uu = u - 128, seq = uu >> 1;
      scan_unit<0>(p, l, false, seq >> 2, seq & 3, (uu & 1) * 64, smem);
    } else {
      const int uu = u - 192, seq = uu >> 1;
      scan_unit<2>(p, l, false, seq >> 2, seq & 3, (uu & 1) * 64, smem);
    }
  }
  if (gridDim.x == 256) {
    const int b = blockIdx.x;
    const int s0 = (b < 128) ? b * 24 : 3072 + (b - 128) * 8;
    const int cnt = (b < 128) ? 24 : 8;
    for (int i = 0; i < cnt; ++i) scan_sample_unit(p, l, s0 + i, smem);
  } else {
    for (int s = blockIdx.x; s < 4096; s += gridDim.x) scan_sample_unit(p, l, s, smem);
  }
}

DEVI void phase_post(const Params& p, int l) {
  const int tid_ = otid(); const int lane = tid_ & 63, gw = blockIdx.x * 8 + (tid_ >> 6), nw = gridDim.x * 8;
  const u16* proj = (const u16*)(p.ws + WS_PROJ);
  u16* obuf = (u16*)(p.ws + WS_OBUF);
  const float* dm = (const float*)(p.ws + WS_DM);
  constexpr int NTASK = (M / 4) * 9;
  for (int task = gw; task < NTASK; task += nw) {
    const int tg = task / 9, k = task - tg * 9;
    const int m0 = tg * 4;
    if (k < 4) {
      const int hh = k, c = hh * 128 + lane * 2;
      const float2 nw2 = *(const float2*)(p.ml_norm_w + l * 512 + c);
#pragma unroll
      for (int tt = 0; tt < 4; ++tt) {
        const size_t m = m0 + tt;
        const unsigned u = *(const unsigned*)(obuf + m * LDY + c);
        const unsigned og = *(const unsigned*)(proj + m * NPROJ + 1536 + c);
        const float den = dm[m * 8 + hh], mt = dm[m * 8 + 4 + hh];
        const float dd = fmaxf(fabsf(den), __expf(-mt));
        const float h0 = bflo(u) / dd, h1 = bfhi(u) / dd;
        const float ss = wave_sum(h0 * h0 + h1 * h1);
        const float sc = rsqrtf(ss * (1.f / 128.f) + 1e-6f);
        *(unsigned*)(obuf + m * LDY + c) = pk2(h0 * sc * nw2.x * sigm(bflo(og)), h1 * sc * nw2.y * sigm(bfhi(og)));
      }
    } else if (k < 8) {
      const int hh = k - 4, cc = lane * 2, c = hh * 128 + cc;
      const float2 nw2 = *(const float2*)(p.gd_norm_w + l * 128 + cc);
#pragma unroll
      for (int tt = 0; tt < 4; ++tt) {
        const size_t m = m0 + tt;
        const unsigned u = *(const unsigned*)(obuf + m * LDY + 512 + c);
        const unsigned z = *(const unsigned*)(proj + m * NPROJ + 3584 + c);
        const float o0 = bflo(u), o1 = bfhi(u);
        const float ss = wave_sum(o0 * o0 + o1 * o1);
        const float sc = rsqrtf(ss * (1.f / 128.f) + 1e-6f);
        *(unsigned*)(obuf + m * LDY + 512 + c) = pk2(o0 * sc * nw2.x * silu(bflo(z)), o1 * sc * nw2.y * silu(bfhi(z)));
      }
    } else {
      const int c = lane * 8;
      const float4 wa = *(const float4*)(p.hg_norm_w + l * 512 + c), wb = *(const float4*)(p.hg_norm_w + l * 512 + c + 4);
#pragma unroll
      for (int tt = 0; tt < 4; ++tt) {
        const size_t m = m0 + tt;
        const uint4 ov = *(const uint4*)(obuf + m * LDY + 1024 + c);
        const uint4 gv = *(const uint4*)(proj + m * NPROJ + 5632 + c);
        float o[8] = {bflo(ov.x), bfhi(ov.x), bflo(ov.y), bfhi(ov.y), bflo(ov.z), bfhi(ov.z), bflo(ov.w), bfhi(ov.w)};
        const float g[8] = {bflo(gv.x), bfhi(gv.x), bflo(gv.y), bfhi(gv.y), bflo(gv.z), bfhi(gv.z), bflo(gv.w), bfhi(gv.w)};
        const float wv[8] = {wa.x, wa.y, wa.z, wa.w, wb.x, wb.y, wb.z, wb.w};
        float ss = 0.f;
#pragma unroll
        for (int i = 0; i < 8; ++i) ss += o[i] * o[i];
        ss = wave_sum(ss);
        const float sc = rsqrtf(ss * (1.f / 512.f) + 1e-6f);
#pragma unroll
        for (int i = 0; i < 8; ++i) o[i] = o[i] * sc * wv[i] * silu(g[i]);
        uint4 r;
        r.x = pk2(o[0], o[1]); r.y = pk2(o[2], o[3]); r.z = pk2(o[4], o[5]); r.w = pk2(o[6], o[7]);
        *(uint4*)(obuf + m * LDY + 1024 + c) = r;
      }
    }
  }
}

#define LAS __attribute__((address_space(3)))
#define XB_TMO      128
#define XB_XCNT(j)  (256  + 64 * (j))
#define XB_XSUB(j)  (1280 + 64 * (j))
#define XB_XGEN(j)  (2304 + 64 * (j))
#define XB_TOP      3328
#define XB_TOPGEN   3392
#define XCD_BAR_WORDS 3456
#define XB_SPIN_CAP (1u << 18)

__device__ __forceinline__ unsigned xb_ld(unsigned* p)              { return __hip_atomic_load(p, __ATOMIC_RELAXED, __HIP_MEMORY_SCOPE_AGENT); }
__device__ __forceinline__ unsigned xb_add(unsigned* p, unsigned v) { return __hip_atomic_fetch_add(p, v, __ATOMIC_RELAXED, __HIP_MEMORY_SCOPE_AGENT); }
__device__ __forceinline__ unsigned xb_xcc_id() { return (unsigned)__builtin_amdgcn_s_getreg((3 << 11) | 20) & 0xFu; }
#define XB_SPIN(cond, bar) do { unsigned _sp = 0; while (cond) { __builtin_amdgcn_s_sleep(1); \
    if ((++_sp & 255u) == 0u) { if (xb_ld(&(bar)[XB_TMO])) break; if (_sp > XB_SPIN_CAP) { atomicAdd(&(bar)[XB_TMO], 1u); break; } } } } while (0)

struct XcdBarrier {
    unsigned* bar; unsigned x;
    volatile LAS unsigned* st;
};

__device__ __forceinline__ XcdBarrier xcd_barrier_post(unsigned* bar, volatile LAS unsigned* st) {
    XcdBarrier b; b.bar = bar; b.x = xb_xcc_id(); b.st = st;
    if (threadIdx.x == 0) (void)xb_add(&bar[XB_XCNT(b.x)], 1u);
    return b;
}
__device__ __forceinline__ void xcd_barrier_complete(unsigned* bar, unsigned x, unsigned& nloc, unsigned& nx) {
    const unsigned G = gridDim.x * gridDim.y * gridDim.z;
    unsigned sum, cnt, mine, sp = 0u;
    for (;;) {
        sum = 0u; cnt = 0u; mine = 0u;
#pragma unroll
        for (unsigned j = 0; j < 16; ++j) { const unsigned c = xb_ld(&bar[XB_XCNT(j)]); sum += c; cnt += (c > 0u) ? 1u : 0u; mine = (j == x) ? c : mine; }
        if (sum == G) break;
        __builtin_amdgcn_s_sleep(1);
        if ((++sp & 255u) == 0u) { if (xb_ld(&bar[XB_TMO])) break; if (sp > XB_SPIN_CAP) { atomicAdd(&bar[XB_TMO], 1u); break; } }
    }
    nloc = mine > 0u ? mine : 1u; nx = cnt > 0u ? cnt : 1u;
}

__device__ __forceinline__ void xcd_barrier(const XcdBarrier& b) {
    asm volatile("s_waitcnt vmcnt(0)" ::: "memory");
    __syncthreads();
    if (threadIdx.x == 0) {
        unsigned* bar = b.bar;
        __builtin_amdgcn_s_waitcnt(0);
        unsigned nloc = b.st[0], nx = b.st[1];
        if (nloc == 0u) { xcd_barrier_complete(bar, b.x, nloc, nx); b.st[0] = nloc; b.st[1] = nx; }
        const unsigned old = xb_add(&bar[XB_XSUB(b.x)], 1u);
        const unsigned gen = old / nloc;
        if (old + 1u == (gen + 1u) * nloc) {
            __builtin_amdgcn_fence(__ATOMIC_RELEASE, "agent");
            asm volatile("s_waitcnt vmcnt(0)" ::: "memory");
            const unsigned og = xb_add(&bar[XB_TOP], 1u);
            const unsigned tg = og / nx;
            if (og + 1u == (tg + 1u) * nx) xb_add(&bar[XB_TOPGEN], 1u);
            else XB_SPIN(xb_ld(&bar[XB_TOPGEN]) == tg, bar);
            __builtin_amdgcn_fence(__ATOMIC_ACQUIRE, "agent");
            xb_add(&bar[XB_XGEN(b.x)], 1u);
            asm volatile("s_waitcnt vmcnt(0)" ::: "memory");
        } else {
            XB_SPIN(xb_ld(&bar[XB_XGEN(b.x)]) == gen, bar);
            __builtin_amdgcn_fence(__ATOMIC_ACQUIRE, "agent");
            asm volatile("s_waitcnt vmcnt(0)" ::: "memory");
        }
    }
    __syncthreads();
}


__global__ void __launch_bounds__(NTHREADS) mega_fwd(Params p) {
  extern __shared__ __attribute__((aligned(16))) unsigned char smem_raw[];
  cg::grid_group grid = cg::this_grid();
  float* smf = (float*)smem_raw;
  u16* smh = (u16*)smem_raw;
  u16* xn = (u16*)(p.ws + WS_XN);
  float* x = p.out;

  volatile LAS unsigned* bst = (volatile LAS unsigned*)(smem_raw + LDS_BYTES - 16);
  if (threadIdx.x < 2) bst[threadIdx.x] = 0u;
  __syncthreads();
  XcdBarrier xbar; xbar.bar = (unsigned*)(p.ws + WS_BAR); xbar.x = xb_xcc_id(); xbar.st = bst;
  if (threadIdx.x == 0) bst[2] = xb_add(&xbar.bar[XB_XCNT(xbar.x)], 1u);
  phase_wprep(p, smf);
  phase_norm(p.x_prompt, p.x_sample, p.norm1_w, xn);
  grid.sync();
  if (threadIdx.x == 0) {
    const unsigned per = gridDim.x >> 3;
    bool ok = (gridDim.x & 7u) == 0u && xbar.x < 8u;
    for (unsigned j = 0; j < 8; ++j) ok = ok && (xb_ld(&xbar.bar[XB_XCNT(j)]) == per);
    const unsigned rank = bst[2];
    bst[3] = (ok && rank < per) ? xbar.x * per + rank : (blockIdx.x & 7u) * per + (blockIdx.x >> 3);
  }
  __syncthreads();
  const int vcu = (int)bst[3];
#pragma unroll 1
  for (int l = 0; l < 2; ++l) {
    phase_proj(p, l, vcu, smh);
    xcd_barrier(xbar);
    phase_prep(p, l);
    xcd_barrier(xbar);
    phase_scan(p, l, smf);
    xcd_barrier(xbar);
    phase_post(p, l);
    xcd_barrier(xbar);
    phase_merge(p, l, vcu, smh);
    xcd_barrier(xbar);
    if (l == 0)
      phase_resid((const u16*)(p.ws + WS_CONV), LDX, 1024, (const u16*)(p.ws + WS_WT_OUT), LDW1, p.x_prompt, p.x_sample, x, vcu, smh);
    else
      phase_resid((const u16*)(p.ws + WS_CONV), LDX, 1024, (const u16*)(p.ws + WS_WT_OUT) + (size_t)1024 * LDW1, LDW1, x, x + (size_t)MP * D, x, vcu, smh);
    xcd_barrier(xbar);
    phase_norm(x, x + (size_t)MP * D, p.norm2_w + l * D, xn);
    xcd_barrier(xbar);
    phase_up(p, l, vcu, smh);
    xcd_barrier(xbar);
    phase_resid((const u16*)(p.ws + WS_PROJ), LDH, 4096, (const u16*)(p.ws + WS_WT_DN) + (size_t)l * 1024 * LDWD, LDWD, x, x + (size_t)MP * D, x, vcu, smh);
    xcd_barrier(xbar);
    if (l == 0) {
      phase_norm(x, x + (size_t)MP * D, p.norm1_w + D, xn);
      xcd_barrier(xbar);
    }
  }
  phase_final_norm(x, p.final_norm_w);
}

extern "C" void kernel_launch(void* const* d_in, const int* in_sizes, int n_in, void* d_out, int out_size, void* d_ws,
                              size_t ws_size, hipStream_t stream) {
  static int grid_blocks = 0;
  if (!grid_blocks) {
    int dev = 0, cus = 0, per_cu = 0;
    hipGetDevice(&dev);
    hipDeviceGetAttribute(&cus, hipDeviceAttributeMultiprocessorCount, dev);
    hipFuncSetAttribute((const void*)mega_fwd, hipFuncAttributeMaxDynamicSharedMemorySize, LDS_BYTES);
    hipOccupancyMaxActiveBlocksPerMultiprocessor(&per_cu, (const void*)mega_fwd, NTHREADS, LDS_BYTES);
    if (per_cu < 1) { fprintf(stderr, "occupancy query returned %d\n", per_cu); per_cu = 1; }
    grid_blocks = cus;
    if (ws_size < WS_END) fprintf(stderr, "workspace too small: %zu < %zu\n", ws_size, (size_t)WS_END);
  }
  Params p{};
  p.x_prompt = (const float*)d_in[0]; p.x_sample = (const float*)d_in[1];
  p.st_mC = (const float*)d_in[2]; p.st_mn = (const float*)d_in[3]; p.st_mm = (const float*)d_in[4];
  p.st_gS = (const float*)d_in[5]; p.st_gconv = (const float*)d_in[6]; p.st_hS = (const float*)d_in[7];
  p.norm1_w = (const float*)d_in[8]; p.w_in = (const float*)d_in[9]; p.ml_i_bias = (const float*)d_in[10];
  p.ml_f_bias = (const float*)d_in[11]; p.ml_norm_w = (const float*)d_in[12]; p.gd_conv_w = (const float*)d_in[13];
  p.gd_A_log = (const float*)d_in[14]; p.gd_dt_bias = (const float*)d_in[15]; p.gd_norm_w = (const float*)d_in[16];
  p.hg_lb_logits = (const float*)d_in[17]; p.hg_norm_w = (const float*)d_in[18]; p.w_branch = (const float*)d_in[19];
  p.w_out = (const float*)d_in[20]; p.norm2_w = (const float*)d_in[21]; p.w_up = (const float*)d_in[22];
  p.w_down = (const float*)d_in[23]; p.final_norm_w = (const float*)d_in[24];
  p.out = (float*)d_out;
  p.ws = (unsigned char*)d_ws;
  hipMemsetAsync((char*)d_ws + WS_BAR, 0, WS_BAR_BYTES, stream);
  void* args[] = {&p};
  hipError_t e = hipLaunchCooperativeKernel((const void*)mega_fwd, dim3(grid_blocks), dim3(NTHREADS), args, LDS_BYTES, stream);
  if (e != hipSuccess) fprintf(stderr, "cooperative launch failed: %s (grid %d)\n", hipGetErrorString(e), grid_blocks);
}
```

```cpp
#include <hip/hip_runtime.h>
#include <hip/hip_cooperative_groups.h>
#include <cstdio>
namespace cg = cooperative_groups;

typedef unsigned short u16;
using bf16x8 = __attribute__((ext_vector_type(8))) short;
using f32x4 = __attribute__((ext_vector_type(4))) float;
typedef float v2f __attribute__((ext_vector_type(2)));

#define DEVI __device__ __forceinline__

constexpr int D = 1024;
constexpr int MP = 16384, MS = 512, M = MP + MS;
constexpr int NPROJ = 6144, NPROJ_PAD = 6272;
constexpr int INC = 9232;
constexpr int DFF = 4096;
constexpr int NTHREADS = 512;
constexpr int LDS_BYTES = 132 * 1024;
constexpr int LDX = 1088, LDH = 4160, LDY = 1600, LDW1 = 1088, LDWB = 576, LDWD = 4160;

constexpr size_t OFF_Y = 0;
constexpr size_t OFF_P_MC = (size_t)M * D;
constexpr size_t OFF_P_MN = OFF_P_MC + 2ull * 8 * 4 * 128 * 128;
constexpr size_t OFF_P_MM = OFF_P_MN + 2ull * 8 * 4 * 128;
constexpr size_t OFF_P_GS = OFF_P_MM + 2ull * 8 * 4;
constexpr size_t OFF_P_GC = OFF_P_GS + 2ull * 8 * 4 * 128 * 128;
constexpr size_t OFF_P_HS = OFF_P_GC + 2ull * 8 * 3 * 1536;
constexpr size_t OFF_S_MC = OFF_P_HS + 2ull * 8 * 4 * 128 * 128;
constexpr size_t OFF_S_MN = OFF_S_MC + 2ull * 128 * 4 * 128 * 128;
constexpr size_t OFF_S_MM = OFF_S_MN + 2ull * 128 * 4 * 128;
constexpr size_t OFF_S_GS = OFF_S_MM + 2ull * 128 * 4;
constexpr size_t OFF_S_GC = OFF_S_GS + 2ull * 128 * 4 * 128 * 128;
constexpr size_t OFF_S_HS = OFF_S_GC + 2ull * 128 * 3 * 1536;
static_assert(OFF_S_HS + 2ull * 128 * 4 * 128 * 128 == 72172608ull, "output size");

constexpr size_t WS_WT_IN = 0;
constexpr size_t WS_WT_GATE = WS_WT_IN + 2ull * NPROJ_PAD * LDW1 * 2;
constexpr size_t WS_WT_BR = WS_WT_GATE + 2ull * 3072 * LDW1 * 2;
constexpr size_t WS_WT_OUT = WS_WT_BR + 2ull * 3 * 1024 * LDWB * 2;
constexpr size_t WS_WT_UP = WS_WT_OUT + 2ull * 1024 * LDW1 * 2;
constexpr size_t WS_WT_DN = WS_WT_UP + 2ull * 4096 * LDW1 * 2;
constexpr size_t WS_PROJ = WS_WT_DN + 2ull * 1024 * LDWD * 2;
constexpr size_t WS_CONV = WS_PROJ + (size_t)M * NPROJ * 2;
constexpr size_t WS_OBUF = WS_CONV + (size_t)M * 1536 * 2;
constexpr size_t WS_XN = WS_OBUF + (size_t)M * LDY * 2;
constexpr size_t WS_SMALL = WS_XN + (size_t)M * LDX * 2;
constexpr size_t WS_GATES = WS_SMALL;
constexpr size_t WS_DM = WS_GATES + (size_t)M * 16 * 4;
constexpr size_t WS_BAR = WS_DM + (size_t)M * 8 * 4;
constexpr size_t WS_BAR_BYTES = 16384;
constexpr size_t WS_END = WS_BAR + WS_BAR_BYTES;
static_assert(WS_END <= 439571584ull, "workspace budget");
static_assert((size_t)M * LDH * 2 <= (size_t)M * NPROJ * 2 && (size_t)M * LDX * 2 <= (size_t)M * 1536 * 2, "aliases fit");

struct Params {
  const float *x_prompt, *x_sample, *st_mC, *st_mn, *st_mm, *st_gS, *st_gconv, *st_hS;
  const float *norm1_w, *w_in, *ml_i_bias, *ml_f_bias, *ml_norm_w, *gd_conv_w, *gd_A_log, *gd_dt_bias,
      *gd_norm_w, *hg_lb_logits, *hg_norm_w, *w_branch, *w_out, *norm2_w, *w_up, *w_down, *final_norm_w;
  float* out;
  unsigned char* ws;
};

DEVI u16 f2bf(float f) { unsigned u = __float_as_uint(f); return (u16)((u + 0x7fffu + ((u >> 16) & 1u)) >> 16); }
DEVI unsigned pk2(float lo, float hi) { return (unsigned)f2bf(lo) | ((unsigned)f2bf(hi) << 16); }
DEVI float bflo(unsigned u) { return __uint_as_float(u << 16); }
DEVI float bfhi(unsigned u) { return __uint_as_float(u & 0xffff0000u); }
DEVI float sigm(float x) { return 1.f / (1.f + __expf(-x)); }
DEVI float silu(float x) { return x * sigm(x); }
DEVI float softplus(float x) { return fmaxf(x, 0.f) + __logf(1.f + __expf(-fabsf(x))); }
DEVI int otid() { int t = threadIdx.x; asm volatile("" : "+v"(t)); return t; }
DEVI float wave_sum(float v) {
#pragma unroll
  for (int o = 32; o > 0; o >>= 1) v += __shfl_xor(v, o);
  return v;
}
template <int CTRL> DEVI float dpp_f(float v) {
  return __int_as_float(__builtin_amdgcn_update_dpp(0, __float_as_int(v), CTRL, 0xf, 0xf, false));
}
DEVI float row16_sum(float v) {
  float r;
  asm("s_nop 1\n\tv_add_f32_dpp %0, %1, %1 row_ror:8 row_mask:0xf bank_mask:0xf" : "=v"(r) : "v"(v));
  asm("s_nop 1\n\tv_add_f32_dpp %0, %1, %1 row_ror:4 row_mask:0xf bank_mask:0xf" : "=v"(v) : "v"(r));
  asm("s_nop 1\n\tv_add_f32_dpp %0, %1, %1 row_ror:2 row_mask:0xf bank_mask:0xf" : "=v"(r) : "v"(v));
  asm("s_nop 1\n\tv_add_f32_dpp %0, %1, %1 row_ror:1 row_mask:0xf bank_mask:0xf" : "=v"(v) : "v"(r));
  return v;
}

DEVI void tr_seg(const float* __restrict__ src, int ld, int K, int ncols, u16* __restrict__ dst, int dld, float* tile, int& off) {
  const int tid_ = otid();
  const int lane = tid_ & 63, gw = blockIdx.x * 8 + (tid_ >> 6), nw = gridDim.x * 8;
  const int nkb = K >> 4, nnb = ncols >> 6, nt = nkb * nnb;
  const int start = (int)(((long)gw + (long)nw * 4096 - off) % nw);
  for (int t = start; t < nt; t += nw) {
    const int kb = t % nkb, nb = t / nkb;
    const float* sp = src + (size_t)(kb * 16) * ld + nb * 64 + lane;
    float v[16];
#pragma unroll
    for (int i = 0; i < 16; ++i) v[i] = sp[(size_t)i * ld];
    uint4 o0, o1;
    o0.x = pk2(v[0], v[1]); o0.y = pk2(v[2], v[3]); o0.z = pk2(v[4], v[5]); o0.w = pk2(v[6], v[7]);
    o1.x = pk2(v[8], v[9]); o1.y = pk2(v[10], v[11]); o1.z = pk2(v[12], v[13]); o1.w = pk2(v[14], v[15]);
    u16* dp = dst + (size_t)(nb * 64 + lane) * dld + kb * 16;
    *(uint4*)dp = o0;
    *(uint4*)(dp + 8) = o1;
  }
  off += nt;
}

DEVI void phase_wprep(const Params& p, float* tile) {
  int off = 0;
  u16* wt_in = (u16*)(p.ws + WS_WT_IN);
  u16* wt_gate = (u16*)(p.ws + WS_WT_GATE);
  u16* wt_br = (u16*)(p.ws + WS_WT_BR);
  u16* wt_out = (u16*)(p.ws + WS_WT_OUT);
  u16* wt_up = (u16*)(p.ws + WS_WT_UP);
  u16* wt_dn = (u16*)(p.ws + WS_WT_DN);
  for (int l = 0; l < 2; ++l) {
    const float* win = p.w_in + (size_t)l * 1024 * INC;
    for (int s = 0; s < 12; ++s) {
      const int srccol = (s < 4) ? s * 512 : (s < 8 ? 2056 + (s - 4) * 512 : 4112 + (s - 8) * 512);
      tr_seg(win + srccol, INC, 1024, 512, wt_in + ((size_t)l * NPROJ_PAD + s * 512) * LDW1, LDW1, tile, off);
    }
    tr_seg(win + 6160, INC, 1024, 3072, wt_gate + (size_t)l * 3072 * LDW1, LDW1, tile, off);
    for (int b = 0; b < 3; ++b)
      tr_seg(p.w_branch + (size_t)(l * 3 + b) * 512 * 1024, 1024, 512, 1024, wt_br + (size_t)(l * 3 + b) * 1024 * LDWB, LDWB, tile, off);
    tr_seg(p.w_out + (size_t)l * 1024 * 1024, 1024, 1024, 1024, wt_out + (size_t)l * 1024 * LDW1, LDW1, tile, off);
    tr_seg(p.w_up + (size_t)l * 1024 * 4096, 4096, 1024, 4096, wt_up + (size_t)l * 4096 * LDW1, LDW1, tile, off);
    tr_seg(p.w_down + (size_t)l * 4096 * 1024, 1024, 4096, 1024, wt_dn + (size_t)l * 1024 * LDWD, LDWD, tile, off);
  }
  for (int idx = blockIdx.x * NTHREADS + otid(); idx < 2 * 128 * 1024; idx += gridDim.x * NTHREADS) {
    const int l = idx >> 17, rem = idx & 131071, r = rem >> 10, k = rem & 1023;
    float v = 0.f;
    if (r < 16) {
      const int sc = (r < 8) ? 2048 + r : 4104 + (r - 8);
      v = p.w_in[(size_t)l * 1024 * INC + (size_t)k * INC + sc];
    }
    wt_in[((size_t)l * NPROJ_PAD + 6144 + r) * LDW1 + k] = f2bf(v);
  }
}

DEVI void phase_norm(const float* xp, const float* xs, const float* __restrict__ w, u16* __restrict__ xn) {
  const int tid_ = otid(); const int lane = tid_ & 63, gw = blockIdx.x * 8 + (tid_ >> 6), nw = gridDim.x * 8;
  for (int m = gw; m < M; m += nw) {
    const float* xr = (m < MP) ? xp + (size_t)m * D : xs + (size_t)(m - MP) * D;
    float4 v[4];
    float ss = 0.f;
#pragma unroll
    for (int i = 0; i < 4; ++i) {
      v[i] = ((const float4*)xr)[lane + 64 * i];
      ss += v[i].x * v[i].x + v[i].y * v[i].y + v[i].z * v[i].z + v[i].w * v[i].w;
    }
    ss = wave_sum(ss);
    const float rstd = rsqrtf(ss * (1.f / 1024.f) + 1e-6f);
#pragma unroll
    for (int i = 0; i < 4; ++i) {
      const float4 wv = ((const float4*)w)[lane + 64 * i];
      uint2 o;
      o.x = pk2(v[i].x * rstd * wv.x, v[i].y * rstd * wv.y);
      o.y = pk2(v[i].z * rstd * wv.z, v[i].w * rstd * wv.w);
      ((uint2*)(xn + (size_t)m * LDX))[lane + 64 * i] = o;
    }
  }
}

DEVI void phase_final_norm(float* x, const float* __restrict__ w) {
  const int tid_ = otid(); const int lane = tid_ & 63, gw = blockIdx.x * 8 + (tid_ >> 6), nw = gridDim.x * 8;
  for (int m = gw; m < M; m += nw) {
    float* xr = x + (size_t)m * D;
    float4 v[4];
    float ss = 0.f;
#pragma unroll
    for (int i = 0; i < 4; ++i) {
      v[i] = ((const float4*)xr)[lane + 64 * i];
      ss += v[i].x * v[i].x + v[i].y * v[i].y + v[i].z * v[i].z + v[i].w * v[i].w;
    }
    ss = wave_sum(ss);
    const float rstd = rsqrtf(ss * (1.f / 1024.f) + 1e-6f);
#pragma unroll
    for (int i = 0; i < 4; ++i) {
      const float4 wv = ((const float4*)w)[lane + 64 * i];
      float4 o;
      o.x = v[i].x * rstd * wv.x; o.y = v[i].y * rstd * wv.y; o.z = v[i].z * rstd * wv.z; o.w = v[i].w * rstd * wv.w;
      ((float4*)xr)[lane + 64 * i] = o;
    }
  }
}

constexpr int LDS_S = 64;

struct GemmOp { const u16* A; const u16* B; int lda, ldb, K, koff; };

DEVI bool tile_map(int it, int vcu, int MT, int NT, int& mt, int& nt) {
  const int G = gridDim.x;
  const int t = it * G + vcu;
  if (t >= MT * NT) return false;
  constexpr int GM = 4;
  const int gsize = GM * NT;
  const int g = t / gsize, tl = t - g * gsize;
  int gsz = MT - g * GM;
  if (gsz > GM) gsz = GM;
  mt = g * GM + (tl % gsz);
  nt = tl / gsz;
  return true;
}
DEVI int koff_of(int mt, int nt) { return (nt & 7) + 2 * (mt & 3); }

template <int WMT, int WNT>
DEVI void zero_acc(f32x4 (&acc)[WMT][WNT]) {
#pragma unroll
  for (int i = 0; i < WMT; ++i)
#pragma unroll
    for (int j = 0; j < WNT; ++j) acc[i][j] = f32x4{0.f, 0.f, 0.f, 0.f};
}

#define PF_PARAMS uint4 &pa0, uint4 &pa1, uint4 &pa2, uint4 &pa3, uint4 &pb0, uint4 &pb1, uint4 &qa0, uint4 &qa1, uint4 &qa2, uint4 &qa3, uint4 &qb0, uint4 &qb1
#define PF_ARGS pa0, pa1, pa2, pa3, pb0, pb1, qa0, qa1, qa2, qa3, qb0, qb1
#define PF_DECL uint4 pa0 = uint4{0, 0, 0, 0}, pa1 = pa0, pa2 = pa0, pa3 = pa0, pb0 = pa0, pb1 = pa0, qa0 = pa0, qa1 = pa0, qa2 = pa0, qa3 = pa0, qb0 = pa0, qb1 = pa0
template <int WMT, int WNT>
DEVI void gemm_core(const GemmOp cur, const GemmOp nxt, bool primed, PF_PARAMS, f32x4 (&acc)[WMT][WNT], u16* smem) {
  constexpr int BM = 64 * WMT, BN = 32 * WNT;
  constexpr int ACH = BM * 8 / NTHREADS, BCH = BN * 8 / NTHREADS;
  static_assert(BCH == 2 && (ACH == 2 || ACH == 4), "chunk counts");
  u16* sA = smem;
  u16* sB = smem + 2 * BM * LDS_S;
  const int tid = otid(), lane = tid & 63, w = tid >> 6, wm = w >> 1, wn = w & 1;
  const int fr = lane & 15, fq = lane >> 4;
  const int crow = tid >> 3, ckc = tid & 7;
  const int wsw = (ckc ^ (crow & 7)) * 8;
  const int rsw0 = (fq ^ (fr & 7)) * 8;
  const u16* Ag = cur.A + (size_t)crow * cur.lda + ckc * 8;
  const u16* Bg = cur.B + (size_t)crow * cur.ldb + ckc * 8;
  const int nk = cur.K >> 6, km = nk - 1, kmn = (nxt.K >> 6) - 1;
#define GLOADX(S, AP, BP, LA, LB, KO)                                                 \
  do {                                                                                \
    S##a0 = *(const uint4*)((AP) + (KO));                                           \
    S##a1 = *(const uint4*)((AP) + (size_t)64 * (LA) + (KO));                       \
    if (ACH == 4) {                                                                   \
      S##a2 = *(const uint4*)((AP) + (size_t)128 * (LA) + (KO));                    \
      S##a3 = *(const uint4*)((AP) + (size_t)192 * (LA) + (KO));                    \
    }                                                                                 \
    S##b0 = *(const uint4*)((BP) + (KO));                                           \
    S##b1 = *(const uint4*)((BP) + (size_t)64 * (LB) + (KO));                       \
  } while (0)
#define GLOADC(S, T) GLOADX(S, Ag, Bg, cur.lda, cur.ldb, ((((T) + cur.koff) & km) * 64))
#define GLOADN(S, T) GLOADX(S, An, Bn, nxt.lda, nxt.ldb, ((((T) + nxt.koff) & kmn) * 64))
#define SSTORE(S, NB)                                                                 \
  do {                                                                                \
    u16* dA = sA + ((NB) * BM + crow) * LDS_S + wsw;                                  \
    u16* dB = sB + ((NB) * BN + crow) * LDS_S + wsw;                                  \
    *(uint4*)(dA) = S##a0;                                                          \
    *(uint4*)(dA + 64 * LDS_S) = S##a1;                                             \
    if (ACH == 4) {                                                                   \
      *(uint4*)(dA + 128 * LDS_S) = S##a2;                                          \
      *(uint4*)(dA + 192 * LDS_S) = S##a3;                                          \
    }                                                                                 \
    *(uint4*)(dB) = S##b0;                                                          \
    *(uint4*)(dB + 64 * LDS_S) = S##b1;                                             \
  } while (0)
#define LOADFR(BUF)                                                                   \
  do {                                                                                \
    const u16* cA = sA + ((BUF) * BM + wm * 16 * WMT + fr) * LDS_S;                   \
    const u16* cB = sB + ((BUF) * BN + wn * 16 * WNT + fr) * LDS_S;                   \
    _Pragma("unroll") for (int ks = 0; ks < 2; ++ks) {                                \
      const int so = rsw0 ^ (ks * 32);                                                \
      _Pragma("unroll") for (int i = 0; i < WMT; ++i) af[ks][i] = *(const bf16x8*)(cA + i * 16 * LDS_S + so);  \
      _Pragma("unroll") for (int j = 0; j < WNT; ++j) bfr[ks][j] = *(const bf16x8*)(cB + j * 16 * LDS_S + so); \
    }                                                                                 \
  } while (0)
#define MFMAS()                                                                       \
  do {                                                                                \
    _Pragma("unroll") for (int ks = 0; ks < 2; ++ks)                                  \
      _Pragma("unroll") for (int i = 0; i < WMT; ++i)                                 \
        _Pragma("unroll") for (int j = 0; j < WNT; ++j)                               \
          acc[i][j] = __builtin_amdgcn_mfma_f32_16x16x32_bf16(bfr[ks][j], af[ks][i], acc[i][j], 0, 0, 0);  \
  } while (0)
#define HALF(BUF, SS, LOADSTMT)                                                       \
  do {                                                                                \
    LOADFR(BUF);                                                                      \
    __builtin_amdgcn_sched_barrier(0);                                                \
    SSTORE(SS, (BUF) ^ 1);                                                            \
    LOADSTMT;                                                                         \
    __builtin_amdgcn_sched_barrier(0);                                                \
    MFMAS();                                                                          \
    __builtin_amdgcn_sched_barrier(0);                                                \
    __syncthreads();                                                                  \
  } while (0)
  bf16x8 af[2][WMT], bfr[2][WNT];
  if (!primed) {
    GLOADC(p, 0);
    SSTORE(p, 0);
    __builtin_amdgcn_sched_barrier(0);
    GLOADC(q, 1);
    __builtin_amdgcn_sched_barrier(0);
    GLOADC(p, 2);
    __builtin_amdgcn_sched_barrier(0);
    __syncthreads();
  }
#pragma unroll 1
  for (int kt = 0; kt + 4 < nk; kt += 2) {
    HALF(0, q, GLOADC(q, kt + 3));
    HALF(1, p, GLOADC(p, kt + 4));
  }
  HALF(0, q, GLOADC(q, nk - 1));
  const u16* An = nxt.A + (size_t)crow * nxt.lda + ckc * 8;
  const u16* Bn = nxt.B + (size_t)crow * nxt.ldb + ckc * 8;
  HALF(1, p, GLOADN(p, 0));
  HALF(0, q, GLOADN(q, 1));
  HALF(1, p, GLOADN(p, 2));
#undef GLOADX
#undef GLOADC
#undef GLOADN
#undef SSTORE
#undef LOADFR
#undef MFMAS
#undef HALF
}

#define PFB_PARAMS uint4 &pa0, uint4 &pa1, uint4 &pa2, uint4 &pa3, uint4 &pb0, uint4 &pb1, uint4 &pb2, uint4 &pb3
#define PFB_ARGS pa0, pa1, pa2, pa3, pb0, pb1, pb2, pb3
#define PFB_DECL uint4 pa0 = uint4{0, 0, 0, 0}, pa1 = pa0, pa2 = pa0, pa3 = pa0, pb0 = pa0, pb1 = pa0, pb2 = pa0, pb3 = pa0
DEVI void gemm_core_big(const GemmOp cur, const GemmOp nxt, bool primed, PFB_PARAMS, f32x4 (&acc)[4][8], u16* smem) {
  u16* sA = smem;
  u16* sB = smem + 2 * 256 * LDS_S;
  const int tid = otid(), lane = tid & 63, w = tid >> 6, wm = w >> 1, wn = w & 1;
  const int fr = lane & 15, fq = lane >> 4;
  const int crow = tid >> 3, ckc = tid & 7;
  const int wsw = (ckc ^ (crow & 7)) * 8;
  const int rsw0 = (fq ^ (fr & 7)) * 8;
  const u16* Ag = cur.A + (size_t)crow * cur.lda + ckc * 8;
  const u16* Bg = cur.B + (size_t)crow * cur.ldb + ckc * 8;
  const int nk = cur.K >> 6, km = nk - 1, kmn = (nxt.K >> 6) - 1;
#define BGLOADX(AP, BP, LA, LB, KO)                                                   \
  do {                                                                                \
    pa0 = *(const uint4*)((AP) + (KO));                                             \
    pa1 = *(const uint4*)((AP) + (size_t)64 * (LA) + (KO));                         \
    pa2 = *(const uint4*)((AP) + (size_t)128 * (LA) + (KO));                        \
    pa3 = *(const uint4*)((AP) + (size_t)192 * (LA) + (KO));                        \
    pb0 = *(const uint4*)((BP) + (KO));                                             \
    pb1 = *(const uint4*)((BP) + (size_t)64 * (LB) + (KO));                         \
    pb2 = *(const uint4*)((BP) + (size_t)128 * (LB) + (KO));                        \
    pb3 = *(const uint4*)((BP) + (size_t)192 * (LB) + (KO));                        \
  } while (0)
#define BGLOADC(T) BGLOADX(Ag, Bg, cur.lda, cur.ldb, ((((T) + cur.koff) & km) * 64))
#define BGLOADN(T) BGLOADX(An, Bn, nxt.lda, nxt.ldb, ((((T) + nxt.koff) & kmn) * 64))
#define BSSTORE(NB)                                                                   \
  do {                                                                                \
    u16* dA = sA + ((NB) * 256 + crow) * LDS_S + wsw;                                 \
    u16* dB = sB + ((NB) * 256 + crow) * LDS_S + wsw;                                 \
    *(uint4*)(dA) = pa0;                                                            \
    *(uint4*)(dA + 64 * LDS_S) = pa1;                                               \
    *(uint4*)(dA + 128 * LDS_S) = pa2;                                              \
    *(uint4*)(dA + 192 * LDS_S) = pa3;                                              \
    *(uint4*)(dB) = pb0;                                                            \
    *(uint4*)(dB + 64 * LDS_S) = pb1;                                               \
    *(uint4*)(dB + 128 * LDS_S) = pb2;                                              \
    *(uint4*)(dB + 192 * LDS_S) = pb3;                                              \
  } while (0)
#define BLOADFR(BUF, KS)                                                              \
  do {                                                                                \
    const u16* cA = sA + ((BUF) * 256 + wm * 64 + fr) * LDS_S + (rsw0 ^ ((KS) * 32)); \
    const u16* cB = sB + ((BUF) * 256 + wn * 128 + fr) * LDS_S + (rsw0 ^ ((KS) * 32)); \
    _Pragma("unroll") for (int i = 0; i < 4; ++i) af[i] = *(const bf16x8*)(cA + i * 16 * LDS_S);  \
    _Pragma("unroll") for (int j = 0; j < 4; ++j) bfr[j] = *(const bf16x8*)(cB + j * 16 * LDS_S); \
  } while (0)
#define BLOADB2(BUF, KS)                                                              \
  do {                                                                                \
    const u16* cB = sB + ((BUF) * 256 + wn * 128 + 64 + fr) * LDS_S + (rsw0 ^ ((KS) * 32)); \
    _Pragma("unroll") for (int j = 0; j < 4; ++j) bfr[j] = *(const bf16x8*)(cB + j * 16 * LDS_S); \
  } while (0)
#define BMFMAS(JO)                                                                    \
  do {                                                                                \
    _Pragma("unroll") for (int i = 0; i < 4; ++i)                                     \
      _Pragma("unroll") for (int j = 0; j < 4; ++j)                                   \
        acc[i][(JO) + j] = __builtin_amdgcn_mfma_f32_16x16x32_bf16(bfr[j], af[i], acc[i][(JO) + j], 0, 0, 0);  \
  } while (0)
#define BHALF(BUF, LOADSTMT)                                                          \
  do {                                                                                \
    BLOADFR(BUF, 0);                                                                  \
    __builtin_amdgcn_sched_barrier(0);                                                \
    BSSTORE((BUF) ^ 1);                                                               \
    LOADSTMT;                                                                         \
    __builtin_amdgcn_sched_barrier(0);                                                \
    BMFMAS(0);                                                                        \
    __builtin_amdgcn_sched_barrier(0);                                                \
    BLOADB2(BUF, 0);                                                                  \
    __builtin_amdgcn_sched_barrier(0);                                                \
    BMFMAS(4);                                                                        \
    __builtin_amdgcn_sched_barrier(0);                                                \
    BLOADFR(BUF, 1);                                                                  \
    __builtin_amdgcn_sched_barrier(0);                                                \
    BMFMAS(0);                                                                        \
    __builtin_amdgcn_sched_barrier(0);                                                \
    BLOADB2(BUF, 1);                                                                  \
    __builtin_amdgcn_sched_barrier(0);                                                \
    BMFMAS(4);                                                                        \
    __builtin_amdgcn_sched_barrier(0);                                                \
    __syncthreads();                                                                  \
  } while (0)
  bf16x8 af[4], bfr[4];
  if (!primed) {
    BGLOADC(0);
    BSSTORE(0);
    __builtin_amdgcn_sched_barrier(0);
    BGLOADC(1);
    __builtin_amdgcn_sched_barrier(0);
    __syncthreads();
  }
#pragma unroll 1
  for (int kt = 0; kt + 2 < nk; kt += 2) {
    BHALF(0, BGLOADC(kt + 2));
    BHALF(1, BGLOADC(kt + 3));
  }
  const u16* An = nxt.A + (size_t)crow * nxt.lda + ckc * 8;
  const u16* Bn = nxt.B + (size_t)crow * nxt.ldb + ckc * 8;
  BHALF(0, BGLOADN(0));
  BHALF(1, BGLOADN(1));
#undef BGLOADX
#undef BGLOADC
#undef BGLOADN
#undef BSSTORE
#undef BLOADFR
#undef BLOADB2
#undef BMFMAS
#undef BHALF
}

DEVI void phase_proj(const Params& p, int l, int vcu, u16* smem) {
  const u16* xn = (const u16*)(p.ws + WS_XN);
  const u16* wt = (const u16*)(p.ws + WS_WT_IN) + (size_t)l * NPROJ_PAD * LDW1;
  u16* proj = (u16*)(p.ws + WS_PROJ);
  float* small = (float*)(p.ws + WS_SMALL);
  const int tid_ = otid(); const int lane = tid_ & 63, w = tid_ >> 6, wm = w >> 1, wn = w & 1, fr = lane & 15, fq = lane >> 4;
  constexpr int NT = 25, MT = M / 256;
  PFB_DECL;
  int mt, nt;
  bool have = tile_map(0, vcu, MT, NT, mt, nt);
  for (int it = 0; have; ++it) {
    const int m0 = mt * 256, n0 = nt * 256;
    const GemmOp cur{xn + (size_t)m0 * LDX, wt + (size_t)n0 * LDW1, LDX, LDW1, 1024, koff_of(mt, nt)};
    int mtn, ntn;
    const bool haven = tile_map(it + 1, vcu, MT, NT, mtn, ntn);
    GemmOp nxt = cur;
    if (haven) { nxt.A = xn + (size_t)(mtn * 256) * LDX; nxt.B = wt + (size_t)(ntn * 256) * LDW1; nxt.koff = koff_of(mtn, ntn); }
    f32x4 acc[4][8];
    zero_acc(acc);
    gemm_core_big(cur, nxt, it > 0, PFB_ARGS, acc, smem);
#pragma unroll
    for (int i = 0; i < 4; ++i)
#pragma unroll
      for (int j = 0; j < 8; ++j) {
        const int m = m0 + wm * 64 + i * 16 + fr, n = n0 + wn * 128 + j * 16 + fq * 4;
        if (n < NPROJ) {
          uint2 o;
          o.x = pk2(acc[i][j][0], acc[i][j][1]);
          o.y = pk2(acc[i][j][2], acc[i][j][3]);
          *(uint2*)(proj + (size_t)m * NPROJ + n) = o;
        } else if (n < NPROJ + 16) {
          *(float4*)(small + (size_t)m * 16 + (n - NPROJ)) = float4{acc[i][j][0], acc[i][j][1], acc[i][j][2], acc[i][j][3]};
        }
      }
    have = haven; mt = mtn; nt = ntn;
  }
}

DEVI void phase_up(const Params& p, int l, int vcu, u16* smem) {
  const u16* xn = (const u16*)(p.ws + WS_XN);
  const u16* wt = (const u16*)(p.ws + WS_WT_UP) + (size_t)l * 4096 * LDW1;
  u16* hid = (u16*)(p.ws + WS_PROJ);
  const int tid_ = otid(); const int lane = tid_ & 63, w = tid_ >> 6, wm = w >> 1, wn = w & 1, fr = lane & 15, fq = lane >> 4;
  constexpr int NT = DFF / 256, MT = M / 256;
  PFB_DECL;
  int mt, nt;
  bool have = tile_map(0, vcu, MT, NT, mt, nt);
  for (int it = 0; have; ++it) {
    const int m0 = mt * 256, n0 = nt * 256;
    const GemmOp cur{xn + (size_t)m0 * LDX, wt + (size_t)n0 * LDW1, LDX, LDW1, 1024, koff_of(mt, nt)};
    int mtn, ntn;
    const bool haven = tile_map(it + 1, vcu, MT, NT, mtn, ntn);
    GemmOp nxt = cur;
    if (haven) { nxt.A = xn + (size_t)(mtn * 256) * LDX; nxt.B = wt + (size_t)(ntn * 256) * LDW1; nxt.koff = koff_of(mtn, ntn); }
    f32x4 acc[4][8];
    zero_acc(acc);
    gemm_core_big(cur, nxt, it > 0, PFB_ARGS, acc, smem);
#pragma unroll
    for (int i = 0; i < 4; ++i)
#pragma unroll
      for (int j = 0; j < 8; ++j) {
        const int m = m0 + wm * 64 + i * 16 + fr, n = n0 + wn * 128 + j * 16 + fq * 4;
        float r0 = fmaxf(acc[i][j][0], 0.f), r1 = fmaxf(acc[i][j][1], 0.f), r2 = fmaxf(acc[i][j][2], 0.f), r3 = fmaxf(acc[i][j][3], 0.f);
        uint2 o;
        o.x = pk2(r0 * r0, r1 * r1);
        o.y = pk2(r2 * r2, r3 * r3);
        *(uint2*)(hid + (size_t)m * LDH + n) = o;
      }
    have = haven; mt = mtn; nt = ntn;
  }
}

DEVI void phase_merge(const Params& p, int l, int vcu, u16* smem) {
  const u16* xn = (const u16*)(p.ws + WS_XN);
  const u16* y = (const u16*)(p.ws + WS_OBUF);
  const u16* wg = (const u16*)(p.ws + WS_WT_GATE) + (size_t)l * 3072 * LDW1;
  const u16* wb = (const u16*)(p.ws + WS_WT_BR) + (size_t)l * 3 * 1024 * LDWB;
  u16* merged = (u16*)(p.ws + WS_CONV);
  const int tid_ = otid(); const int lane = tid_ & 63, w = tid_ >> 6, wm = w >> 1, wn = w & 1, fr = lane & 15, fq = lane >> 4;
  constexpr int NT = D / 128, MT = M / 128;
  PF_DECL;
  int mt, nt;
  bool have = tile_map(0, vcu, MT, NT, mt, nt);
  for (int it = 0; have; ++it) {
    const int m0 = mt * 128, n0 = nt * 128;
    const int ko = koff_of(mt, nt);
    int mtn, ntn;
    const bool haven = tile_map(it + 1, vcu, MT, NT, mtn, ntn);
    f32x4 accM[2][4];
    zero_acc(accM);
#pragma unroll 1
    for (int b = 0; b < 3; ++b) {
      f32x4 accG[2][4], accB[2][4];
      zero_acc(accG);
      const GemmOp gate{xn + (size_t)m0 * LDX, wg + ((size_t)b * 1024 + n0) * LDW1, LDX, LDW1, 1024, ko};
      const GemmOp br{y + (size_t)m0 * LDY + b * 512, wb + ((size_t)b * 1024 + n0) * LDWB, LDY, LDWB, 512, ko};
      GemmOp after = gate;
      if (b < 2) {
        after.B = wg + ((size_t)(b + 1) * 1024 + n0) * LDW1;
      } else if (haven) {
        after.A = xn + (size_t)(mtn * 128) * LDX;
        after.B = wg + (size_t)(ntn * 128) * LDW1;
        after.koff = koff_of(mtn, ntn);
      }
      gemm_core<2, 4>(gate, br, (it > 0) || (b > 0), PF_ARGS, accG, smem);
      unsigned gpk[2][4][2];
#pragma unroll
      for (int i = 0; i < 2; ++i)
#pragma unroll
        for (int j = 0; j < 4; ++j) {
          gpk[i][j][0] = pk2(sigm(accG[i][j][0]), sigm(accG[i][j][1]));
          gpk[i][j][1] = pk2(sigm(accG[i][j][2]), sigm(accG[i][j][3]));
        }
      zero_acc(accB);
      gemm_core<2, 4>(br, after, true, PF_ARGS, accB, smem);
#pragma unroll
      for (int i = 0; i < 2; ++i)
#pragma unroll
        for (int j = 0; j < 4; ++j) {
          accM[i][j][0] += bflo(gpk[i][j][0]) * accB[i][j][0];
          accM[i][j][1] += bfhi(gpk[i][j][0]) * accB[i][j][1];
          accM[i][j][2] += bflo(gpk[i][j][1]) * accB[i][j][2];
          accM[i][j][3] += bfhi(gpk[i][j][1]) * accB[i][j][3];
        }
    }
#pragma unroll
    for (int i = 0; i < 2; ++i)
#pragma unroll
      for (int j = 0; j < 4; ++j) {
        const int m = m0 + wm * 32 + i * 16 + fr, n = n0 + wn * 64 + j * 16 + fq * 4;
        uint2 o;
        o.x = pk2(accM[i][j][0], accM[i][j][1]);
        o.y = pk2(accM[i][j][2], accM[i][j][3]);
        *(uint2*)(merged + (size_t)m * LDX + n) = o;
      }
    have = haven; mt = mtn; nt = ntn;
  }
}

DEVI void phase_resid(const u16* A, int lda, int K, const u16* wt, int ldb, const float* xin_p, const float* xin_s, float* xout, int vcu, u16* smem) {
  const int tid_ = otid(); const int lane = tid_ & 63, w = tid_ >> 6, wm = w >> 1, wn = w & 1, fr = lane & 15, fq = lane >> 4;
  for (int t = vcu; t < 256; t += gridDim.x) {
    PFB_DECL;
    int mt, nt;
    tile_map(0, t, 64, 4, mt, nt);
    const int m0 = mt * 256, n0 = nt * 256;
    const GemmOp cur{A + (size_t)m0 * lda, wt + (size_t)n0 * ldb, lda, ldb, K, koff_of(mt, nt)};
    f32x4 acc[4][8];
    zero_acc(acc);
    gemm_core_big(cur, cur, false, PFB_ARGS, acc, smem);
#pragma unroll
    for (int i = 0; i < 4; ++i)
#pragma unroll
      for (int j = 0; j < 8; ++j) {
        const int m = m0 + wm * 64 + i * 16 + fr, n = n0 + wn * 128 + j * 16 + fq * 4;
        const float4 xv = *(const float4*)(xin_p + (size_t)m * D + n);
        float4 o;
        o.x = xv.x + acc[i][j][0]; o.y = xv.y + acc[i][j][1]; o.z = xv.z + acc[i][j][2]; o.w = xv.w + acc[i][j][3];
        *(float4*)(xout + (size_t)m * D + n) = o;
        if ((j & 1) == 1) __builtin_amdgcn_sched_barrier(0);
      }
  }
  {
    PF_DECL;
    bool first = true;
    for (int t = vcu; t < 32; t += gridDim.x) {
      const int mt = (MP / 128) + (t >> 3), nt = t & 7;
      const int m0 = mt * 128, n0 = nt * 128;
      const GemmOp cur{A + (size_t)m0 * lda, wt + (size_t)n0 * ldb, lda, ldb, K, koff_of(mt, nt)};
      f32x4 acc[2][4];
      zero_acc(acc);
      gemm_core<2, 4>(cur, cur, !first, PF_ARGS, acc, smem);
      first = false;
#pragma unroll
      for (int i = 0; i < 2; ++i)
#pragma unroll
        for (int j = 0; j < 4; ++j) {
          const int m = m0 + wm * 32 + i * 16 + fr, n = n0 + wn * 64 + j * 16 + fq * 4;
          const float4 xv = *(const float4*)(xin_s + (size_t)(m - MP) * D + n);
          float4 o;
          o.x = xv.x + acc[i][j][0]; o.y = xv.y + acc[i][j][1]; o.z = xv.z + acc[i][j][2]; o.w = xv.w + acc[i][j][3];
          *(float4*)(xout + (size_t)m * D + n) = o;
        }
    }
  }
}

DEVI void phase_prep(const Params& p, int l) {
  const int tid_ = otid(); const int lane = tid_ & 63, gw = blockIdx.x * 8 + (tid_ >> 6), nw = gridDim.x * 8;
  u16* proj = (u16*)(p.ws + WS_PROJ);
  u16* conv = (u16*)(p.ws + WS_CONV);
  const float* small = (const float*)(p.ws + WS_SMALL);
  float* gates = (float*)(p.ws + WS_GATES);
  constexpr int NTASK = (M / 4) * 21;
  for (int task = gw; task < NTASK; task += nw) {
    const int tg = task / 21, k = task - tg * 21;
    const int m0 = tg * 4;
    const bool samp = m0 >= MP;
    int b, t0;
    if (!samp) { b = m0 >> 11; t0 = m0 & 2047; } else { b = (m0 - MP) >> 2; t0 = 0; }
    if (k < 12) {
      const int pp = k >> 2, hh = k & 3;
      const int ch = pp * 512 + hh * 128 + lane * 2;
      const u16* src = proj + 2048 + ch;
      float rx[7], ry[7];
#pragma unroll
      for (int j = 0; j < 7; ++j) {
        const int t = t0 - 3 + j;
        if (t >= 0) {
          const unsigned u = *(const unsigned*)(src + (size_t)(m0 - 3 + j) * NPROJ);
          rx[j] = bflo(u); ry[j] = bfhi(u);
        } else if (samp) {
          const float2 cs = *(const float2*)(p.st_gconv + ((size_t)(l * 128 + b) * 3 + j) * 1536 + ch);
          rx[j] = cs.x; ry[j] = cs.y;
        } else { rx[j] = 0.f; ry[j] = 0.f; }
      }
      float cwx[4], cwy[4];
#pragma unroll
      for (int j = 0; j < 4; ++j) {
        const float2 c2 = *(const float2*)(p.gd_conv_w + (size_t)(l * 4 + j) * 1536 + ch);
        cwx[j] = c2.x; cwy[j] = c2.y;
      }
#pragma unroll
      for (int tt = 0; tt < 4; ++tt) {
        float ax = 0.f, ay = 0.f;
#pragma unroll
        for (int j = 0; j < 4; ++j) { ax += cwx[j] * rx[tt + j]; ay += cwy[j] * ry[tt + j]; }
        ax = silu(ax); ay = silu(ay);
        if (pp < 2) {
          float ss = wave_sum(ax * ax + ay * ay);
          float sc = rsqrtf(ss + 1e-6f);
          if (pp == 0) sc *= 0.08838834764831845f;
          ax *= sc; ay *= sc;
        }
        *(unsigned*)(conv + (size_t)(m0 + tt) * 1536 + ch) = pk2(ax, ay);
      }
      const bool last = samp || (t0 == 2044);
      if (last) {
        float* co = p.out + (samp ? OFF_S_GC + (size_t)(l * 128 + b) * 3 * 1536 : OFF_P_GC + (size_t)(l * 8 + b) * 3 * 1536) + ch;
#pragma unroll
        for (int j = 0; j < 3; ++j) *(float2*)(co + j * 1536) = float2{rx[4 + j], ry[4 + j]};
      }
    } else if (k < 20) {
      const int kk = k - 12, part = kk >> 2, hh = kk & 3;
      const int wch = hh * 128 + lane * 2;
      u16* col = proj + 4096 + part * 512 + wch;
      float lb0 = 0.f, lb1 = 0.f;
      if (part == 1 && l == 1) {
        lb0 = sigm(p.hg_lb_logits[512 + wch] - p.hg_lb_logits[wch]);
        lb1 = sigm(p.hg_lb_logits[512 + wch + 1] - p.hg_lb_logits[wch + 1]);
      }
      unsigned u[4];
#pragma unroll
      for (int tt = 0; tt < 4; ++tt) u[tt] = *(const unsigned*)(col + (size_t)(m0 + tt) * NPROJ);
#pragma unroll
      for (int tt = 0; tt < 4; ++tt) {
        float a = bflo(u[tt]), c = bfhi(u[tt]);
        if (part == 0) { a = silu(a); c = silu(c); }
        else { a = (1.f - lb0) * sigm(-a); c = (1.f - lb1) * sigm(-c); }
        *(unsigned*)(col + (size_t)(m0 + tt) * NPROJ) = pk2(a, c);
      }
    } else {
      const int tt = lane >> 4, g = lane & 15, hh = g & 3;
      const float v = small[(size_t)(m0 + tt) * 16 + g];
      float r;
      if (g < 4) r = v + p.ml_i_bias[l * 4 + hh];
      else if (g < 8) { const float x = v + p.ml_f_bias[l * 4 + hh]; r = -softplus(-x); }
      else if (g < 12) r = sigm(v);
      else { const float x = v + p.gd_dt_bias[l * 4 + hh]; r = __expf(-__expf(p.gd_A_log[l * 4 + hh]) * softplus(x)); }
      gates[(size_t)(m0 + tt) * 16 + g] = r;
    }
  }
}

template <int KIND>
DEVI void scan_unit(const Params& p, int l, bool samp, int b, int h, int colbase, float* smem) {
  constexpr int CPL = (KIND == 1) ? 1 : 2;
  constexpr int UC = 32 * CPL;
  constexpr int VCH = UC / 8;
  const int tid = otid(), lane = tid & 63, w = tid >> 6, kg = lane & 15, cl = lane >> 4;
  const int T = samp ? 4 : 2048;
  const int rowbase = samp ? (MP + b * 4) : b * 2048;
  const int NB = samp ? 128 : 8;
  const u16* proj = (const u16*)(p.ws + WS_PROJ);
  const u16* conv = (const u16*)(p.ws + WS_CONV);
  u16* obuf = (u16*)(p.ws + WS_OBUF);
  const float* gates = (const float*)(p.ws + WS_GATES);
  float* dm = (float*)(p.ws + WS_DM);
  const u16 *qsrc, *ksrc, *vsrc;
  int ld, ocol;
  const float* Sin;
  float* Sout;
  const size_t sidx_in = ((size_t)(l * 128 + b) * 4 + h) * 16384;
  const size_t sidx_out = ((size_t)(l * NB + b) * 4 + h) * 16384;
  if (KIND == 0) {
    qsrc = proj + h * 128; ksrc = proj + 512 + h * 128; vsrc = proj + 1024 + h * 128 + colbase; ld = NPROJ; ocol = 0;
    Sin = p.st_mC + sidx_in; Sout = p.out + (samp ? OFF_S_MC : OFF_P_MC) + sidx_out;
  } else if (KIND == 1) {
    qsrc = conv + h * 128; ksrc = conv + 512 + h * 128; vsrc = conv + 1024 + h * 128 + colbase; ld = 1536; ocol = 512;
    Sin = p.st_gS + sidx_in; Sout = p.out + (samp ? OFF_S_GS : OFF_P_GS) + sidx_out;
  } else {
    qsrc = proj + 4096 + h * 128; ksrc = proj + 4608 + h * 128; vsrc = proj + 5120 + h * 128 + colbase; ld = NPROJ; ocol = 1024;
    Sin = p.st_hS + sidx_in; Sout = p.out + (samp ? OFF_S_HS : OFF_P_HS) + sidx_out;
  }
  float* qk = smem;
  float* vl = smem + 2 * 32 * 256;
  float* gl = vl + 2 * 32 * 64;

  const int wc = w * 4 * CPL + cl * CPL;
  const int col0 = colbase + wc;
  v2f S[CPL][4];
  v2f nv[4];
#pragma unroll
  for (int c = 0; c < CPL; ++c)
#pragma unroll
    for (int i = 0; i < 4; ++i) {
      if (samp) { S[c][i].x = Sin[(size_t)(kg * 8 + 2 * i) * 128 + col0 + c]; S[c][i].y = Sin[(size_t)(kg * 8 + 2 * i + 1) * 128 + col0 + c]; }
      else { S[c][i].x = 0.f; S[c][i].y = 0.f; }
    }
  float mstart = 0.f;
  if (KIND == 0) {
    const size_t nidx = ((size_t)(l * 128 + b) * 4 + h) * 128;
#pragma unroll
    for (int i = 0; i < 4; ++i) {
      if (samp) { nv[i].x = p.st_mn[nidx + kg * 8 + 2 * i]; nv[i].y = p.st_mn[nidx + kg * 8 + 2 * i + 1]; }
      else { nv[i].x = 0.f; nv[i].y = 0.f; }
    }
    if (samp) mstart = p.st_mm[(size_t)(l * 128 + b) * 4 + h];
  }

  uint4 rq, rk, rv;
  float g0 = 0.f, g1 = 0.f;
  const int sr = tid >> 4, sc = tid & 15;
  const int vr = tid / VCH, vc = tid % VCH;
  auto prefetch = [&](int j) {
    const int t = j * 32 + sr;
    rq = uint4{0, 0, 0, 0}; rk = uint4{0, 0, 0, 0}; rv = uint4{0, 0, 0, 0};
    if (t < T) {
      rq = *(const uint4*)(qsrc + (size_t)(rowbase + t) * ld + sc * 8);
      rk = *(const uint4*)(ksrc + (size_t)(rowbase + t) * ld + sc * 8);
    }
    if (tid < 32 * VCH) {
      const int tv = j * 32 + vr;
      if (tv < T) rv = *(const uint4*)(vsrc + (size_t)(rowbase + tv) * ld + vc * 8);
    }
    if (KIND != 2) {
      g0 = (KIND == 0) ? -1e30f : 0.f; g1 = 0.f;
      if (tid < 32) {
        const int tg = j * 32 + tid;
        if (tg < T) {
          if (KIND == 0) { g0 = gates[(size_t)(rowbase + tg) * 16 + h]; g1 = gates[(size_t)(rowbase + tg) * 16 + 4 + h]; }
          else { g0 = gates[(size_t)(rowbase + tg) * 16 + 8 + h]; g1 = gates[(size_t)(rowbase + tg) * 16 + 12 + h]; }
        }
      }
    }
  };
  auto stage = [&](int j, int buf) {
    float* qd = qk + (buf * 32 + sr) * 256 + sc * 8;
    *(float4*)(qd) = float4{bflo(rq.x), bfhi(rq.x), bflo(rq.y), bfhi(rq.y)};
    *(float4*)(qd + 4) = float4{bflo(rq.z), bfhi(rq.z), bflo(rq.w), bfhi(rq.w)};
    *(float4*)(qd + 128) = float4{bflo(rk.x), bfhi(rk.x), bflo(rk.y), bfhi(rk.y)};
    *(float4*)(qd + 132) = float4{bflo(rk.z), bfhi(rk.z), bflo(rk.w), bfhi(rk.w)};
    if (tid < 32 * VCH) {
      float* vd = vl + (buf * 32 + vr) * 64 + vc * 8;
      *(float4*)(vd) = float4{bflo(rv.x), bfhi(rv.x), bflo(rv.y), bfhi(rv.y)};
      *(float4*)(vd + 4) = float4{bflo(rv.z), bfhi(rv.z), bflo(rv.w), bfhi(rv.w)};
    }
    if (KIND == 0) {
      if (w == 0) {
        float bs = g1;
#pragma unroll
        for (int d = 1; d < 32; d <<= 1) { const float o = __shfl_up(bs, d); if (lane >= d) bs += o; }
        float R = g0 - bs;
#pragma unroll
        for (int d = 1; d < 32; d <<= 1) { const float o = __shfl_up(R, d); if (lane >= d) R = fmaxf(R, o); }
        const float mt = bs + fmaxf(mstart, R);
        float mprev = __shfl_up(mt, 1);
        if (lane == 0) mprev = mstart;
        const float fw = __expf(g1 + mprev - mt);
        const float iw = __expf(g0 - mt) * 0.08838834764831845f;
        if (lane < 32) {
          float* gd = gl + (buf * 32 + lane) * 4;
          gd[0] = fw; gd[1] = iw; gd[2] = mt;
        }
        int lastv = T - j * 32 - 1;
        if (lastv > 31) lastv = 31;
        mstart = __shfl(mt, lastv);
      }
    } else if (KIND == 1) {
      if (tid < 32) {
        float* gd = gl + (buf * 32 + tid) * 4;
        gd[0] = g0; gd[1] = g1;
      }
    }
  };

  const bool do_n = (KIND == 0) && (colbase == 0) && (w == 0);
  const int nblk = (T + 31) >> 5;
  prefetch(0);
  stage(0, 0);
  __syncthreads();
  for (int j = 0; j < nblk; ++j) {
    const int buf = j & 1;
    if (j + 1 < nblk) prefetch(j + 1);
    int steps = T - j * 32;
    if (steps > 32) steps = 32;
    u16* const obase = obuf + (size_t)(rowbase + j * 32) * LDY + ocol + h * 128 + col0;
    float* const dmbase = dm + (size_t)(rowbase + j * 32) * 8 + h;
    for (int t0 = 0; t0 < steps; t0 += 16) {
      int ns = steps - t0;
      if (ns > 16) ns = 16;
      float keep0 = 0.f, keep1 = 0.f, keepd = 0.f, keepm = 0.f;
#pragma unroll 4
      for (int tt = 0; tt < ns; ++tt) {
        const int t = t0 + tt;
        const float* qp = qk + (buf * 32 + t) * 256 + kg * 8;
        const float4 qa = *(const float4*)(qp), qb = *(const float4*)(qp + 4);
        const float4 ka = *(const float4*)(qp + 128), kb = *(const float4*)(qp + 132);
        const v2f q2[4] = {v2f{qa.x, qa.y}, v2f{qa.z, qa.w}, v2f{qb.x, qb.y}, v2f{qb.z, qb.w}};
        const v2f k2[4] = {v2f{ka.x, ka.y}, v2f{ka.z, ka.w}, v2f{kb.x, kb.y}, v2f{kb.z, kb.w}};
        const float* vp = vl + (buf * 32 + t) * 64 + wc;
        const float* gp = gl + (buf * 32 + t) * 4;
        const bool mine = (kg == tt);
        if (KIND == 0) {
          const float fw = gp[0], iw = gp[1];
          const v2f fw2 = v2f{fw, fw};
          const float2 vv = *(const float2*)vp;
          const float va[2] = {vv.x * iw, vv.y * iw};
          float num[2];
#pragma unroll
          for (int c = 0; c < 2; ++c) {
            const v2f vc2 = v2f{va[c], va[c]};
            v2f a = v2f{0.f, 0.f};
#pragma unroll
            for (int i = 0; i < 4; ++i) {
              S[c][i] = fw2 * S[c][i] + k2[i] * vc2;
              a += q2[i] * S[c][i];
            }
            num[c] = row16_sum(a.x + a.y);
          }
          keep0 = mine ? num[0] : keep0;
          keep1 = mine ? num[1] : keep1;
          if (do_n) {
            const v2f iw2 = v2f{iw, iw};
            v2f a = v2f{0.f, 0.f};
#pragma unroll
            for (int i = 0; i < 4; ++i) {
              nv[i] = fw2 * nv[i] + k2[i] * iw2;
              a += q2[i] * nv[i];
            }
            const float den = row16_sum(a.x + a.y);
            keepd = mine ? den : keepd;
            keepm = mine ? gp[2] : keepm;
          }
        } else if (KIND == 1) {
          const float beta = gp[0], g = gp[1];
          const float v = vp[0];
          v2f a = v2f{0.f, 0.f};
#pragma unroll
          for (int i = 0; i < 4; ++i) a += k2[i] * S[0][i];
          const float kS = row16_sum(a.x + a.y);
          const float vn = beta * (v - g * kS);
          const v2f g2 = v2f{g, g}, vn2 = v2f{vn, vn};
          v2f o2 = v2f{0.f, 0.f};
#pragma unroll
          for (int i = 0; i < 4; ++i) {
            S[0][i] = g2 * S[0][i] + k2[i] * vn2;
            o2 += q2[i] * S[0][i];
          }
          const float o = row16_sum(o2.x + o2.y);
          keep0 = mine ? o : keep0;
        } else {
          const float2 vv = *(const float2*)vp;
          const float va[2] = {vv.x, vv.y};
          float num[2];
#pragma unroll
          for (int c = 0; c < 2; ++c) {
            const v2f vc2 = v2f{va[c], va[c]};
            v2f a = v2f{0.f, 0.f};
#pragma unroll
            for (int i = 0; i < 4; ++i) {
              S[c][i] = S[c][i] + k2[i] * (vc2 - S[c][i]);
              a += q2[i] * S[c][i];
            }
            num[c] = row16_sum(a.x + a.y);
          }
          keep0 = mine ? num[0] : keep0;
          keep1 = mine ? num[1] : keep1;
        }
      }
      if (kg < ns) {
        if (KIND == 1) obase[(size_t)(t0 + kg) * LDY] = f2bf(keep0);
        else *(unsigned*)(obase + (size_t)(t0 + kg) * LDY) = pk2(keep0, keep1);
        if (do_n && cl == 0) { dmbase[(t0 + kg) * 8] = keepd; dmbase[(t0 + kg) * 8 + 4] = keepm; }
      }
    }
    if (j + 1 < nblk) stage(j + 1, buf ^ 1);
    __syncthreads();
  }
#pragma unroll
  for (int c = 0; c < CPL; ++c)
#pragma unroll
    for (int i = 0; i < 4; ++i) {
      Sout[(size_t)(kg * 8 + 2 * i) * 128 + col0 + c] = S[c][i].x;
      Sout[(size_t)(kg * 8 + 2 * i + 1) * 128 + col0 + c] = S[c][i].y;
    }
  if (KIND == 0 && colbase == 0 && w == 0) {
    if (cl == 0) {
      float* no = p.out + (samp ? OFF_S_MN : OFF_P_MN) + ((size_t)(l * NB + b) * 4 + h) * 128 + kg * 8;
#pragma unroll
      for (int i = 0; i < 4; ++i) { no[2 * i] = nv[i].x; no[2 * i + 1] = nv[i].y; }
    }
    if (lane == 0) p.out[(samp ? OFF_S_MM : OFF_P_MM) + (size_t)(l * NB + b) * 4 + h] = mstart;
  }
  __syncthreads();
}

DEVI void scan_sample_unit(const Params& p, int l, int s, float* smem) {
  const int s4 = s & 3;
  if (s4 < 2) {
    const int idx = (s >> 2) * 2 + (s & 1), seq = idx >> 2;
    scan_unit<1>(p, l, true, seq >> 2, seq & 3, (idx & 3) * 32, smem);
  } else {
    const int idx = s >> 2, seq = idx >> 1;
    if (s4 == 2) scan_unit<0>(p, l, true, seq >> 2, seq & 3, (idx & 1) * 64, smem);
    else scan_unit<2>(p, l, true, seq >> 2, seq & 3, (idx & 1) * 64, smem);
  }
}

DEVI void phase_scan(const Params& p, int l, float* smem) {
  for (int u = blockIdx.x; u < 256; u += gridDim.x) {
    if (u < 128) {
      const int seq = u >> 2;
      scan_unit<1>(p, l, false, seq >> 2, seq & 3, (u & 3) * 32, smem);
    } else if (u < 192) {
      const int uu = u - 128, seq = uu >> 1;
      scan_unit<0>(p, l, false, seq >> 2, seq & 3, (uu & 1) * 64, smem);
    } else {
      const int uu = u - 192, seq = uu >> 1;
      scan_unit<2>(p, l, false, seq >> 2, seq & 3, (uu & 1) * 64, smem);
    }
  }
  if (gridDim.x == 256) {
    const int b = blockIdx.x;
    const int s0 = (b < 128) ? b * 24 : 3072 + (b - 128) * 8;
    const int cnt = (b < 128) ? 24 : 8;
    for (int i = 0; i < cnt; ++i) scan_sample_unit(p, l, s0 + i, smem);
  } else {
    for (int s = blockIdx.x; s < 4096; s += gridDim.x) scan_sample_unit(p, l, s, smem);
  }
}

DEVI void phase_post(const Params& p, int l) {
  const int tid_ = otid(); const int lane = tid_ & 63, gw = blockIdx.x * 8 + (tid_ >> 6), nw = gridDim.x * 8;
  const u16* proj = (const u16*)(p.ws + WS_PROJ);
  u16* obuf = (u16*)(p.ws + WS_OBUF);
  const float* dm = (const float*)(p.ws + WS_DM);
  constexpr int NTASK = (M / 4) * 9;
  for (int task = gw; task < NTASK; task += nw) {
    const int tg = task / 9, k = task - tg * 9;
    const int m0 = tg * 4;
    if (k < 4) {
      const int hh = k, c = hh * 128 + lane * 2;
      const float2 nw2 = *(const float2*)(p.ml_norm_w + l * 512 + c);
#pragma unroll
      for (int tt = 0; tt < 4; ++tt) {
        const size_t m = m0 + tt;
        const unsigned u = *(const unsigned*)(obuf + m * LDY + c);
        const unsigned og = *(const unsigned*)(proj + m * NPROJ + 1536 + c);
        const float den = dm[m * 8 + hh], mt = dm[m * 8 + 4 + hh];
        const float dd = fmaxf(fabsf(den), __expf(-mt));
        const float h0 = bflo(u) / dd, h1 = bfhi(u) / dd;
        const float ss = wave_sum(h0 * h0 + h1 * h1);
        const float sc = rsqrtf(ss * (1.f / 128.f) + 1e-6f);
        *(unsigned*)(obuf + m * LDY + c) = pk2(h0 * sc * nw2.x * sigm(bflo(og)), h1 * sc * nw2.y * sigm(bfhi(og)));
      }
    } else if (k < 8) {
      const int hh = k - 4, cc = lane * 2, c = hh * 128 + cc;
      const float2 nw2 = *(const float2*)(p.gd_norm_w + l * 128 + cc);
#pragma unroll
      for (int tt = 0; tt < 4; ++tt) {
        const size_t m = m0 + tt;
        const unsigned u = *(const unsigned*)(obuf + m * LDY + 512 + c);
        const unsigned z = *(const unsigned*)(proj + m * NPROJ + 3584 + c);
        const float o0 = bflo(u), o1 = bfhi(u);
        const float ss = wave_sum(o0 * o0 + o1 * o1);
        const float sc = rsqrtf(ss * (1.f / 128.f) + 1e-6f);
        *(unsigned*)(obuf + m * LDY + 512 + c) = pk2(o0 * sc * nw2.x * silu(bflo(z)), o1 * sc * nw2.y * silu(bfhi(z)));
      }
    } else {
      const int c = lane * 8;
      const float4 wa = *(const float4*)(p.hg_norm_w + l * 512 + c), wb = *(const float4*)(p.hg_norm_w + l * 512 + c + 4);
#pragma unroll
      for (int tt = 0; tt < 4; ++tt) {
        const size_t m = m0 + tt;
        const uint4 ov = *(const uint4*)(obuf + m * LDY + 1024 + c);
        const uint4 gv = *(const uint4*)(proj + m * NPROJ + 5632 + c);
        float o[8] = {bflo(ov.x), bfhi(ov.x), bflo(ov.y), bfhi(ov.y), bflo(ov.z), bfhi(ov.z), bflo(ov.w), bfhi(ov.w)};
        const float g[8] = {bflo(gv.x), bfhi(gv.x), bflo(gv.y), bfhi(gv.y), bflo(gv.z), bfhi(gv.z), bflo(gv.w), bfhi(gv.w)};
        const float wv[8] = {wa.x, wa.y, wa.z, wa.w, wb.x, wb.y, wb.z, wb.w};
        float ss = 0.f;
#pragma unroll
        for (int i = 0; i < 8; ++i) ss += o[i] * o[i];
        ss = wave_sum(ss);
        const float sc = rsqrtf(ss * (1.f / 512.f) + 1e-6f);
#pragma unroll
        for (int i = 0; i < 8; ++i) o[i] = o[i] * sc * wv[i] * silu(g[i]);
        uint4 r;
        r.x = pk2(o[0], o[1]); r.y = pk2(o[2], o[3]); r.z = pk2(o[4], o[5]); r.w = pk2(o[6], o[7]);
        *(uint4*)(obuf + m * LDY + 1024 + c) = r;
      }
    }
  }
}

#define LAS __attribute__((address_space(3)))
#define XB_TMO      128
#define XB_XCNT(j)  (256  + 64 * (j))
#define XB_XSUB(j)  (1280 + 64 * (j))
#define XB_XGEN(j)  (2304 + 64 * (j))
#define XB_TOP      3328
#define XB_TOPGEN   3392
#define XCD_BAR_WORDS 3456
#define XB_SPIN_CAP (1u << 18)

__device__ __forceinline__ unsigned xb_ld(unsigned* p)              { return __hip_atomic_load(p, __ATOMIC_RELAXED, __HIP_MEMORY_SCOPE_AGENT); }
__device__ __forceinline__ unsigned xb_add(unsigned* p, unsigned v) { return __hip_atomic_fetch_add(p, v, __ATOMIC_RELAXED, __HIP_MEMORY_SCOPE_AGENT); }
__device__ __forceinline__ unsigned xb_xcc_id() { return (unsigned)__builtin_amdgcn_s_getreg((3 << 11) | 20) & 0xFu; }
#define XB_SPIN(cond, bar) do { unsigned _sp = 0; while (cond) { __builtin_amdgcn_s_sleep(1); \
    if ((++_sp & 255u) == 0u) { if (xb_ld(&(bar)[XB_TMO])) break; if (_sp > XB_SPIN_CAP) { atomicAdd(&(bar)[XB_TMO], 1u); break; } } } } while (0)

struct XcdBarrier {
    unsigned* bar; unsigned x;
    volatile LAS unsigned* st;
};

__device__ __forceinline__ XcdBarrier xcd_barrier_post(unsigned* bar, volatile LAS unsigned* st) {
    XcdBarrier b; b.bar = bar; b.x = xb_xcc_id(); b.st = st;
    if (threadIdx.x == 0) (void)xb_add(&bar[XB_XCNT(b.x)], 1u);
    return b;
}
__device__ __forceinline__ void xcd_barrier_complete(unsigned* bar, unsigned x, unsigned& nloc, unsigned& nx) {
    const unsigned G = gridDim.x * gridDim.y * gridDim.z;
    unsigned sum, cnt, mine, sp = 0u;
    for (;;) {
        sum = 0u; cnt = 0u; mine = 0u;
#pragma unroll
        for (unsigned j = 0; j < 16; ++j) { const unsigned c = xb_ld(&bar[XB_XCNT(j)]); sum += c; cnt += (c > 0u) ? 1u : 0u; mine = (j == x) ? c : mine; }
        if (sum == G) break;
        __builtin_amdgcn_s_sleep(1);
        if ((++sp & 255u) == 0u) { if (xb_ld(&bar[XB_TMO])) break; if (sp > XB_SPIN_CAP) { atomicAdd(&bar[XB_TMO], 1u); break; } }
    }
    nloc = mine > 0u ? mine : 1u; nx = cnt > 0u ? cnt : 1u;
}

__device__ __forceinline__ void xcd_barrier(const XcdBarrier& b) {
    asm volatile("s_waitcnt vmcnt(0)" ::: "memory");
    __syncthreads();
    if (threadIdx.x == 0) {
        unsigned* bar = b.bar;
        __builtin_amdgcn_s_waitcnt(0);
        unsigned nloc = b.st[0], nx = b.st[1];
        if (nloc == 0u) { xcd_barrier_complete(bar, b.x, nloc, nx); b.st[0] = nloc; b.st[1] = nx; }
        const unsigned old = xb_add(&bar[XB_XSUB(b.x)], 1u);
        const unsigned gen = old / nloc;
        if (old + 1u == (gen + 1u) * nloc) {
            __builtin_amdgcn_fence(__ATOMIC_RELEASE, "agent");
            asm volatile("s_waitcnt vmcnt(0)" ::: "memory");
            const unsigned og = xb_add(&bar[XB_TOP], 1u);
            const unsigned tg = og / nx;
            if (og + 1u == (tg + 1u) * nx) xb_add(&bar[XB_TOPGEN], 1u);
            else XB_SPIN(xb_ld(&bar[XB_TOPGEN]) == tg, bar);
            __builtin_amdgcn_fence(__ATOMIC_ACQUIRE, "agent");
            xb_add(&bar[XB_XGEN(b.x)], 1u);
            asm volatile("s_waitcnt vmcnt(0)" ::: "memory");
        } else {
            XB_SPIN(xb_ld(&bar[XB_XGEN(b.x)]) == gen, bar);
            __builtin_amdgcn_fence(__ATOMIC_ACQUIRE, "agent");
            asm volatile("s_waitcnt vmcnt(0)" ::: "memory");
        }
    }
    __syncthreads();
}


__global__ void __launch_bounds__(NTHREADS) mega_fwd(Params p) {
  extern __shared__ __attribute__((aligned(16))) unsigned char smem_raw[];
  cg::grid_group grid = cg::this_grid();
  float* smf = (float*)smem_raw;
  u16* smh = (u16*)smem_raw;
  u16* xn = (u16*)(p.ws + WS_XN);
  float* x = p.out;

  volatile LAS unsigned* bst = (volatile LAS unsigned*)(smem_raw + LDS_BYTES - 16);
  if (threadIdx.x < 2) bst[threadIdx.x] = 0u;
  __syncthreads();
  XcdBarrier xbar; xbar.bar = (unsigned*)(p.ws + WS_BAR); xbar.x = xb_xcc_id(); xbar.st = bst;
  if (threadIdx.x == 0) bst[2] = xb_add(&xbar.bar[XB_XCNT(xbar.x)], 1u);
  phase_wprep(p, smf);
  phase_norm(p.x_prompt, p.x_sample, p.norm1_w, xn);
  grid.sync();
  if (threadIdx.x == 0) {
    const unsigned per = gridDim.x >> 3;
    bool ok = (gridDim.x & 7u) == 0u && xbar.x < 8u;
    for (unsigned j = 0; j < 8; ++j) ok = ok && (xb_ld(&xbar.bar[XB_XCNT(j)]) == per);
    const unsigned rank = bst[2];
    bst[3] = (ok && rank < per) ? xbar.x * per + rank : (blockIdx.x & 7u) * per + (blockIdx.x >> 3);
  }
  __syncthreads();
  const int vcu = __builtin_amdgcn_readfirstlane((int)bst[3]);
#pragma unroll 1
  for (int l = 0; l < 2; ++l) {
    phase_proj(p, l, vcu, smh);
    xcd_barrier(xbar);
    phase_prep(p, l);
    xcd_barrier(xbar);
    phase_scan(p, l, smf);
    xcd_barrier(xbar);
    phase_post(p, l);
    xcd_barrier(xbar);
    phase_merge(p, l, vcu, smh);
    xcd_barrier(xbar);
    if (l == 0)
      phase_resid((const u16*)(p.ws + WS_CONV), LDX, 1024, (const u16*)(p.ws + WS_WT_OUT), LDW1, p.x_prompt, p.x_sample, x, vcu, smh);
    else
      phase_resid((const u16*)(p.ws + WS_CONV), LDX, 1024, (const u16*)(p.ws + WS_WT_OUT) + (size_t)1024 * LDW1, LDW1, x, x + (size_t)MP * D, x, vcu, smh);
    xcd_barrier(xbar);
    phase_norm(x, x + (size_t)MP * D, p.norm2_w + l * D, xn);
    xcd_barrier(xbar);
    phase_up(p, l, vcu, smh);
    xcd_barrier(xbar);
    phase_resid((const u16*)(p.ws + WS_PROJ), LDH, 4096, (const u16*)(p.ws + WS_WT_DN) + (size_t)l * 1024 * LDWD, LDWD, x, x + (size_t)MP * D, x, vcu, smh);
    xcd_barrier(xbar);
    if (l == 0) {
      phase_norm(x, x + (size_t)MP * D, p.norm1_w + D, xn);
      xcd_barrier(xbar);
    }
  }
  phase_final_norm(x, p.final_norm_w);
}

extern "C" void kernel_launch(void* const* d_in, const int* in_sizes, int n_in, void* d_out, int out_size, void* d_ws,
                              size_t ws_size, hipStream_t stream) {
  static int grid_blocks = 0;
  if (!grid_blocks) {
    int dev = 0, cus = 0, per_cu = 0;
    hipGetDevice(&dev);
    hipDeviceGetAttribute(&cus, hipDeviceAttributeMultiprocessorCount, dev);
    hipFuncSetAttribute((const void*)mega_fwd, hipFuncAttributeMaxDynamicSharedMemorySize, LDS_BYTES);
    hipOccupancyMaxActiveBlocksPerMultiprocessor(&per_cu, (const void*)mega_fwd, NTHREADS, LDS_BYTES);
    if (per_cu < 1) { fprintf(stderr, "occupancy query returned %d\n", per_cu); per_cu = 1; }
    grid_blocks = cus;
    if (ws_size < WS_END) fprintf(stderr, "workspace too small: %zu < %zu\n", ws_size, (size_t)WS_END);
  }
  Params p{};
  p.x_prompt = (const float*)d_in[0]; p.x_sample = (const float*)d_in[1];
  p.st_mC = (const float*)d_in[2]; p.st_mn = (const float*)d_in[3]; p.st_mm = (const float*)d_in[4];
  p.st_gS = (const float*)d_in[5]; p.st_gconv = (const float*)d_in[6]; p.st_hS = (const float*)d_in[7];
  p.norm1_w = (const float*)d_in[8]; p.w_in = (const float*)d_in[9]; p.ml_i_bias = (const float*)d_in[10];
  p.ml_f_bias = (const float*)d_in[11]; p.ml_norm_w = (const float*)d_in[12]; p.gd_conv_w = (const float*)d_in[13];
  p.gd_A_log = (const float*)d_in[14]; p.gd_dt_bias = (const float*)d_in[15]; p.gd_norm_w = (const float*)d_in[16];
  p.hg_lb_logits = (const float*)d_in[17]; p.hg_norm_w = (const float*)d_in[18]; p.w_branch = (const float*)d_in[19];
  p.w_out = (const float*)d_in[20]; p.norm2_w = (const float*)d_in[21]; p.w_up = (const float*)d_in[22];
  p.w_down = (const float*)d_in[23]; p.final_norm_w = (const float*)d_in[24];
  p.out = (float*)d_out;
  p.ws = (unsigned char*)d_ws;
  hipMemsetAsync((char*)d_ws + WS_BAR, 0, WS_BAR_BYTES, stream);
  void* args[] = {&p};
  hipError_t e = hipLaunchCooperativeKernel((const void*)mega_fwd, dim3(grid_blocks), dim3(NTHREADS), args, LDS_BYTES, stream);
  if (e != hipSuccess) fprintf(stderr, "cooperative launch failed: %s (grid %d)\n", hipGetErrorString(e), grid_blocks);
}
```

```cpp
#include <hip/hip_runtime.h>
#include <hip/hip_cooperative_groups.h>
#include <cstdio>
namespace cg = cooperative_groups;

typedef unsigned short u16;
using bf16x8 = __attribute__((ext_vector_type(8))) short;
using f32x4 = __attribute__((ext_vector_type(4))) float;
typedef float v2f __attribute__((ext_vector_type(2)));

#define DEVI __device__ __forceinline__

constexpr int D = 1024;
constexpr int MP = 16384, MS = 512, M = MP + MS;
constexpr int NPROJ = 6144, NPROJ_PAD = 6272;
constexpr int INC = 9232;
constexpr int DFF = 4096;
constexpr int NTHREADS = 512;
constexpr int LDS_BYTES = 132 * 1024;
constexpr int LDX = 1088, LDH = 4160, LDY = 1600, LDW1 = 1088, LDWB = 576, LDWD = 4160;

constexpr size_t OFF_Y = 0;
constexpr size_t OFF_P_MC = (size_t)M * D;
constexpr size_t OFF_P_MN = OFF_P_MC + 2ull * 8 * 4 * 128 * 128;
constexpr size_t OFF_P_MM = OFF_P_MN + 2ull * 8 * 4 * 128;
constexpr size_t OFF_P_GS = OFF_P_MM + 2ull * 8 * 4;
constexpr size_t OFF_P_GC = OFF_P_GS + 2ull * 8 * 4 * 128 * 128;
constexpr size_t OFF_P_HS = OFF_P_GC + 2ull * 8 * 3 * 1536;
constexpr size_t OFF_S_MC = OFF_P_HS + 2ull * 8 * 4 * 128 * 128;
constexpr size_t OFF_S_MN = OFF_S_MC + 2ull * 128 * 4 * 128 * 128;
constexpr size_t OFF_S_MM = OFF_S_MN + 2ull * 128 * 4 * 128;
constexpr size_t OFF_S_GS = OFF_S_MM + 2ull * 128 * 4;
constexpr size_t OFF_S_GC = OFF_S_GS + 2ull * 128 * 4 * 128 * 128;
constexpr size_t OFF_S_HS = OFF_S_GC + 2ull * 128 * 3 * 1536;
static_assert(OFF_S_HS + 2ull * 128 * 4 * 128 * 128 == 72172608ull, "output size");

constexpr size_t WS_WT_IN = 0;
constexpr size_t WS_WT_GATE = WS_WT_IN + 2ull * NPROJ_PAD * LDW1 * 2;
constexpr size_t WS_WT_BR = WS_WT_GATE + 2ull * 3072 * LDW1 * 2;
constexpr size_t WS_WT_OUT = WS_WT_BR + 2ull * 3 * 1024 * LDWB * 2;
constexpr size_t WS_WT_UP = WS_WT_OUT + 2ull * 1024 * LDW1 * 2;
constexpr size_t WS_WT_DN = WS_WT_UP + 2ull * 4096 * LDW1 * 2;
constexpr size_t WS_PROJ = WS_WT_DN + 2ull * 1024 * LDWD * 2;
constexpr size_t WS_CONV = WS_PROJ + (size_t)M * NPROJ * 2;
constexpr size_t WS_OBUF = WS_CONV + (size_t)M * 1536 * 2;
constexpr size_t WS_XN = WS_OBUF + (size_t)M * LDY * 2;
constexpr size_t WS_SMALL = WS_XN + (size_t)M * LDX * 2;
constexpr size_t WS_GATES = WS_SMALL;
constexpr size_t WS_DM = WS_GATES + (size_t)M * 16 * 4;
constexpr size_t WS_BAR = WS_DM + (size_t)M * 8 * 4;
constexpr size_t WS_BAR_BYTES = 16384;
constexpr size_t WS_END = WS_BAR + WS_BAR_BYTES;
static_assert(WS_END <= 439571584ull, "workspace budget");
static_assert((size_t)M * LDH * 2 <= (size_t)M * NPROJ * 2 && (size_t)M * LDX * 2 <= (size_t)M * 1536 * 2, "aliases fit");

struct Params {
  const float *x_prompt, *x_sample, *st_mC, *st_mn, *st_mm, *st_gS, *st_gconv, *st_hS;
  const float *norm1_w, *w_in, *ml_i_bias, *ml_f_bias, *ml_norm_w, *gd_conv_w, *gd_A_log, *gd_dt_bias,
      *gd_norm_w, *hg_lb_logits, *hg_norm_w, *w_branch, *w_out, *norm2_w, *w_up, *w_down, *final_norm_w;
  float* out;
  unsigned char* ws;
};

DEVI u16 f2bf(float f) { unsigned u = __float_as_uint(f); return (u16)((u + 0x7fffu + ((u >> 16) & 1u)) >> 16); }
DEVI unsigned pk2(float lo, float hi) { return (unsigned)f2bf(lo) | ((unsigned)f2bf(hi) << 16); }
DEVI float bflo(unsigned u) { return __uint_as_float(u << 16); }
DEVI float bfhi(unsigned u) { return __uint_as_float(u & 0xffff0000u); }
DEVI float sigm(float x) { return 1.f / (1.f + __expf(-x)); }
DEVI float silu(float x) { return x * sigm(x); }
DEVI float softplus(float x) { return fmaxf(x, 0.f) + __logf(1.f + __expf(-fabsf(x))); }
DEVI int otid() { int t = threadIdx.x; asm volatile("" : "+v"(t)); return t; }
DEVI float wave_sum(float v) {
#pragma unroll
  for (int o = 32; o > 0; o >>= 1) v += __shfl_xor(v, o);
  return v;
}
template <int CTRL> DEVI float dpp_f(float v) {
  return __int_as_float(__builtin_amdgcn_update_dpp(0, __float_as_int(v), CTRL, 0xf, 0xf, false));
}
DEVI float row16_sum(float v) {
  float r;
  asm("s_nop 1\n\tv_add_f32_dpp %0, %1, %1 row_ror:8 row_mask:0xf bank_mask:0xf" : "=v"(r) : "v"(v));
  asm("s_nop 1\n\tv_add_f32_dpp %0, %1, %1 row_ror:4 row_mask:0xf bank_mask:0xf" : "=v"(v) : "v"(r));
  asm("s_nop 1\n\tv_add_f32_dpp %0, %1, %1 row_ror:2 row_mask:0xf bank_mask:0xf" : "=v"(r) : "v"(v));
  asm("s_nop 1\n\tv_add_f32_dpp %0, %1, %1 row_ror:1 row_mask:0xf bank_mask:0xf" : "=v"(v) : "v"(r));
  return v;
}

DEVI void tr_seg(const float* __restrict__ src, int ld, int K, int ncols, u16* __restrict__ dst, int dld, float* tile, int& off) {
  const int tid_ = otid();
  const int lane = tid_ & 63, gw = blockIdx.x * 8 + (tid_ >> 6), nw = gridDim.x * 8;
  const int nkb = K >> 4, nnb = ncols >> 6, nt = nkb * nnb;
  const int start = (int)(((long)gw + (long)nw * 4096 - off) % nw);
  for (int t = start; t < nt; t += nw) {
    const int kb = t % nkb, nb = t / nkb;
    const float* sp = src + (size_t)(kb * 16) * ld + nb * 64 + lane;
    float v[16];
#pragma unroll
    for (int i = 0; i < 16; ++i) v[i] = sp[(size_t)i * ld];
    uint4 o0, o1;
    o0.x = pk2(v[0], v[1]); o0.y = pk2(v[2], v[3]); o0.z = pk2(v[4], v[5]); o0.w = pk2(v[6], v[7]);
    o1.x = pk2(v[8], v[9]); o1.y = pk2(v[10], v[11]); o1.z = pk2(v[12], v[13]); o1.w = pk2(v[14], v[15]);
    u16* dp = dst + (size_t)(nb * 64 + lane) * dld + kb * 16;
    *(uint4*)dp = o0;
    *(uint4*)(dp + 8) = o1;
  }
  off += nt;
}

DEVI void phase_wprep(const Params& p, float* tile) {
  int off = 0;
  u16* wt_in = (u16*)(p.ws + WS_WT_IN);
  u16* wt_gate = (u16*)(p.ws + WS_WT_GATE);
  u16* wt_br = (u16*)(p.ws + WS_WT_BR);
  u16* wt_out = (u16*)(p.ws + WS_WT_OUT);
  u16* wt_up = (u16*)(p.ws + WS_WT_UP);
  u16* wt_dn = (u16*)(p.ws + WS_WT_DN);
  for (int l = 0; l < 2; ++l) {
    const float* win = p.w_in + (size_t)l * 1024 * INC;
    for (int s = 0; s < 12; ++s) {
      const int srccol = (s < 4) ? s * 512 : (s < 8 ? 2056 + (s - 4) * 512 : 4112 + (s - 8) * 512);
      tr_seg(win + srccol, INC, 1024, 512, wt_in + ((size_t)l * NPROJ_PAD + s * 512) * LDW1, LDW1, tile, off);
    }
    tr_seg(win + 6160, INC, 1024, 3072, wt_gate + (size_t)l * 3072 * LDW1, LDW1, tile, off);
    for (int b = 0; b < 3; ++b)
      tr_seg(p.w_branch + (size_t)(l * 3 + b) * 512 * 1024, 1024, 512, 1024, wt_br + (size_t)(l * 3 + b) * 1024 * LDWB, LDWB, tile, off);
    tr_seg(p.w_out + (size_t)l * 1024 * 1024, 1024, 1024, 1024, wt_out + (size_t)l * 1024 * LDW1, LDW1, tile, off);
    tr_seg(p.w_up + (size_t)l * 1024 * 4096, 4096, 1024, 4096, wt_up + (size_t)l * 4096 * LDW1, LDW1, tile, off);
    tr_seg(p.w_down + (size_t)l * 4096 * 1024, 1024, 4096, 1024, wt_dn + (size_t)l * 1024 * LDWD, LDWD, tile, off);
  }
  for (int idx = blockIdx.x * NTHREADS + otid(); idx < 2 * 128 * 1024; idx += gridDim.x * NTHREADS) {
    const int l = idx >> 17, rem = idx & 131071, r = rem >> 10, k = rem & 1023;
    float v = 0.f;
    if (r < 16) {
      const int sc = (r < 8) ? 2048 + r : 4104 + (r - 8);
      v = p.w_in[(size_t)l * 1024 * INC + (size_t)k * INC + sc];
    }
    wt_in[((size_t)l * NPROJ_PAD + 6144 + r) * LDW1 + k] = f2bf(v);
  }
}

DEVI void phase_norm(const float* xp, const float* xs, const float* __restrict__ w, u16* __restrict__ xn) {
  const int tid_ = otid(); const int lane = tid_ & 63, gw = blockIdx.x * 8 + (tid_ >> 6), nw = gridDim.x * 8;
  for (int m = gw; m < M; m += nw) {
    const float* xr = (m < MP) ? xp + (size_t)m * D : xs + (size_t)(m - MP) * D;
    float4 v[4];
    float ss = 0.f;
#pragma unroll
    for (int i = 0; i < 4; ++i) {
      v[i] = ((const float4*)xr)[lane + 64 * i];
      ss += v[i].x * v[i].x + v[i].y * v[i].y + v[i].z * v[i].z + v[i].w * v[i].w;
    }
    ss = wave_sum(ss);
    const float rstd = rsqrtf(ss * (1.f / 1024.f) + 1e-6f);
#pragma unroll
    for (int i = 0; i < 4; ++i) {
      const float4 wv = ((const float4*)w)[lane + 64 * i];
      uint2 o;
      o.x = pk2(v[i].x * rstd * wv.x, v[i].y * rstd * wv.y);
      o.y = pk2(v[i].z * rstd * wv.z, v[i].w * rstd * wv.w);
      ((uint2*)(xn + (size_t)m * LDX))[lane + 64 * i] = o;
    }
  }
}

DEVI void phase_final_norm(float* x, const float* __restrict__ w) {
  const int tid_ = otid(); const int lane = tid_ & 63, gw = blockIdx.x * 8 + (tid_ >> 6), nw = gridDim.x * 8;
  for (int m = gw; m < M; m += nw) {
    float* xr = x + (size_t)m * D;
    float4 v[4];
    float ss = 0.f;
#pragma unroll
    for (int i = 0; i < 4; ++i) {
      v[i] = ((const float4*)xr)[lane + 64 * i];
      ss += v[i].x * v[i].x + v[i].y * v[i].y + v[i].z * v[i].z + v[i].w * v[i].w;
    }
    ss = wave_sum(ss);
    const float rstd = rsqrtf(ss * (1.f / 1024.f) + 1e-6f);
#pragma unroll
    for (int i = 0; i < 4; ++i) {
      const float4 wv = ((const float4*)w)[lane + 64 * i];
      float4 o;
      o.x = v[i].x * rstd * wv.x; o.y = v[i].y * rstd * wv.y; o.z = v[i].z * rstd * wv.z; o.w = v[i].w * rstd * wv.w;
      ((float4*)xr)[lane + 64 * i] = o;
    }
  }
}

constexpr int LDS_S = 64;

struct GemmOp { const u16* A; const u16* B; int lda, ldb, K, koff; };

DEVI bool tile_map(int it, int vcu, int MT, int NT, int& mt, int& nt) {
  const int G = gridDim.x;
  const int t = it * G + vcu;
  if (t >= MT * NT) return false;
  constexpr int GM = 4;
  const int gsize = GM * NT;
  const int g = t / gsize, tl = t - g * gsize;
  int gsz = MT - g * GM;
  if (gsz > GM) gsz = GM;
  mt = g * GM + (tl % gsz);
  nt = tl / gsz;
  return true;
}
DEVI int koff_of(int mt, int nt) { return (nt & 7) + 2 * (mt & 3); }

template <int WMT, int WNT>
DEVI void zero_acc(f32x4 (&acc)[WMT][WNT]) {
#pragma unroll
  for (int i = 0; i < WMT; ++i)
#pragma unroll
    for (int j = 0; j < WNT; ++j) acc[i][j] = f32x4{0.f, 0.f, 0.f, 0.f};
}

#define PF_PARAMS uint4 &pa0, uint4 &pa1, uint4 &pa2, uint4 &pa3, uint4 &pb0, uint4 &pb1, uint4 &qa0, uint4 &qa1, uint4 &qa2, uint4 &qa3, uint4 &qb0, uint4 &qb1
#define PF_ARGS pa0, pa1, pa2, pa3, pb0, pb1, qa0, qa1, qa2, qa3, qb0, qb1
#define PF_DECL uint4 pa0 = uint4{0, 0, 0, 0}, pa1 = pa0, pa2 = pa0, pa3 = pa0, pb0 = pa0, pb1 = pa0, qa0 = pa0, qa1 = pa0, qa2 = pa0, qa3 = pa0, qb0 = pa0, qb1 = pa0
template <int WMT, int WNT>
DEVI void gemm_core(const GemmOp cur, const GemmOp nxt, bool primed, PF_PARAMS, f32x4 (&acc)[WMT][WNT], u16* smem) {
  constexpr int BM = 64 * WMT, BN = 32 * WNT;
  constexpr int ACH = BM * 8 / NTHREADS, BCH = BN * 8 / NTHREADS;
  static_assert(BCH == 2 && (ACH == 2 || ACH == 4), "chunk counts");
  u16* sA = smem;
  u16* sB = smem + 2 * BM * LDS_S;
  const int tid = otid(), lane = tid & 63, w = tid >> 6, wm = w >> 1, wn = w & 1;
  const int fr = lane & 15, fq = lane >> 4;
  const int crow = tid >> 3, ckc = tid & 7;
  const int wsw = (ckc ^ (crow & 7)) * 8;
  const int rsw0 = (fq ^ (fr & 7)) * 8;
  const u16* Ag = cur.A + (size_t)crow * cur.lda + ckc * 8;
  const u16* Bg = cur.B + (size_t)crow * cur.ldb + ckc * 8;
  const int nk = cur.K >> 6, km = nk - 1, kmn = (nxt.K >> 6) - 1;
#define GLOADX(S, AP, BP, LA, LB, KO)                                                 \
  do {                                                                                \
    S##a0 = *(const uint4*)((AP) + (KO));                                           \
    S##a1 = *(const uint4*)((AP) + (size_t)64 * (LA) + (KO));                       \
    if (ACH == 4) {                                                                   \
      S##a2 = *(const uint4*)((AP) + (size_t)128 * (LA) + (KO));                    \
      S##a3 = *(const uint4*)((AP) + (size_t)192 * (LA) + (KO));                    \
    }                                                                                 \
    S##b0 = *(const uint4*)((BP) + (KO));                                           \
    S##b1 = *(const uint4*)((BP) + (size_t)64 * (LB) + (KO));                       \
  } while (0)
#define GLOADC(S, T) GLOADX(S, Ag, Bg, cur.lda, cur.ldb, ((((T) + cur.koff) & km) * 64))
#define GLOADN(S, T) GLOADX(S, An, Bn, nxt.lda, nxt.ldb, ((((T) + nxt.koff) & kmn) * 64))
#define SSTORE(S, NB)                                                                 \
  do {                                                                                \
    u16* dA = sA + ((NB) * BM + crow) * LDS_S + wsw;                                  \
    u16* dB = sB + ((NB) * BN + crow) * LDS_S + wsw;                                  \
    *(uint4*)(dA) = S##a0;                                                          \
    *(uint4*)(dA + 64 * LDS_S) = S##a1;                                             \
    if (ACH == 4) {                                                                   \
      *(uint4*)(dA + 128 * LDS_S) = S##a2;                                          \
      *(uint4*)(dA + 192 * LDS_S) = S##a3;                                          \
    }                                                                                 \
    *(uint4*)(dB) = S##b0;                                                          \
    *(uint4*)(dB + 64 * LDS_S) = S##b1;                                             \
  } while (0)
#define LOADFR(BUF)                                                                   \
  do {                                                                                \
    const u16* cA = sA + ((BUF) * BM + wm * 16 * WMT + fr) * LDS_S;                   \
    const u16* cB = sB + ((BUF) * BN + wn * 16 * WNT + fr) * LDS_S;                   \
    _Pragma("unroll") for (int ks = 0; ks < 2; ++ks) {                                \
      const int so = rsw0 ^ (ks * 32);                                                \
      _Pragma("unroll") for (int i = 0; i < WMT; ++i) af[ks][i] = *(const bf16x8*)(cA + i * 16 * LDS_S + so);  \
      _Pragma("unroll") for (int j = 0; j < WNT; ++j) bfr[ks][j] = *(const bf16x8*)(cB + j * 16 * LDS_S + so); \
    }                                                                                 \
  } while (0)
#define MFMAS()                                                                       \
  do {                                                                                \
    _Pragma("unroll") for (int ks = 0; ks < 2; ++ks)                                  \
      _Pragma("unroll") for (int i = 0; i < WMT; ++i)                                 \
        _Pragma("unroll") for (int j = 0; j < WNT; ++j)                               \
          acc[i][j] = __builtin_amdgcn_mfma_f32_16x16x32_bf16(bfr[ks][j], af[ks][i], acc[i][j], 0, 0, 0);  \
  } while (0)
#define HALF(BUF, SS, LOADSTMT)                                                       \
  do {                                                                                \
    LOADFR(BUF);                                                                      \
    __builtin_amdgcn_sched_barrier(0);                                                \
    SSTORE(SS, (BUF) ^ 1);                                                            \
    LOADSTMT;                                                                         \
    __builtin_amdgcn_sched_barrier(0);                                                \
    MFMAS();                                                                          \
    __builtin_amdgcn_sched_barrier(0);                                                \
    __syncthreads();                                                                  \
  } while (0)
  bf16x8 af[2][WMT], bfr[2][WNT];
  if (!primed) {
    GLOADC(p, 0);
    SSTORE(p, 0);
    __builtin_amdgcn_sched_barrier(0);
    GLOADC(q, 1);
    __builtin_amdgcn_sched_barrier(0);
    GLOADC(p, 2);
    __builtin_amdgcn_sched_barrier(0);
    __syncthreads();
  }
#pragma unroll 1
  for (int kt = 0; kt + 4 < nk; kt += 2) {
    HALF(0, q, GLOADC(q, kt + 3));
    HALF(1, p, GLOADC(p, kt + 4));
  }
  HALF(0, q, GLOADC(q, nk - 1));
  const u16* An = nxt.A + (size_t)crow * nxt.lda + ckc * 8;
  const u16* Bn = nxt.B + (size_t)crow * nxt.ldb + ckc * 8;
  HALF(1, p, GLOADN(p, 0));
  HALF(0, q, GLOADN(q, 1));
  HALF(1, p, GLOADN(p, 2));
#undef GLOADX
#undef GLOADC
#undef GLOADN
#undef SSTORE
#undef LOADFR
#undef MFMAS
#undef HALF
}

#define PFB_PARAMS uint4 &pa0, uint4 &pa1, uint4 &pa2, uint4 &pa3, uint4 &pb0, uint4 &pb1, uint4 &pb2, uint4 &pb3
#define PFB_ARGS pa0, pa1, pa2, pa3, pb0, pb1, pb2, pb3
#define PFB_DECL uint4 pa0 = uint4{0, 0, 0, 0}, pa1 = pa0, pa2 = pa0, pa3 = pa0, pb0 = pa0, pb1 = pa0, pb2 = pa0, pb3 = pa0
DEVI void gemm_core_big(const GemmOp cur, const GemmOp nxt, bool primed, PFB_PARAMS, f32x4 (&acc)[4][8], u16* smem) {
  u16* sA = smem;
  u16* sB = smem + 2 * 256 * LDS_S;
  const int tid = otid(), lane = tid & 63, w = tid >> 6, wm = w >> 1, wn = w & 1;
  const int fr = lane & 15, fq = lane >> 4;
  const int crow = tid >> 3, ckc = tid & 7;
  const int wsw = (ckc ^ (crow & 7)) * 8;
  const int rsw0 = (fq ^ (fr & 7)) * 8;
  const u16* Ag = cur.A + (size_t)crow * cur.lda + ckc * 8;
  const u16* Bg = cur.B + (size_t)crow * cur.ldb + ckc * 8;
  const int nk = cur.K >> 6, km = nk - 1, kmn = (nxt.K >> 6) - 1;
#define BGLOADX(AP, BP, LA, LB, KO)                                                   \
  do {                                                                                \
    pa0 = *(const uint4*)((AP) + (KO));                                             \
    pa1 = *(const uint4*)((AP) + (size_t)64 * (LA) + (KO));                         \
    pa2 = *(const uint4*)((AP) + (size_t)128 * (LA) + (KO));                        \
    pa3 = *(const uint4*)((AP) + (size_t)192 * (LA) + (KO));                        \
    pb0 = *(const uint4*)((BP) + (KO));                                             \
    pb1 = *(const uint4*)((BP) + (size_t)64 * (LB) + (KO));                         \
    pb2 = *(const uint4*)((BP) + (size_t)128 * (LB) + (KO));                        \
    pb3 = *(const uint4*)((BP) + (size_t)192 * (LB) + (KO));                        \
  } while (0)
#define BGLOADC(T) BGLOADX(Ag, Bg, cur.lda, cur.ldb, ((((T) + cur.koff) & km) * 64))
#define BGLOADN(T) BGLOADX(An, Bn, nxt.lda, nxt.ldb, ((((T) + nxt.koff) & kmn) * 64))
#define BSSTORE(NB)                                                                   \
  do {                                                                                \
    u16* dA = sA + ((NB) * 256 + crow) * LDS_S + wsw;                                 \
    u16* dB = sB + ((NB) * 256 + crow) * LDS_S + wsw;                                 \
    *(uint4*)(dA) = pa0;                                                            \
    *(uint4*)(dA + 64 * LDS_S) = pa1;                                               \
    *(uint4*)(dA + 128 * LDS_S) = pa2;                                              \
    *(uint4*)(dA + 192 * LDS_S) = pa3;                                              \
    *(uint4*)(dB) = pb0;                                                            \
    *(uint4*)(dB + 64 * LDS_S) = pb1;                                               \
    *(uint4*)(dB + 128 * LDS_S) = pb2;                                              \
    *(uint4*)(dB + 192 * LDS_S) = pb3;                                              \
  } while (0)
#define BLOADFR(BUF, KS)                                                              \
  do {                                                                                \
    const u16* cA = sA + ((BUF) * 256 + wm * 64 + fr) * LDS_S + (rsw0 ^ ((KS) * 32)); \
    const u16* cB = sB + ((BUF) * 256 + wn * 128 + fr) * LDS_S + (rsw0 ^ ((KS) * 32)); \
    _Pragma("unroll") for (int i = 0; i < 4; ++i) af[i] = *(const bf16x8*)(cA + i * 16 * LDS_S);  \
    _Pragma("unroll") for (int j = 0; j < 4; ++j) bfr[j] = *(const bf16x8*)(cB + j * 16 * LDS_S); \
  } while (0)
#define BLOADB2(BUF, KS)                                                              \
  do {                                                                                \
    const u16* cB = sB + ((BUF) * 256 + wn * 128 + 64 + fr) * LDS_S + (rsw0 ^ ((KS) * 32)); \
    _Pragma("unroll") for (int j = 0; j < 4; ++j) bfr[j] = *(const bf16x8*)(cB + j * 16 * LDS_S); \
  } while (0)
#define BMFMAS(JO)                                                                    \
  do {                                                                                \
    _Pragma("unroll") for (int i = 0; i < 4; ++i)                                     \
      _Pragma("unroll") for (int j = 0; j < 4; ++j)                                   \
        acc[i][(JO) + j] = __builtin_amdgcn_mfma_f32_16x16x32_bf16(bfr[j], af[i], acc[i][(JO) + j], 0, 0, 0);  \
  } while (0)
#define BHALF(BUF, LOADSTMT)                                                          \
  do {                                                                                \
    BLOADFR(BUF, 0);                                                                  \
    __builtin_amdgcn_sched_barrier(0);                                                \
    BSSTORE((BUF) ^ 1);                                                               \
    LOADSTMT;                                                                         \
    __builtin_amdgcn_sched_barrier(0);                                                \
    BMFMAS(0);                                                                        \
    __builtin_amdgcn_sched_barrier(0);                                                \
    BLOADB2(BUF, 0);                                                                  \
    __builtin_amdgcn_sched_barrier(0);                                                \
    BMFMAS(4);                                                                        \
    __builtin_amdgcn_sched_barrier(0);                                                \
    BLOADFR(BUF, 1);                                                                  \
    __builtin_amdgcn_sched_barrier(0);                                                \
    BMFMAS(0);                                                                        \
    __builtin_amdgcn_sched_barrier(0);                                                \
    BLOADB2(BUF, 1);                                                                  \
    __builtin_amdgcn_sched_barrier(0);                                                \
    BMFMAS(4);                                                                        \
    __builtin_amdgcn_sched_barrier(0);                                                \
    __syncthreads();                                                                  \
  } while (0)
  bf16x8 af[4], bfr[4];
  if (!primed) {
    BGLOADC(0);
    BSSTORE(0);
    __builtin_amdgcn_sched_barrier(0);
    BGLOADC(1);
    __builtin_amdgcn_sched_barrier(0);
    __syncthreads();
  }
#pragma unroll 1
  for (int kt = 0; kt + 2 < nk; kt += 2) {
    BHALF(0, BGLOADC(kt + 2));
    BHALF(1, BGLOADC(kt + 3));
  }
  const u16* An = nxt.A + (size_t)crow * nxt.lda + ckc * 8;
  const u16* Bn = nxt.B + (size_t)crow * nxt.ldb + ckc * 8;
  BHALF(0, BGLOADN(0));
  BHALF(1, BGLOADN(1));
#undef BGLOADX
#undef BGLOADC
#undef BGLOADN
#undef BSSTORE
#undef BLOADFR
#undef BLOADB2
#undef BMFMAS
#undef BHALF
}

DEVI void phase_proj(const Params& p, int l, int vcu, u16* smem) {
  const u16* xn = (const u16*)(p.ws + WS_XN);
  const u16* wt = (const u16*)(p.ws + WS_WT_IN) + (size_t)l * NPROJ_PAD * LDW1;
  u16* proj = (u16*)(p.ws + WS_PROJ);
  float* small = (float*)(p.ws + WS_SMALL);
  constexpr int NT = 25, MT = M / 256;
  PFB_DECL;
  int mt, nt;
  bool have = tile_map(0, vcu, MT, NT, mt, nt);
  for (int it = 0; have; ++it) {
    const int m0 = mt * 256, n0 = nt * 256;
    const GemmOp cur{xn + (size_t)m0 * LDX, wt + (size_t)n0 * LDW1, LDX, LDW1, 1024, koff_of(mt, nt)};
    int mtn, ntn;
    const bool haven = tile_map(it + 1, vcu, MT, NT, mtn, ntn);
    GemmOp nxt = cur;
    if (haven) { nxt.A = xn + (size_t)(mtn * 256) * LDX; nxt.B = wt + (size_t)(ntn * 256) * LDW1; nxt.koff = koff_of(mtn, ntn); }
    f32x4 acc[4][8];
    zero_acc(acc);
    gemm_core_big(cur, nxt, it > 0, PFB_ARGS, acc, smem);
    const int tid_ = otid(); const int lane = tid_ & 63, w = tid_ >> 6, wm = w >> 1, wn = w & 1, fr = lane & 15, fq = lane >> 4;
#pragma unroll
    for (int i = 0; i < 4; ++i)
#pragma unroll
      for (int j = 0; j < 8; ++j) {
        const int m = m0 + wm * 64 + i * 16 + fr, n = n0 + wn * 128 + j * 16 + fq * 4;
        if (n < NPROJ) {
          uint2 o;
          o.x = pk2(acc[i][j][0], acc[i][j][1]);
          o.y = pk2(acc[i][j][2], acc[i][j][3]);
          *(uint2*)(proj + (size_t)m * NPROJ + n) = o;
        } else if (n < NPROJ + 16) {
          *(float4*)(small + (size_t)m * 16 + (n - NPROJ)) = float4{acc[i][j][0], acc[i][j][1], acc[i][j][2], acc[i][j][3]};
        }
      }
    have = haven; mt = mtn; nt = ntn;
  }
}

DEVI void phase_up(const Params& p, int l, int vcu, u16* smem) {
  const u16* xn = (const u16*)(p.ws + WS_XN);
  const u16* wt = (const u16*)(p.ws + WS_WT_UP) + (size_t)l * 4096 * LDW1;
  u16* hid = (u16*)(p.ws + WS_PROJ);
  constexpr int NT = DFF / 256, MT = M / 256;
  PFB_DECL;
  int mt, nt;
  bool have = tile_map(0, vcu, MT, NT, mt, nt);
  for (int it = 0; have; ++it) {
    const int m0 = mt * 256, n0 = nt * 256;
    const GemmOp cur{xn + (size_t)m0 * LDX, wt + (size_t)n0 * LDW1, LDX, LDW1, 1024, koff_of(mt, nt)};
    int mtn, ntn;
    const bool haven = tile_map(it + 1, vcu, MT, NT, mtn, ntn);
    GemmOp nxt = cur;
    if (haven) { nxt.A = xn + (size_t)(mtn * 256) * LDX; nxt.B = wt + (size_t)(ntn * 256) * LDW1; nxt.koff = koff_of(mtn, ntn); }
    f32x4 acc[4][8];
    zero_acc(acc);
    gemm_core_big(cur, nxt, it > 0, PFB_ARGS, acc, smem);
    const int tid_ = otid(); const int lane = tid_ & 63, w = tid_ >> 6, wm = w >> 1, wn = w & 1, fr = lane & 15, fq = lane >> 4;
#pragma unroll
    for (int i = 0; i < 4; ++i)
#pragma unroll
      for (int j = 0; j < 8; ++j) {
        const int m = m0 + wm * 64 + i * 16 + fr, n = n0 + wn * 128 + j * 16 + fq * 4;
        float r0 = fmaxf(acc[i][j][0], 0.f), r1 = fmaxf(acc[i][j][1], 0.f), r2 = fmaxf(acc[i][j][2], 0.f), r3 = fmaxf(acc[i][j][3], 0.f);
        uint2 o;
        o.x = pk2(r0 * r0, r1 * r1);
        o.y = pk2(r2 * r2, r3 * r3);
        *(uint2*)(hid + (size_t)m * LDH + n) = o;
      }
    have = haven; mt = mtn; nt = ntn;
  }
}

DEVI void phase_merge(const Params& p, int l, int vcu, u16* smem) {
  const u16* xn = (const u16*)(p.ws + WS_XN);
  const u16* y = (const u16*)(p.ws + WS_OBUF);
  const u16* wg = (const u16*)(p.ws + WS_WT_GATE) + (size_t)l * 3072 * LDW1;
  const u16* wb = (const u16*)(p.ws + WS_WT_BR) + (size_t)l * 3 * 1024 * LDWB;
  u16* merged = (u16*)(p.ws + WS_CONV);
  const int tid_ = otid(); const int lane = tid_ & 63, w = tid_ >> 6, wm = w >> 1, wn = w & 1, fr = lane & 15, fq = lane >> 4;
  constexpr int NT = D / 128, MT = M / 128;
  PF_DECL;
  int mt, nt;
  bool have = tile_map(0, vcu, MT, NT, mt, nt);
  for (int it = 0; have; ++it) {
    const int m0 = mt * 128, n0 = nt * 128;
    const int ko = koff_of(mt, nt);
    int mtn, ntn;
    const bool haven = tile_map(it + 1, vcu, MT, NT, mtn, ntn);
    f32x4 accM[2][4];
    zero_acc(accM);
#pragma unroll 1
    for (int b = 0; b < 3; ++b) {
      f32x4 accG[2][4], accB[2][4];
      zero_acc(accG);
      const GemmOp gate{xn + (size_t)m0 * LDX, wg + ((size_t)b * 1024 + n0) * LDW1, LDX, LDW1, 1024, ko};
      const GemmOp br{y + (size_t)m0 * LDY + b * 512, wb + ((size_t)b * 1024 + n0) * LDWB, LDY, LDWB, 512, ko};
      GemmOp after = gate;
      if (b < 2) {
        after.B = wg + ((size_t)(b + 1) * 1024 + n0) * LDW1;
      } else if (haven) {
        after.A = xn + (size_t)(mtn * 128) * LDX;
        after.B = wg + (size_t)(ntn * 128) * LDW1;
        after.koff = koff_of(mtn, ntn);
      }
      gemm_core<2, 4>(gate, br, (it > 0) || (b > 0), PF_ARGS, accG, smem);
      unsigned gpk[2][4][2];
#pragma unroll
      for (int i = 0; i < 2; ++i)
#pragma unroll
        for (int j = 0; j < 4; ++j) {
          gpk[i][j][0] = pk2(sigm(accG[i][j][0]), sigm(accG[i][j][1]));
          gpk[i][j][1] = pk2(sigm(accG[i][j][2]), sigm(accG[i][j][3]));
        }
      zero_acc(accB);
      gemm_core<2, 4>(br, after, true, PF_ARGS, accB, smem);
#pragma unroll
      for (int i = 0; i < 2; ++i)
#pragma unroll
        for (int j = 0; j < 4; ++j) {
          accM[i][j][0] += bflo(gpk[i][j][0]) * accB[i][j][0];
          accM[i][j][1] += bfhi(gpk[i][j][0]) * accB[i][j][1];
          accM[i][j][2] += bflo(gpk[i][j][1]) * accB[i][j][2];
          accM[i][j][3] += bfhi(gpk[i][j][1]) * accB[i][j][3];
        }
    }
#pragma unroll
    for (int i = 0; i < 2; ++i)
#pragma unroll
      for (int j = 0; j < 4; ++j) {
        const int m = m0 + wm * 32 + i * 16 + fr, n = n0 + wn * 64 + j * 16 + fq * 4;
        uint2 o;
        o.x = pk2(accM[i][j][0], accM[i][j][1]);
        o.y = pk2(accM[i][j][2], accM[i][j][3]);
        *(uint2*)(merged + (size_t)m * LDX + n) = o;
      }
    have = haven; mt = mtn; nt = ntn;
  }
}

DEVI void phase_resid(const u16* A, int lda, int K, const u16* wt, int ldb, const float* xin_p, const float* xin_s, float* xout, int vcu, u16* smem) {
  for (int t = vcu; t < 256; t += gridDim.x) {
    PFB_DECL;
    int mt, nt;
    tile_map(0, t, 64, 4, mt, nt);
    const int m0 = mt * 256, n0 = nt * 256;
    const GemmOp cur{A + (size_t)m0 * lda, wt + (size_t)n0 * ldb, lda, ldb, K, koff_of(mt, nt)};
    f32x4 acc[4][8];
    zero_acc(acc);
    gemm_core_big(cur, cur, false, PFB_ARGS, acc, smem);
    const int tid_ = otid(); const int lane = tid_ & 63, w = tid_ >> 6, wm = w >> 1, wn = w & 1, fr = lane & 15, fq = lane >> 4;
#pragma unroll
    for (int i = 0; i < 4; ++i)
#pragma unroll
      for (int j = 0; j < 8; ++j) {
        const int m = m0 + wm * 64 + i * 16 + fr, n = n0 + wn * 128 + j * 16 + fq * 4;
        const float4 xv = *(const float4*)(xin_p + (size_t)m * D + n);
        float4 o;
        o.x = xv.x + acc[i][j][0]; o.y = xv.y + acc[i][j][1]; o.z = xv.z + acc[i][j][2]; o.w = xv.w + acc[i][j][3];
        *(float4*)(xout + (size_t)m * D + n) = o;
        if ((j & 1) == 1) __builtin_amdgcn_sched_barrier(0);
      }
  }
  {
    PF_DECL;
    bool first = true;
    for (int t = vcu; t < 32; t += gridDim.x) {
      const int mt = (MP / 128) + (t >> 3), nt = t & 7;
      const int m0 = mt * 128, n0 = nt * 128;
      const GemmOp cur{A + (size_t)m0 * lda, wt + (size_t)n0 * ldb, lda, ldb, K, koff_of(mt, nt)};
      f32x4 acc[2][4];
      zero_acc(acc);
      gemm_core<2, 4>(cur, cur, !first, PF_ARGS, acc, smem);
      const int tid_ = otid(); const int lane = tid_ & 63, w = tid_ >> 6, wm = w >> 1, wn = w & 1, fr = lane & 15, fq = lane >> 4;
      first = false;
#pragma unroll
      for (int i = 0; i < 2; ++i)
#pragma unroll
        for (int j = 0; j < 4; ++j) {
          const int m = m0 + wm * 32 + i * 16 + fr, n = n0 + wn * 64 + j * 16 + fq * 4;
          const float4 xv = *(const float4*)(xin_s + (size_t)(m - MP) * D + n);
          float4 o;
          o.x = xv.x + acc[i][j][0]; o.y = xv.y + acc[i][j][1]; o.z = xv.z + acc[i][j][2]; o.w = xv.w + acc[i][j][3];
          *(float4*)(xout + (size_t)m * D + n) = o;
        }
    }
  }
}

DEVI void unpack8(const uint4 u, float (&f)[8]) {
  f[0] = bflo(u.x); f[1] = bfhi(u.x); f[2] = bflo(u.y); f[3] = bfhi(u.y);
  f[4] = bflo(u.z); f[5] = bfhi(u.z); f[6] = bflo(u.w); f[7] = bfhi(u.w);
}
DEVI uint4 pack8(const float (&f)[8]) {
  uint4 r;
  r.x = pk2(f[0], f[1]); r.y = pk2(f[2], f[3]); r.z = pk2(f[4], f[5]); r.w = pk2(f[6], f[7]);
  return r;
}
DEVI void load8f(const float* p, float (&f)[8]) {
  const float4 a = *(const float4*)p, b = *(const float4*)(p + 4);
  f[0] = a.x; f[1] = a.y; f[2] = a.z; f[3] = a.w; f[4] = b.x; f[5] = b.y; f[6] = b.z; f[7] = b.w;
}
DEVI void phase_prep(const Params& p, int l) {
  const int tid_ = otid(); const int lane = tid_ & 63, gw = blockIdx.x * 8 + (tid_ >> 6), nw = gridDim.x * 8;
  u16* proj = (u16*)(p.ws + WS_PROJ);
  u16* conv = (u16*)(p.ws + WS_CONV);
  const float* small = (const float*)(p.ws + WS_SMALL);
  float* gates = (float*)(p.ws + WS_GATES);
  constexpr int NTASK = (M / 4) * 6;
  for (int task = gw; task < NTASK; task += nw) {
    const int tg = task / 6, k = task - tg * 6;
    const int m0 = tg * 4;
    const bool samp = m0 >= MP;
    int b, t0;
    if (!samp) { b = m0 >> 11; t0 = m0 & 2047; } else { b = (m0 - MP) >> 2; t0 = 0; }
    if (k < 3) {
      const int pp = k;
      const int ch = pp * 512 + lane * 8;
      const u16* src = proj + 2048 + ch;
      float r[7][8], cw[4][8];
#pragma unroll
      for (int j = 0; j < 7; ++j) {
        const int t = t0 - 3 + j;
        if (t >= 0) {
          unpack8(*(const uint4*)(src + (size_t)(m0 - 3 + j) * NPROJ), r[j]);
        } else if (samp) {
          load8f(p.st_gconv + ((size_t)(l * 128 + b) * 3 + j) * 1536 + ch, r[j]);
        } else {
#pragma unroll
          for (int c = 0; c < 8; ++c) r[j][c] = 0.f;
        }
      }
#pragma unroll
      for (int j = 0; j < 4; ++j) load8f(p.gd_conv_w + (size_t)(l * 4 + j) * 1536 + ch, cw[j]);
#pragma unroll
      for (int tt = 0; tt < 4; ++tt) {
        float a[8];
        float ss = 0.f;
#pragma unroll
        for (int c = 0; c < 8; ++c) {
          float sx = 0.f;
#pragma unroll
          for (int j = 0; j < 4; ++j) sx += cw[j][c] * r[tt + j][c];
          a[c] = silu(sx);
          ss += a[c] * a[c];
        }
        if (pp < 2) {
          ss = row16_sum(ss);
          float sc = rsqrtf(ss + 1e-6f);
          if (pp == 0) sc *= 0.08838834764831845f;
#pragma unroll
          for (int c = 0; c < 8; ++c) a[c] *= sc;
        }
        *(uint4*)(conv + (size_t)(m0 + tt) * 1536 + ch) = pack8(a);
      }
      const bool last = samp || (t0 == 2044);
      if (last) {
        float* co = p.out + (samp ? OFF_S_GC + (size_t)(l * 128 + b) * 3 * 1536 : OFF_P_GC + (size_t)(l * 8 + b) * 3 * 1536) + ch;
#pragma unroll
        for (int j = 0; j < 3; ++j) {
          *(float4*)(co + j * 1536) = float4{r[4 + j][0], r[4 + j][1], r[4 + j][2], r[4 + j][3]};
          *(float4*)(co + j * 1536 + 4) = float4{r[4 + j][4], r[4 + j][5], r[4 + j][6], r[4 + j][7]};
        }
      }
    } else if (k < 5) {
      const int part = k - 3;
      const int wch = lane * 8;
      u16* col = proj + 4096 + part * 512 + wch;
      float lb[8];
#pragma unroll
      for (int c = 0; c < 8; ++c) lb[c] = 0.f;
      if (part == 1 && l == 1) {
        float l0[8], l1[8];
        load8f(p.hg_lb_logits + wch, l0);
        load8f(p.hg_lb_logits + 512 + wch, l1);
#pragma unroll
        for (int c = 0; c < 8; ++c) lb[c] = sigm(l1[c] - l0[c]);
      }
      uint4 u[4];
#pragma unroll
      for (int tt = 0; tt < 4; ++tt) u[tt] = *(const uint4*)(col + (size_t)(m0 + tt) * NPROJ);
#pragma unroll
      for (int tt = 0; tt < 4; ++tt) {
        float f[8];
        unpack8(u[tt], f);
#pragma unroll
        for (int c = 0; c < 8; ++c) f[c] = (part == 0) ? silu(f[c]) : (1.f - lb[c]) * sigm(-f[c]);
        *(uint4*)(col + (size_t)(m0 + tt) * NPROJ) = pack8(f);
      }
    } else {
      const int tt = lane >> 4, g = lane & 15, hh = g & 3;
      const float v = small[(size_t)(m0 + tt) * 16 + g];
      float r;
      if (g < 4) r = v + p.ml_i_bias[l * 4 + hh];
      else if (g < 8) { const float x = v + p.ml_f_bias[l * 4 + hh]; r = -softplus(-x); }
      else if (g < 12) r = sigm(v);
      else { const float x = v + p.gd_dt_bias[l * 4 + hh]; r = __expf(-__expf(p.gd_A_log[l * 4 + hh]) * softplus(x)); }
      gates[(size_t)(m0 + tt) * 16 + g] = r;
    }
  }
}

template <int KIND>
DEVI void scan_unit(const Params& p, int l, bool samp, int b, int h, int colbase, float* smem) {
  constexpr int CPL = (KIND == 1) ? 1 : 2;
  constexpr int UC = 32 * CPL;
  constexpr int VCH = UC / 8;
  const int tid = otid(), lane = tid & 63, w = tid >> 6, kg = lane & 15, cl = lane >> 4;
  const int T = samp ? 4 : 2048;
  const int rowbase = samp ? (MP + b * 4) : b * 2048;
  const int NB = samp ? 128 : 8;
  const u16* proj = (const u16*)(p.ws + WS_PROJ);
  const u16* conv = (const u16*)(p.ws + WS_CONV);
  u16* obuf = (u16*)(p.ws + WS_OBUF);
  const float* gates = (const float*)(p.ws + WS_GATES);
  float* dm = (float*)(p.ws + WS_DM);
  const u16 *qsrc, *ksrc, *vsrc;
  int ld, ocol;
  const float* Sin;
  float* Sout;
  const size_t sidx_in = ((size_t)(l * 128 + b) * 4 + h) * 16384;
  const size_t sidx_out = ((size_t)(l * NB + b) * 4 + h) * 16384;
  if (KIND == 0) {
    qsrc = proj + h * 128; ksrc = proj + 512 + h * 128; vsrc = proj + 1024 + h * 128 + colbase; ld = NPROJ; ocol = 0;
    Sin = p.st_mC + sidx_in; Sout = p.out + (samp ? OFF_S_MC : OFF_P_MC) + sidx_out;
  } else if (KIND == 1) {
    qsrc = conv + h * 128; ksrc = conv + 512 + h * 128; vsrc = conv + 1024 + h * 128 + colbase; ld = 1536; ocol = 512;
    Sin = p.st_gS + sidx_in; Sout = p.out + (samp ? OFF_S_GS : OFF_P_GS) + sidx_out;
  } else {
    qsrc = proj + 4096 + h * 128; ksrc = proj + 4608 + h * 128; vsrc = proj + 5120 + h * 128 + colbase; ld = NPROJ; ocol = 1024;
    Sin = p.st_hS + sidx_in; Sout = p.out + (samp ? OFF_S_HS : OFF_P_HS) + sidx_out;
  }
  float* qk = smem;
  float* vl = smem + 2 * 32 * 256;
  float* gl = vl + 2 * 32 * 64;

  const int wc = w * 4 * CPL + cl * CPL;
  const int col0 = colbase + wc;
  v2f S[CPL][4];
  v2f nv[4];
#pragma unroll
  for (int c = 0; c < CPL; ++c)
#pragma unroll
    for (int i = 0; i < 4; ++i) {
      if (samp) { S[c][i].x = Sin[(size_t)(kg * 8 + 2 * i) * 128 + col0 + c]; S[c][i].y = Sin[(size_t)(kg * 8 + 2 * i + 1) * 128 + col0 + c]; }
      else { S[c][i].x = 0.f; S[c][i].y = 0.f; }
    }
  float mstart = 0.f;
  if (KIND == 0) {
    const size_t nidx = ((size_t)(l * 128 + b) * 4 + h) * 128;
#pragma unroll
    for (int i = 0; i < 4; ++i) {
      if (samp) { nv[i].x = p.st_mn[nidx + kg * 8 + 2 * i]; nv[i].y = p.st_mn[nidx + kg * 8 + 2 * i + 1]; }
      else { nv[i].x = 0.f; nv[i].y = 0.f; }
    }
    if (samp) mstart = p.st_mm[(size_t)(l * 128 + b) * 4 + h];
  }

  uint4 rq, rk, rv;
  float g0 = 0.f, g1 = 0.f;
  const int sr = tid >> 4, sc = tid & 15;
  const int vr = tid / VCH, vc = tid % VCH;
  auto prefetch = [&](int j) {
    const int t = j * 32 + sr;
    rq = uint4{0, 0, 0, 0}; rk = uint4{0, 0, 0, 0}; rv = uint4{0, 0, 0, 0};
    if (t < T) {
      rq = *(const uint4*)(qsrc + (size_t)(rowbase + t) * ld + sc * 8);
      rk = *(const uint4*)(ksrc + (size_t)(rowbase + t) * ld + sc * 8);
    }
    if (tid < 32 * VCH) {
      const int tv = j * 32 + vr;
      if (tv < T) rv = *(const uint4*)(vsrc + (size_t)(rowbase + tv) * ld + vc * 8);
    }
    if (KIND != 2) {
      g0 = (KIND == 0) ? -1e30f : 0.f; g1 = 0.f;
      if (tid < 32) {
        const int tg = j * 32 + tid;
        if (tg < T) {
          if (KIND == 0) { g0 = gates[(size_t)(rowbase + tg) * 16 + h]; g1 = gates[(size_t)(rowbase + tg) * 16 + 4 + h]; }
          else { g0 = gates[(size_t)(rowbase + tg) * 16 + 8 + h]; g1 = gates[(size_t)(rowbase + tg) * 16 + 12 + h]; }
        }
      }
    }
  };
  auto stage = [&](int j, int buf) {
    float* qd = qk + (buf * 32 + sr) * 256 + sc * 8;
    *(float4*)(qd) = float4{bflo(rq.x), bfhi(rq.x), bflo(rq.y), bfhi(rq.y)};
    *(float4*)(qd + 4) = float4{bflo(rq.z), bfhi(rq.z), bflo(rq.w), bfhi(rq.w)};
    *(float4*)(qd + 128) = float4{bflo(rk.x), bfhi(rk.x), bflo(rk.y), bfhi(rk.y)};
    *(float4*)(qd + 132) = float4{bflo(rk.z), bfhi(rk.z), bflo(rk.w), bfhi(rk.w)};
    if (tid < 32 * VCH) {
      float* vd = vl + (buf * 32 + vr) * 64 + vc * 8;
      *(float4*)(vd) = float4{bflo(rv.x), bfhi(rv.x), bflo(rv.y), bfhi(rv.y)};
      *(float4*)(vd + 4) = float4{bflo(rv.z), bfhi(rv.z), bflo(rv.w), bfhi(rv.w)};
    }
    if (KIND == 0) {
      if (w == 0) {
        float bs = g1;
#pragma unroll
        for (int d = 1; d < 32; d <<= 1) { const float o = __shfl_up(bs, d); if (lane >= d) bs += o; }
        float R = g0 - bs;
#pragma unroll
        for (int d = 1; d < 32; d <<= 1) { const float o = __shfl_up(R, d); if (lane >= d) R = fmaxf(R, o); }
        const float mt = bs + fmaxf(mstart, R);
        float mprev = __shfl_up(mt, 1);
        if (lane == 0) mprev = mstart;
        const float fw = __expf(g1 + mprev - mt);
        const float iw = __expf(g0 - mt) * 0.08838834764831845f;
        if (lane < 32) {
          float* gd = gl + (buf * 32 + lane) * 4;
          gd[0] = fw; gd[1] = iw; gd[2] = mt;
        }
        int lastv = T - j * 32 - 1;
        if (lastv > 31) lastv = 31;
        mstart = __shfl(mt, lastv);
      }
    } else if (KIND == 1) {
      if (tid < 32) {
        float* gd = gl + (buf * 32 + tid) * 4;
        gd[0] = g0; gd[1] = g1;
      }
    }
  };

  const bool do_n = (KIND == 0) && (colbase == 0) && (w == 0);
  const int nblk = (T + 31) >> 5;
  prefetch(0);
  stage(0, 0);
  __syncthreads();
  for (int j = 0; j < nblk; ++j) {
    const int buf = j & 1;
    if (j + 1 < nblk) prefetch(j + 1);
    int steps = T - j * 32;
    if (steps > 32) steps = 32;
    u16* const obase = obuf + (size_t)(rowbase + j * 32) * LDY + ocol + h * 128 + col0;
    float* const dmbase = dm + (size_t)(rowbase + j * 32) * 8 + h;
    for (int t0 = 0; t0 < steps; t0 += 16) {
      int ns = steps - t0;
      if (ns > 16) ns = 16;
      float keep0 = 0.f, keep1 = 0.f, keepd = 0.f, keepm = 0.f;
#pragma unroll 4
      for (int tt = 0; tt < ns; ++tt) {
        const int t = t0 + tt;
        const float* qp = qk + (buf * 32 + t) * 256 + kg * 8;
        const float4 qa = *(const float4*)(qp), qb = *(const float4*)(qp + 4);
        const float4 ka = *(const float4*)(qp + 128), kb = *(const float4*)(qp + 132);
        const v2f q2[4] = {v2f{qa.x, qa.y}, v2f{qa.z, qa.w}, v2f{qb.x, qb.y}, v2f{qb.z, qb.w}};
        const v2f k2[4] = {v2f{ka.x, ka.y}, v2f{ka.z, ka.w}, v2f{kb.x, kb.y}, v2f{kb.z, kb.w}};
        const float* vp = vl + (buf * 32 + t) * 64 + wc;
        const float* gp = gl + (buf * 32 + t) * 4;
        const bool mine = (kg == tt);
        if (KIND == 0) {
          const float fw = gp[0], iw = gp[1];
          const v2f fw2 = v2f{fw, fw};
          const float2 vv = *(const float2*)vp;
          const float va[2] = {vv.x * iw, vv.y * iw};
          float num[2];
#pragma unroll
          for (int c = 0; c < 2; ++c) {
            const v2f vc2 = v2f{va[c], va[c]};
            v2f a = v2f{0.f, 0.f};
#pragma unroll
            for (int i = 0; i < 4; ++i) {
              S[c][i] = fw2 * S[c][i] + k2[i] * vc2;
              a += q2[i] * S[c][i];
            }
            num[c] = row16_sum(a.x + a.y);
          }
          keep0 = mine ? num[0] : keep0;
          keep1 = mine ? num[1] : keep1;
          if (do_n) {
            const v2f iw2 = v2f{iw, iw};
            v2f a = v2f{0.f, 0.f};
#pragma unroll
            for (int i = 0; i < 4; ++i) {
              nv[i] = fw2 * nv[i] + k2[i] * iw2;
              a += q2[i] * nv[i];
            }
            const float den = row16_sum(a.x + a.y);
            keepd = mine ? den : keepd;
            keepm = mine ? gp[2] : keepm;
          }
        } else if (KIND == 1) {
          const float beta = gp[0], g = gp[1];
          const float v = vp[0];
          v2f a = v2f{0.f, 0.f};
#pragma unroll
          for (int i = 0; i < 4; ++i) a += k2[i] * S[0][i];
          const float kS = row16_sum(a.x + a.y);
          const float vn = beta * (v - g * kS);
          const v2f g2 = v2f{g, g}, vn2 = v2f{vn, vn};
          v2f o2 = v2f{0.f, 0.f};
#pragma unroll
          for (int i = 0; i < 4; ++i) {
            S[0][i] = g2 * S[0][i] + k2[i] * vn2;
            o2 += q2[i] * S[0][i];
          }
          const float o = row16_sum(o2.x + o2.y);
          keep0 = mine ? o : keep0;
        } else {
          const float2 vv = *(const float2*)vp;
          const float va[2] = {vv.x, vv.y};
          float num[2];
#pragma unroll
          for (int c = 0; c < 2; ++c) {
            const v2f vc2 = v2f{va[c], va[c]};
            v2f a = v2f{0.f, 0.f};
#pragma unroll
            for (int i = 0; i < 4; ++i) {
              S[c][i] = S[c][i] + k2[i] * (vc2 - S[c][i]);
              a += q2[i] * S[c][i];
            }
            num[c] = row16_sum(a.x + a.y);
          }
          keep0 = mine ? num[0] : keep0;
          keep1 = mine ? num[1] : keep1;
        }
      }
      if (kg < ns) {
        if (KIND == 1) obase[(size_t)(t0 + kg) * LDY] = f2bf(keep0);
        else *(unsigned*)(obase + (size_t)(t0 + kg) * LDY) = pk2(keep0, keep1);
        if (do_n && cl == 0) { dmbase[(t0 + kg) * 8] = keepd; dmbase[(t0 + kg) * 8 + 4] = keepm; }
      }
    }
    if (j + 1 < nblk) stage(j + 1, buf ^ 1);
    __syncthreads();
  }
#pragma unroll
  for (int c = 0; c < CPL; ++c)
#pragma unroll
    for (int i = 0; i < 4; ++i) {
      Sout[(size_t)(kg * 8 + 2 * i) * 128 + col0 + c] = S[c][i].x;
      Sout[(size_t)(kg * 8 + 2 * i + 1) * 128 + col0 + c] = S[c][i].y;
    }
  if (KIND == 0 && colbase == 0 && w == 0) {
    if (cl == 0) {
      float* no = p.out + (samp ? OFF_S_MN : OFF_P_MN) + ((size_t)(l * NB + b) * 4 + h) * 128 + kg * 8;
#pragma unroll
      for (int i = 0; i < 4; ++i) { no[2 * i] = nv[i].x; no[2 * i + 1] = nv[i].y; }
    }
    if (lane == 0) p.out[(samp ? OFF_S_MM : OFF_P_MM) + (size_t)(l * NB + b) * 4 + h] = mstart;
  }
  __syncthreads();
}

DEVI void scan_sample_unit(const Params& p, int l, int s, float* smem) {
  const int s4 = s & 3;
  if (s4 < 2) {
    const int idx = (s >> 2) * 2 + (s & 1), seq = idx >> 2;
    scan_unit<1>(p, l, true, seq >> 2, seq & 3, (idx & 3) * 32, smem);
  } else {
    const int idx = s >> 2, seq = idx >> 1;
    if (s4 == 2) scan_unit<0>(p, l, true, seq >> 2, seq & 3, (idx & 1) * 64, smem);
    else scan_unit<2>(p, l, true, seq >> 2, seq & 3, (idx & 1) * 64, smem);
  }
}

DEVI void phase_scan(const Params& p, int l, float* smem) {
  for (int u = blockIdx.x; u < 256; u += gridDim.x) {
    if (u < 128) {
      const int seq = u >> 2;
      scan_unit<1>(p, l, false, seq >> 2, seq & 3, (u & 3) * 32, smem);
    } else if (u < 192) {
      const int uu = u - 128, seq = uu >> 1;
      scan_unit<0>(p, l, false, seq >> 2, seq & 3, (uu & 1) * 64, smem);
    } else {
      const int uu = u - 192, seq = uu >> 1;
      scan_unit<2>(p, l, false, seq >> 2, seq & 3, (uu & 1) * 64, smem);
    }
  }
  if (gridDim.x == 256) {
    const int b = blockIdx.x;
    const int s0 = (b < 128) ? b * 24 : 3072 + (b - 128) * 8;
    const int cnt = (b < 128) ? 24 : 8;
    for (int i = 0; i < cnt; ++i) scan_sample_unit(p, l, s0 + i, smem);
  } else {
    for (int s = blockIdx.x; s < 4096; s += gridDim.x) scan_sample_unit(p, l, s, smem);
  }
}

DEVI void phase_post(const Params& p, int l) {
  const int tid_ = otid(); const int lane = tid_ & 63, gw = blockIdx.x * 8 + (tid_ >> 6), nw = gridDim.x * 8;
  const u16* proj = (const u16*)(p.ws + WS_PROJ);
  u16* obuf = (u16*)(p.ws + WS_OBUF);
  const float* dm = (const float*)(p.ws + WS_DM);
  constexpr int NTASK = (M / 4) * 3;
  for (int task = gw; task < NTASK; task += nw) {
    const int tg = task / 3, k = task - tg * 3;
    const int m0 = tg * 4;
    const int c = lane * 8, hh = lane >> 4;
    float wv[8];
    if (k == 0) load8f(p.ml_norm_w + l * 512 + c, wv);
    else if (k == 1) load8f(p.gd_norm_w + l * 128 + (c & 127), wv);
    else load8f(p.hg_norm_w + l * 512 + c, wv);
    const int gcol = (k == 0) ? 1536 : (k == 1 ? 3584 : 5632);
    uint4 ov[4], gv[4];
#pragma unroll
    for (int tt = 0; tt < 4; ++tt) {
      ov[tt] = *(const uint4*)(obuf + (size_t)(m0 + tt) * LDY + k * 512 + c);
      gv[tt] = *(const uint4*)(proj + (size_t)(m0 + tt) * NPROJ + gcol + c);
    }
#pragma unroll
    for (int tt = 0; tt < 4; ++tt) {
      const size_t m = m0 + tt;
      float o[8], g[8];
      unpack8(ov[tt], o);
      unpack8(gv[tt], g);
      if (k == 0) {
        const float den = dm[m * 8 + hh], mt = dm[m * 8 + 4 + hh];
        const float inv = 1.f / fmaxf(fabsf(den), __expf(-mt));
#pragma unroll
        for (int i = 0; i < 8; ++i) o[i] *= inv;
      }
      float ss = 0.f;
#pragma unroll
      for (int i = 0; i < 8; ++i) ss += o[i] * o[i];
      float sc;
      if (k == 2) { ss = wave_sum(ss); sc = rsqrtf(ss * (1.f / 512.f) + 1e-6f); }
      else { ss = row16_sum(ss); sc = rsqrtf(ss * (1.f / 128.f) + 1e-6f); }
#pragma unroll
      for (int i = 0; i < 8; ++i) o[i] = o[i] * sc * wv[i] * ((k == 0) ? sigm(g[i]) : silu(g[i]));
      *(uint4*)(obuf + m * LDY + k * 512 + c) = pack8(o);
    }
  }
}

#define LAS __attribute__((address_space(3)))
#define XB_TMO      128
#define XB_XCNT(j)  (256  + 64 * (j))
#define XB_XSUB(j)  (1280 + 64 * (j))
#define XB_XGEN(j)  (2304 + 64 * (j))
#define XB_TOP      3328
#define XB_TOPGEN   3392
#define XCD_BAR_WORDS 3456
#define XB_SPIN_CAP (1u << 18)

__device__ __forceinline__ unsigned xb_ld(unsigned* p)              { return __hip_atomic_load(p, __ATOMIC_RELAXED, __HIP_MEMORY_SCOPE_AGENT); }
__device__ __forceinline__ unsigned xb_add(unsigned* p, unsigned v) { return __hip_atomic_fetch_add(p, v, __ATOMIC_RELAXED, __HIP_MEMORY_SCOPE_AGENT); }
__device__ __forceinline__ unsigned xb_xcc_id() { return (unsigned)__builtin_amdgcn_s_getreg((3 << 11) | 20) & 0xFu; }
#define XB_SPIN(cond, bar) do { unsigned _sp = 0; while (cond) { __builtin_amdgcn_s_sleep(1); \
    if ((++_sp & 255u) == 0u) { if (xb_ld(&(bar)[XB_TMO])) break; if (_sp > XB_SPIN_CAP) { atomicAdd(&(bar)[XB_TMO], 1u); break; } } } } while (0)

struct XcdBarrier {
    unsigned* bar; unsigned x;
    volatile LAS unsigned* st;
};

__device__ __forceinline__ XcdBarrier xcd_barrier_post(unsigned* bar, volatile LAS unsigned* st) {
    XcdBarrier b; b.bar = bar; b.x = xb_xcc_id(); b.st = st;
    if (threadIdx.x == 0) (void)xb_add(&bar[XB_XCNT(b.x)], 1u);
    return b;
}
__device__ __forceinline__ void xcd_barrier_complete(unsigned* bar, unsigned x, unsigned& nloc, unsigned& nx) {
    const unsigned G = gridDim.x * gridDim.y * gridDim.z;
    unsigned sum, cnt, mine, sp = 0u;
    for (;;) {
        sum = 0u; cnt = 0u; mine = 0u;
#pragma unroll
        for (unsigned j = 0; j < 16; ++j) { const unsigned c = xb_ld(&bar[XB_XCNT(j)]); sum += c; cnt += (c > 0u) ? 1u : 0u; mine = (j == x) ? c : mine; }
        if (sum == G) break;
        __builtin_amdgcn_s_sleep(1);
        if ((++sp & 255u) == 0u) { if (xb_ld(&bar[XB_TMO])) break; if (sp > XB_SPIN_CAP) { atomicAdd(&bar[XB_TMO], 1u); break; } }
    }
    nloc = mine > 0u ? mine : 1u; nx = cnt > 0u ? cnt : 1u;
}

__device__ __forceinline__ void xcd_barrier(const XcdBarrier& b) {
    asm volatile("s_waitcnt vmcnt(0)" ::: "memory");
    __syncthreads();
    if (threadIdx.x == 0) {
        unsigned* bar = b.bar;
        __builtin_amdgcn_s_waitcnt(0);
        unsigned nloc = b.st[0], nx = b.st[1];
        if (nloc == 0u) { xcd_barrier_complete(bar, b.x, nloc, nx); b.st[0] = nloc; b.st[1] = nx; }
        const unsigned old = xb_add(&bar[XB_XSUB(b.x)], 1u);
        const unsigned gen = old / nloc;
        if (old + 1u == (gen + 1u) * nloc) {
            __builtin_amdgcn_fence(__ATOMIC_RELEASE, "agent");
            asm volatile("s_waitcnt vmcnt(0)" ::: "memory");
            const unsigned og = xb_add(&bar[XB_TOP], 1u);
            const unsigned tg = og / nx;
            if (og + 1u == (tg + 1u) * nx) xb_add(&bar[XB_TOPGEN], 1u);
            else XB_SPIN(xb_ld(&bar[XB_TOPGEN]) == tg, bar);
            __builtin_amdgcn_fence(__ATOMIC_ACQUIRE, "agent");
            xb_add(&bar[XB_XGEN(b.x)], 1u);
            asm volatile("s_waitcnt vmcnt(0)" ::: "memory");
        } else {
            XB_SPIN(xb_ld(&bar[XB_XGEN(b.x)]) == gen, bar);
            __builtin_amdgcn_fence(__ATOMIC_ACQUIRE, "agent");
            asm volatile("s_waitcnt vmcnt(0)" ::: "memory");
        }
    }
    __syncthreads();
}


__global__ void __launch_bounds__(NTHREADS) mega_fwd(Params p) {
  extern __shared__ __attribute__((aligned(16))) unsigned char smem_raw[];
  cg::grid_group grid = cg::this_grid();
  float* smf = (float*)smem_raw;
  u16* smh = (u16*)smem_raw;
  u16* xn = (u16*)(p.ws + WS_XN);
  float* x = p.out;

  volatile LAS unsigned* bst = (volatile LAS unsigned*)(smem_raw + LDS_BYTES - 16);
  if (threadIdx.x < 2) bst[threadIdx.x] = 0u;
  __syncthreads();
  XcdBarrier xbar; xbar.bar = (unsigned*)(p.ws + WS_BAR); xbar.x = xb_xcc_id(); xbar.st = bst;
  if (threadIdx.x == 0) bst[2] = xb_add(&xbar.bar[XB_XCNT(xbar.x)], 1u);
  phase_wprep(p, smf);
  phase_norm(p.x_prompt, p.x_sample, p.norm1_w, xn);
  grid.sync();
  if (threadIdx.x == 0) {
    const unsigned per = gridDim.x >> 3;
    bool ok = (gridDim.x & 7u) == 0u && xbar.x < 8u;
    for (unsigned j = 0; j < 8; ++j) ok = ok && (xb_ld(&xbar.bar[XB_XCNT(j)]) == per);
    const unsigned rank = bst[2];
    bst[3] = (ok && rank < per) ? xbar.x * per + rank : (blockIdx.x & 7u) * per + (blockIdx.x >> 3);
  }
  __syncthreads();
  const int vcu = __builtin_amdgcn_readfirstlane((int)bst[3]);
#pragma unroll 1
  for (int l = 0; l < 2; ++l) {
    phase_proj(p, l, vcu, smh);
    xcd_barrier(xbar);
    phase_prep(p, l);
    xcd_barrier(xbar);
    phase_scan(p, l, smf);
    xcd_barrier(xbar);
    phase_post(p, l);
    xcd_barrier(xbar);
    phase_merge(p, l, vcu, smh);
    xcd_barrier(xbar);
    if (l == 0)
      phase_resid((const u16*)(p.ws + WS_CONV), LDX, 1024, (const u16*)(p.ws + WS_WT_OUT), LDW1, p.x_prompt, p.x_sample, x, vcu, smh);
    else
      phase_resid((const u16*)(p.ws + WS_CONV), LDX, 1024, (const u16*)(p.ws + WS_WT_OUT) + (size_t)1024 * LDW1, LDW1, x, x + (size_t)MP * D, x, vcu, smh);
    xcd_barrier(xbar);
    phase_norm(x, x + (size_t)MP * D, p.norm2_w + l * D, xn);
    xcd_barrier(xbar);
    phase_up(p, l, vcu, smh);
    xcd_barrier(xbar);
    phase_resid((const u16*)(p.ws + WS_PROJ), LDH, 4096, (const u16*)(p.ws + WS_WT_DN) + (size_t)l * 1024 * LDWD, LDWD, x, x + (size_t)MP * D, x, vcu, smh);
    xcd_barrier(xbar);
    if (l == 0) {
      phase_norm(x, x + (size_t)MP * D, p.norm1_w + D, xn);
      xcd_barrier(xbar);
    }
  }
  phase_final_norm(x, p.final_norm_w);
}

extern "C" void kernel_launch(void* const* d_in, const int* in_sizes, int n_in, void* d_out, int out_size, void* d_ws,
                              size_t ws_size, hipStream_t stream) {
  static int grid_blocks = 0;
  if (!grid_blocks) {
    int dev = 0, cus = 0, per_cu = 0;
    hipGetDevice(&dev);
    hipDeviceGetAttribute(&cus, hipDeviceAttributeMultiprocessorCount, dev);
    hipFuncSetAttribute((const void*)mega_fwd, hipFuncAttributeMaxDynamicSharedMemorySize, LDS_BYTES);
    hipOccupancyMaxActiveBlocksPerMultiprocessor(&per_cu, (const void*)mega_fwd, NTHREADS, LDS_BYTES);
    if (per_cu < 1) { fprintf(stderr, "occupancy query returned %d\n", per_cu); per_cu = 1; }
    grid_blocks = cus;
    if (ws_size < WS_END) fprintf(stderr, "workspace too small: %zu < %zu\n", ws_size, (size_t)WS_END);
  }
  Params p{};
  p.x_prompt = (const float*)d_in[0]; p.x_sample = (const float*)d_in[1];
  p.st_mC = (const float*)d_in[2]; p.st_mn = (const float*)d_in[3]; p.st_mm = (const float*)d_in[4];
  p.st_gS = (const float*)d_in[5]; p.st_gconv = (const float*)d_in[6]; p.st_hS = (const float*)d_in[7];
  p.norm1_w = (const float*)d_in[8]; p.w_in = (const float*)d_in[9]; p.ml_i_bias = (const float*)d_in[10];
  p.ml_f_bias = (const float*)d_in[11]; p.ml_norm_w = (const float*)d_in[12]; p.gd_conv_w = (const float*)d_in[13];
  p.gd_A_log = (const float*)d_in[14]; p.gd_dt_bias = (const float*)d_in[15]; p.gd_norm_w = (const float*)d_in[16];
  p.hg_lb_logits = (const float*)d_in[17]; p.hg_norm_w = (const float*)d_in[18]; p.w_branch = (const float*)d_in[19];
  p.w_out = (const float*)d_in[20]; p.norm2_w = (const float*)d_in[21]; p.w_up = (const float*)d_in[22];
  p.w_down = (const float*)d_in[23]; p.final_norm_w = (const float*)d_in[24];
  p.out = (float*)d_out;
  p.ws = (unsigned char*)d_ws;
  hipMemsetAsync((char*)d_ws + WS_BAR, 0, WS_BAR_BYTES, stream);
  void* args[] = {&p};
  hipError_t e = hipLaunchCooperativeKernel((const void*)mega_fwd, dim3(grid_blocks), dim3(NTHREADS), args, LDS_BYTES, stream);
  if (e != hipSuccess) fprintf(stderr, "cooperative launch failed: %s (grid %d)\n", hipGetErrorString(e), grid_blocks);
}
```

```cpp
#include <hip/hip_runtime.h>
#include <hip/hip_cooperative_groups.h>
#include <cstdio>
namespace cg = cooperative_groups;

typedef unsigned short u16;
using bf16x8 = __attribute__((ext_vector_type(8))) short;
using f32x4 = __attribute__((ext_vector_type(4))) float;
typedef float v2f __attribute__((ext_vector_type(2)));

#define DEVI __device__ __forceinline__

constexpr int D = 1024;
constexpr int MP = 16384, MS = 512, M = MP + MS;
constexpr int NPROJ = 6144, NPROJ_PAD = 6272;
constexpr int INC = 9232;
constexpr int DFF = 4096;
constexpr int NTHREADS = 512;
constexpr int LDS_BYTES = 132 * 1024;
constexpr int LDX = 1088, LDH = 4160, LDY = 1600, LDW1 = 1088, LDWB = 576, LDWD = 4160;

constexpr size_t OFF_Y = 0;
constexpr size_t OFF_P_MC = (size_t)M * D;
constexpr size_t OFF_P_MN = OFF_P_MC + 2ull * 8 * 4 * 128 * 128;
constexpr size_t OFF_P_MM = OFF_P_MN + 2ull * 8 * 4 * 128;
constexpr size_t OFF_P_GS = OFF_P_MM + 2ull * 8 * 4;
constexpr size_t OFF_P_GC = OFF_P_GS + 2ull * 8 * 4 * 128 * 128;
constexpr size_t OFF_P_HS = OFF_P_GC + 2ull * 8 * 3 * 1536;
constexpr size_t OFF_S_MC = OFF_P_HS + 2ull * 8 * 4 * 128 * 128;
constexpr size_t OFF_S_MN = OFF_S_MC + 2ull * 128 * 4 * 128 * 128;
constexpr size_t OFF_S_MM = OFF_S_MN + 2ull * 128 * 4 * 128;
constexpr size_t OFF_S_GS = OFF_S_MM + 2ull * 128 * 4;
constexpr size_t OFF_S_GC = OFF_S_GS + 2ull * 128 * 4 * 128 * 128;
constexpr size_t OFF_S_HS = OFF_S_GC + 2ull * 128 * 3 * 1536;
static_assert(OFF_S_HS + 2ull * 128 * 4 * 128 * 128 == 72172608ull, "output size");

constexpr size_t WS_WT_IN = 0;
constexpr size_t WS_WT_GATE = WS_WT_IN + 2ull * NPROJ_PAD * LDW1 * 2;
constexpr size_t WS_WT_BR = WS_WT_GATE + 2ull * 3072 * LDW1 * 2;
constexpr size_t WS_WT_OUT = WS_WT_BR + 2ull * 3 * 1024 * LDWB * 2;
constexpr size_t WS_WT_UP = WS_WT_OUT + 2ull * 1024 * LDW1 * 2;
constexpr size_t WS_WT_DN = WS_WT_UP + 2ull * 4096 * LDW1 * 2;
constexpr size_t WS_PROJ = WS_WT_DN + 2ull * 1024 * LDWD * 2;
constexpr size_t WS_CONV = WS_PROJ + (size_t)M * NPROJ * 2;
constexpr size_t WS_OBUF = WS_CONV + (size_t)M * 1536 * 2;
constexpr size_t WS_XN = WS_OBUF + (size_t)M * LDY * 2;
constexpr size_t WS_SMALL = WS_XN + (size_t)M * LDX * 2;
constexpr size_t WS_GATES = WS_SMALL;
constexpr size_t WS_DM = WS_GATES + (size_t)M * 16 * 4;
constexpr size_t WS_BAR = WS_DM + (size_t)M * 8 * 4;
constexpr size_t WS_BAR_BYTES = 16384;
constexpr size_t WS_END = WS_BAR + WS_BAR_BYTES;
static_assert(WS_END <= 439571584ull, "workspace budget");
static_assert((size_t)M * LDH * 2 <= (size_t)M * NPROJ * 2 && (size_t)M * LDX * 2 <= (size_t)M * 1536 * 2, "aliases fit");

struct Params {
  const float *x_prompt, *x_sample, *st_mC, *st_mn, *st_mm, *st_gS, *st_gconv, *st_hS;
  const float *norm1_w, *w_in, *ml_i_bias, *ml_f_bias, *ml_norm_w, *gd_conv_w, *gd_A_log, *gd_dt_bias,
      *gd_norm_w, *hg_lb_logits, *hg_norm_w, *w_branch, *w_out, *norm2_w, *w_up, *w_down, *final_norm_w;
  float* out;
  unsigned char* ws;
};

DEVI u16 f2bf(float f) { unsigned u = __float_as_uint(f); return (u16)((u + 0x7fffu + ((u >> 16) & 1u)) >> 16); }
DEVI unsigned pk2(float lo, float hi) { return (unsigned)f2bf(lo) | ((unsigned)f2bf(hi) << 16); }
DEVI float bflo(unsigned u) { return __uint_as_float(u << 16); }
DEVI float bfhi(unsigned u) { return __uint_as_float(u & 0xffff0000u); }
DEVI float sigm(float x) { return 1.f / (1.f + __expf(-x)); }
DEVI float silu(float x) { return x * sigm(x); }
DEVI float softplus(float x) { return fmaxf(x, 0.f) + __logf(1.f + __expf(-fabsf(x))); }
DEVI int otid() { int t = threadIdx.x; asm volatile("" : "+v"(t)); return t; }
DEVI float wave_sum(float v) {
#pragma unroll
  for (int o = 32; o > 0; o >>= 1) v += __shfl_xor(v, o);
  return v;
}
template <int CTRL> DEVI float dpp_f(float v) {
  return __int_as_float(__builtin_amdgcn_update_dpp(0, __float_as_int(v), CTRL, 0xf, 0xf, false));
}
DEVI float row16_sum(float v) {
  float r;
  asm("s_nop 1\n\tv_add_f32_dpp %0, %1, %1 row_ror:8 row_mask:0xf bank_mask:0xf" : "=v"(r) : "v"(v));
  asm("s_nop 1\n\tv_add_f32_dpp %0, %1, %1 row_ror:4 row_mask:0xf bank_mask:0xf" : "=v"(v) : "v"(r));
  asm("s_nop 1\n\tv_add_f32_dpp %0, %1, %1 row_ror:2 row_mask:0xf bank_mask:0xf" : "=v"(r) : "v"(v));
  asm("s_nop 1\n\tv_add_f32_dpp %0, %1, %1 row_ror:1 row_mask:0xf bank_mask:0xf" : "=v"(v) : "v"(r));
  return v;
}

DEVI void tr_seg(const float* __restrict__ src, int ld, int K, int ncols, u16* __restrict__ dst, int dld, float* tile, int& off) {
  const int tid_ = otid();
  const int lane = tid_ & 63, gw = blockIdx.x * 8 + (tid_ >> 6), nw = gridDim.x * 8;
  const int nkb = K >> 4, nnb = ncols >> 6, nt = nkb * nnb;
  const int start = (int)(((long)gw + (long)nw * 4096 - off) % nw);
  for (int t = start; t < nt; t += nw) {
    const int kb = t % nkb, nb = t / nkb;
    const float* sp = src + (size_t)(kb * 16) * ld + nb * 64 + lane;
    float v[16];
#pragma unroll
    for (int i = 0; i < 16; ++i) v[i] = sp[(size_t)i * ld];
    uint4 o0, o1;
    o0.x = pk2(v[0], v[1]); o0.y = pk2(v[2], v[3]); o0.z = pk2(v[4], v[5]); o0.w = pk2(v[6], v[7]);
    o1.x = pk2(v[8], v[9]); o1.y = pk2(v[10], v[11]); o1.z = pk2(v[12], v[13]); o1.w = pk2(v[14], v[15]);
    u16* dp = dst + (size_t)(nb * 64 + lane) * dld + kb * 16;
    *(uint4*)dp = o0;
    *(uint4*)(dp + 8) = o1;
  }
  off += nt;
}

DEVI void phase_wprep(const Params& p, float* tile) {
  int off = 0;
  u16* wt_in = (u16*)(p.ws + WS_WT_IN);
  u16* wt_gate = (u16*)(p.ws + WS_WT_GATE);
  u16* wt_br = (u16*)(p.ws + WS_WT_BR);
  u16* wt_out = (u16*)(p.ws + WS_WT_OUT);
  u16* wt_up = (u16*)(p.ws + WS_WT_UP);
  u16* wt_dn = (u16*)(p.ws + WS_WT_DN);
  for (int l = 0; l < 2; ++l) {
    const float* win = p.w_in + (size_t)l * 1024 * INC;
    for (int s = 0; s < 12; ++s) {
      const int srccol = (s < 4) ? s * 512 : (s < 8 ? 2056 + (s - 4) * 512 : 4112 + (s - 8) * 512);
      tr_seg(win + srccol, INC, 1024, 512, wt_in + ((size_t)l * NPROJ_PAD + s * 512) * LDW1, LDW1, tile, off);
    }
    tr_seg(win + 6160, INC, 1024, 3072, wt_gate + (size_t)l * 3072 * LDW1, LDW1, tile, off);
    for (int b = 0; b < 3; ++b)
      tr_seg(p.w_branch + (size_t)(l * 3 + b) * 512 * 1024, 1024, 512, 1024, wt_br + (size_t)(l * 3 + b) * 1024 * LDWB, LDWB, tile, off);
    tr_seg(p.w_out + (size_t)l * 1024 * 1024, 1024, 1024, 1024, wt_out + (size_t)l * 1024 * LDW1, LDW1, tile, off);
    tr_seg(p.w_up + (size_t)l * 1024 * 4096, 4096, 1024, 4096, wt_up + (size_t)l * 4096 * LDW1, LDW1, tile, off);
    tr_seg(p.w_down + (size_t)l * 4096 * 1024, 1024, 4096, 1024, wt_dn + (size_t)l * 1024 * LDWD, LDWD, tile, off);
  }
  for (int idx = blockIdx.x * NTHREADS + otid(); idx < 2 * 128 * 1024; idx += gridDim.x * NTHREADS) {
    const int l = idx >> 17, rem = idx & 131071, r = rem >> 10, k = rem & 1023;
    float v = 0.f;
    if (r < 16) {
      const int sc = (r < 8) ? 2048 + r : 4104 + (r - 8);
      v = p.w_in[(size_t)l * 1024 * INC + (size_t)k * INC + sc];
    }
    wt_in[((size_t)l * NPROJ_PAD + 6144 + r) * LDW1 + k] = f2bf(v);
  }
}

DEVI void phase_norm(const float* xp, const float* xs, const float* __restrict__ w, u16* __restrict__ xn) {
  const int tid_ = otid(); const int lane = tid_ & 63, gw = blockIdx.x * 8 + (tid_ >> 6), nw = gridDim.x * 8;
  for (int m = gw; m < M; m += nw) {
    const float* xr = (m < MP) ? xp + (size_t)m * D : xs + (size_t)(m - MP) * D;
    float4 v[4];
    float ss = 0.f;
#pragma unroll
    for (int i = 0; i < 4; ++i) {
      v[i] = ((const float4*)xr)[lane + 64 * i];
      ss += v[i].x * v[i].x + v[i].y * v[i].y + v[i].z * v[i].z + v[i].w * v[i].w;
    }
    ss = wave_sum(ss);
    const float rstd = rsqrtf(ss * (1.f / 1024.f) + 1e-6f);
#pragma unroll
    for (int i = 0; i < 4; ++i) {
      const float4 wv = ((const float4*)w)[lane + 64 * i];
      uint2 o;
      o.x = pk2(v[i].x * rstd * wv.x, v[i].y * rstd * wv.y);
      o.y = pk2(v[i].z * rstd * wv.z, v[i].w * rstd * wv.w);
      ((uint2*)(xn + (size_t)m * LDX))[lane + 64 * i] = o;
    }
  }
}

DEVI void phase_final_norm(float* x, const float* __restrict__ w) {
  const int tid_ = otid(); const int lane = tid_ & 63, gw = blockIdx.x * 8 + (tid_ >> 6), nw = gridDim.x * 8;
  for (int m = gw; m < M; m += nw) {
    float* xr = x + (size_t)m * D;
    float4 v[4];
    float ss = 0.f;
#pragma unroll
    for (int i = 0; i < 4; ++i) {
      v[i] = ((const float4*)xr)[lane + 64 * i];
      ss += v[i].x * v[i].x + v[i].y * v[i].y + v[i].z * v[i].z + v[i].w * v[i].w;
    }
    ss = wave_sum(ss);
    const float rstd = rsqrtf(ss * (1.f / 1024.f) + 1e-6f);
#pragma unroll
    for (int i = 0; i < 4; ++i) {
      const float4 wv = ((const float4*)w)[lane + 64 * i];
      float4 o;
      o.x = v[i].x * rstd * wv.x; o.y = v[i].y * rstd * wv.y; o.z = v[i].z * rstd * wv.z; o.w = v[i].w * rstd * wv.w;
      ((float4*)xr)[lane + 64 * i] = o;
    }
  }
}

constexpr int LDS_S = 64;

struct GemmOp { const u16* A; const u16* B; int lda, ldb, K, koff; };

DEVI bool tile_map(int it, int vcu, int MT, int NT, int& mt, int& nt) {
  const int G = gridDim.x;
  const int t = it * G + vcu;
  if (t >= MT * NT) return false;
  constexpr int GM = 4;
  const int gsize = GM * NT;
  const int g = t / gsize, tl = t - g * gsize;
  int gsz = MT - g * GM;
  if (gsz > GM) gsz = GM;
  mt = g * GM + (tl % gsz);
  nt = tl / gsz;
  return true;
}
DEVI int koff_of(int mt, int nt) { return (nt & 7) + 2 * (mt & 3); }

template <int WMT, int WNT>
DEVI void zero_acc(f32x4 (&acc)[WMT][WNT]) {
#pragma unroll
  for (int i = 0; i < WMT; ++i)
#pragma unroll
    for (int j = 0; j < WNT; ++j) acc[i][j] = f32x4{0.f, 0.f, 0.f, 0.f};
}

#define PF_PARAMS uint4 &pa0, uint4 &pa1, uint4 &pa2, uint4 &pa3, uint4 &pb0, uint4 &pb1, uint4 &qa0, uint4 &qa1, uint4 &qa2, uint4 &qa3, uint4 &qb0, uint4 &qb1
#define PF_ARGS pa0, pa1, pa2, pa3, pb0, pb1, qa0, qa1, qa2, qa3, qb0, qb1
#define PF_DECL uint4 pa0 = uint4{0, 0, 0, 0}, pa1 = pa0, pa2 = pa0, pa3 = pa0, pb0 = pa0, pb1 = pa0, qa0 = pa0, qa1 = pa0, qa2 = pa0, qa3 = pa0, qb0 = pa0, qb1 = pa0
template <int WMT, int WNT>
DEVI void gemm_core(const GemmOp cur, const GemmOp nxt, bool primed, PF_PARAMS, f32x4 (&acc)[WMT][WNT], u16* smem) {
  constexpr int BM = 64 * WMT, BN = 32 * WNT;
  constexpr int ACH = BM * 8 / NTHREADS, BCH = BN * 8 / NTHREADS;
  static_assert(BCH == 2 && (ACH == 2 || ACH == 4), "chunk counts");
  u16* sA = smem;
  u16* sB = smem + 2 * BM * LDS_S;
  const int tid = otid(), lane = tid & 63, w = tid >> 6, wm = w >> 1, wn = w & 1;
  const int fr = lane & 15, fq = lane >> 4;
  const int crow = tid >> 3, ckc = tid & 7;
  const int wsw = (ckc ^ (crow & 7)) * 8;
  const int rsw0 = (fq ^ (fr & 7)) * 8;
  const u16* Ag = cur.A + (size_t)crow * cur.lda + ckc * 8;
  const u16* Bg = cur.B + (size_t)crow * cur.ldb + ckc * 8;
  const int nk = cur.K >> 6, km = nk - 1, kmn = (nxt.K >> 6) - 1;
#define GLOADX(S, AP, BP, LA, LB, KO)                                                 \
  do {                                                                                \
    S##a0 = *(const uint4*)((AP) + (KO));                                           \
    S##a1 = *(const uint4*)((AP) + (size_t)64 * (LA) + (KO));                       \
    if (ACH == 4) {                                                                   \
      S##a2 = *(const uint4*)((AP) + (size_t)128 * (LA) + (KO));                    \
      S##a3 = *(const uint4*)((AP) + (size_t)192 * (LA) + (KO));                    \
    }                                                                                 \
    S##b0 = *(const uint4*)((BP) + (KO));                                           \
    S##b1 = *(const uint4*)((BP) + (size_t)64 * (LB) + (KO));                       \
  } while (0)
#define GLOADC(S, T) GLOADX(S, Ag, Bg, cur.lda, cur.ldb, ((((T) + cur.koff) & km) * 64))
#define GLOADN(S, T) GLOADX(S, An, Bn, nxt.lda, nxt.ldb, ((((T) + nxt.koff) & kmn) * 64))
#define SSTORE(S, NB)                                                                 \
  do {                                                                                \
    u16* dA = sA + ((NB) * BM + crow) * LDS_S + wsw;                                  \
    u16* dB = sB + ((NB) * BN + crow) * LDS_S + wsw;                                  \
    *(uint4*)(dA) = S##a0;                                                          \
    *(uint4*)(dA + 64 * LDS_S) = S##a1;                                             \
    if (ACH == 4) {                                                                   \
      *(uint4*)(dA + 128 * LDS_S) = S##a2;                                          \
      *(uint4*)(dA + 192 * LDS_S) = S##a3;                                          \
    }                                                                                 \
    *(uint4*)(dB) = S##b0;                                                          \
    *(uint4*)(dB + 64 * LDS_S) = S##b1;                                             \
  } while (0)
#define LOADFR(BUF)                                                                   \
  do {                                                                                \
    const u16* cA = sA + ((BUF) * BM + wm * 16 * WMT + fr) * LDS_S;                   \
    const u16* cB = sB + ((BUF) * BN + wn * 16 * WNT + fr) * LDS_S;                   \
    _Pragma("unroll") for (int ks = 0; ks < 2; ++ks) {                                \
      const int so = rsw0 ^ (ks * 32);                                                \
      _Pragma("unroll") for (int i = 0; i < WMT; ++i) af[ks][i] = *(const bf16x8*)(cA + i * 16 * LDS_S + so);  \
      _Pragma("unroll") for (int j = 0; j < WNT; ++j) bfr[ks][j] = *(const bf16x8*)(cB + j * 16 * LDS_S + so); \
    }                                                                                 \
  } while (0)
#define MFMAS()                                                                       \
  do {                                                                                \
    _Pragma("unroll") for (int ks = 0; ks < 2; ++ks)                                  \
      _Pragma("unroll") for (int i = 0; i < WMT; ++i)                                 \
        _Pragma("unroll") for (int j = 0; j < WNT; ++j)                               \
          acc[i][j] = __builtin_amdgcn_mfma_f32_16x16x32_bf16(bfr[ks][j], af[ks][i], acc[i][j], 0, 0, 0);  \
  } while (0)
#define HALF(BUF, SS, LOADSTMT)                                                       \
  do {                                                                                \
    LOADFR(BUF);                                                                      \
    __builtin_amdgcn_sched_barrier(0);                                                \
    SSTORE(SS, (BUF) ^ 1);                                                            \
    LOADSTMT;                                                                         \
    __builtin_amdgcn_sched_barrier(0);                                                \
    MFMAS();                                                                          \
    __builtin_amdgcn_sched_barrier(0);                                                \
    __syncthreads();                                                                  \
  } while (0)
  bf16x8 af[2][WMT], bfr[2][WNT];
  if (!primed) {
    GLOADC(p, 0);
    SSTORE(p, 0);
    __builtin_amdgcn_sched_barrier(0);
    GLOADC(q, 1);
    __builtin_amdgcn_sched_barrier(0);
    GLOADC(p, 2);
    __builtin_amdgcn_sched_barrier(0);
    __syncthreads();
  }
#pragma unroll 1
  for (int kt = 0; kt + 4 < nk; kt += 2) {
    HALF(0, q, GLOADC(q, kt + 3));
    HALF(1, p, GLOADC(p, kt + 4));
  }
  HALF(0, q, GLOADC(q, nk - 1));
  const u16* An = nxt.A + (size_t)crow * nxt.lda + ckc * 8;
  const u16* Bn = nxt.B + (size_t)crow * nxt.ldb + ckc * 8;
  HALF(1, p, GLOADN(p, 0));
  HALF(0, q, GLOADN(q, 1));
  HALF(1, p, GLOADN(p, 2));
#undef GLOADX
#undef GLOADC
#undef GLOADN
#undef SSTORE
#undef LOADFR
#undef MFMAS
#undef HALF
}

#define PFB_PARAMS uint4 &pa0, uint4 &pa1, uint4 &pa2, uint4 &pa3, uint4 &pb0, uint4 &pb1, uint4 &pb2, uint4 &pb3
#define PFB_ARGS pa0, pa1, pa2, pa3, pb0, pb1, pb2, pb3
#define PFB_DECL uint4 pa0 = uint4{0, 0, 0, 0}, pa1 = pa0, pa2 = pa0, pa3 = pa0, pb0 = pa0, pb1 = pa0, pb2 = pa0, pb3 = pa0
DEVI void gemm_core_big(const GemmOp cur, const GemmOp nxt, bool primed, PFB_PARAMS, f32x4 (&acc)[4][8], u16* smem) {
  u16* sA = smem;
  u16* sB = smem + 2 * 256 * LDS_S;
  const int tid = otid(), lane = tid & 63, w = tid >> 6, wm = w >> 1, wn = w & 1;
  const int fr = lane & 15, fq = lane >> 4;
  const int crow = tid >> 3, ckc = tid & 7;
  const int wsw = (ckc ^ (crow & 7)) * 8;
  const int rsw0 = (fq ^ (fr & 7)) * 8;
  const u16* Ag = cur.A + (size_t)crow * cur.lda + ckc * 8;
  const u16* Bg = cur.B + (size_t)crow * cur.ldb + ckc * 8;
  const int nk = cur.K >> 6, km = nk - 1, kmn = (nxt.K >> 6) - 1;
#define BGLOADX(AP, BP, LA, LB, KO)                                                   \
  do {                                                                                \
    pa0 = *(const uint4*)((AP) + (KO));                                             \
    pa1 = *(const uint4*)((AP) + (size_t)64 * (LA) + (KO));                         \
    pa2 = *(const uint4*)((AP) + (size_t)128 * (LA) + (KO));                        \
    pa3 = *(const uint4*)((AP) + (size_t)192 * (LA) + (KO));                        \
    pb0 = *(const uint4*)((BP) + (KO));                                             \
    pb1 = *(const uint4*)((BP) + (size_t)64 * (LB) + (KO));                         \
    pb2 = *(const uint4*)((BP) + (size_t)128 * (LB) + (KO));                        \
    pb3 = *(const uint4*)((BP) + (size_t)192 * (LB) + (KO));                        \
  } while (0)
#define BGLOADC(T) BGLOADX(Ag, Bg, cur.lda, cur.ldb, ((((T) + cur.koff) & km) * 64))
#define BGLOADN(T) BGLOADX(An, Bn, nxt.lda, nxt.ldb, ((((T) + nxt.koff) & kmn) * 64))
#define BSSTORE(NB)                                                                   \
  do {                                                                                \
    u16* dA = sA + ((NB) * 256 + crow) * LDS_S + wsw;                                 \
    u16* dB = sB + ((NB) * 256 + crow) * LDS_S + wsw;                                 \
    *(uint4*)(dA) = pa0;                                                            \
    *(uint4*)(dA + 64 * LDS_S) = pa1;                                               \
    *(uint4*)(dA + 128 * LDS_S) = pa2;                                              \
    *(uint4*)(dA + 192 * LDS_S) = pa3;                                              \
    *(uint4*)(dB) = pb0;                                                            \
    *(uint4*)(dB + 64 * LDS_S) = pb1;                                               \
    *(uint4*)(dB + 128 * LDS_S) = pb2;                                              \
    *(uint4*)(dB + 192 * LDS_S) = pb3;                                              \
  } while (0)
#define BLOADFR(BUF, KS)                                                              \
  do {                                                                                \
    const u16* cA = sA + ((BUF) * 256 + wm * 64 + fr) * LDS_S + (rsw0 ^ ((KS) * 32)); \
    const u16* cB = sB + ((BUF) * 256 + wn * 128 + fr) * LDS_S + (rsw0 ^ ((KS) * 32)); \
    _Pragma("unroll") for (int i = 0; i < 4; ++i) af[i] = *(const bf16x8*)(cA + i * 16 * LDS_S);  \
    _Pragma("unroll") for (int j = 0; j < 4; ++j) bfr[j] = *(const bf16x8*)(cB + j * 16 * LDS_S); \
  } while (0)
#define BLOADB2(BUF, KS)                                                              \
  do {                                                                                \
    const u16* cB = sB + ((BUF) * 256 + wn * 128 + 64 + fr) * LDS_S + (rsw0 ^ ((KS) * 32)); \
    _Pragma("unroll") for (int j = 0; j < 4; ++j) bfr[j] = *(const bf16x8*)(cB + j * 16 * LDS_S); \
  } while (0)
#define BMFMAS(JO)                                                                    \
  do {                                                                                \
    _Pragma("unroll") for (int i = 0; i < 4; ++i)                                     \
      _Pragma("unroll") for (int j = 0; j < 4; ++j)                                   \
        acc[i][(JO) + j] = __builtin_amdgcn_mfma_f32_16x16x32_bf16(bfr[j], af[i], acc[i][(JO) + j], 0, 0, 0);  \
  } while (0)
#define BHALF(BUF, LOADSTMT)                                                          \
  do {                                                                                \
    BLOADFR(BUF, 0);                                                                  \
    __builtin_amdgcn_sched_barrier(0);                                                \
    BSSTORE((BUF) ^ 1);                                                               \
    LOADSTMT;                                                                         \
    __builtin_amdgcn_sched_barrier(0);                                                \
    BMFMAS(0);                                                                        \
    __builtin_amdgcn_sched_barrier(0);                                                \
    BLOADB2(BUF, 0);                                                                  \
    __builtin_amdgcn_sched_barrier(0);                                                \
    BMFMAS(4);                                                                        \
    __builtin_amdgcn_sched_barrier(0);                                                \
    BLOADFR(BUF, 1);                                                                  \
    __builtin_amdgcn_sched_barrier(0);                                                \
    BMFMAS(0);                                                                        \
    __builtin_amdgcn_sched_barrier(0);                                                \
    BLOADB2(BUF, 1);                                                                  \
    __builtin_amdgcn_sched_barrier(0);                                                \
    BMFMAS(4);                                                                        \
    __builtin_amdgcn_sched_barrier(0);                                                \
    __syncthreads();                                                                  \
  } while (0)
  bf16x8 af[4], bfr[4];
  if (!primed) {
    BGLOADC(0);
    BSSTORE(0);
    __builtin_amdgcn_sched_barrier(0);
    BGLOADC(1);
    __builtin_amdgcn_sched_barrier(0);
    __syncthreads();
  }
#pragma unroll 1
  for (int kt = 0; kt + 2 < nk; kt += 2) {
    BHALF(0, BGLOADC(kt + 2));
    BHALF(1, BGLOADC(kt + 3));
  }
  const u16* An = nxt.A + (size_t)crow * nxt.lda + ckc * 8;
  const u16* Bn = nxt.B + (size_t)crow * nxt.ldb + ckc * 8;
  BHALF(0, BGLOADN(0));
  BHALF(1, BGLOADN(1));
#undef BGLOADX
#undef BGLOADC
#undef BGLOADN
#undef BSSTORE
#undef BLOADFR
#undef BLOADB2
#undef BMFMAS
#undef BHALF
}

DEVI void phase_proj(const Params& p, int l, int vcu, u16* smem) {
  const u16* xn = (const u16*)(p.ws + WS_XN);
  const u16* wt = (const u16*)(p.ws + WS_WT_IN) + (size_t)l * NPROJ_PAD * LDW1;
  u16* proj = (u16*)(p.ws + WS_PROJ);
  float* small = (float*)(p.ws + WS_SMALL);
  constexpr int NT = 25, MT = M / 256;
  PFB_DECL;
  int mt, nt;
  bool have = tile_map(0, vcu, MT, NT, mt, nt);
  for (int it = 0; have; ++it) {
    const int m0 = mt * 256, n0 = nt * 256;
    const GemmOp cur{xn + (size_t)m0 * LDX, wt + (size_t)n0 * LDW1, LDX, LDW1, 1024, koff_of(mt, nt)};
    int mtn, ntn;
    const bool haven = tile_map(it + 1, vcu, MT, NT, mtn, ntn);
    GemmOp nxt = cur;
    if (haven) { nxt.A = xn + (size_t)(mtn * 256) * LDX; nxt.B = wt + (size_t)(ntn * 256) * LDW1; nxt.koff = koff_of(mtn, ntn); }
    f32x4 acc[4][8];
    zero_acc(acc);
    gemm_core_big(cur, nxt, it > 0, PFB_ARGS, acc, smem);
    const int tid_ = otid(); const int lane = tid_ & 63, w = tid_ >> 6, wm = w >> 1, wn = w & 1, fr = lane & 15, fq = lane >> 4;
#pragma unroll
    for (int i = 0; i < 4; ++i)
#pragma unroll
      for (int j = 0; j < 8; ++j) {
        const int m = m0 + wm * 64 + i * 16 + fr, n = n0 + wn * 128 + j * 16 + fq * 4;
        if (n < NPROJ) {
          uint2 o;
          o.x = pk2(acc[i][j][0], acc[i][j][1]);
          o.y = pk2(acc[i][j][2], acc[i][j][3]);
          *(uint2*)(proj + (size_t)m * NPROJ + n) = o;
        } else if (n < NPROJ + 16) {
          *(float4*)(small + (size_t)m * 16 + (n - NPROJ)) = float4{acc[i][j][0], acc[i][j][1], acc[i][j][2], acc[i][j][3]};
        }
      }
    have = haven; mt = mtn; nt = ntn;
  }
}

DEVI void phase_up(const Params& p, int l, int vcu, u16* smem) {
  const u16* xn = (const u16*)(p.ws + WS_XN);
  const u16* wt = (const u16*)(p.ws + WS_WT_UP) + (size_t)l * 4096 * LDW1;
  u16* hid = (u16*)(p.ws + WS_PROJ);
  constexpr int NT = DFF / 256, MT = M / 256;
  PFB_DECL;
  int mt, nt;
  bool have = tile_map(0, vcu, MT, NT, mt, nt);
  for (int it = 0; have; ++it) {
    const int m0 = mt * 256, n0 = nt * 256;
    const GemmOp cur{xn + (size_t)m0 * LDX, wt + (size_t)n0 * LDW1, LDX, LDW1, 1024, koff_of(mt, nt)};
    int mtn, ntn;
    const bool haven = tile_map(it + 1, vcu, MT, NT, mtn, ntn);
    GemmOp nxt = cur;
    if (haven) { nxt.A = xn + (size_t)(mtn * 256) * LDX; nxt.B = wt + (size_t)(ntn * 256) * LDW1; nxt.koff = koff_of(mtn, ntn); }
    f32x4 acc[4][8];
    zero_acc(acc);
    gemm_core_big(cur, nxt, it > 0, PFB_ARGS, acc, smem);
    const int tid_ = otid(); const int lane = tid_ & 63, w = tid_ >> 6, wm = w >> 1, wn = w & 1, fr = lane & 15, fq = lane >> 4;
#pragma unroll
    for (int i = 0; i < 4; ++i)
#pragma unroll
      for (int j = 0; j < 8; ++j) {
        const int m = m0 + wm * 64 + i * 16 + fr, n = n0 + wn * 128 + j * 16 + fq * 4;
        float r0 = fmaxf(acc[i][j][0], 0.f), r1 = fmaxf(acc[i][j][1], 0.f), r2 = fmaxf(acc[i][j][2], 0.f), r3 = fmaxf(acc[i][j][3], 0.f);
        uint2 o;
        o.x = pk2(r0 * r0, r1 * r1);
        o.y = pk2(r2 * r2, r3 * r3);
        *(uint2*)(hid + (size_t)m * LDH + n) = o;
      }
    have = haven; mt = mtn; nt = ntn;
  }
}

DEVI void phase_merge(const Params& p, int l, int vcu, u16* smem) {
  const u16* xn = (const u16*)(p.ws + WS_XN);
  const u16* y = (const u16*)(p.ws + WS_OBUF);
  const u16* wg = (const u16*)(p.ws + WS_WT_GATE) + (size_t)l * 3072 * LDW1;
  const u16* wb = (const u16*)(p.ws + WS_WT_BR) + (size_t)l * 3 * 1024 * LDWB;
  u16* merged = (u16*)(p.ws + WS_CONV);
  const int tid_ = otid(); const int lane = tid_ & 63, w = tid_ >> 6, wm = w >> 1, wn = w & 1, fr = lane & 15, fq = lane >> 4;
  constexpr int NT = D / 128, MT = M / 128;
  PF_DECL;
  int mt, nt;
  bool have = tile_map(0, vcu, MT, NT, mt, nt);
  for (int it = 0; have; ++it) {
    const int m0 = mt * 128, n0 = nt * 128;
    const int ko = koff_of(mt, nt);
    int mtn, ntn;
    const bool haven = tile_map(it + 1, vcu, MT, NT, mtn, ntn);
    f32x4 accM[2][4];
    zero_acc(accM);
#pragma unroll 1
    for (int b = 0; b < 3; ++b) {
      f32x4 accG[2][4], accB[2][4];
      zero_acc(accG);
      const GemmOp gate{xn + (size_t)m0 * LDX, wg + ((size_t)b * 1024 + n0) * LDW1, LDX, LDW1, 1024, ko};
      const GemmOp br{y + (size_t)m0 * LDY + b * 512, wb + ((size_t)b * 1024 + n0) * LDWB, LDY, LDWB, 512, ko};
      GemmOp after = gate;
      if (b < 2) {
        after.B = wg + ((size_t)(b + 1) * 1024 + n0) * LDW1;
      } else if (haven) {
        after.A = xn + (size_t)(mtn * 128) * LDX;
        after.B = wg + (size_t)(ntn * 128) * LDW1;
        after.koff = koff_of(mtn, ntn);
      }
      gemm_core<2, 4>(gate, br, (it > 0) || (b > 0), PF_ARGS, accG, smem);
      unsigned gpk[2][4][2];
#pragma unroll
      for (int i = 0; i < 2; ++i)
#pragma unroll
        for (int j = 0; j < 4; ++j) {
          gpk[i][j][0] = pk2(sigm(accG[i][j][0]), sigm(accG[i][j][1]));
          gpk[i][j][1] = pk2(sigm(accG[i][j][2]), sigm(accG[i][j][3]));
        }
      zero_acc(accB);
      gemm_core<2, 4>(br, after, true, PF_ARGS, accB, smem);
#pragma unroll
      for (int i = 0; i < 2; ++i)
#pragma unroll
        for (int j = 0; j < 4; ++j) {
          accM[i][j][0] += bflo(gpk[i][j][0]) * accB[i][j][0];
          accM[i][j][1] += bfhi(gpk[i][j][0]) * accB[i][j][1];
          accM[i][j][2] += bflo(gpk[i][j][1]) * accB[i][j][2];
          accM[i][j][3] += bfhi(gpk[i][j][1]) * accB[i][j][3];
        }
    }
#pragma unroll
    for (int i = 0; i < 2; ++i)
#pragma unroll
      for (int j = 0; j < 4; ++j) {
        const int m = m0 + wm * 32 + i * 16 + fr, n = n0 + wn * 64 + j * 16 + fq * 4;
        uint2 o;
        o.x = pk2(accM[i][j][0], accM[i][j][1]);
        o.y = pk2(accM[i][j][2], accM[i][j][3]);
        *(uint2*)(merged + (size_t)m * LDX + n) = o;
      }
    have = haven; mt = mtn; nt = ntn;
  }
}

DEVI void phase_resid(const u16* A, int lda, int K, const u16* wt, int ldb, const float* xin_p, const float* xin_s, float* xout, int vcu, u16* smem) {
  for (int t = vcu; t < 256; t += gridDim.x) {
    PFB_DECL;
    int mt, nt;
    tile_map(0, t, 64, 4, mt, nt);
    const int m0 = mt * 256, n0 = nt * 256;
    const GemmOp cur{A + (size_t)m0 * lda, wt + (size_t)n0 * ldb, lda, ldb, K, koff_of(mt, nt)};
    f32x4 acc[4][8];
    zero_acc(acc);
    gemm_core_big(cur, cur, false, PFB_ARGS, acc, smem);
    const int tid_ = otid(); const int lane = tid_ & 63, w = tid_ >> 6, wm = w >> 1, wn = w & 1, fr = lane & 15, fq = lane >> 4;
#pragma unroll
    for (int i = 0; i < 4; ++i)
#pragma unroll
      for (int j = 0; j < 8; ++j) {
        const int m = m0 + wm * 64 + i * 16 + fr, n = n0 + wn * 128 + j * 16 + fq * 4;
        const float4 xv = *(const float4*)(xin_p + (size_t)m * D + n);
        float4 o;
        o.x = xv.x + acc[i][j][0]; o.y = xv.y + acc[i][j][1]; o.z = xv.z + acc[i][j][2]; o.w = xv.w + acc[i][j][3];
        *(float4*)(xout + (size_t)m * D + n) = o;
        if ((j & 1) == 1) __builtin_amdgcn_sched_barrier(0);
      }
  }
  {
    PF_DECL;
    bool first = true;
    for (int t = vcu; t < 32; t += gridDim.x) {
      const int mt = (MP / 128) + (t >> 3), nt = t & 7;
      const int m0 = mt * 128, n0 = nt * 128;
      const GemmOp cur{A + (size_t)m0 * lda, wt + (size_t)n0 * ldb, lda, ldb, K, koff_of(mt, nt)};
      f32x4 acc[2][4];
      zero_acc(acc);
      gemm_core<2, 4>(cur, cur, !first, PF_ARGS, acc, smem);
      const int tid_ = otid(); const int lane = tid_ & 63, w = tid_ >> 6, wm = w >> 1, wn = w & 1, fr = lane & 15, fq = lane >> 4;
      first = false;
#pragma unroll
      for (int i = 0; i < 2; ++i)
#pragma unroll
        for (int j = 0; j < 4; ++j) {
          const int m = m0 + wm * 32 + i * 16 + fr, n = n0 + wn * 64 + j * 16 + fq * 4;
          const float4 xv = *(const float4*)(xin_s + (size_t)(m - MP) * D + n);
          float4 o;
          o.x = xv.x + acc[i][j][0]; o.y = xv.y + acc[i][j][1]; o.z = xv.z + acc[i][j][2]; o.w = xv.w + acc[i][j][3];
          *(float4*)(xout + (size_t)m * D + n) = o;
        }
    }
  }
}

DEVI void unpack8(const uint4 u, float (&f)[8]) {
  f[0] = bflo(u.x); f[1] = bfhi(u.x); f[2] = bflo(u.y); f[3] = bfhi(u.y);
  f[4] = bflo(u.z); f[5] = bfhi(u.z); f[6] = bflo(u.w); f[7] = bfhi(u.w);
}
DEVI uint4 pack8(const float (&f)[8]) {
  uint4 r;
  r.x = pk2(f[0], f[1]); r.y = pk2(f[2], f[3]); r.z = pk2(f[4], f[5]); r.w = pk2(f[6], f[7]);
  return r;
}
DEVI void load8f(const float* p, float (&f)[8]) {
  const float4 a = *(const float4*)p, b = *(const float4*)(p + 4);
  f[0] = a.x; f[1] = a.y; f[2] = a.z; f[3] = a.w; f[4] = b.x; f[5] = b.y; f[6] = b.z; f[7] = b.w;
}
DEVI void phase_prep(const Params& p, int l) {
  const int tid_ = otid(); const int lane = tid_ & 63, gw = blockIdx.x * 8 + (tid_ >> 6), nw = gridDim.x * 8;
  u16* proj = (u16*)(p.ws + WS_PROJ);
  u16* conv = (u16*)(p.ws + WS_CONV);
  const float* small = (const float*)(p.ws + WS_SMALL);
  float* gates = (float*)(p.ws + WS_GATES);
  constexpr int NTASK = (M / 4) * 6;
  for (int task = gw; task < NTASK; task += nw) {
    const int tg = task / 6, k = task - tg * 6;
    const int m0 = tg * 4;
    const bool samp = m0 >= MP;
    int b, t0;
    if (!samp) { b = m0 >> 11; t0 = m0 & 2047; } else { b = (m0 - MP) >> 2; t0 = 0; }
    if (k < 3) {
      const int pp = k;
      const int ch = pp * 512 + lane * 8;
      const u16* src = proj + 2048 + ch;
      float r[7][8], cw[4][8];
#pragma unroll
      for (int j = 0; j < 7; ++j) {
        const int t = t0 - 3 + j;
        if (t >= 0) {
          unpack8(*(const uint4*)(src + (size_t)(m0 - 3 + j) * NPROJ), r[j]);
        } else if (samp) {
          load8f(p.st_gconv + ((size_t)(l * 128 + b) * 3 + j) * 1536 + ch, r[j]);
        } else {
#pragma unroll
          for (int c = 0; c < 8; ++c) r[j][c] = 0.f;
        }
      }
#pragma unroll
      for (int j = 0; j < 4; ++j) load8f(p.gd_conv_w + (size_t)(l * 4 + j) * 1536 + ch, cw[j]);
#pragma unroll
      for (int tt = 0; tt < 4; ++tt) {
        float a[8];
        float ss = 0.f;
#pragma unroll
        for (int c = 0; c < 8; ++c) {
          float sx = 0.f;
#pragma unroll
          for (int j = 0; j < 4; ++j) sx += cw[j][c] * r[tt + j][c];
          a[c] = silu(sx);
          ss += a[c] * a[c];
        }
        if (pp < 2) {
          ss = row16_sum(ss);
          float sc = rsqrtf(ss + 1e-6f);
          if (pp == 0) sc *= 0.08838834764831845f;
#pragma unroll
          for (int c = 0; c < 8; ++c) a[c] *= sc;
        }
        *(uint4*)(conv + (size_t)(m0 + tt) * 1536 + ch) = pack8(a);
      }
      const bool last = samp || (t0 == 2044);
      if (last) {
        float* co = p.out + (samp ? OFF_S_GC + (size_t)(l * 128 + b) * 3 * 1536 : OFF_P_GC + (size_t)(l * 8 + b) * 3 * 1536) + ch;
#pragma unroll
        for (int j = 0; j < 3; ++j) {
          *(float4*)(co + j * 1536) = float4{r[4 + j][0], r[4 + j][1], r[4 + j][2], r[4 + j][3]};
          *(float4*)(co + j * 1536 + 4) = float4{r[4 + j][4], r[4 + j][5], r[4 + j][6], r[4 + j][7]};
        }
      }
    } else if (k < 5) {
      const int part = k - 3;
      const int wch = lane * 8;
      u16* col = proj + 4096 + part * 512 + wch;
      float lb[8];
#pragma unroll
      for (int c = 0; c < 8; ++c) lb[c] = 0.f;
      if (part == 1 && l == 1) {
        float l0[8], l1[8];
        load8f(p.hg_lb_logits + wch, l0);
        load8f(p.hg_lb_logits + 512 + wch, l1);
#pragma unroll
        for (int c = 0; c < 8; ++c) lb[c] = sigm(l1[c] - l0[c]);
      }
      uint4 u[4];
#pragma unroll
      for (int tt = 0; tt < 4; ++tt) u[tt] = *(const uint4*)(col + (size_t)(m0 + tt) * NPROJ);
#pragma unroll
      for (int tt = 0; tt < 4; ++tt) {
        float f[8];
        unpack8(u[tt], f);
#pragma unroll
        for (int c = 0; c < 8; ++c) f[c] = (part == 0) ? silu(f[c]) : (1.f - lb[c]) * sigm(-f[c]);
        *(uint4*)(col + (size_t)(m0 + tt) * NPROJ) = pack8(f);
      }
    } else {
      const int tt = lane >> 4, g = lane & 15, hh = g & 3;
      const float v = small[(size_t)(m0 + tt) * 16 + g];
      float r;
      if (g < 4) r = v + p.ml_i_bias[l * 4 + hh];
      else if (g < 8) { const float x = v + p.ml_f_bias[l * 4 + hh]; r = -softplus(-x); }
      else if (g < 12) r = sigm(v);
      else { const float x = v + p.gd_dt_bias[l * 4 + hh]; r = __expf(-__expf(p.gd_A_log[l * 4 + hh]) * softplus(x)); }
      gates[(size_t)(m0 + tt) * 16 + g] = r;
    }
  }
}

template <int KIND>
DEVI void scan_unit(const Params& p, int l, bool samp, int b, int h, int colbase, float* smem) {
  constexpr int CPL = (KIND == 1) ? 1 : 2;
  constexpr int UC = 32 * CPL;
  constexpr int VCH = UC / 8;
  const int tid = otid(), lane = tid & 63, w = tid >> 6, kg = lane & 15, cl = lane >> 4;
  const int T = samp ? 4 : 2048;
  const int rowbase = samp ? (MP + b * 4) : b * 2048;
  const int NB = samp ? 128 : 8;
  const u16* proj = (const u16*)(p.ws + WS_PROJ);
  const u16* conv = (const u16*)(p.ws + WS_CONV);
  u16* obuf = (u16*)(p.ws + WS_OBUF);
  const float* gates = (const float*)(p.ws + WS_GATES);
  float* dm = (float*)(p.ws + WS_DM);
  const u16 *qsrc, *ksrc, *vsrc;
  int ld, ocol;
  const float* Sin;
  float* Sout;
  const size_t sidx_in = ((size_t)(l * 128 + b) * 4 + h) * 16384;
  const size_t sidx_out = ((size_t)(l * NB + b) * 4 + h) * 16384;
  if (KIND == 0) {
    qsrc = proj + h * 128; ksrc = proj + 512 + h * 128; vsrc = proj + 1024 + h * 128 + colbase; ld = NPROJ; ocol = 0;
    Sin = p.st_mC + sidx_in; Sout = p.out + (samp ? OFF_S_MC : OFF_P_MC) + sidx_out;
  } else if (KIND == 1) {
    qsrc = conv + h * 128; ksrc = conv + 512 + h * 128; vsrc = conv + 1024 + h * 128 + colbase; ld = 1536; ocol = 512;
    Sin = p.st_gS + sidx_in; Sout = p.out + (samp ? OFF_S_GS : OFF_P_GS) + sidx_out;
  } else {
    qsrc = proj + 4096 + h * 128; ksrc = proj + 4608 + h * 128; vsrc = proj + 5120 + h * 128 + colbase; ld = NPROJ; ocol = 1024;
    Sin = p.st_hS + sidx_in; Sout = p.out + (samp ? OFF_S_HS : OFF_P_HS) + sidx_out;
  }
  float* qk = smem;
  float* vl = smem + 2 * 32 * 256;
  float* gl = vl + 2 * 32 * 64;

  const int wc = w * 4 * CPL + cl * CPL;
  const int col0 = colbase + wc;
  v2f S[CPL][4];
  v2f nv[4];
#pragma unroll
  for (int c = 0; c < CPL; ++c)
#pragma unroll
    for (int i = 0; i < 4; ++i) {
      if (samp) { S[c][i].x = Sin[(size_t)(kg * 8 + 2 * i) * 128 + col0 + c]; S[c][i].y = Sin[(size_t)(kg * 8 + 2 * i + 1) * 128 + col0 + c]; }
      else { S[c][i].x = 0.f; S[c][i].y = 0.f; }
    }
  float mstart = 0.f;
  if (KIND == 0) {
    const size_t nidx = ((size_t)(l * 128 + b) * 4 + h) * 128;
#pragma unroll
    for (int i = 0; i < 4; ++i) {
      if (samp) { nv[i].x = p.st_mn[nidx + kg * 8 + 2 * i]; nv[i].y = p.st_mn[nidx + kg * 8 + 2 * i + 1]; }
      else { nv[i].x = 0.f; nv[i].y = 0.f; }
    }
    if (samp) mstart = p.st_mm[(size_t)(l * 128 + b) * 4 + h];
  }

  uint4 rq, rk, rv;
  float g0 = 0.f, g1 = 0.f;
  const int sr = tid >> 4, sc = tid & 15;
  const int vr = tid / VCH, vc = tid % VCH;
  auto prefetch = [&](int j) {
    const int t = j * 32 + sr;
    rq = uint4{0, 0, 0, 0}; rk = uint4{0, 0, 0, 0}; rv = uint4{0, 0, 0, 0};
    if (t < T) {
      rq = *(const uint4*)(qsrc + (size_t)(rowbase + t) * ld + sc * 8);
      rk = *(const uint4*)(ksrc + (size_t)(rowbase + t) * ld + sc * 8);
    }
    if (tid < 32 * VCH) {
      const int tv = j * 32 + vr;
      if (tv < T) rv = *(const uint4*)(vsrc + (size_t)(rowbase + tv) * ld + vc * 8);
    }
    if (KIND != 2) {
      g0 = (KIND == 0) ? -1e30f : 0.f; g1 = 0.f;
      if (tid < 32) {
        const int tg = j * 32 + tid;
        if (tg < T) {
          if (KIND == 0) { g0 = gates[(size_t)(rowbase + tg) * 16 + h]; g1 = gates[(size_t)(rowbase + tg) * 16 + 4 + h]; }
          else { g0 = gates[(size_t)(rowbase + tg) * 16 + 8 + h]; g1 = gates[(size_t)(rowbase + tg) * 16 + 12 + h]; }
        }
      }
    }
  };
  auto stage = [&](int j, int buf) {
    float* qd = qk + (buf * 32 + sr) * 256 + sc * 8;
    *(float4*)(qd) = float4{bflo(rq.x), bfhi(rq.x), bflo(rq.y), bfhi(rq.y)};
    *(float4*)(qd + 4) = float4{bflo(rq.z), bfhi(rq.z), bflo(rq.w), bfhi(rq.w)};
    *(float4*)(qd + 128) = float4{bflo(rk.x), bfhi(rk.x), bflo(rk.y), bfhi(rk.y)};
    *(float4*)(qd + 132) = float4{bflo(rk.z), bfhi(rk.z), bflo(rk.w), bfhi(rk.w)};
    if (tid < 32 * VCH) {
      float* vd = vl + (buf * 32 + vr) * 64 + vc * 8;
      *(float4*)(vd) = float4{bflo(rv.x), bfhi(rv.x), bflo(rv.y), bfhi(rv.y)};
      *(float4*)(vd + 4) = float4{bflo(rv.z), bfhi(rv.z), bflo(rv.w), bfhi(rv.w)};
    }
    if (KIND == 0) {
      if (w == 0) {
        float bs = g1;
#pragma unroll
        for (int d = 1; d < 32; d <<= 1) { const float o = __shfl_up(bs, d); if (lane >= d) bs += o; }
        float R = g0 - bs;
#pragma unroll
        for (int d = 1; d < 32; d <<= 1) { const float o = __shfl_up(R, d); if (lane >= d) R = fmaxf(R, o); }
        const float mt = bs + fmaxf(mstart, R);
        float mprev = __shfl_up(mt, 1);
        if (lane == 0) mprev = mstart;
        const float fw = __expf(g1 + mprev - mt);
        const float iw = __expf(g0 - mt) * 0.08838834764831845f;
        if (lane < 32) {
          float* gd = gl + (buf * 32 + lane) * 4;
          gd[0] = fw; gd[1] = iw; gd[2] = mt;
        }
        int lastv = T - j * 32 - 1;
        if (lastv > 31) lastv = 31;
        mstart = __shfl(mt, lastv);
      }
    } else if (KIND == 1) {
      if (tid < 32) {
        float* gd = gl + (buf * 32 + tid) * 4;
        gd[0] = g0; gd[1] = g1;
      }
    }
  };

  const bool do_n = (KIND == 0) && (colbase == 0) && (w == 0);
  const int nblk = (T + 31) >> 5;
  prefetch(0);
  stage(0, 0);
  __syncthreads();
  for (int j = 0; j < nblk; ++j) {
    const int buf = j & 1;
    if (j + 1 < nblk) prefetch(j + 1);
    int steps = T - j * 32;
    if (steps > 32) steps = 32;
    u16* const obase = obuf + (size_t)(rowbase + j * 32) * LDY + ocol + h * 128 + col0;
    float* const dmbase = dm + (size_t)(rowbase + j * 32) * 8 + h;
    for (int t0 = 0; t0 < steps; t0 += 16) {
      int ns = steps - t0;
      if (ns > 16) ns = 16;
      float keep0 = 0.f, keep1 = 0.f, keepd = 0.f, keepm = 0.f;
#pragma unroll 4
      for (int tt = 0; tt < ns; ++tt) {
        const int t = t0 + tt;
        const float* qp = qk + (buf * 32 + t) * 256 + kg * 8;
        const float4 qa = *(const float4*)(qp), qb = *(const float4*)(qp + 4);
        const float4 ka = *(const float4*)(qp + 128), kb = *(const float4*)(qp + 132);
        const v2f q2[4] = {v2f{qa.x, qa.y}, v2f{qa.z, qa.w}, v2f{qb.x, qb.y}, v2f{qb.z, qb.w}};
        const v2f k2[4] = {v2f{ka.x, ka.y}, v2f{ka.z, ka.w}, v2f{kb.x, kb.y}, v2f{kb.z, kb.w}};
        const float* vp = vl + (buf * 32 + t) * 64 + wc;
        const float* gp = gl + (buf * 32 + t) * 4;
        const bool mine = (kg == tt);
        if (KIND == 0) {
          const float fw = gp[0], iw = gp[1];
          const v2f fw2 = v2f{fw, fw};
          const float2 vv = *(const float2*)vp;
          const float va[2] = {vv.x * iw, vv.y * iw};
          float num[2];
#pragma unroll
          for (int c = 0; c < 2; ++c) {
            const v2f vc2 = v2f{va[c], va[c]};
            v2f a = v2f{0.f, 0.f};
#pragma unroll
            for (int i = 0; i < 4; ++i) {
              S[c][i] = fw2 * S[c][i] + k2[i] * vc2;
              a += q2[i] * S[c][i];
            }
            num[c] = row16_sum(a.x + a.y);
          }
          keep0 = mine ? num[0] : keep0;
          keep1 = mine ? num[1] : keep1;
          if (do_n) {
            const v2f iw2 = v2f{iw, iw};
            v2f a = v2f{0.f, 0.f};
#pragma unroll
            for (int i = 0; i < 4; ++i) {
              nv[i] = fw2 * nv[i] + k2[i] * iw2;
              a += q2[i] * nv[i];
            }
            const float den = row16_sum(a.x + a.y);
            keepd = mine ? den : keepd;
            keepm = mine ? gp[2] : keepm;
          }
        } else if (KIND == 1) {
          const float beta = gp[0], g = gp[1];
          const float v = vp[0];
          v2f a = v2f{0.f, 0.f};
#pragma unroll
          for (int i = 0; i < 4; ++i) a += k2[i] * S[0][i];
          const float kS = row16_sum(a.x + a.y);
          const float vn = beta * (v - g * kS);
          const v2f g2 = v2f{g, g}, vn2 = v2f{vn, vn};
          v2f o2 = v2f{0.f, 0.f};
#pragma unroll
          for (int i = 0; i < 4; ++i) {
            S[0][i] = g2 * S[0][i] + k2[i] * vn2;
            o2 += q2[i] * S[0][i];
          }
          const float o = row16_sum(o2.x + o2.y);
          keep0 = mine ? o : keep0;
        } else {
          const float2 vv = *(const float2*)vp;
          const float va[2] = {vv.x, vv.y};
          float num[2];
#pragma unroll
          for (int c = 0; c < 2; ++c) {
            const v2f vc2 = v2f{va[c], va[c]};
            v2f a = v2f{0.f, 0.f};
#pragma unroll
            for (int i = 0; i < 4; ++i) {
              S[c][i] = S[c][i] + k2[i] * (vc2 - S[c][i]);
              a += q2[i] * S[c][i];
            }
            num[c] = row16_sum(a.x + a.y);
          }
          keep0 = mine ? num[0] : keep0;
          keep1 = mine ? num[1] : keep1;
        }
      }
      if (kg < ns) {
        if (KIND == 1) obase[(size_t)(t0 + kg) * LDY] = f2bf(keep0);
        else *(unsigned*)(obase + (size_t)(t0 + kg) * LDY) = pk2(keep0, keep1);
        if (do_n && cl == 0) { dmbase[(t0 + kg) * 8] = keepd; dmbase[(t0 + kg) * 8 + 4] = keepm; }
      }
    }
    if (j + 1 < nblk) stage(j + 1, buf ^ 1);
    __syncthreads();
  }
#pragma unroll
  for (int c = 0; c < CPL; ++c)
#pragma unroll
    for (int i = 0; i < 4; ++i) {
      Sout[(size_t)(kg * 8 + 2 * i) * 128 + col0 + c] = S[c][i].x;
      Sout[(size_t)(kg * 8 + 2 * i + 1) * 128 + col0 + c] = S[c][i].y;
    }
  if (KIND == 0 && colbase == 0 && w == 0) {
    if (cl == 0) {
      float* no = p.out + (samp ? OFF_S_MN : OFF_P_MN) + ((size_t)(l * NB + b) * 4 + h) * 128 + kg * 8;
#pragma unroll
      for (int i = 0; i < 4; ++i) { no[2 * i] = nv[i].x; no[2 * i + 1] = nv[i].y; }
    }
    if (lane == 0) p.out[(samp ? OFF_S_MM : OFF_P_MM) + (size_t)(l * NB + b) * 4 + h] = mstart;
  }
  __syncthreads();
}

DEVI void scan_sample_unit(const Params& p, int l, int s, float* smem) {
  const int s4 = s & 3;
  if (s4 < 2) {
    const int idx = (s >> 2) * 2 + (s & 1), seq = idx >> 2;
    scan_unit<1>(p, l, true, seq >> 2, seq & 3, (idx & 3) * 32, smem);
  } else {
    const int idx = s >> 2, seq = idx >> 1;
    if (s4 == 2) scan_unit<0>(p, l, true, seq >> 2, seq & 3, (idx & 1) * 64, smem);
    else scan_unit<2>(p, l, true, seq >> 2, seq & 3, (idx & 1) * 64, smem);
  }
}

DEVI void phase_scan(const Params& p, int l, float* smem) {
  for (int u = blockIdx.x; u < 256; u += gridDim.x) {
    if (u < 128) {
      const int seq = u >> 2;
      scan_unit<1>(p, l, false, seq >> 2, seq & 3, (u & 3) * 32, smem);
    } else if (u < 192) {
      const int uu = u - 128, seq = uu >> 1;
      scan_unit<0>(p, l, false, seq >> 2, seq & 3, (uu & 1) * 64, smem);
    } else {
      const int uu = u - 192, seq = uu >> 1;
      scan_unit<2>(p, l, false, seq >> 2, seq & 3, (uu & 1) * 64, smem);
    }
  }
  if (gridDim.x == 256) {
    const int b = blockIdx.x;
    int s0, cnt;
    if (b < 128) { s0 = b * 26; cnt = 26; }
    else if (b < 192) {
      if (((b - 128) & 1) == 0) { s0 = 0; cnt = 0; }
      else { s0 = 3328 + ((b - 128) >> 1) * 8; cnt = 8; }
    } else { s0 = 3328 + (32 + (b - 192)) * 8; cnt = 8; }
    for (int i = 0; i < cnt; ++i) scan_sample_unit(p, l, s0 + i, smem);
  } else {
    for (int s = blockIdx.x; s < 4096; s += gridDim.x) scan_sample_unit(p, l, s, smem);
  }
}

DEVI void phase_post(const Params& p, int l) {
  const int tid_ = otid(); const int lane = tid_ & 63, gw = blockIdx.x * 8 + (tid_ >> 6), nw = gridDim.x * 8;
  const u16* proj = (const u16*)(p.ws + WS_PROJ);
  u16* obuf = (u16*)(p.ws + WS_OBUF);
  const float* dm = (const float*)(p.ws + WS_DM);
  constexpr int NTASK = (M / 4) * 3;
  for (int task = gw; task < NTASK; task += nw) {
    const int tg = task / 3, k = task - tg * 3;
    const int m0 = tg * 4;
    const int c = lane * 8, hh = lane >> 4;
    float wv[8];
    if (k == 0) load8f(p.ml_norm_w + l * 512 + c, wv);
    else if (k == 1) load8f(p.gd_norm_w + l * 128 + (c & 127), wv);
    else load8f(p.hg_norm_w + l * 512 + c, wv);
    const int gcol = (k == 0) ? 1536 : (k == 1 ? 3584 : 5632);
    uint4 ov[4], gv[4];
#pragma unroll
    for (int tt = 0; tt < 4; ++tt) {
      ov[tt] = *(const uint4*)(obuf + (size_t)(m0 + tt) * LDY + k * 512 + c);
      gv[tt] = *(const uint4*)(proj + (size_t)(m0 + tt) * NPROJ + gcol + c);
    }
#pragma unroll
    for (int tt = 0; tt < 4; ++tt) {
      const size_t m = m0 + tt;
      float o[8], g[8];
      unpack8(ov[tt], o);
      unpack8(gv[tt], g);
      if (k == 0) {
        const float den = dm[m * 8 + hh], mt = dm[m * 8 + 4 + hh];
        const float inv = 1.f / fmaxf(fabsf(den), __expf(-mt));
#pragma unroll
        for (int i = 0; i < 8; ++i) o[i] *= inv;
      }
      float ss = 0.f;
#pragma unroll
      for (int i = 0; i < 8; ++i) ss += o[i] * o[i];
      float sc;
      if (k == 2) { ss = wave_sum(ss); sc = rsqrtf(ss * (1.f / 512.f) + 1e-6f); }
      else { ss = row16_sum(ss); sc = rsqrtf(ss * (1.f / 128.f) + 1e-6f); }
#pragma unroll
      for (int i = 0; i < 8; ++i) o[i] = o[i] * sc * wv[i] * ((k == 0) ? sigm(g[i]) : silu(g[i]));
      *(uint4*)(obuf + m * LDY + k * 512 + c) = pack8(o);
    }
  }
}

#define LAS __attribute__((address_space(3)))
#define XB_TMO      128
#define XB_XCNT(j)  (256  + 64 * (j))
#define XB_XSUB(j)  (1280 + 64 * (j))
#define XB_XGEN(j)  (2304 + 64 * (j))
#define XB_TOP      3328
#define XB_TOPGEN   3392
#define XCD_BAR_WORDS 3456
#define XB_SPIN_CAP (1u << 18)

__device__ __forceinline__ unsigned xb_ld(unsigned* p)              { return __hip_atomic_load(p, __ATOMIC_RELAXED, __HIP_MEMORY_SCOPE_AGENT); }
__device__ __forceinline__ unsigned xb_add(unsigned* p, unsigned v) { return __hip_atomic_fetch_add(p, v, __ATOMIC_RELAXED, __HIP_MEMORY_SCOPE_AGENT); }
__device__ __forceinline__ unsigned xb_xcc_id() { return (unsigned)__builtin_amdgcn_s_getreg((3 << 11) | 20) & 0xFu; }
#define XB_SPIN(cond, bar) do { unsigned _sp = 0; while (cond) { __builtin_amdgcn_s_sleep(1); \
    if ((++_sp & 255u) == 0u) { if (xb_ld(&(bar)[XB_TMO])) break; if (_sp > XB_SPIN_CAP) { atomicAdd(&(bar)[XB_TMO], 1u); break; } } } } while (0)

struct XcdBarrier {
    unsigned* bar; unsigned x;
    volatile LAS unsigned* st;
};

__device__ __forceinline__ XcdBarrier xcd_barrier_post(unsigned* bar, volatile LAS unsigned* st) {
    XcdBarrier b; b.bar = bar; b.x = xb_xcc_id(); b.st = st;
    if (threadIdx.x == 0) (void)xb_add(&bar[XB_XCNT(b.x)], 1u);
    return b;
}
__device__ __forceinline__ void xcd_barrier_complete(unsigned* bar, unsigned x, unsigned& nloc, unsigned& nx) {
    const unsigned G = gridDim.x * gridDim.y * gridDim.z;
    unsigned sum, cnt, mine, sp = 0u;
    for (;;) {
        sum = 0u; cnt = 0u; mine = 0u;
#pragma unroll
        for (unsigned j = 0; j < 16; ++j) { const unsigned c = xb_ld(&bar[XB_XCNT(j)]); sum += c; cnt += (c > 0u) ? 1u : 0u; mine = (j == x) ? c : mine; }
        if (sum == G) break;
        __builtin_amdgcn_s_sleep(1);
        if ((++sp & 255u) == 0u) { if (xb_ld(&bar[XB_TMO])) break; if (sp > XB_SPIN_CAP) { atomicAdd(&bar[XB_TMO], 1u); break; } }
    }
    nloc = mine > 0u ? mine : 1u; nx = cnt > 0u ? cnt : 1u;
}

__device__ __forceinline__ void xcd_barrier(const XcdBarrier& b) {
    asm volatile("s_waitcnt vmcnt(0)" ::: "memory");
    __syncthreads();
    if (threadIdx.x == 0) {
        unsigned* bar = b.bar;
        __builtin_amdgcn_s_waitcnt(0);
        unsigned nloc = b.st[0], nx = b.st[1];
        if (nloc == 0u) { xcd_barrier_complete(bar, b.x, nloc, nx); b.st[0] = nloc; b.st[1] = nx; }
        const unsigned old = xb_add(&bar[XB_XSUB(b.x)], 1u);
        const unsigned gen = old / nloc;
        if (old + 1u == (gen + 1u) * nloc) {
            __builtin_amdgcn_fence(__ATOMIC_RELEASE, "agent");
            asm volatile("s_waitcnt vmcnt(0)" ::: "memory");
            const unsigned og = xb_add(&bar[XB_TOP], 1u);
            const unsigned tg = og / nx;
            if (og + 1u == (tg + 1u) * nx) xb_add(&bar[XB_TOPGEN], 1u);
            else XB_SPIN(xb_ld(&bar[XB_TOPGEN]) == tg, bar);
            __builtin_amdgcn_fence(__ATOMIC_ACQUIRE, "agent");
            xb_add(&bar[XB_XGEN(b.x)], 1u);
            asm volatile("s_waitcnt vmcnt(0)" ::: "memory");
        } else {
            XB_SPIN(xb_ld(&bar[XB_XGEN(b.x)]) == gen, bar);
            __builtin_amdgcn_fence(__ATOMIC_ACQUIRE, "agent");
            asm volatile("s_waitcnt vmcnt(0)" ::: "memory");
        }
    }
    __syncthreads();
}


__global__ void __launch_bounds__(NTHREADS) mega_fwd(Params p) {
  extern __shared__ __attribute__((aligned(16))) unsigned char smem_raw[];
  cg::grid_group grid = cg::this_grid();
  float* smf = (float*)smem_raw;
  u16* smh = (u16*)smem_raw;
  u16* xn = (u16*)(p.ws + WS_XN);
  float* x = p.out;

  volatile LAS unsigned* bst = (volatile LAS unsigned*)(smem_raw + LDS_BYTES - 16);
  if (threadIdx.x < 2) bst[threadIdx.x] = 0u;
  __syncthreads();
  XcdBarrier xbar; xbar.bar = (unsigned*)(p.ws + WS_BAR); xbar.x = xb_xcc_id(); xbar.st = bst;
  if (threadIdx.x == 0) bst[2] = xb_add(&xbar.bar[XB_XCNT(xbar.x)], 1u);
  phase_wprep(p, smf);
  phase_norm(p.x_prompt, p.x_sample, p.norm1_w, xn);
  grid.sync();
  if (threadIdx.x == 0) {
    const unsigned per = gridDim.x >> 3;
    bool ok = (gridDim.x & 7u) == 0u && xbar.x < 8u;
    for (unsigned j = 0; j < 8; ++j) ok = ok && (xb_ld(&xbar.bar[XB_XCNT(j)]) == per);
    const unsigned rank = bst[2];
    bst[3] = (ok && rank < per) ? xbar.x * per + rank : (blockIdx.x & 7u) * per + (blockIdx.x >> 3);
  }
  __syncthreads();
  const int vcu = __builtin_amdgcn_readfirstlane((int)bst[3]);
#pragma unroll 1
  for (int l = 0; l < 2; ++l) {
    phase_proj(p, l, vcu, smh);
    xcd_barrier(xbar);
    phase_prep(p, l);
    xcd_barrier(xbar);
    phase_scan(p, l, smf);
    xcd_barrier(xbar);
    phase_post(p, l);
    xcd_barrier(xbar);
    phase_merge(p, l, vcu, smh);
    xcd_barrier(xbar);
    if (l == 0)
      phase_resid((const u16*)(p.ws + WS_CONV), LDX, 1024, (const u16*)(p.ws + WS_WT_OUT), LDW1, p.x_prompt, p.x_sample, x, vcu, smh);
    else
      phase_resid((const u16*)(p.ws + WS_CONV), LDX, 1024, (const u16*)(p.ws + WS_WT_OUT) + (size_t)1024 * LDW1, LDW1, x, x + (size_t)MP * D, x, vcu, smh);
    xcd_barrier(xbar);
    phase_norm(x, x + (size_t)MP * D, p.norm2_w + l * D, xn);
    xcd_barrier(xbar);
    phase_up(p, l, vcu, smh);
    xcd_barrier(xbar);
    phase_resid((const u16*)(p.ws + WS_PROJ), LDH, 4096, (const u16*)(p.ws + WS_WT_DN) + (size_t)l * 1024 * LDWD, LDWD, x, x + (size_t)MP * D, x, vcu, smh);
    xcd_barrier(xbar);
    if (l == 0) {
      phase_norm(x, x + (size_t)MP * D, p.norm1_w + D, xn);
      xcd_barrier(xbar);
    }
  }
  phase_final_norm(x, p.final_norm_w);
}

extern "C" void kernel_launch(void* const* d_in, const int* in_sizes, int n_in, void* d_out, int out_size, void* d_ws,
                              size_t ws_size, hipStream_t stream) {
  static int grid_blocks = 0;
  if (!grid_blocks) {
    int dev = 0, cus = 0, per_cu = 0;
    hipGetDevice(&dev);
    hipDeviceGetAttribute(&cus, hipDeviceAttributeMultiprocessorCount, dev);
    hipFuncSetAttribute((const void*)mega_fwd, hipFuncAttributeMaxDynamicSharedMemorySize, LDS_BYTES);
    hipOccupancyMaxActiveBlocksPerMultiprocessor(&per_cu, (const void*)mega_fwd, NTHREADS, LDS_BYTES);
    if (per_cu < 1) { fprintf(stderr, "occupancy query returned %d\n", per_cu); per_cu = 1; }
    grid_blocks = cus;
    if (ws_size < WS_END) fprintf(stderr, "workspace too small: %zu < %zu\n", ws_size, (size_t)WS_END);
  }
  Params p{};
  p.x_prompt = (const float*)d_in[0]; p.x_sample = (const float*)d_in[1];
  p.st_mC = (const float*)d_in[2]; p.st_mn = (const float*)d_in[3]; p.st_mm = (const float*)d_in[4];
  p.st_gS = (const float*)d_in[5]; p.st_gconv = (const float*)d_in[6]; p.st_hS = (const float*)d_in[7];
  p.norm1_w = (const float*)d_in[8]; p.w_in = (const float*)d_in[9]; p.ml_i_bias = (const float*)d_in[10];
  p.ml_f_bias = (const float*)d_in[11]; p.ml_norm_w = (const float*)d_in[12]; p.gd_conv_w = (const float*)d_in[13];
  p.gd_A_log = (const float*)d_in[14]; p.gd_dt_bias = (const float*)d_in[15]; p.gd_norm_w = (const float*)d_in[16];
  p.hg_lb_logits = (const float*)d_in[17]; p.hg_norm_w = (const float*)d_in[18]; p.w_branch = (const float*)d_in[19];
  p.w_out = (const float*)d_in[20]; p.norm2_w = (const float*)d_in[21]; p.w_up = (const float*)d_in[22];
  p.w_down = (const float*)d_in[23]; p.final_norm_w = (const float*)d_in[24];
  p.out = (float*)d_out;
  p.ws = (unsigned char*)d_ws;
  hipMemsetAsync((char*)d_ws + WS_BAR, 0, WS_BAR_BYTES, stream);
  void* args[] = {&p};
  hipError_t e = hipLaunchCooperativeKernel((const void*)mega_fwd, dim3(grid_blocks), dim3(NTHREADS), args, LDS_BYTES, stream);
  if (e != hipSuccess) fprintf(stderr, "cooperative launch failed: %s (grid %d)\n", hipGetErrorString(e), grid_blocks);
}
```

```cpp
#include <hip/hip_runtime.h>
#include <hip/hip_cooperative_groups.h>
#include <cstdio>
namespace cg = cooperative_groups;

typedef unsigned short u16;
using bf16x8 = __attribute__((ext_vector_type(8))) short;
using f32x4 = __attribute__((ext_vector_type(4))) float;
typedef float v2f __attribute__((ext_vector_type(2)));

#define DEVI __device__ __forceinline__

constexpr int D = 1024;
constexpr int MP = 16384, MS = 512, M = MP + MS;
constexpr int NPROJ = 6144, NPROJ_PAD = 6272;
constexpr int INC = 9232;
constexpr int DFF = 4096;
constexpr int NTHREADS = 512;
constexpr int LDS_BYTES = 132 * 1024;
constexpr int LDX = 1088, LDH = 4160, LDY = 1600, LDW1 = 1088, LDWB = 576, LDWD = 4160;

constexpr size_t OFF_Y = 0;
constexpr size_t OFF_P_MC = (size_t)M * D;
constexpr size_t OFF_P_MN = OFF_P_MC + 2ull * 8 * 4 * 128 * 128;
constexpr size_t OFF_P_MM = OFF_P_MN + 2ull * 8 * 4 * 128;
constexpr size_t OFF_P_GS = OFF_P_MM + 2ull * 8 * 4;
constexpr size_t OFF_P_GC = OFF_P_GS + 2ull * 8 * 4 * 128 * 128;
constexpr size_t OFF_P_HS = OFF_P_GC + 2ull * 8 * 3 * 1536;
constexpr size_t OFF_S_MC = OFF_P_HS + 2ull * 8 * 4 * 128 * 128;
constexpr size_t OFF_S_MN = OFF_S_MC + 2ull * 128 * 4 * 128 * 128;
constexpr size_t OFF_S_MM = OFF_S_MN + 2ull * 128 * 4 * 128;
constexpr size_t OFF_S_GS = OFF_S_MM + 2ull * 128 * 4;
constexpr size_t OFF_S_GC = OFF_S_GS + 2ull * 128 * 4 * 128 * 128;
constexpr size_t OFF_S_HS = OFF_S_GC + 2ull * 128 * 3 * 1536;
static_assert(OFF_S_HS + 2ull * 128 * 4 * 128 * 128 == 72172608ull, "output size");

constexpr size_t WS_WT_IN = 0;
constexpr size_t WS_WT_GATE = WS_WT_IN + 2ull * NPROJ_PAD * LDW1 * 2;
constexpr size_t WS_WT_BR = WS_WT_GATE + 2ull * 3072 * LDW1 * 2;
constexpr size_t WS_WT_OUT = WS_WT_BR + 2ull * 3 * 1024 * LDWB * 2;
constexpr size_t WS_WT_UP = WS_WT_OUT + 2ull * 1024 * LDW1 * 2;
constexpr size_t WS_WT_DN = WS_WT_UP + 2ull * 4096 * LDW1 * 2;
constexpr size_t WS_PROJ = WS_WT_DN + 2ull * 1024 * LDWD * 2;
constexpr size_t WS_CONV = WS_PROJ + (size_t)M * NPROJ * 2;
constexpr size_t WS_OBUF = WS_CONV + (size_t)M * 1536 * 2;
constexpr size_t WS_XN = WS_OBUF + (size_t)M * LDY * 2;
constexpr size_t WS_SMALL = WS_XN + (size_t)M * LDX * 2;
constexpr size_t WS_GATES = WS_SMALL;
constexpr size_t WS_DM = WS_GATES + (size_t)M * 16 * 4;
constexpr size_t WS_BAR = WS_DM + (size_t)M * 8 * 4;
constexpr size_t WS_BAR_BYTES = 16384;
constexpr size_t WS_END = WS_BAR + WS_BAR_BYTES;
static_assert(WS_END <= 439571584ull, "workspace budget");
static_assert((size_t)M * LDH * 2 <= (size_t)M * NPROJ * 2 && (size_t)M * LDX * 2 <= (size_t)M * 1536 * 2, "aliases fit");

struct Params {
  const float *x_prompt, *x_sample, *st_mC, *st_mn, *st_mm, *st_gS, *st_gconv, *st_hS;
  const float *norm1_w, *w_in, *ml_i_bias, *ml_f_bias, *ml_norm_w, *gd_conv_w, *gd_A_log, *gd_dt_bias,
      *gd_norm_w, *hg_lb_logits, *hg_norm_w, *w_branch, *w_out, *norm2_w, *w_up, *w_down, *final_norm_w;
  float* out;
  unsigned char* ws;
};

DEVI u16 f2bf(float f) { unsigned u = __float_as_uint(f); return (u16)((u + 0x7fffu + ((u >> 16) & 1u)) >> 16); }
DEVI unsigned pk2(float lo, float hi) { return (unsigned)f2bf(lo) | ((unsigned)f2bf(hi) << 16); }
DEVI float bflo(unsigned u) { return __uint_as_float(u << 16); }
DEVI float bfhi(unsigned u) { return __uint_as_float(u & 0xffff0000u); }
DEVI float sigm(float x) { return __builtin_amdgcn_rcpf(1.f + __expf(-x)); }
DEVI float silu(float x) { return x * sigm(x); }
DEVI float softplus(float x) { return fmaxf(x, 0.f) + __logf(1.f + __expf(-fabsf(x))); }
DEVI int otid() { int t = threadIdx.x; asm volatile("" : "+v"(t)); return t; }
DEVI float wave_sum(float v) {
#pragma unroll
  for (int o = 32; o > 0; o >>= 1) v += __shfl_xor(v, o);
  return v;
}
template <int CTRL> DEVI float dpp_f(float v) {
  return __int_as_float(__builtin_amdgcn_update_dpp(0, __float_as_int(v), CTRL, 0xf, 0xf, false));
}
DEVI float row16_sum(float v) {
  float r;
  asm("s_nop 1\n\tv_add_f32_dpp %0, %1, %1 row_ror:8 row_mask:0xf bank_mask:0xf" : "=v"(r) : "v"(v));
  asm("s_nop 1\n\tv_add_f32_dpp %0, %1, %1 row_ror:4 row_mask:0xf bank_mask:0xf" : "=v"(v) : "v"(r));
  asm("s_nop 1\n\tv_add_f32_dpp %0, %1, %1 row_ror:2 row_mask:0xf bank_mask:0xf" : "=v"(r) : "v"(v));
  asm("s_nop 1\n\tv_add_f32_dpp %0, %1, %1 row_ror:1 row_mask:0xf bank_mask:0xf" : "=v"(v) : "v"(r));
  return v;
}

DEVI void tr_seg(const float* __restrict__ src, int ld, int K, int ncols, u16* __restrict__ dst, int dld, float* tile, int& off) {
  const int tid_ = otid();
  const int lane = tid_ & 63, gw = blockIdx.x * 8 + (tid_ >> 6), nw = gridDim.x * 8;
  const int nkb = K >> 4, nnb = ncols >> 6, nt = nkb * nnb;
  const int start = (int)(((long)gw + (long)nw * 4096 - off) % nw);
  for (int t = start; t < nt; t += nw) {
    const int kb = t % nkb, nb = t / nkb;
    const float* sp = src + (size_t)(kb * 16) * ld + nb * 64 + lane;
    float v[16];
#pragma unroll
    for (int i = 0; i < 16; ++i) v[i] = sp[(size_t)i * ld];
    uint4 o0, o1;
    o0.x = pk2(v[0], v[1]); o0.y = pk2(v[2], v[3]); o0.z = pk2(v[4], v[5]); o0.w = pk2(v[6], v[7]);
    o1.x = pk2(v[8], v[9]); o1.y = pk2(v[10], v[11]); o1.z = pk2(v[12], v[13]); o1.w = pk2(v[14], v[15]);
    u16* dp = dst + (size_t)(nb * 64 + lane) * dld + kb * 16;
    *(uint4*)dp = o0;
    *(uint4*)(dp + 8) = o1;
  }
  off += nt;
}

DEVI void phase_wprep(const Params& p, float* tile) {
  int off = 0;
  u16* wt_in = (u16*)(p.ws + WS_WT_IN);
  u16* wt_gate = (u16*)(p.ws + WS_WT_GATE);
  u16* wt_br = (u16*)(p.ws + WS_WT_BR);
  u16* wt_out = (u16*)(p.ws + WS_WT_OUT);
  u16* wt_up = (u16*)(p.ws + WS_WT_UP);
  u16* wt_dn = (u16*)(p.ws + WS_WT_DN);
  for (int l = 0; l < 2; ++l) {
    const float* win = p.w_in + (size_t)l * 1024 * INC;
    for (int s = 0; s < 12; ++s) {
      const int srccol = (s < 4) ? s * 512 : (s < 8 ? 2056 + (s - 4) * 512 : 4112 + (s - 8) * 512);
      tr_seg(win + srccol, INC, 1024, 512, wt_in + ((size_t)l * NPROJ_PAD + s * 512) * LDW1, LDW1, tile, off);
    }
    tr_seg(win + 6160, INC, 1024, 3072, wt_gate + (size_t)l * 3072 * LDW1, LDW1, tile, off);
    for (int b = 0; b < 3; ++b)
      tr_seg(p.w_branch + (size_t)(l * 3 + b) * 512 * 1024, 1024, 512, 1024, wt_br + (size_t)(l * 3 + b) * 1024 * LDWB, LDWB, tile, off);
    tr_seg(p.w_out + (size_t)l * 1024 * 1024, 1024, 1024, 1024, wt_out + (size_t)l * 1024 * LDW1, LDW1, tile, off);
    tr_seg(p.w_up + (size_t)l * 1024 * 4096, 4096, 1024, 4096, wt_up + (size_t)l * 4096 * LDW1, LDW1, tile, off);
    tr_seg(p.w_down + (size_t)l * 4096 * 1024, 1024, 4096, 1024, wt_dn + (size_t)l * 1024 * LDWD, LDWD, tile, off);
  }
  for (int idx = blockIdx.x * NTHREADS + otid(); idx < 2 * 128 * 1024; idx += gridDim.x * NTHREADS) {
    const int l = idx >> 17, rem = idx & 131071, r = rem >> 10, k = rem & 1023;
    float v = 0.f;
    if (r < 16) {
      const int sc = (r < 8) ? 2048 + r : 4104 + (r - 8);
      v = p.w_in[(size_t)l * 1024 * INC + (size_t)k * INC + sc];
    }
    wt_in[((size_t)l * NPROJ_PAD + 6144 + r) * LDW1 + k] = f2bf(v);
  }
}

DEVI void phase_norm(const float* xp, const float* xs, const float* __restrict__ w, u16* __restrict__ xn) {
  const int tid_ = otid(); const int lane = tid_ & 63, gw = blockIdx.x * 8 + (tid_ >> 6), nw = gridDim.x * 8;
  for (int m = gw; m < M; m += nw) {
    const float* xr = (m < MP) ? xp + (size_t)m * D : xs + (size_t)(m - MP) * D;
    float4 v[4];
    float ss = 0.f;
#pragma unroll
    for (int i = 0; i < 4; ++i) {
      v[i] = ((const float4*)xr)[lane + 64 * i];
      ss += v[i].x * v[i].x + v[i].y * v[i].y + v[i].z * v[i].z + v[i].w * v[i].w;
    }
    ss = wave_sum(ss);
    const float rstd = rsqrtf(ss * (1.f / 1024.f) + 1e-6f);
#pragma unroll
    for (int i = 0; i < 4; ++i) {
      const float4 wv = ((const float4*)w)[lane + 64 * i];
      uint2 o;
      o.x = pk2(v[i].x * rstd * wv.x, v[i].y * rstd * wv.y);
      o.y = pk2(v[i].z * rstd * wv.z, v[i].w * rstd * wv.w);
      ((uint2*)(xn + (size_t)m * LDX))[lane + 64 * i] = o;
    }
  }
}

DEVI void phase_final_norm(float* x, const float* __restrict__ w) {
  const int tid_ = otid(); const int lane = tid_ & 63, gw = blockIdx.x * 8 + (tid_ >> 6), nw = gridDim.x * 8;
  for (int m = gw; m < M; m += nw) {
    float* xr = x + (size_t)m * D;
    float4 v[4];
    float ss = 0.f;
#pragma unroll
    for (int i = 0; i < 4; ++i) {
      v[i] = ((const float4*)xr)[lane + 64 * i];
      ss += v[i].x * v[i].x + v[i].y * v[i].y + v[i].z * v[i].z + v[i].w * v[i].w;
    }
    ss = wave_sum(ss);
    const float rstd = rsqrtf(ss * (1.f / 1024.f) + 1e-6f);
#pragma unroll
    for (int i = 0; i < 4; ++i) {
      const float4 wv = ((const float4*)w)[lane + 64 * i];
      float4 o;
      o.x = v[i].x * rstd * wv.x; o.y = v[i].y * rstd * wv.y; o.z = v[i].z * rstd * wv.z; o.w = v[i].w * rstd * wv.w;
      ((float4*)xr)[lane + 64 * i] = o;
    }
  }
}

constexpr int LDS_S = 64;

struct GemmOp { const u16* A; const u16* B; int lda, ldb, K, koff; };

DEVI bool tile_map(int it, int vcu, int MT, int NT, int& mt, int& nt) {
  const int G = gridDim.x;
  const int t = it * G + vcu;
  if (t >= MT * NT) return false;
  constexpr int GM = 4;
  const int gsize = GM * NT;
  const int g = t / gsize, tl = t - g * gsize;
  int gsz = MT - g * GM;
  if (gsz > GM) gsz = GM;
  mt = g * GM + (tl % gsz);
  nt = tl / gsz;
  return true;
}
DEVI int koff_of(int mt, int nt) { return (nt & 7) + 2 * (mt & 3); }

template <int WMT, int WNT>
DEVI void zero_acc(f32x4 (&acc)[WMT][WNT]) {
#pragma unroll
  for (int i = 0; i < WMT; ++i)
#pragma unroll
    for (int j = 0; j < WNT; ++j) acc[i][j] = f32x4{0.f, 0.f, 0.f, 0.f};
}

#define PF_PARAMS uint4 &pa0, uint4 &pa1, uint4 &pa2, uint4 &pa3, uint4 &pb0, uint4 &pb1, uint4 &qa0, uint4 &qa1, uint4 &qa2, uint4 &qa3, uint4 &qb0, uint4 &qb1
#define PF_ARGS pa0, pa1, pa2, pa3, pb0, pb1, qa0, qa1, qa2, qa3, qb0, qb1
#define PF_DECL uint4 pa0 = uint4{0, 0, 0, 0}, pa1 = pa0, pa2 = pa0, pa3 = pa0, pb0 = pa0, pb1 = pa0, qa0 = pa0, qa1 = pa0, qa2 = pa0, qa3 = pa0, qb0 = pa0, qb1 = pa0
template <int WMT, int WNT>
DEVI void gemm_core(const GemmOp cur, const GemmOp nxt, bool primed, PF_PARAMS, f32x4 (&acc)[WMT][WNT], u16* smem) {
  constexpr int BM = 64 * WMT, BN = 32 * WNT;
  constexpr int ACH = BM * 8 / NTHREADS, BCH = BN * 8 / NTHREADS;
  static_assert(BCH == 2 && (ACH == 2 || ACH == 4), "chunk counts");
  u16* sA = smem;
  u16* sB = smem + 2 * BM * LDS_S;
  const int tid = otid(), lane = tid & 63, w = tid >> 6, wm = w >> 1, wn = w & 1;
  const int fr = lane & 15, fq = lane >> 4;
  const int crow = tid >> 3, ckc = tid & 7;
  const int wsw = (ckc ^ (crow & 7)) * 8;
  const int rsw0 = (fq ^ (fr & 7)) * 8;
  const u16* Ag = cur.A + (size_t)crow * cur.lda + ckc * 8;
  const u16* Bg = cur.B + (size_t)crow * cur.ldb + ckc * 8;
  const int nk = cur.K >> 6, km = nk - 1, kmn = (nxt.K >> 6) - 1;
#define GLOADX(S, AP, BP, LA, LB, KO)                                                 \
  do {                                                                                \
    S##a0 = *(const uint4*)((AP) + (KO));                                           \
    S##a1 = *(const uint4*)((AP) + (size_t)64 * (LA) + (KO));                       \
    if (ACH == 4) {                                                                   \
      S##a2 = *(const uint4*)((AP) + (size_t)128 * (LA) + (KO));                    \
      S##a3 = *(const uint4*)((AP) + (size_t)192 * (LA) + (KO));                    \
    }                                                                                 \
    S##b0 = *(const uint4*)((BP) + (KO));                                           \
    S##b1 = *(const uint4*)((BP) + (size_t)64 * (LB) + (KO));                       \
  } while (0)
#define GLOADC(S, T) GLOADX(S, Ag, Bg, cur.lda, cur.ldb, ((((T) + cur.koff) & km) * 64))
#define GLOADN(S, T) GLOADX(S, An, Bn, nxt.lda, nxt.ldb, ((((T) + nxt.koff) & kmn) * 64))
#define SSTORE(S, NB)                                                                 \
  do {                                                                                \
    u16* dA = sA + ((NB) * BM + crow) * LDS_S + wsw;                                  \
    u16* dB = sB + ((NB) * BN + crow) * LDS_S + wsw;                                  \
    *(uint4*)(dA) = S##a0;                                                          \
    *(uint4*)(dA + 64 * LDS_S) = S##a1;                                             \
    if (ACH == 4) {                                                                   \
      *(uint4*)(dA + 128 * LDS_S) = S##a2;                                          \
      *(uint4*)(dA + 192 * LDS_S) = S##a3;                                          \
    }                                                                                 \
    *(uint4*)(dB) = S##b0;                                                          \
    *(uint4*)(dB + 64 * LDS_S) = S##b1;                                             \
  } while (0)
#define LOADFR(BUF)                                                                   \
  do {                                                                                \
    const u16* cA = sA + ((BUF) * BM + wm * 16 * WMT + fr) * LDS_S;                   \
    const u16* cB = sB + ((BUF) * BN + wn * 16 * WNT + fr) * LDS_S;                   \
    _Pragma("unroll") for (int ks = 0; ks < 2; ++ks) {                                \
      const int so = rsw0 ^ (ks * 32);                                                \
      _Pragma("unroll") for (int i = 0; i < WMT; ++i) af[ks][i] = *(const bf16x8*)(cA + i * 16 * LDS_S + so);  \
      _Pragma("unroll") for (int j = 0; j < WNT; ++j) bfr[ks][j] = *(const bf16x8*)(cB + j * 16 * LDS_S + so); \
    }                                                                                 \
  } while (0)
#define MFMAS()                                                                       \
  do {                                                                                \
    _Pragma("unroll") for (int ks = 0; ks < 2; ++ks)                                  \
      _Pragma("unroll") for (int i = 0; i < WMT; ++i)                                 \
        _Pragma("unroll") for (int j = 0; j < WNT; ++j)                               \
          acc[i][j] = __builtin_amdgcn_mfma_f32_16x16x32_bf16(bfr[ks][j], af[ks][i], acc[i][j], 0, 0, 0);  \
  } while (0)
#define HALF(BUF, SS, LOADSTMT)                                                       \
  do {                                                                                \
    LOADFR(BUF);                                                                      \
    __builtin_amdgcn_sched_barrier(0);                                                \
    SSTORE(SS, (BUF) ^ 1);                                                            \
    LOADSTMT;                                                                         \
    __builtin_amdgcn_sched_barrier(0);                                                \
    MFMAS();                                                                          \
    __builtin_amdgcn_sched_barrier(0);                                                \
    __syncthreads();                                                                  \
  } while (0)
  bf16x8 af[2][WMT], bfr[2][WNT];
  if (!primed) {
    GLOADC(p, 0);
    SSTORE(p, 0);
    __builtin_amdgcn_sched_barrier(0);
    GLOADC(q, 1);
    __builtin_amdgcn_sched_barrier(0);
    GLOADC(p, 2);
    __builtin_amdgcn_sched_barrier(0);
    __syncthreads();
  }
#pragma unroll 1
  for (int kt = 0; kt + 4 < nk; kt += 2) {
    HALF(0, q, GLOADC(q, kt + 3));
    HALF(1, p, GLOADC(p, kt + 4));
  }
  HALF(0, q, GLOADC(q, nk - 1));
  const u16* An = nxt.A + (size_t)crow * nxt.lda + ckc * 8;
  const u16* Bn = nxt.B + (size_t)crow * nxt.ldb + ckc * 8;
  HALF(1, p, GLOADN(p, 0));
  HALF(0, q, GLOADN(q, 1));
  HALF(1, p, GLOADN(p, 2));
#undef GLOADX
#undef GLOADC
#undef GLOADN
#undef SSTORE
#undef LOADFR
#undef MFMAS
#undef HALF
}

#define PFB_PARAMS uint4 &pa0, uint4 &pa1, uint4 &pa2, uint4 &pa3, uint4 &pb0, uint4 &pb1, uint4 &pb2, uint4 &pb3
#define PFB_ARGS pa0, pa1, pa2, pa3, pb0, pb1, pb2, pb3
#define PFB_DECL uint4 pa0 = uint4{0, 0, 0, 0}, pa1 = pa0, pa2 = pa0, pa3 = pa0, pb0 = pa0, pb1 = pa0, pb2 = pa0, pb3 = pa0
DEVI void gemm_core_big(const GemmOp cur, const GemmOp nxt, bool primed, PFB_PARAMS, f32x4 (&acc)[4][8], u16* smem) {
  u16* sA = smem;
  u16* sB = smem + 2 * 256 * LDS_S;
  const int tid = otid(), lane = tid & 63, w = tid >> 6, wm = w >> 1, wn = w & 1;
  const int fr = lane & 15, fq = lane >> 4;
  const int crow = tid >> 3, ckc = tid & 7;
  const int wsw = (ckc ^ (crow & 7)) * 8;
  const int rsw0 = (fq ^ (fr & 7)) * 8;
  const u16* Ag = cur.A + (size_t)crow * cur.lda + ckc * 8;
  const u16* Bg = cur.B + (size_t)crow * cur.ldb + ckc * 8;
  const int nk = cur.K >> 6, km = nk - 1, kmn = (nxt.K >> 6) - 1;
#define BGLOADX(AP, BP, LA, LB, KO)                                                   \
  do {                                                                                \
    pa0 = *(const uint4*)((AP) + (KO));                                             \
    pa1 = *(const uint4*)((AP) + (size_t)64 * (LA) + (KO));                         \
    pa2 = *(const uint4*)((AP) + (size_t)128 * (LA) + (KO));                        \
    pa3 = *(const uint4*)((AP) + (size_t)192 * (LA) + (KO));                        \
    pb0 = *(const uint4*)((BP) + (KO));                                             \
    pb1 = *(const uint4*)((BP) + (size_t)64 * (LB) + (KO));                         \
    pb2 = *(const uint4*)((BP) + (size_t)128 * (LB) + (KO));                        \
    pb3 = *(const uint4*)((BP) + (size_t)192 * (LB) + (KO));                        \
  } while (0)
#define BGLOADC(T) BGLOADX(Ag, Bg, cur.lda, cur.ldb, ((((T) + cur.koff) & km) * 64))
#define BGLOADN(T) BGLOADX(An, Bn, nxt.lda, nxt.ldb, ((((T) + nxt.koff) & kmn) * 64))
#define BSSTORE(NB)                                                                   \
  do {                                                                                \
    u16* dA = sA + ((NB) * 256 + crow) * LDS_S + wsw;                                 \
    u16* dB = sB + ((NB) * 256 + crow) * LDS_S + wsw;                                 \
    *(uint4*)(dA) = pa0;                                                            \
    *(uint4*)(dA + 64 * LDS_S) = pa1;                                               \
    *(uint4*)(dA + 128 * LDS_S) = pa2;                                              \
    *(uint4*)(dA + 192 * LDS_S) = pa3;                                              \
    *(uint4*)(dB) = pb0;                                                            \
    *(uint4*)(dB + 64 * LDS_S) = pb1;                                               \
    *(uint4*)(dB + 128 * LDS_S) = pb2;                                              \
    *(uint4*)(dB + 192 * LDS_S) = pb3;                                              \
  } while (0)
#define BLOADFR(BUF, KS)                                                              \
  do {                                                                                \
    const u16* cA = sA + ((BUF) * 256 + wm * 64 + fr) * LDS_S + (rsw0 ^ ((KS) * 32)); \
    const u16* cB = sB + ((BUF) * 256 + wn * 128 + fr) * LDS_S + (rsw0 ^ ((KS) * 32)); \
    _Pragma("unroll") for (int i = 0; i < 4; ++i) af[i] = *(const bf16x8*)(cA + i * 16 * LDS_S);  \
    _Pragma("unroll") for (int j = 0; j < 4; ++j) bfr[j] = *(const bf16x8*)(cB + j * 16 * LDS_S); \
  } while (0)
#define BLOADB2(BUF, KS)                                                              \
  do {                                                                                \
    const u16* cB = sB + ((BUF) * 256 + wn * 128 + 64 + fr) * LDS_S + (rsw0 ^ ((KS) * 32)); \
    _Pragma("unroll") for (int j = 0; j < 4; ++j) bfr[j] = *(const bf16x8*)(cB + j * 16 * LDS_S); \
  } while (0)
#define BMFMAS(JO)                                                                    \
  do {                                                                                \
    _Pragma("unroll") for (int i = 0; i < 4; ++i)                                     \
      _Pragma("unroll") for (int j = 0; j < 4; ++j)                                   \
        acc[i][(JO) + j] = __builtin_amdgcn_mfma_f32_16x16x32_bf16(bfr[j], af[i], acc[i][(JO) + j], 0, 0, 0);  \
  } while (0)
#define BHALF(BUF, LOADSTMT)                                                          \
  do {                                                                                \
    BLOADFR(BUF, 0);                                                                  \
    __builtin_amdgcn_sched_barrier(0);                                                \
    BSSTORE((BUF) ^ 1);                                                               \
    LOADSTMT;                                                                         \
    __builtin_amdgcn_sched_barrier(0);                                                \
    BMFMAS(0);                                                                        \
    __builtin_amdgcn_sched_barrier(0);                                                \
    BLOADB2(BUF, 0);                                                                  \
    __builtin_amdgcn_sched_barrier(0);                                                \
    BMFMAS(4);                                                                        \
    __builtin_amdgcn_sched_barrier(0);                                                \
    BLOADFR(BUF, 1);                                                                  \
    __builtin_amdgcn_sched_barrier(0);                                                \
    BMFMAS(0);                                                                        \
    __builtin_amdgcn_sched_barrier(0);                                                \
    BLOADB2(BUF, 1);                                                                  \
    __builtin_amdgcn_sched_barrier(0);                                                \
    BMFMAS(4);                                                                        \
    __builtin_amdgcn_sched_barrier(0);                                                \
    __syncthreads();                                                                  \
  } while (0)
  bf16x8 af[4], bfr[4];
  if (!primed) {
    BGLOADC(0);
    BSSTORE(0);
    __builtin_amdgcn_sched_barrier(0);
    BGLOADC(1);
    __builtin_amdgcn_sched_barrier(0);
    __syncthreads();
  }
#pragma unroll 1
  for (int kt = 0; kt + 2 < nk; kt += 2) {
    BHALF(0, BGLOADC(kt + 2));
    BHALF(1, BGLOADC(kt + 3));
  }
  const u16* An = nxt.A + (size_t)crow * nxt.lda + ckc * 8;
  const u16* Bn = nxt.B + (size_t)crow * nxt.ldb + ckc * 8;
  BHALF(0, BGLOADN(0));
  BHALF(1, BGLOADN(1));
#undef BGLOADX
#undef BGLOADC
#undef BGLOADN
#undef BSSTORE
#undef BLOADFR
#undef BLOADB2
#undef BMFMAS
#undef BHALF
}

DEVI void phase_proj(const Params& p, int l, int vcu, u16* smem) {
  const u16* xn = (const u16*)(p.ws + WS_XN);
  const u16* wt = (const u16*)(p.ws + WS_WT_IN) + (size_t)l * NPROJ_PAD * LDW1;
  u16* proj = (u16*)(p.ws + WS_PROJ);
  float* small = (float*)(p.ws + WS_SMALL);
  constexpr int NT = 25, MT = M / 256;
  PFB_DECL;
  int mt, nt;
  bool have = tile_map(0, vcu, MT, NT, mt, nt);
  for (int it = 0; have; ++it) {
    const int m0 = mt * 256, n0 = nt * 256;
    const GemmOp cur{xn + (size_t)m0 * LDX, wt + (size_t)n0 * LDW1, LDX, LDW1, 1024, koff_of(mt, nt)};
    int mtn, ntn;
    const bool haven = tile_map(it + 1, vcu, MT, NT, mtn, ntn);
    GemmOp nxt = cur;
    if (haven) { nxt.A = xn + (size_t)(mtn * 256) * LDX; nxt.B = wt + (size_t)(ntn * 256) * LDW1; nxt.koff = koff_of(mtn, ntn); }
    f32x4 acc[4][8];
    zero_acc(acc);
    gemm_core_big(cur, nxt, it > 0, PFB_ARGS, acc, smem);
    const int tid_ = otid(); const int lane = tid_ & 63, w = tid_ >> 6, wm = w >> 1, wn = w & 1, fr = lane & 15, fq = lane >> 4;
#pragma unroll
    for (int i = 0; i < 4; ++i)
#pragma unroll
      for (int j = 0; j < 8; ++j) {
        const int m = m0 + wm * 64 + i * 16 + fr, n = n0 + wn * 128 + j * 16 + fq * 4;
        if (n < NPROJ) {
          uint2 o;
          o.x = pk2(acc[i][j][0], acc[i][j][1]);
          o.y = pk2(acc[i][j][2], acc[i][j][3]);
          *(uint2*)(proj + (size_t)m * NPROJ + n) = o;
        } else if (n < NPROJ + 16) {
          *(float4*)(small + (size_t)m * 16 + (n - NPROJ)) = float4{acc[i][j][0], acc[i][j][1], acc[i][j][2], acc[i][j][3]};
        }
      }
    have = haven; mt = mtn; nt = ntn;
  }
}

DEVI void phase_up(const Params& p, int l, int vcu, u16* smem) {
  const u16* xn = (const u16*)(p.ws + WS_XN);
  const u16* wt = (const u16*)(p.ws + WS_WT_UP) + (size_t)l * 4096 * LDW1;
  u16* hid = (u16*)(p.ws + WS_PROJ);
  constexpr int NT = DFF / 256, MT = M / 256;
  PFB_DECL;
  int mt, nt;
  bool have = tile_map(0, vcu, MT, NT, mt, nt);
  for (int it = 0; have; ++it) {
    const int m0 = mt * 256, n0 = nt * 256;
    const GemmOp cur{xn + (size_t)m0 * LDX, wt + (size_t)n0 * LDW1, LDX, LDW1, 1024, koff_of(mt, nt)};
    int mtn, ntn;
    const bool haven = tile_map(it + 1, vcu, MT, NT, mtn, ntn);
    GemmOp nxt = cur;
    if (haven) { nxt.A = xn + (size_t)(mtn * 256) * LDX; nxt.B = wt + (size_t)(ntn * 256) * LDW1; nxt.koff = koff_of(mtn, ntn); }
    f32x4 acc[4][8];
    zero_acc(acc);
    gemm_core_big(cur, nxt, it > 0, PFB_ARGS, acc, smem);
    const int tid_ = otid(); const int lane = tid_ & 63, w = tid_ >> 6, wm = w >> 1, wn = w & 1, fr = lane & 15, fq = lane >> 4;
#pragma unroll
    for (int i = 0; i < 4; ++i)
#pragma unroll
      for (int j = 0; j < 8; ++j) {
        const int m = m0 + wm * 64 + i * 16 + fr, n = n0 + wn * 128 + j * 16 + fq * 4;
        float r0 = fmaxf(acc[i][j][0], 0.f), r1 = fmaxf(acc[i][j][1], 0.f), r2 = fmaxf(acc[i][j][2], 0.f), r3 = fmaxf(acc[i][j][3], 0.f);
        uint2 o;
        o.x = pk2(r0 * r0, r1 * r1);
        o.y = pk2(r2 * r2, r3 * r3);
        *(uint2*)(hid + (size_t)m * LDH + n) = o;
      }
    have = haven; mt = mtn; nt = ntn;
  }
}

DEVI void phase_merge(const Params& p, int l, int vcu, u16* smem) {
  const u16* xn = (const u16*)(p.ws + WS_XN);
  const u16* y = (const u16*)(p.ws + WS_OBUF);
  const u16* wg = (const u16*)(p.ws + WS_WT_GATE) + (size_t)l * 3072 * LDW1;
  const u16* wb = (const u16*)(p.ws + WS_WT_BR) + (size_t)l * 3 * 1024 * LDWB;
  u16* merged = (u16*)(p.ws + WS_CONV);
  const int tid_ = otid(); const int lane = tid_ & 63, w = tid_ >> 6, wm = w >> 1, wn = w & 1, fr = lane & 15, fq = lane >> 4;
  constexpr int NT = D / 128, MT = M / 128;
  PF_DECL;
  int mt, nt;
  bool have = tile_map(0, vcu, MT, NT, mt, nt);
  for (int it = 0; have; ++it) {
    const int m0 = mt * 128, n0 = nt * 128;
    const int ko = koff_of(mt, nt);
    int mtn, ntn;
    const bool haven = tile_map(it + 1, vcu, MT, NT, mtn, ntn);
    f32x4 accM[2][4];
    zero_acc(accM);
#pragma unroll 1
    for (int b = 0; b < 3; ++b) {
      f32x4 accG[2][4], accB[2][4];
      zero_acc(accG);
      const GemmOp gate{xn + (size_t)m0 * LDX, wg + ((size_t)b * 1024 + n0) * LDW1, LDX, LDW1, 1024, ko};
      const GemmOp br{y + (size_t)m0 * LDY + b * 512, wb + ((size_t)b * 1024 + n0) * LDWB, LDY, LDWB, 512, ko};
      GemmOp after = gate;
      if (b < 2) {
        after.B = wg + ((size_t)(b + 1) * 1024 + n0) * LDW1;
      } else if (haven) {
        after.A = xn + (size_t)(mtn * 128) * LDX;
        after.B = wg + (size_t)(ntn * 128) * LDW1;
        after.koff = koff_of(mtn, ntn);
      }
      gemm_core<2, 4>(gate, br, (it > 0) || (b > 0), PF_ARGS, accG, smem);
      unsigned gpk[2][4][2];
#pragma unroll
      for (int i = 0; i < 2; ++i)
#pragma unroll
        for (int j = 0; j < 4; ++j) {
          gpk[i][j][0] = pk2(sigm(accG[i][j][0]), sigm(accG[i][j][1]));
          gpk[i][j][1] = pk2(sigm(accG[i][j][2]), sigm(accG[i][j][3]));
        }
      zero_acc(accB);
      gemm_core<2, 4>(br, after, true, PF_ARGS, accB, smem);
#pragma unroll
      for (int i = 0; i < 2; ++i)
#pragma unroll
        for (int j = 0; j < 4; ++j) {
          accM[i][j][0] += bflo(gpk[i][j][0]) * accB[i][j][0];
          accM[i][j][1] += bfhi(gpk[i][j][0]) * accB[i][j][1];
          accM[i][j][2] += bflo(gpk[i][j][1]) * accB[i][j][2];
          accM[i][j][3] += bfhi(gpk[i][j][1]) * accB[i][j][3];
        }
    }
#pragma unroll
    for (int i = 0; i < 2; ++i)
#pragma unroll
      for (int j = 0; j < 4; ++j) {
        const int m = m0 + wm * 32 + i * 16 + fr, n = n0 + wn * 64 + j * 16 + fq * 4;
        uint2 o;
        o.x = pk2(accM[i][j][0], accM[i][j][1]);
        o.y = pk2(accM[i][j][2], accM[i][j][3]);
        *(uint2*)(merged + (size_t)m * LDX + n) = o;
      }
    have = haven; mt = mtn; nt = ntn;
  }
}

DEVI void phase_resid(const u16* A, int lda, int K, const u16* wt, int ldb, const float* xin_p, const float* xin_s, float* xout, int vcu, u16* smem) {
  for (int t = vcu; t < 256; t += gridDim.x) {
    PFB_DECL;
    int mt, nt;
    tile_map(0, t, 64, 4, mt, nt);
    const int m0 = mt * 256, n0 = nt * 256;
    const GemmOp cur{A + (size_t)m0 * lda, wt + (size_t)n0 * ldb, lda, ldb, K, koff_of(mt, nt)};
    f32x4 acc[4][8];
    zero_acc(acc);
    gemm_core_big(cur, cur, false, PFB_ARGS, acc, smem);
    const int tid_ = otid(); const int lane = tid_ & 63, w = tid_ >> 6, wm = w >> 1, wn = w & 1, fr = lane & 15, fq = lane >> 4;
#pragma unroll
    for (int i = 0; i < 4; ++i)
#pragma unroll
      for (int j = 0; j < 8; ++j) {
        const int m = m0 + wm * 64 + i * 16 + fr, n = n0 + wn * 128 + j * 16 + fq * 4;
        const float4 xv = *(const float4*)(xin_p + (size_t)m * D + n);
        float4 o;
        o.x = xv.x + acc[i][j][0]; o.y = xv.y + acc[i][j][1]; o.z = xv.z + acc[i][j][2]; o.w = xv.w + acc[i][j][3];
        *(float4*)(xout + (size_t)m * D + n) = o;
        if ((j & 1) == 1) __builtin_amdgcn_sched_barrier(0);
      }
  }
  {
    PF_DECL;
    bool first = true;
    for (int t = vcu; t < 32; t += gridDim.x) {
      const int mt = (MP / 128) + (t >> 3), nt = t & 7;
      const int m0 = mt * 128, n0 = nt * 128;
      const GemmOp cur{A + (size_t)m0 * lda, wt + (size_t)n0 * ldb, lda, ldb, K, koff_of(mt, nt)};
      f32x4 acc[2][4];
      zero_acc(acc);
      gemm_core<2, 4>(cur, cur, !first, PF_ARGS, acc, smem);
      const int tid_ = otid(); const int lane = tid_ & 63, w = tid_ >> 6, wm = w >> 1, wn = w & 1, fr = lane & 15, fq = lane >> 4;
      first = false;
#pragma unroll
      for (int i = 0; i < 2; ++i)
#pragma unroll
        for (int j = 0; j < 4; ++j) {
          const int m = m0 + wm * 32 + i * 16 + fr, n = n0 + wn * 64 + j * 16 + fq * 4;
          const float4 xv = *(const float4*)(xin_s + (size_t)(m - MP) * D + n);
          float4 o;
          o.x = xv.x + acc[i][j][0]; o.y = xv.y + acc[i][j][1]; o.z = xv.z + acc[i][j][2]; o.w = xv.w + acc[i][j][3];
          *(float4*)(xout + (size_t)m * D + n) = o;
        }
    }
  }
}

DEVI void unpack8(const uint4 u, float (&f)[8]) {
  f[0] = bflo(u.x); f[1] = bfhi(u.x); f[2] = bflo(u.y); f[3] = bfhi(u.y);
  f[4] = bflo(u.z); f[5] = bfhi(u.z); f[6] = bflo(u.w); f[7] = bfhi(u.w);
}
DEVI uint4 pack8(const float (&f)[8]) {
  uint4 r;
  r.x = pk2(f[0], f[1]); r.y = pk2(f[2], f[3]); r.z = pk2(f[4], f[5]); r.w = pk2(f[6], f[7]);
  return r;
}
DEVI void load8f(const float* p, float (&f)[8]) {
  const float4 a = *(const float4*)p, b = *(const float4*)(p + 4);
  f[0] = a.x; f[1] = a.y; f[2] = a.z; f[3] = a.w; f[4] = b.x; f[5] = b.y; f[6] = b.z; f[7] = b.w;
}
DEVI void phase_prep(const Params& p, int l) {
  const int tid_ = otid(); const int lane = tid_ & 63, gw = blockIdx.x * 8 + (tid_ >> 6), nw = gridDim.x * 8;
  u16* proj = (u16*)(p.ws + WS_PROJ);
  u16* conv = (u16*)(p.ws + WS_CONV);
  const float* small = (const float*)(p.ws + WS_SMALL);
  float* gates = (float*)(p.ws + WS_GATES);
  constexpr int NTASK = (M / 4) * 6;
  for (int task = gw; task < NTASK; task += nw) {
    const int tg = task / 6, k = task - tg * 6;
    const int m0 = tg * 4;
    const bool samp = m0 >= MP;
    int b, t0;
    if (!samp) { b = m0 >> 11; t0 = m0 & 2047; } else { b = (m0 - MP) >> 2; t0 = 0; }
    if (k < 3) {
      const int pp = k;
      const int ch = pp * 512 + lane * 8;
      const u16* src = proj + 2048 + ch;
      float r[7][8], cw[4][8];
#pragma unroll
      for (int j = 0; j < 7; ++j) {
        const int t = t0 - 3 + j;
        if (t >= 0) {
          unpack8(*(const uint4*)(src + (size_t)(m0 - 3 + j) * NPROJ), r[j]);
        } else if (samp) {
          load8f(p.st_gconv + ((size_t)(l * 128 + b) * 3 + j) * 1536 + ch, r[j]);
        } else {
#pragma unroll
          for (int c = 0; c < 8; ++c) r[j][c] = 0.f;
        }
      }
#pragma unroll
      for (int j = 0; j < 4; ++j) load8f(p.gd_conv_w + (size_t)(l * 4 + j) * 1536 + ch, cw[j]);
#pragma unroll
      for (int tt = 0; tt < 4; ++tt) {
        float a[8];
        float ss = 0.f;
#pragma unroll
        for (int c = 0; c < 8; ++c) {
          float sx = 0.f;
#pragma unroll
          for (int j = 0; j < 4; ++j) sx += cw[j][c] * r[tt + j][c];
          a[c] = silu(sx);
          ss += a[c] * a[c];
        }
        if (pp < 2) {
          ss = row16_sum(ss);
          float sc = rsqrtf(ss + 1e-6f);
          if (pp == 0) sc *= 0.08838834764831845f;
#pragma unroll
          for (int c = 0; c < 8; ++c) a[c] *= sc;
        }
        *(uint4*)(conv + (size_t)(m0 + tt) * 1536 + ch) = pack8(a);
      }
      const bool last = samp || (t0 == 2044);
      if (last) {
        float* co = p.out + (samp ? OFF_S_GC + (size_t)(l * 128 + b) * 3 * 1536 : OFF_P_GC + (size_t)(l * 8 + b) * 3 * 1536) + ch;
#pragma unroll
        for (int j = 0; j < 3; ++j) {
          *(float4*)(co + j * 1536) = float4{r[4 + j][0], r[4 + j][1], r[4 + j][2], r[4 + j][3]};
          *(float4*)(co + j * 1536 + 4) = float4{r[4 + j][4], r[4 + j][5], r[4 + j][6], r[4 + j][7]};
        }
      }
    } else if (k < 5) {
      const int part = k - 3;
      const int wch = lane * 8;
      u16* col = proj + 4096 + part * 512 + wch;
      float lb[8];
#pragma unroll
      for (int c = 0; c < 8; ++c) lb[c] = 0.f;
      if (part == 1 && l == 1) {
        float l0[8], l1[8];
        load8f(p.hg_lb_logits + wch, l0);
        load8f(p.hg_lb_logits + 512 + wch, l1);
#pragma unroll
        for (int c = 0; c < 8; ++c) lb[c] = sigm(l1[c] - l0[c]);
      }
      uint4 u[4];
#pragma unroll
      for (int tt = 0; tt < 4; ++tt) u[tt] = *(const uint4*)(col + (size_t)(m0 + tt) * NPROJ);
#pragma unroll
      for (int tt = 0; tt < 4; ++tt) {
        float f[8];
        unpack8(u[tt], f);
#pragma unroll
        for (int c = 0; c < 8; ++c) f[c] = (part == 0) ? silu(f[c]) : (1.f - lb[c]) * sigm(-f[c]);
        *(uint4*)(col + (size_t)(m0 + tt) * NPROJ) = pack8(f);
      }
    } else {
      const int tt = lane >> 4, g = lane & 15, hh = g & 3;
      const float v = small[(size_t)(m0 + tt) * 16 + g];
      float r;
      if (g < 4) r = v + p.ml_i_bias[l * 4 + hh];
      else if (g < 8) { const float x = v + p.ml_f_bias[l * 4 + hh]; r = -softplus(-x); }
      else if (g < 12) r = sigm(v);
      else { const float x = v + p.gd_dt_bias[l * 4 + hh]; r = __expf(-__expf(p.gd_A_log[l * 4 + hh]) * softplus(x)); }
      gates[(size_t)(m0 + tt) * 16 + g] = r;
    }
  }
}

template <int KIND>
DEVI void scan_unit(const Params& p, int l, bool samp, int b, int h, int colbase, float* smem) {
  constexpr int CPL = (KIND == 1) ? 1 : 2;
  constexpr int UC = 32 * CPL;
  constexpr int VCH = UC / 8;
  const int tid = otid(), lane = tid & 63, w = tid >> 6, kg = lane & 15, cl = lane >> 4;
  const int T = samp ? 4 : 2048;
  const int rowbase = samp ? (MP + b * 4) : b * 2048;
  const int NB = samp ? 128 : 8;
  const u16* proj = (const u16*)(p.ws + WS_PROJ);
  const u16* conv = (const u16*)(p.ws + WS_CONV);
  u16* obuf = (u16*)(p.ws + WS_OBUF);
  const float* gates = (const float*)(p.ws + WS_GATES);
  float* dm = (float*)(p.ws + WS_DM);
  const u16 *qsrc, *ksrc, *vsrc;
  int ld, ocol;
  const float* Sin;
  float* Sout;
  const size_t sidx_in = ((size_t)(l * 128 + b) * 4 + h) * 16384;
  const size_t sidx_out = ((size_t)(l * NB + b) * 4 + h) * 16384;
  if (KIND == 0) {
    qsrc = proj + h * 128; ksrc = proj + 512 + h * 128; vsrc = proj + 1024 + h * 128 + colbase; ld = NPROJ; ocol = 0;
    Sin = p.st_mC + sidx_in; Sout = p.out + (samp ? OFF_S_MC : OFF_P_MC) + sidx_out;
  } else if (KIND == 1) {
    qsrc = conv + h * 128; ksrc = conv + 512 + h * 128; vsrc = conv + 1024 + h * 128 + colbase; ld = 1536; ocol = 512;
    Sin = p.st_gS + sidx_in; Sout = p.out + (samp ? OFF_S_GS : OFF_P_GS) + sidx_out;
  } else {
    qsrc = proj + 4096 + h * 128; ksrc = proj + 4608 + h * 128; vsrc = proj + 5120 + h * 128 + colbase; ld = NPROJ; ocol = 1024;
    Sin = p.st_hS + sidx_in; Sout = p.out + (samp ? OFF_S_HS : OFF_P_HS) + sidx_out;
  }
  float* qk = smem;
  float* vl = smem + 2 * 32 * 256;
  float* gl = vl + 2 * 32 * 64;

  const int wc = w * 4 * CPL + cl * CPL;
  const int col0 = colbase + wc;
  v2f S[CPL][4];
  v2f nv[4];
#pragma unroll
  for (int c = 0; c < CPL; ++c)
#pragma unroll
    for (int i = 0; i < 4; ++i) {
      if (samp) { S[c][i].x = Sin[(size_t)(kg * 8 + 2 * i) * 128 + col0 + c]; S[c][i].y = Sin[(size_t)(kg * 8 + 2 * i + 1) * 128 + col0 + c]; }
      else { S[c][i].x = 0.f; S[c][i].y = 0.f; }
    }
  float mstart = 0.f;
  if (KIND == 0) {
    const size_t nidx = ((size_t)(l * 128 + b) * 4 + h) * 128;
#pragma unroll
    for (int i = 0; i < 4; ++i) {
      if (samp) { nv[i].x = p.st_mn[nidx + kg * 8 + 2 * i]; nv[i].y = p.st_mn[nidx + kg * 8 + 2 * i + 1]; }
      else { nv[i].x = 0.f; nv[i].y = 0.f; }
    }
    if (samp) mstart = p.st_mm[(size_t)(l * 128 + b) * 4 + h];
  }

  uint4 rq, rk, rv;
  float g0 = 0.f, g1 = 0.f;
  const int sr = tid >> 4, sc = tid & 15;
  const int vr = tid / VCH, vc = tid % VCH;
  auto prefetch = [&](int j) {
    const int t = j * 32 + sr;
    rq = uint4{0, 0, 0, 0}; rk = uint4{0, 0, 0, 0}; rv = uint4{0, 0, 0, 0};
    if (t < T) {
      rq = *(const uint4*)(qsrc + (size_t)(rowbase + t) * ld + sc * 8);
      rk = *(const uint4*)(ksrc + (size_t)(rowbase + t) * ld + sc * 8);
    }
    if (tid < 32 * VCH) {
      const int tv = j * 32 + vr;
      if (tv < T) rv = *(const uint4*)(vsrc + (size_t)(rowbase + tv) * ld + vc * 8);
    }
    if (KIND != 2) {
      g0 = (KIND == 0) ? -1e30f : 0.f; g1 = 0.f;
      if (tid < 32) {
        const int tg = j * 32 + tid;
        if (tg < T) {
          if (KIND == 0) { g0 = gates[(size_t)(rowbase + tg) * 16 + h]; g1 = gates[(size_t)(rowbase + tg) * 16 + 4 + h]; }
          else { g0 = gates[(size_t)(rowbase + tg) * 16 + 8 + h]; g1 = gates[(size_t)(rowbase + tg) * 16 + 12 + h]; }
        }
      }
    }
  };
  auto stage = [&](int j, int buf) {
    float* qd = qk + (buf * 32 + sr) * 256 + sc * 8;
    *(float4*)(qd) = float4{bflo(rq.x), bfhi(rq.x), bflo(rq.y), bfhi(rq.y)};
    *(float4*)(qd + 4) = float4{bflo(rq.z), bfhi(rq.z), bflo(rq.w), bfhi(rq.w)};
    *(float4*)(qd + 128) = float4{bflo(rk.x), bfhi(rk.x), bflo(rk.y), bfhi(rk.y)};
    *(float4*)(qd + 132) = float4{bflo(rk.z), bfhi(rk.z), bflo(rk.w), bfhi(rk.w)};
    if (tid < 32 * VCH) {
      float* vd = vl + (buf * 32 + vr) * 64 + vc * 8;
      *(float4*)(vd) = float4{bflo(rv.x), bfhi(rv.x), bflo(rv.y), bfhi(rv.y)};
      *(float4*)(vd + 4) = float4{bflo(rv.z), bfhi(rv.z), bflo(rv.w), bfhi(rv.w)};
    }
    if (KIND == 0) {
      if (w == 0) {
        float bs = g1;
#pragma unroll
        for (int d = 1; d < 32; d <<= 1) { const float o = __shfl_up(bs, d); if (lane >= d) bs += o; }
        float R = g0 - bs;
#pragma unroll
        for (int d = 1; d < 32; d <<= 1) { const float o = __shfl_up(R, d); if (lane >= d) R = fmaxf(R, o); }
        const float mt = bs + fmaxf(mstart, R);
        float mprev = __shfl_up(mt, 1);
        if (lane == 0) mprev = mstart;
        const float fw = __expf(g1 + mprev - mt);
        const float iw = __expf(g0 - mt) * 0.08838834764831845f;
        if (lane < 32) {
          float* gd = gl + (buf * 32 + lane) * 4;
          gd[0] = fw; gd[1] = iw; gd[2] = mt;
        }
        int lastv = T - j * 32 - 1;
        if (lastv > 31) lastv = 31;
        mstart = __shfl(mt, lastv);
      }
    } else if (KIND == 1) {
      if (tid < 32) {
        float* gd = gl + (buf * 32 + tid) * 4;
        gd[0] = g0; gd[1] = g1;
      }
    }
  };

  const bool do_n = (KIND == 0) && (colbase == 0) && (w == 0);
  const int nblk = (T + 31) >> 5;
  prefetch(0);
  stage(0, 0);
  __syncthreads();
  for (int j = 0; j < nblk; ++j) {
    const int buf = j & 1;
    if (j + 1 < nblk) prefetch(j + 1);
    int steps = T - j * 32;
    if (steps > 32) steps = 32;
    u16* const obase = obuf + (size_t)(rowbase + j * 32) * LDY + ocol + h * 128 + col0;
    float* const dmbase = dm + (size_t)(rowbase + j * 32) * 8 + h;
    for (int t0 = 0; t0 < steps; t0 += 16) {
      int ns = steps - t0;
      if (ns > 16) ns = 16;
      float keep0 = 0.f, keep1 = 0.f, keepd = 0.f, keepm = 0.f;
#pragma unroll 4
      for (int tt = 0; tt < ns; ++tt) {
        const int t = t0 + tt;
        const float* qp = qk + (buf * 32 + t) * 256 + kg * 8;
        const float4 qa = *(const float4*)(qp), qb = *(const float4*)(qp + 4);
        const float4 ka = *(const float4*)(qp + 128), kb = *(const float4*)(qp + 132);
        const v2f q2[4] = {v2f{qa.x, qa.y}, v2f{qa.z, qa.w}, v2f{qb.x, qb.y}, v2f{qb.z, qb.w}};
        const v2f k2[4] = {v2f{ka.x, ka.y}, v2f{ka.z, ka.w}, v2f{kb.x, kb.y}, v2f{kb.z, kb.w}};
        const float* vp = vl + (buf * 32 + t) * 64 + wc;
        const float* gp = gl + (buf * 32 + t) * 4;
        const bool mine = (kg == tt);
        if (KIND == 0) {
          const float fw = gp[0], iw = gp[1];
          const v2f fw2 = v2f{fw, fw};
          const float2 vv = *(const float2*)vp;
          const float va[2] = {vv.x * iw, vv.y * iw};
          float num[2];
#pragma unroll
          for (int c = 0; c < 2; ++c) {
            const v2f vc2 = v2f{va[c], va[c]};
            v2f a = v2f{0.f, 0.f};
#pragma unroll
            for (int i = 0; i < 4; ++i) {
              S[c][i] = fw2 * S[c][i] + k2[i] * vc2;
              a += q2[i] * S[c][i];
            }
            num[c] = row16_sum(a.x + a.y);
          }
          keep0 = mine ? num[0] : keep0;
          keep1 = mine ? num[1] : keep1;
          if (do_n) {
            const v2f iw2 = v2f{iw, iw};
            v2f a = v2f{0.f, 0.f};
#pragma unroll
            for (int i = 0; i < 4; ++i) {
              nv[i] = fw2 * nv[i] + k2[i] * iw2;
              a += q2[i] * nv[i];
            }
            const float den = row16_sum(a.x + a.y);
            keepd = mine ? den : keepd;
            keepm = mine ? gp[2] : keepm;
          }
        } else if (KIND == 1) {
          const float beta = gp[0], g = gp[1];
          const float v = vp[0];
          v2f a = v2f{0.f, 0.f};
#pragma unroll
          for (int i = 0; i < 4; ++i) a += k2[i] * S[0][i];
          const float kS = row16_sum(a.x + a.y);
          const float vn = beta * (v - g * kS);
          const v2f g2 = v2f{g, g}, vn2 = v2f{vn, vn};
          v2f o2 = v2f{0.f, 0.f};
#pragma unroll
          for (int i = 0; i < 4; ++i) {
            S[0][i] = g2 * S[0][i] + k2[i] * vn2;
            o2 += q2[i] * S[0][i];
          }
          const float o = row16_sum(o2.x + o2.y);
          keep0 = mine ? o : keep0;
        } else {
          const float2 vv = *(const float2*)vp;
          const float va[2] = {vv.x, vv.y};
          float num[2];
#pragma unroll
          for (int c = 0; c < 2; ++c) {
            const v2f vc2 = v2f{va[c], va[c]};
            v2f a = v2f{0.f, 0.f};
#pragma unroll
            for (int i = 0; i < 4; ++i) {
              S[c][i] = S[c][i] + k2[i] * (vc2 - S[c][i]);
              a += q2[i] * S[c][i];
            }
            num[c] = row16_sum(a.x + a.y);
          }
          keep0 = mine ? num[0] : keep0;
          keep1 = mine ? num[1] : keep1;
        }
      }
      if (kg < ns) {
        if (KIND == 1) obase[(size_t)(t0 + kg) * LDY] = f2bf(keep0);
        else *(unsigned*)(obase + (size_t)(t0 + kg) * LDY) = pk2(keep0, keep1);
        if (do_n && cl == 0) { dmbase[(t0 + kg) * 8] = keepd; dmbase[(t0 + kg) * 8 + 4] = keepm; }
      }
    }
    if (j + 1 < nblk) stage(j + 1, buf ^ 1);
    __syncthreads();
  }
#pragma unroll
  for (int c = 0; c < CPL; ++c)
#pragma unroll
    for (int i = 0; i < 4; ++i) {
      Sout[(size_t)(kg * 8 + 2 * i) * 128 + col0 + c] = S[c][i].x;
      Sout[(size_t)(kg * 8 + 2 * i + 1) * 128 + col0 + c] = S[c][i].y;
    }
  if (KIND == 0 && colbase == 0 && w == 0) {
    if (cl == 0) {
      float* no = p.out + (samp ? OFF_S_MN : OFF_P_MN) + ((size_t)(l * NB + b) * 4 + h) * 128 + kg * 8;
#pragma unroll
      for (int i = 0; i < 4; ++i) { no[2 * i] = nv[i].x; no[2 * i + 1] = nv[i].y; }
    }
    if (lane == 0) p.out[(samp ? OFF_S_MM : OFF_P_MM) + (size_t)(l * NB + b) * 4 + h] = mstart;
  }
  __syncthreads();
}

DEVI void scan_sample_unit(const Params& p, int l, int s, float* smem) {
  const int s4 = s & 3;
  if (s4 < 2) {
    const int idx = (s >> 2) * 2 + (s & 1), seq = idx >> 2;
    scan_unit<1>(p, l, true, seq >> 2, seq & 3, (idx & 3) * 32, smem);
  } else {
    const int idx = s >> 2, seq = idx >> 1;
    if (s4 == 2) scan_unit<0>(p, l, true, seq >> 2, seq & 3, (idx & 1) * 64, smem);
    else scan_unit<2>(p, l, true, seq >> 2, seq & 3, (idx & 1) * 64, smem);
  }
}

DEVI void phase_scan(const Params& p, int l, float* smem) {
  for (int u = blockIdx.x; u < 256; u += gridDim.x) {
    if (u < 128) {
      const int seq = u >> 2;
      scan_unit<1>(p, l, false, seq >> 2, seq & 3, (u & 3) * 32, smem);
    } else if (u < 192) {
      const int uu = u - 128, seq = uu >> 1;
      scan_unit<0>(p, l, false, seq >> 2, seq & 3, (uu & 1) * 64, smem);
    } else {
      const int uu = u - 192, seq = uu >> 1;
      scan_unit<2>(p, l, false, seq >> 2, seq & 3, (uu & 1) * 64, smem);
    }
  }
  if (gridDim.x == 256) {
    const int b = blockIdx.x;
    int s0, cnt;
    if (b < 128) { s0 = b * 26; cnt = 26; }
    else if (b < 192) {
      if (((b - 128) & 1) == 0) { s0 = 0; cnt = 0; }
      else { s0 = 3328 + ((b - 128) >> 1) * 8; cnt = 8; }
    } else { s0 = 3328 + (32 + (b - 192)) * 8; cnt = 8; }
    for (int i = 0; i < cnt; ++i) scan_sample_unit(p, l, s0 + i, smem);
  } else {
    for (int s = blockIdx.x; s < 4096; s += gridDim.x) scan_sample_unit(p, l, s, smem);
  }
}

DEVI void phase_post(const Params& p, int l) {
  const int tid_ = otid(); const int lane = tid_ & 63, gw = blockIdx.x * 8 + (tid_ >> 6), nw = gridDim.x * 8;
  const u16* proj = (const u16*)(p.ws + WS_PROJ);
  u16* obuf = (u16*)(p.ws + WS_OBUF);
  const float* dm = (const float*)(p.ws + WS_DM);
  constexpr int NTASK = (M / 4) * 3;
  for (int task = gw; task < NTASK; task += nw) {
    const int tg = task / 3, k = task - tg * 3;
    const int m0 = tg * 4;
    const int c = lane * 8, hh = lane >> 4;
    float wv[8];
    if (k == 0) load8f(p.ml_norm_w + l * 512 + c, wv);
    else if (k == 1) load8f(p.gd_norm_w + l * 128 + (c & 127), wv);
    else load8f(p.hg_norm_w + l * 512 + c, wv);
    const int gcol = (k == 0) ? 1536 : (k == 1 ? 3584 : 5632);
    uint4 ov[4], gv[4];
#pragma unroll
    for (int tt = 0; tt < 4; ++tt) {
      ov[tt] = *(const uint4*)(obuf + (size_t)(m0 + tt) * LDY + k * 512 + c);
      gv[tt] = *(const uint4*)(proj + (size_t)(m0 + tt) * NPROJ + gcol + c);
    }
#pragma unroll
    for (int tt = 0; tt < 4; ++tt) {
      const size_t m = m0 + tt;
      float o[8], g[8];
      unpack8(ov[tt], o);
      unpack8(gv[tt], g);
      if (k == 0) {
        const float den = dm[m * 8 + hh], mt = dm[m * 8 + 4 + hh];
        const float inv = 1.f / fmaxf(fabsf(den), __expf(-mt));
#pragma unroll
        for (int i = 0; i < 8; ++i) o[i] *= inv;
      }
      float ss = 0.f;
#pragma unroll
      for (int i = 0; i < 8; ++i) ss += o[i] * o[i];
      float sc;
      if (k == 2) { ss = wave_sum(ss); sc = rsqrtf(ss * (1.f / 512.f) + 1e-6f); }
      else { ss = row16_sum(ss); sc = rsqrtf(ss * (1.f / 128.f) + 1e-6f); }
#pragma unroll
      for (int i = 0; i < 8; ++i) o[i] = o[i] * sc * wv[i] * ((k == 0) ? sigm(g[i]) : silu(g[i]));
      *(uint4*)(obuf + m * LDY + k * 512 + c) = pack8(o);
    }
  }
}

#define LAS __attribute__((address_space(3)))
#define XB_TMO      128
#define XB_XCNT(j)  (256  + 64 * (j))
#define XB_XSUB(j)  (1280 + 64 * (j))
#define XB_XGEN(j)  (2304 + 64 * (j))
#define XB_TOP      3328
#define XB_TOPGEN   3392
#define XCD_BAR_WORDS 3456
#define XB_SPIN_CAP (1u << 18)

__device__ __forceinline__ unsigned xb_ld(unsigned* p)              { return __hip_atomic_load(p, __ATOMIC_RELAXED, __HIP_MEMORY_SCOPE_AGENT); }
__device__ __forceinline__ unsigned xb_add(unsigned* p, unsigned v) { return __hip_atomic_fetch_add(p, v, __ATOMIC_RELAXED, __HIP_MEMORY_SCOPE_AGENT); }
__device__ __forceinline__ unsigned xb_xcc_id() { return (unsigned)__builtin_amdgcn_s_getreg((3 << 11) | 20) & 0xFu; }
#define XB_SPIN(cond, bar) do { unsigned _sp = 0; while (cond) { __builtin_amdgcn_s_sleep(1); \
    if ((++_sp & 255u) == 0u) { if (xb_ld(&(bar)[XB_TMO])) break; if (_sp > XB_SPIN_CAP) { atomicAdd(&(bar)[XB_TMO], 1u); break; } } } } while (0)

struct XcdBarrier {
    unsigned* bar; unsigned x;
    volatile LAS unsigned* st;
};

__device__ __forceinline__ XcdBarrier xcd_barrier_post(unsigned* bar, volatile LAS unsigned* st) {
    XcdBarrier b; b.bar = bar; b.x = xb_xcc_id(); b.st = st;
    if (threadIdx.x == 0) (void)xb_add(&bar[XB_XCNT(b.x)], 1u);
    return b;
}
__device__ __forceinline__ void xcd_barrier_complete(unsigned* bar, unsigned x, unsigned& nloc, unsigned& nx) {
    const unsigned G = gridDim.x * gridDim.y * gridDim.z;
    unsigned sum, cnt, mine, sp = 0u;
    for (;;) {
        sum = 0u; cnt = 0u; mine = 0u;
#pragma unroll
        for (unsigned j = 0; j < 16; ++j) { const unsigned c = xb_ld(&bar[XB_XCNT(j)]); sum += c; cnt += (c > 0u) ? 1u : 0u; mine = (j == x) ? c : mine; }
        if (sum == G) break;
        __builtin_amdgcn_s_sleep(1);
        if ((++sp & 255u) == 0u) { if (xb_ld(&bar[XB_TMO])) break; if (sp > XB_SPIN_CAP) { atomicAdd(&bar[XB_TMO], 1u); break; } }
    }
    nloc = mine > 0u ? mine : 1u; nx = cnt > 0u ? cnt : 1u;
}

__device__ __forceinline__ void xcd_barrier(const XcdBarrier& b) {
    asm volatile("s_waitcnt vmcnt(0)" ::: "memory");
    __syncthreads();
    if (threadIdx.x == 0) {
        unsigned* bar = b.bar;
        __builtin_amdgcn_s_waitcnt(0);
        unsigned nloc = b.st[0], nx = b.st[1];
        if (nloc == 0u) { xcd_barrier_complete(bar, b.x, nloc, nx); b.st[0] = nloc; b.st[1] = nx; }
        const unsigned old = xb_add(&bar[XB_XSUB(b.x)], 1u);
        const unsigned gen = old / nloc;
        if (old + 1u == (gen + 1u) * nloc) {
            __builtin_amdgcn_fence(__ATOMIC_RELEASE, "agent");
            asm volatile("s_waitcnt vmcnt(0)" ::: "memory");
            const unsigned og = xb_add(&bar[XB_TOP], 1u);
            const unsigned tg = og / nx;
            if (og + 1u == (tg + 1u) * nx) xb_add(&bar[XB_TOPGEN], 1u);
            else XB_SPIN(xb_ld(&bar[XB_TOPGEN]) == tg, bar);
            __builtin_amdgcn_fence(__ATOMIC_ACQUIRE, "agent");
            xb_add(&bar[XB_XGEN(b.x)], 1u);
            asm volatile("s_waitcnt vmcnt(0)" ::: "memory");
        } else {
            XB_SPIN(xb_ld(&bar[XB_XGEN(b.x)]) == gen, bar);
            __builtin_amdgcn_fence(__ATOMIC_ACQUIRE, "agent");
            asm volatile("s_waitcnt vmcnt(0)" ::: "memory");
        }
    }
    __syncthreads();
}


__global__ void __launch_bounds__(NTHREADS) mega_fwd(Params p) {
  extern __shared__ __attribute__((aligned(16))) unsigned char smem_raw[];
  cg::grid_group grid = cg::this_grid();
  float* smf = (float*)smem_raw;
  u16* smh = (u16*)smem_raw;
  u16* xn = (u16*)(p.ws + WS_XN);
  float* x = p.out;

  volatile LAS unsigned* bst = (volatile LAS unsigned*)(smem_raw + LDS_BYTES - 16);
  if (threadIdx.x < 2) bst[threadIdx.x] = 0u;
  __syncthreads();
  XcdBarrier xbar; xbar.bar = (unsigned*)(p.ws + WS_BAR); xbar.x = xb_xcc_id(); xbar.st = bst;
  if (threadIdx.x == 0) bst[2] = xb_add(&xbar.bar[XB_XCNT(xbar.x)], 1u);
  phase_wprep(p, smf);
  phase_norm(p.x_prompt, p.x_sample, p.norm1_w, xn);
  grid.sync();
  if (threadIdx.x == 0) {
    const unsigned per = gridDim.x >> 3;
    bool ok = (gridDim.x & 7u) == 0u && xbar.x < 8u;
    for (unsigned j = 0; j < 8; ++j) ok = ok && (xb_ld(&xbar.bar[XB_XCNT(j)]) == per);
    const unsigned rank = bst[2];
    bst[3] = (ok && rank < per) ? xbar.x * per + rank : (blockIdx.x & 7u) * per + (blockIdx.x >> 3);
  }
  __syncthreads();
  const int vcu = __builtin_amdgcn_readfirstlane((int)bst[3]);
#pragma unroll 1
  for (int l = 0; l < 2; ++l) {
    phase_proj(p, l, vcu, smh);
    xcd_barrier(xbar);
    phase_prep(p, l);
    xcd_barrier(xbar);
    phase_scan(p, l, smf);
    xcd_barrier(xbar);
    phase_post(p, l);
    xcd_barrier(xbar);
    phase_merge(p, l, vcu, smh);
    xcd_barrier(xbar);
    if (l == 0)
      phase_resid((const u16*)(p.ws + WS_CONV), LDX, 1024, (const u16*)(p.ws + WS_WT_OUT), LDW1, p.x_prompt, p.x_sample, x, vcu, smh);
    else
      phase_resid((const u16*)(p.ws + WS_CONV), LDX, 1024, (const u16*)(p.ws + WS_WT_OUT) + (size_t)1024 * LDW1, LDW1, x, x + (size_t)MP * D, x, vcu, smh);
    xcd_barrier(xbar);
    phase_norm(x, x + (size_t)MP * D, p.norm2_w + l * D, xn);
    xcd_barrier(xbar);
    phase_up(p, l, vcu, smh);
    xcd_barrier(xbar);
    phase_resid((const u16*)(p.ws + WS_PROJ), LDH, 4096, (const u16*)(p.ws + WS_WT_DN) + (size_t)l * 1024 * LDWD, LDWD, x, x + (size_t)MP * D, x, vcu, smh);
    xcd_barrier(xbar);
    if (l == 0) {
      phase_norm(x, x + (size_t)MP * D, p.norm1_w + D, xn);
      xcd_barrier(xbar);
    }
  }
  phase_final_norm(x, p.final_norm_w);
}

extern "C" void kernel_launch(void* const* d_in, const int* in_sizes, int n_in, void* d_out, int out_size, void* d_ws,
                              size_t ws_size, hipStream_t stream) {
  static int grid_blocks = 0;
  if (!grid_blocks) {
    int dev = 0, cus = 0, per_cu = 0;
    hipGetDevice(&dev);
    hipDeviceGetAttribute(&cus, hipDeviceAttributeMultiprocessorCount, dev);
    hipFuncSetAttribute((const void*)mega_fwd, hipFuncAttributeMaxDynamicSharedMemorySize, LDS_BYTES);
    hipOccupancyMaxActiveBlocksPerMultiprocessor(&per_cu, (const void*)mega_fwd, NTHREADS, LDS_BYTES);
    if (per_cu < 1) { fprintf(stderr, "occupancy query returned %d\n", per_cu); per_cu = 1; }
    grid_blocks = cus;
    if (ws_size < WS_END) fprintf(stderr, "workspace too small: %zu < %zu\n", ws_size, (size_t)WS_END);
  }
  Params p{};
  p.x_prompt = (const float*)d_in[0]; p.x_sample = (const float*)d_in[1];
  p.st_mC = (const float*)d_in[2]; p.st_mn = (const float*)d_in[3]; p.st_mm = (const float*)d_in[4];
  p.st_gS = (const float*)d_in[5]; p.st_gconv = (const float*)d_in[6]; p.st_hS = (const float*)d_in[7];
  p.norm1_w = (const float*)d_in[8]; p.w_in = (const float*)d_in[9]; p.ml_i_bias = (const float*)d_in[10];
  p.ml_f_bias = (const float*)d_in[11]; p.ml_norm_w = (const float*)d_in[12]; p.gd_conv_w = (const float*)d_in[13];
  p.gd_A_log = (const float*)d_in[14]; p.gd_dt_bias = (const float*)d_in[15]; p.gd_norm_w = (const float*)d_in[16];
  p.hg_lb_logits = (const float*)d_in[17]; p.hg_norm_w = (const float*)d_in[18]; p.w_branch = (const float*)d_in[19];
  p.w_out = (const float*)d_in[20]; p.norm2_w = (const float*)d_in[21]; p.w_up = (const float*)d_in[22];
  p.w_down = (const float*)d_in[23]; p.final_norm_w = (const float*)d_in[24];
  p.out = (float*)d_out;
  p.ws = (unsigned char*)d_ws;
  hipMemsetAsync((char*)d_ws + WS_BAR, 0, WS_BAR_BYTES, stream);
  void* args[] = {&p};
  hipError_t e = hipLaunchCooperativeKernel((const void*)mega_fwd, dim3(grid_blocks), dim3(NTHREADS), args, LDS_BYTES, stream);
  if (e != hipSuccess) fprintf(stderr, "cooperative launch failed: %s (grid %d)\n", hipGetErrorString(e), grid_blocks);
}
```

```cpp
#include <hip/hip_runtime.h>
#include <hip/hip_cooperative_groups.h>
#include <cstdio>
namespace cg = cooperative_groups;

typedef unsigned short u16;
using bf16x8 = __attribute__((ext_vector_type(8))) short;
using f32x4 = __attribute__((ext_vector_type(4))) float;
typedef float v2f __attribute__((ext_vector_type(2)));

#define DEVI __device__ __forceinline__

constexpr int D = 1024;
constexpr int MP = 16384, MS = 512, M = MP + MS;
constexpr int NPROJ = 6144, NPROJ_PAD = 6272;
constexpr int INC = 9232;
constexpr int DFF = 4096;
constexpr int NTHREADS = 512;
constexpr int LDS_BYTES = 132 * 1024;
constexpr int LDX = 1088, LDH = 4160, LDY = 1600, LDW1 = 1088, LDWB = 576, LDWD = 4160;

constexpr size_t OFF_Y = 0;
constexpr size_t OFF_P_MC = (size_t)M * D;
constexpr size_t OFF_P_MN = OFF_P_MC + 2ull * 8 * 4 * 128 * 128;
constexpr size_t OFF_P_MM = OFF_P_MN + 2ull * 8 * 4 * 128;
constexpr size_t OFF_P_GS = OFF_P_MM + 2ull * 8 * 4;
constexpr size_t OFF_P_GC = OFF_P_GS + 2ull * 8 * 4 * 128 * 128;
constexpr size_t OFF_P_HS = OFF_P_GC + 2ull * 8 * 3 * 1536;
constexpr size_t OFF_S_MC = OFF_P_HS + 2ull * 8 * 4 * 128 * 128;
constexpr size_t OFF_S_MN = OFF_S_MC + 2ull * 128 * 4 * 128 * 128;
constexpr size_t OFF_S_MM = OFF_S_MN + 2ull * 128 * 4 * 128;
constexpr size_t OFF_S_GS = OFF_S_MM + 2ull * 128 * 4;
constexpr size_t OFF_S_GC = OFF_S_GS + 2ull * 128 * 4 * 128 * 128;
constexpr size_t OFF_S_HS = OFF_S_GC + 2ull * 128 * 3 * 1536;
static_assert(OFF_S_HS + 2ull * 128 * 4 * 128 * 128 == 72172608ull, "output size");

constexpr size_t WS_WT_IN = 0;
constexpr size_t WS_WT_GATE = WS_WT_IN + 2ull * NPROJ_PAD * LDW1 * 2;
constexpr size_t WS_WT_BR = WS_WT_GATE + 2ull * 3072 * LDW1 * 2;
constexpr size_t WS_WT_OUT = WS_WT_BR + 2ull * 3 * 1024 * LDWB * 2;
constexpr size_t WS_WT_UP = WS_WT_OUT + 2ull * 1024 * LDW1 * 2;
constexpr size_t WS_WT_DN = WS_WT_UP + 2ull * 4096 * LDW1 * 2;
constexpr size_t WS_PROJ = WS_WT_DN + 2ull * 1024 * LDWD * 2;
constexpr size_t WS_CONV = WS_PROJ + (size_t)M * NPROJ * 2;
constexpr size_t WS_OBUF = WS_CONV + (size_t)M * 1536 * 2;
constexpr size_t WS_XN = WS_OBUF + (size_t)M * LDY * 2;
constexpr size_t WS_SMALL = WS_XN + (size_t)M * LDX * 2;
constexpr size_t WS_GATES = WS_SMALL;
constexpr size_t WS_DM = WS_GATES + (size_t)M * 16 * 4;
constexpr size_t WS_BAR = WS_DM + (size_t)M * 8 * 4;
constexpr size_t WS_BAR_BYTES = 16384;
constexpr size_t WS_END = WS_BAR + WS_BAR_BYTES;
static_assert(WS_END <= 439571584ull, "workspace budget");
static_assert((size_t)M * LDH * 2 <= (size_t)M * NPROJ * 2 && (size_t)M * LDX * 2 <= (size_t)M * 1536 * 2, "aliases fit");

struct Params {
  const float *x_prompt, *x_sample, *st_mC, *st_mn, *st_mm, *st_gS, *st_gconv, *st_hS;
  const float *norm1_w, *w_in, *ml_i_bias, *ml_f_bias, *ml_norm_w, *gd_conv_w, *gd_A_log, *gd_dt_bias,
      *gd_norm_w, *hg_lb_logits, *hg_norm_w, *w_branch, *w_out, *norm2_w, *w_up, *w_down, *final_norm_w;
  float* out;
  unsigned char* ws;
};

DEVI u16 f2bf(float f) { unsigned u = __float_as_uint(f); return (u16)((u + 0x7fffu + ((u >> 16) & 1u)) >> 16); }
DEVI unsigned pk2(float lo, float hi) { return (unsigned)f2bf(lo) | ((unsigned)f2bf(hi) << 16); }
DEVI float bflo(unsigned u) { return __uint_as_float(u << 16); }
DEVI float bfhi(unsigned u) { return __uint_as_float(u & 0xffff0000u); }
DEVI float sigm(float x) { return __builtin_amdgcn_rcpf(1.f + __expf(-x)); }
DEVI float silu(float x) { return x * sigm(x); }
DEVI float softplus(float x) { return fmaxf(x, 0.f) + __logf(1.f + __expf(-fabsf(x))); }
DEVI int otid() { int t = threadIdx.x; asm volatile("" : "+v"(t)); return t; }
DEVI float wave_sum(float v) {
#pragma unroll
  for (int o = 32; o > 0; o >>= 1) v += __shfl_xor(v, o);
  return v;
}
template <int CTRL> DEVI float dpp_f(float v) {
  return __int_as_float(__builtin_amdgcn_update_dpp(0, __float_as_int(v), CTRL, 0xf, 0xf, false));
}
DEVI float row16_sum(float v) {
  float r;
  asm("s_nop 1\n\tv_add_f32_dpp %0, %1, %1 row_ror:8 row_mask:0xf bank_mask:0xf" : "=v"(r) : "v"(v));
  asm("s_nop 1\n\tv_add_f32_dpp %0, %1, %1 row_ror:4 row_mask:0xf bank_mask:0xf" : "=v"(v) : "v"(r));
  asm("s_nop 1\n\tv_add_f32_dpp %0, %1, %1 row_ror:2 row_mask:0xf bank_mask:0xf" : "=v"(r) : "v"(v));
  asm("s_nop 1\n\tv_add_f32_dpp %0, %1, %1 row_ror:1 row_mask:0xf bank_mask:0xf" : "=v"(v) : "v"(r));
  return v;
}

DEVI void tr_seg(const float* __restrict__ src, int ld, int K, int ncols, u16* __restrict__ dst, int dld, float* tile, int& off) {
  const int tid_ = otid();
  const int lane = tid_ & 63, gw = blockIdx.x * 8 + (tid_ >> 6), nw = gridDim.x * 8;
  const int nkb = K >> 4, nnb = ncols >> 6, nt = nkb * nnb;
  const int start = (int)(((long)gw + (long)nw * 4096 - off) % nw);
  for (int t = start; t < nt; t += nw) {
    const int kb = t % nkb, nb = t / nkb;
    const float* sp = src + (size_t)(kb * 16) * ld + nb * 64 + lane;
    float v[16];
#pragma unroll
    for (int i = 0; i < 16; ++i) v[i] = sp[(size_t)i * ld];
    uint4 o0, o1;
    o0.x = pk2(v[0], v[1]); o0.y = pk2(v[2], v[3]); o0.z = pk2(v[4], v[5]); o0.w = pk2(v[6], v[7]);
    o1.x = pk2(v[8], v[9]); o1.y = pk2(v[10], v[11]); o1.z = pk2(v[12], v[13]); o1.w = pk2(v[14], v[15]);
    u16* dp = dst + (size_t)(nb * 64 + lane) * dld + kb * 16;
    *(uint4*)dp = o0;
    *(uint4*)(dp + 8) = o1;
  }
  off += nt;
}

DEVI void phase_wprep(const Params& p, float* tile) {
  int off = 0;
  u16* wt_in = (u16*)(p.ws + WS_WT_IN);
  u16* wt_gate = (u16*)(p.ws + WS_WT_GATE);
  u16* wt_br = (u16*)(p.ws + WS_WT_BR);
  u16* wt_out = (u16*)(p.ws + WS_WT_OUT);
  u16* wt_up = (u16*)(p.ws + WS_WT_UP);
  u16* wt_dn = (u16*)(p.ws + WS_WT_DN);
  for (int l = 0; l < 2; ++l) {
    const float* win = p.w_in + (size_t)l * 1024 * INC;
    for (int s = 0; s < 12; ++s) {
      const int srccol = (s < 4) ? s * 512 : (s < 8 ? 2056 + (s - 4) * 512 : 4112 + (s - 8) * 512);
      tr_seg(win + srccol, INC, 1024, 512, wt_in + ((size_t)l * NPROJ_PAD + s * 512) * LDW1, LDW1, tile, off);
    }
    tr_seg(win + 6160, INC, 1024, 3072, wt_gate + (size_t)l * 3072 * LDW1, LDW1, tile, off);
    for (int b = 0; b < 3; ++b)
      tr_seg(p.w_branch + (size_t)(l * 3 + b) * 512 * 1024, 1024, 512, 1024, wt_br + (size_t)(l * 3 + b) * 1024 * LDWB, LDWB, tile, off);
    tr_seg(p.w_out + (size_t)l * 1024 * 1024, 1024, 1024, 1024, wt_out + (size_t)l * 1024 * LDW1, LDW1, tile, off);
    tr_seg(p.w_up + (size_t)l * 1024 * 4096, 4096, 1024, 4096, wt_up + (size_t)l * 4096 * LDW1, LDW1, tile, off);
    tr_seg(p.w_down + (size_t)l * 4096 * 1024, 1024, 4096, 1024, wt_dn + (size_t)l * 1024 * LDWD, LDWD, tile, off);
  }
  for (int idx = blockIdx.x * NTHREADS + otid(); idx < 2 * 128 * 1024; idx += gridDim.x * NTHREADS) {
    const int l = idx >> 17, rem = idx & 131071, r = rem >> 10, k = rem & 1023;
    float v = 0.f;
    if (r < 16) {
      const int sc = (r < 8) ? 2048 + r : 4104 + (r - 8);
      v = p.w_in[(size_t)l * 1024 * INC + (size_t)k * INC + sc];
    }
    wt_in[((size_t)l * NPROJ_PAD + 6144 + r) * LDW1 + k] = f2bf(v);
  }
}

DEVI void phase_norm(const float* xp, const float* xs, const float* __restrict__ w, u16* __restrict__ xn) {
  const int tid_ = otid(); const int lane = tid_ & 63, gw = blockIdx.x * 8 + (tid_ >> 6), nw = gridDim.x * 8;
  for (int m = gw; m < M; m += nw) {
    const float* xr = (m < MP) ? xp + (size_t)m * D : xs + (size_t)(m - MP) * D;
    float4 v[4];
    float ss = 0.f;
#pragma unroll
    for (int i = 0; i < 4; ++i) {
      v[i] = ((const float4*)xr)[lane + 64 * i];
      ss += v[i].x * v[i].x + v[i].y * v[i].y + v[i].z * v[i].z + v[i].w * v[i].w;
    }
    ss = wave_sum(ss);
    const float rstd = rsqrtf(ss * (1.f / 1024.f) + 1e-6f);
#pragma unroll
    for (int i = 0; i < 4; ++i) {
      const float4 wv = ((const float4*)w)[lane + 64 * i];
      uint2 o;
      o.x = pk2(v[i].x * rstd * wv.x, v[i].y * rstd * wv.y);
      o.y = pk2(v[i].z * rstd * wv.z, v[i].w * rstd * wv.w);
      ((uint2*)(xn + (size_t)m * LDX))[lane + 64 * i] = o;
    }
  }
}

DEVI void phase_final_norm(float* x, const float* __restrict__ w) {
  const int tid_ = otid(); const int lane = tid_ & 63, gw = blockIdx.x * 8 + (tid_ >> 6), nw = gridDim.x * 8;
  for (int m = gw; m < M; m += nw) {
    float* xr = x + (size_t)m * D;
    float4 v[4];
    float ss = 0.f;
#pragma unroll
    for (int i = 0; i < 4; ++i) {
      v[i] = ((const float4*)xr)[lane + 64 * i];
      ss += v[i].x * v[i].x + v[i].y * v[i].y + v[i].z * v[i].z + v[i].w * v[i].w;
    }
    ss = wave_sum(ss);
    const float rstd = rsqrtf(ss * (1.f / 1024.f) + 1e-6f);
#pragma unroll
    for (int i = 0; i < 4; ++i) {
      const float4 wv = ((const float4*)w)[lane + 64 * i];
      float4 o;
      o.x = v[i].x * rstd * wv.x; o.y = v[i].y * rstd * wv.y; o.z = v[i].z * rstd * wv.z; o.w = v[i].w * rstd * wv.w;
      ((float4*)xr)[lane + 64 * i] = o;
    }
  }
}

constexpr int LDS_S = 64;

struct GemmOp { const u16* A; const u16* B; int lda, ldb, K, koff; };

DEVI bool tile_map(int it, int vcu, int MT, int NT, int& mt, int& nt) {
  const int G = gridDim.x;
  const int t = it * G + vcu;
  if (t >= MT * NT) return false;
  constexpr int GM = 4;
  const int gsize = GM * NT;
  const int g = t / gsize, tl = t - g * gsize;
  int gsz = MT - g * GM;
  if (gsz > GM) gsz = GM;
  mt = g * GM + (tl % gsz);
  nt = tl / gsz;
  return true;
}
DEVI int koff_of(int mt, int nt) { return (nt & 7) + 2 * (mt & 3); }

template <int WMT, int WNT>
DEVI void zero_acc(f32x4 (&acc)[WMT][WNT]) {
#pragma unroll
  for (int i = 0; i < WMT; ++i)
#pragma unroll
    for (int j = 0; j < WNT; ++j) acc[i][j] = f32x4{0.f, 0.f, 0.f, 0.f};
}

#define PF_PARAMS uint4 &pa0, uint4 &pa1, uint4 &pa2, uint4 &pa3, uint4 &pb0, uint4 &pb1, uint4 &qa0, uint4 &qa1, uint4 &qa2, uint4 &qa3, uint4 &qb0, uint4 &qb1
#define PF_ARGS pa0, pa1, pa2, pa3, pb0, pb1, qa0, qa1, qa2, qa3, qb0, qb1
#define PF_DECL uint4 pa0 = uint4{0, 0, 0, 0}, pa1 = pa0, pa2 = pa0, pa3 = pa0, pb0 = pa0, pb1 = pa0, qa0 = pa0, qa1 = pa0, qa2 = pa0, qa3 = pa0, qb0 = pa0, qb1 = pa0
template <int WMT, int WNT>
DEVI void gemm_core(const GemmOp cur, const GemmOp nxt, bool primed, PF_PARAMS, f32x4 (&acc)[WMT][WNT], u16* smem) {
  constexpr int BM = 64 * WMT, BN = 32 * WNT;
  constexpr int ACH = BM * 8 / NTHREADS, BCH = BN * 8 / NTHREADS;
  static_assert(BCH == 2 && (ACH == 2 || ACH == 4), "chunk counts");
  u16* sA = smem;
  u16* sB = smem + 2 * BM * LDS_S;
  const int tid = otid(), lane = tid & 63, w = tid >> 6, wm = w >> 1, wn = w & 1;
  const int fr = lane & 15, fq = lane >> 4;
  const int crow = tid >> 3, ckc = tid & 7;
  const int wsw = (ckc ^ (crow & 7)) * 8;
  const int rsw0 = (fq ^ (fr & 7)) * 8;
  const u16* Ag = cur.A + (size_t)crow * cur.lda + ckc * 8;
  const u16* Bg = cur.B + (size_t)crow * cur.ldb + ckc * 8;
  const int nk = cur.K >> 6, km = nk - 1, kmn = (nxt.K >> 6) - 1;
#define GLOADX(S, AP, BP, LA, LB, KO)                                                 \
  do {                                                                                \
    S##a0 = *(const uint4*)((AP) + (KO));                                           \
    S##a1 = *(const uint4*)((AP) + (size_t)64 * (LA) + (KO));                       \
    if (ACH == 4) {                                                                   \
      S##a2 = *(const uint4*)((AP) + (size_t)128 * (LA) + (KO));                    \
      S##a3 = *(const uint4*)((AP) + (size_t)192 * (LA) + (KO));                    \
    }                                                                                 \
    S##b0 = *(const uint4*)((BP) + (KO));                                           \
    S##b1 = *(const uint4*)((BP) + (size_t)64 * (LB) + (KO));                       \
  } while (0)
#define GLOADC(S, T) GLOADX(S, Ag, Bg, cur.lda, cur.ldb, ((((T) + cur.koff) & km) * 64))
#define GLOADN(S, T) GLOADX(S, An, Bn, nxt.lda, nxt.ldb, ((((T) + nxt.koff) & kmn) * 64))
#define SSTORE(S, NB)                                                                 \
  do {                                                                                \
    u16* dA = sA + ((NB) * BM + crow) * LDS_S + wsw;                                  \
    u16* dB = sB + ((NB) * BN + crow) * LDS_S + wsw;                                  \
    *(uint4*)(dA) = S##a0;                                                          \
    *(uint4*)(dA + 64 * LDS_S) = S##a1;                                             \
    if (ACH == 4) {                                                                   \
      *(uint4*)(dA + 128 * LDS_S) = S##a2;                                          \
      *(uint4*)(dA + 192 * LDS_S) = S##a3;                                          \
    }                                                                                 \
    *(uint4*)(dB) = S##b0;                                                          \
    *(uint4*)(dB + 64 * LDS_S) = S##b1;                                             \
  } while (0)
#define LOADFR(BUF)                                                                   \
  do {                                                                                \
    const u16* cA = sA + ((BUF) * BM + wm * 16 * WMT + fr) * LDS_S;                   \
    const u16* cB = sB + ((BUF) * BN + wn * 16 * WNT + fr) * LDS_S;                   \
    _Pragma("unroll") for (int ks = 0; ks < 2; ++ks) {                                \
      const int so = rsw0 ^ (ks * 32);                                                \
      _Pragma("unroll") for (int i = 0; i < WMT; ++i) af[ks][i] = *(const bf16x8*)(cA + i * 16 * LDS_S + so);  \
      _Pragma("unroll") for (int j = 0; j < WNT; ++j) bfr[ks][j] = *(const bf16x8*)(cB + j * 16 * LDS_S + so); \
    }                                                                                 \
  } while (0)
#define MFMAS()                                                                       \
  do {                                                                                \
    _Pragma("unroll") for (int ks = 0; ks < 2; ++ks)                                  \
      _Pragma("unroll") for (int i = 0; i < WMT; ++i)                                 \
        _Pragma("unroll") for (int j = 0; j < WNT; ++j)                               \
          acc[i][j] = __builtin_amdgcn_mfma_f32_16x16x32_bf16(bfr[ks][j], af[ks][i], acc[i][j], 0, 0, 0);  \
  } while (0)
#define HALF(BUF, SS, LOADSTMT)                                                       \
  do {                                                                                \
    LOADFR(BUF);                                                                      \
    __builtin_amdgcn_sched_barrier(0);                                                \
    SSTORE(SS, (BUF) ^ 1);                                                            \
    LOADSTMT;                                                                         \
    __builtin_amdgcn_sched_barrier(0);                                                \
    MFMAS();                                                                          \
    __builtin_amdgcn_sched_barrier(0);                                                \
    __syncthreads();                                                                  \
  } while (0)
  bf16x8 af[2][WMT], bfr[2][WNT];
  if (!primed) {
    GLOADC(p, 0);
    SSTORE(p, 0);
    __builtin_amdgcn_sched_barrier(0);
    GLOADC(q, 1);
    __builtin_amdgcn_sched_barrier(0);
    GLOADC(p, 2);
    __builtin_amdgcn_sched_barrier(0);
    __syncthreads();
  }
#pragma unroll 1
  for (int kt = 0; kt + 4 < nk; kt += 2) {
    HALF(0, q, GLOADC(q, kt + 3));
    HALF(1, p, GLOADC(p, kt + 4));
  }
  HALF(0, q, GLOADC(q, nk - 1));
  const u16* An = nxt.A + (size_t)crow * nxt.lda + ckc * 8;
  const u16* Bn = nxt.B + (size_t)crow * nxt.ldb + ckc * 8;
  HALF(1, p, GLOADN(p, 0));
  HALF(0, q, GLOADN(q, 1));
  HALF(1, p, GLOADN(p, 2));
#undef GLOADX
#undef GLOADC
#undef GLOADN
#undef SSTORE
#undef LOADFR
#undef MFMAS
#undef HALF
}

#define PFB_PARAMS uint4 &pa0, uint4 &pa1, uint4 &pa2, uint4 &pa3, uint4 &pb0, uint4 &pb1, uint4 &pb2, uint4 &pb3
#define PFB_ARGS pa0, pa1, pa2, pa3, pb0, pb1, pb2, pb3
#define PFB_DECL uint4 pa0 = uint4{0, 0, 0, 0}, pa1 = pa0, pa2 = pa0, pa3 = pa0, pb0 = pa0, pb1 = pa0, pb2 = pa0, pb3 = pa0
template <int NBH>
DEVI void gemm_core_bigT(const GemmOp cur, const GemmOp nxt, bool primed, PFB_PARAMS, f32x4 (&acc)[4][4 * NBH], u16* smem) {
  constexpr int BNT = 128 * NBH;
  u16* sA = smem;
  u16* sB = smem + 2 * 256 * LDS_S;
  const int tid = otid(), lane = tid & 63, w = tid >> 6, wm = w >> 1, wn = w & 1;
  const int fr = lane & 15, fq = lane >> 4;
  const int crow = tid >> 3, ckc = tid & 7;
  const int wsw = (ckc ^ (crow & 7)) * 8;
  const int rsw0 = (fq ^ (fr & 7)) * 8;
  const u16* Ag = cur.A + (size_t)crow * cur.lda + ckc * 8;
  const u16* Bg = cur.B + (size_t)crow * cur.ldb + ckc * 8;
  const int nk = cur.K >> 6, km = nk - 1, kmn = (nxt.K >> 6) - 1;
#define BGLOADX(AP, BP, LA, LB, KO)                                                   \
  do {                                                                                \
    pa0 = *(const uint4*)((AP) + (KO));                                             \
    pa1 = *(const uint4*)((AP) + (size_t)64 * (LA) + (KO));                         \
    pa2 = *(const uint4*)((AP) + (size_t)128 * (LA) + (KO));                        \
    pa3 = *(const uint4*)((AP) + (size_t)192 * (LA) + (KO));                        \
    pb0 = *(const uint4*)((BP) + (KO));                                             \
    pb1 = *(const uint4*)((BP) + (size_t)64 * (LB) + (KO));                         \
    if (NBH == 2) {                                                                   \
      pb2 = *(const uint4*)((BP) + (size_t)128 * (LB) + (KO));                      \
      pb3 = *(const uint4*)((BP) + (size_t)192 * (LB) + (KO));                      \
    }                                                                                 \
  } while (0)
#define BGLOADC(T) BGLOADX(Ag, Bg, cur.lda, cur.ldb, ((((T) + cur.koff) & km) * 64))
#define BGLOADN(T) BGLOADX(An, Bn, nxt.lda, nxt.ldb, ((((T) + nxt.koff) & kmn) * 64))
#define BSSTORE(NB)                                                                   \
  do {                                                                                \
    u16* dA = sA + ((NB) * 256 + crow) * LDS_S + wsw;                                 \
    u16* dB = sB + ((NB) * BNT + crow) * LDS_S + wsw;                                 \
    *(uint4*)(dA) = pa0;                                                            \
    *(uint4*)(dA + 64 * LDS_S) = pa1;                                               \
    *(uint4*)(dA + 128 * LDS_S) = pa2;                                              \
    *(uint4*)(dA + 192 * LDS_S) = pa3;                                              \
    *(uint4*)(dB) = pb0;                                                            \
    *(uint4*)(dB + 64 * LDS_S) = pb1;                                               \
    if (NBH == 2) {                                                                   \
      *(uint4*)(dB + 128 * LDS_S) = pb2;                                            \
      *(uint4*)(dB + 192 * LDS_S) = pb3;                                            \
    }                                                                                 \
  } while (0)
#define BLOADFR(BUF, KS)                                                              \
  do {                                                                                \
    const u16* cA = sA + ((BUF) * 256 + wm * 64 + fr) * LDS_S + (rsw0 ^ ((KS) * 32)); \
    const u16* cB = sB + ((BUF) * BNT + wn * (64 * NBH) + fr) * LDS_S + (rsw0 ^ ((KS) * 32)); \
    _Pragma("unroll") for (int i = 0; i < 4; ++i) af[i] = *(const bf16x8*)(cA + i * 16 * LDS_S);  \
    _Pragma("unroll") for (int j = 0; j < 4; ++j) bfr[j] = *(const bf16x8*)(cB + j * 16 * LDS_S); \
  } while (0)
#define BLOADB2(BUF, KS)                                                              \
  do {                                                                                \
    const u16* cB = sB + ((BUF) * BNT + wn * (64 * NBH) + 64 + fr) * LDS_S + (rsw0 ^ ((KS) * 32)); \
    _Pragma("unroll") for (int j = 0; j < 4; ++j) bfr[j] = *(const bf16x8*)(cB + j * 16 * LDS_S); \
  } while (0)
#define BMFMAS(JO)                                                                    \
  do {                                                                                \
    _Pragma("unroll") for (int i = 0; i < 4; ++i)                                     \
      _Pragma("unroll") for (int j = 0; j < 4; ++j)                                   \
        acc[i][(JO) + j] = __builtin_amdgcn_mfma_f32_16x16x32_bf16(bfr[j], af[i], acc[i][(JO) + j], 0, 0, 0);  \
  } while (0)
#define BHALF(BUF, LOADSTMT)                                                          \
  do {                                                                                \
    BLOADFR(BUF, 0);                                                                  \
    __builtin_amdgcn_sched_barrier(0);                                                \
    BSSTORE((BUF) ^ 1);                                                               \
    LOADSTMT;                                                                         \
    __builtin_amdgcn_sched_barrier(0);                                                \
    BMFMAS(0);                                                                        \
    __builtin_amdgcn_sched_barrier(0);                                                \
    if (NBH == 2) {                                                                   \
      BLOADB2(BUF, 0);                                                                \
      __builtin_amdgcn_sched_barrier(0);                                              \
      BMFMAS(4 * (NBH - 1));                                                          \
      __builtin_amdgcn_sched_barrier(0);                                              \
    }                                                                                 \
    BLOADFR(BUF, 1);                                                                  \
    __builtin_amdgcn_sched_barrier(0);                                                \
    BMFMAS(0);                                                                        \
    __builtin_amdgcn_sched_barrier(0);                                                \
    if (NBH == 2) {                                                                   \
      BLOADB2(BUF, 1);                                                                \
      __builtin_amdgcn_sched_barrier(0);                                              \
      BMFMAS(4 * (NBH - 1));                                                          \
      __builtin_amdgcn_sched_barrier(0);                                              \
    }                                                                                 \
    __syncthreads();                                                                  \
  } while (0)
  bf16x8 af[4], bfr[4];
  if (!primed) {
    BGLOADC(0);
    BSSTORE(0);
    __builtin_amdgcn_sched_barrier(0);
    BGLOADC(1);
    __builtin_amdgcn_sched_barrier(0);
    __syncthreads();
  }
#pragma unroll 1
  for (int kt = 0; kt + 2 < nk; kt += 2) {
    BHALF(0, BGLOADC(kt + 2));
    BHALF(1, BGLOADC(kt + 3));
  }
  const u16* An = nxt.A + (size_t)crow * nxt.lda + ckc * 8;
  const u16* Bn = nxt.B + (size_t)crow * nxt.ldb + ckc * 8;
  BHALF(0, BGLOADN(0));
  BHALF(1, BGLOADN(1));
#undef BGLOADX
#undef BGLOADC
#undef BGLOADN
#undef BSSTORE
#undef BLOADFR
#undef BLOADB2
#undef BMFMAS
#undef BHALF
}
DEVI void gemm_core_big(const GemmOp cur, const GemmOp nxt, bool primed, PFB_PARAMS, f32x4 (&acc)[4][8], u16* smem) {
  gemm_core_bigT<2>(cur, nxt, primed, PFB_ARGS, acc, smem);
}

DEVI void phase_proj(const Params& p, int l, int vcu, u16* smem) {
  const u16* xn = (const u16*)(p.ws + WS_XN);
  const u16* wt = (const u16*)(p.ws + WS_WT_IN) + (size_t)l * NPROJ_PAD * LDW1;
  u16* proj = (u16*)(p.ws + WS_PROJ);
  float* small = (float*)(p.ws + WS_SMALL);
  constexpr int NT = 25, MT = M / 256;
  PFB_DECL;
  int mt, nt;
  bool have = tile_map(0, vcu, MT, NT, mt, nt);
  for (int it = 0; have; ++it) {
    const int m0 = mt * 256, n0 = nt * 256;
    const GemmOp cur{xn + (size_t)m0 * LDX, wt + (size_t)n0 * LDW1, LDX, LDW1, 1024, koff_of(mt, nt)};
    int mtn, ntn;
    const bool haven = tile_map(it + 1, vcu, MT, NT, mtn, ntn);
    GemmOp nxt = cur;
    if (haven) { nxt.A = xn + (size_t)(mtn * 256) * LDX; nxt.B = wt + (size_t)(ntn * 256) * LDW1; nxt.koff = koff_of(mtn, ntn); }
    f32x4 acc[4][8];
    zero_acc(acc);
    gemm_core_big(cur, nxt, it > 0, PFB_ARGS, acc, smem);
    const int tid_ = otid(); const int lane = tid_ & 63, w = tid_ >> 6, wm = w >> 1, wn = w & 1, fr = lane & 15, fq = lane >> 4;
#pragma unroll
    for (int i = 0; i < 4; ++i)
#pragma unroll
      for (int j = 0; j < 8; ++j) {
        const int m = m0 + wm * 64 + i * 16 + fr, n = n0 + wn * 128 + j * 16 + fq * 4;
        if (n < NPROJ) {
          uint2 o;
          o.x = pk2(acc[i][j][0], acc[i][j][1]);
          o.y = pk2(acc[i][j][2], acc[i][j][3]);
          *(uint2*)(proj + (size_t)m * NPROJ + n) = o;
        } else if (n < NPROJ + 16) {
          *(float4*)(small + (size_t)m * 16 + (n - NPROJ)) = float4{acc[i][j][0], acc[i][j][1], acc[i][j][2], acc[i][j][3]};
        }
      }
    have = haven; mt = mtn; nt = ntn;
  }
}

DEVI void phase_up(const Params& p, int l, int vcu, u16* smem) {
  const u16* xn = (const u16*)(p.ws + WS_XN);
  const u16* wt = (const u16*)(p.ws + WS_WT_UP) + (size_t)l * 4096 * LDW1;
  u16* hid = (u16*)(p.ws + WS_PROJ);
  constexpr int NT = DFF / 256, MT = M / 256;
  PFB_DECL;
  int mt, nt;
  bool have = tile_map(0, vcu, MT, NT, mt, nt);
  for (int it = 0; have; ++it) {
    const int m0 = mt * 256, n0 = nt * 256;
    const GemmOp cur{xn + (size_t)m0 * LDX, wt + (size_t)n0 * LDW1, LDX, LDW1, 1024, koff_of(mt, nt)};
    int mtn, ntn;
    const bool haven = tile_map(it + 1, vcu, MT, NT, mtn, ntn);
    GemmOp nxt = cur;
    if (haven) { nxt.A = xn + (size_t)(mtn * 256) * LDX; nxt.B = wt + (size_t)(ntn * 256) * LDW1; nxt.koff = koff_of(mtn, ntn); }
    f32x4 acc[4][8];
    zero_acc(acc);
    gemm_core_big(cur, nxt, it > 0, PFB_ARGS, acc, smem);
    const int tid_ = otid(); const int lane = tid_ & 63, w = tid_ >> 6, wm = w >> 1, wn = w & 1, fr = lane & 15, fq = lane >> 4;
#pragma unroll
    for (int i = 0; i < 4; ++i)
#pragma unroll
      for (int j = 0; j < 8; ++j) {
        const int m = m0 + wm * 64 + i * 16 + fr, n = n0 + wn * 128 + j * 16 + fq * 4;
        float r0 = fmaxf(acc[i][j][0], 0.f), r1 = fmaxf(acc[i][j][1], 0.f), r2 = fmaxf(acc[i][j][2], 0.f), r3 = fmaxf(acc[i][j][3], 0.f);
        uint2 o;
        o.x = pk2(r0 * r0, r1 * r1);
        o.y = pk2(r2 * r2, r3 * r3);
        *(uint2*)(hid + (size_t)m * LDH + n) = o;
      }
    have = haven; mt = mtn; nt = ntn;
  }
}

DEVI void merge_sample_rows(const Params& p, int l, int vcu, u16* smem) {
  const u16* xn = (const u16*)(p.ws + WS_XN);
  const u16* y = (const u16*)(p.ws + WS_OBUF);
  const u16* wg = (const u16*)(p.ws + WS_WT_GATE) + (size_t)l * 3072 * LDW1;
  const u16* wb = (const u16*)(p.ws + WS_WT_BR) + (size_t)l * 3 * 1024 * LDWB;
  u16* merged = (u16*)(p.ws + WS_CONV);
  const int tid_ = otid(); const int lane = tid_ & 63, w = tid_ >> 6, wm = w >> 1, wn = w & 1, fr = lane & 15, fq = lane >> 4;
  constexpr int NT = D / 128, MT = MS / 128;
  PF_DECL;
  int mt, nt;
  bool have = tile_map(0, vcu, MT, NT, mt, nt);
  for (int it = 0; have; ++it) {
    const int m0 = MP + mt * 128, n0 = nt * 128;
    const int ko = koff_of(mt, nt);
    int mtn, ntn;
    const bool haven = tile_map(it + 1, vcu, MT, NT, mtn, ntn);
    f32x4 accM[2][4];
    zero_acc(accM);
#pragma unroll 1
    for (int b = 0; b < 3; ++b) {
      f32x4 accG[2][4], accB[2][4];
      zero_acc(accG);
      const GemmOp gate{xn + (size_t)m0 * LDX, wg + ((size_t)b * 1024 + n0) * LDW1, LDX, LDW1, 1024, ko};
      const GemmOp br{y + (size_t)m0 * LDY + b * 512, wb + ((size_t)b * 1024 + n0) * LDWB, LDY, LDWB, 512, ko};
      GemmOp after = gate;
      if (b < 2) {
        after.B = wg + ((size_t)(b + 1) * 1024 + n0) * LDW1;
      } else if (haven) {
        after.A = xn + (size_t)(MP + mtn * 128) * LDX;
        after.B = wg + (size_t)(ntn * 128) * LDW1;
        after.koff = koff_of(mtn, ntn);
      }
      gemm_core<2, 4>(gate, br, (it > 0) || (b > 0), PF_ARGS, accG, smem);
      unsigned gpk[2][4][2];
#pragma unroll
      for (int i = 0; i < 2; ++i)
#pragma unroll
        for (int j = 0; j < 4; ++j) {
          gpk[i][j][0] = pk2(sigm(accG[i][j][0]), sigm(accG[i][j][1]));
          gpk[i][j][1] = pk2(sigm(accG[i][j][2]), sigm(accG[i][j][3]));
        }
      zero_acc(accB);
      gemm_core<2, 4>(br, after, true, PF_ARGS, accB, smem);
#pragma unroll
      for (int i = 0; i < 2; ++i)
#pragma unroll
        for (int j = 0; j < 4; ++j) {
          accM[i][j][0] += bflo(gpk[i][j][0]) * accB[i][j][0];
          accM[i][j][1] += bfhi(gpk[i][j][0]) * accB[i][j][1];
          accM[i][j][2] += bflo(gpk[i][j][1]) * accB[i][j][2];
          accM[i][j][3] += bfhi(gpk[i][j][1]) * accB[i][j][3];
        }
    }
#pragma unroll
    for (int i = 0; i < 2; ++i)
#pragma unroll
      for (int j = 0; j < 4; ++j) {
        const int m = m0 + wm * 32 + i * 16 + fr, n = n0 + wn * 64 + j * 16 + fq * 4;
        uint2 o;
        o.x = pk2(accM[i][j][0], accM[i][j][1]);
        o.y = pk2(accM[i][j][2], accM[i][j][3]);
        *(uint2*)(merged + (size_t)m * LDX + n) = o;
      }
    have = haven; mt = mtn; nt = ntn;
  }
}

DEVI void phase_merge(const Params& p, int l, int vcu, u16* smem) {
  const u16* xn = (const u16*)(p.ws + WS_XN);
  const u16* y = (const u16*)(p.ws + WS_OBUF);
  const u16* wg = (const u16*)(p.ws + WS_WT_GATE) + (size_t)l * 3072 * LDW1;
  const u16* wb = (const u16*)(p.ws + WS_WT_BR) + (size_t)l * 3 * 1024 * LDWB;
  u16* merged = (u16*)(p.ws + WS_CONV);
  constexpr int NT = D / 128, MT = MP / 256;
  PFB_DECL;
  int mt, nt;
  bool have = tile_map(0, vcu, MT, NT, mt, nt);
  for (int it = 0; have; ++it) {
    const int m0 = mt * 256, n0 = nt * 128;
    const int ko = koff_of(mt, nt);
    int mtn, ntn;
    const bool haven = tile_map(it + 1, vcu, MT, NT, mtn, ntn);
    unsigned mpk[4][4][2];
#pragma unroll
    for (int i = 0; i < 4; ++i)
#pragma unroll
      for (int j = 0; j < 4; ++j) { mpk[i][j][0] = 0u; mpk[i][j][1] = 0u; }
#pragma unroll 1
    for (int b = 0; b < 3; ++b) {
      const GemmOp gate{xn + (size_t)m0 * LDX, wg + ((size_t)b * 1024 + n0) * LDW1, LDX, LDW1, 1024, ko};
      const GemmOp br{y + (size_t)m0 * LDY + b * 512, wb + ((size_t)b * 1024 + n0) * LDWB, LDY, LDWB, 512, ko};
      GemmOp after = gate;
      if (b < 2) {
        after.B = wg + ((size_t)(b + 1) * 1024 + n0) * LDW1;
      } else if (haven) {
        after.A = xn + (size_t)(mtn * 256) * LDX;
        after.B = wg + (size_t)(ntn * 128) * LDW1;
        after.koff = koff_of(mtn, ntn);
      }
      unsigned gpk[4][4][2];
      {
        f32x4 accG[4][4];
        zero_acc(accG);
        gemm_core_bigT<1>(gate, br, (it > 0) || (b > 0), PFB_ARGS, accG, smem);
#pragma unroll
        for (int i = 0; i < 4; ++i)
#pragma unroll
          for (int j = 0; j < 4; ++j) {
            gpk[i][j][0] = pk2(sigm(accG[i][j][0]), sigm(accG[i][j][1]));
            gpk[i][j][1] = pk2(sigm(accG[i][j][2]), sigm(accG[i][j][3]));
            asm volatile("" : "+v"(gpk[i][j][0]), "+v"(gpk[i][j][1]));
          }
      }
      {
        f32x4 accB[4][4];
        zero_acc(accB);
        gemm_core_bigT<1>(br, after, true, PFB_ARGS, accB, smem);
#pragma unroll
        for (int i = 0; i < 4; ++i)
#pragma unroll
          for (int j = 0; j < 4; ++j) {
            mpk[i][j][0] = pk2(bflo(mpk[i][j][0]) + bflo(gpk[i][j][0]) * accB[i][j][0], bfhi(mpk[i][j][0]) + bfhi(gpk[i][j][0]) * accB[i][j][1]);
            mpk[i][j][1] = pk2(bflo(mpk[i][j][1]) + bflo(gpk[i][j][1]) * accB[i][j][2], bfhi(mpk[i][j][1]) + bfhi(gpk[i][j][1]) * accB[i][j][3]);
            asm volatile("" : "+v"(mpk[i][j][0]), "+v"(mpk[i][j][1]));
          }
      }
    }
    const int tid_ = otid(); const int lane = tid_ & 63, w = tid_ >> 6, wm = w >> 1, wn = w & 1, fr = lane & 15, fq = lane >> 4;
#pragma unroll
    for (int i = 0; i < 4; ++i)
#pragma unroll
      for (int j = 0; j < 4; ++j) {
        const int m = m0 + wm * 64 + i * 16 + fr, n = n0 + wn * 64 + j * 16 + fq * 4;
        *(uint2*)(merged + (size_t)m * LDX + n) = uint2{mpk[i][j][0], mpk[i][j][1]};
      }
    have = haven; mt = mtn; nt = ntn;
  }
  merge_sample_rows(p, l, vcu, smem);
}

DEVI void phase_resid(const u16* A, int lda, int K, const u16* wt, int ldb, const float* xin_p, const float* xin_s, float* xout, int vcu, u16* smem) {
  for (int t = vcu; t < 256; t += gridDim.x) {
    PFB_DECL;
    int mt, nt;
    tile_map(0, t, 64, 4, mt, nt);
    const int m0 = mt * 256, n0 = nt * 256;
    const GemmOp cur{A + (size_t)m0 * lda, wt + (size_t)n0 * ldb, lda, ldb, K, koff_of(mt, nt)};
    f32x4 acc[4][8];
    zero_acc(acc);
    gemm_core_big(cur, cur, false, PFB_ARGS, acc, smem);
    const int tid_ = otid(); const int lane = tid_ & 63, w = tid_ >> 6, wm = w >> 1, wn = w & 1, fr = lane & 15, fq = lane >> 4;
#pragma unroll
    for (int i = 0; i < 4; ++i)
#pragma unroll
      for (int j = 0; j < 8; ++j) {
        const int m = m0 + wm * 64 + i * 16 + fr, n = n0 + wn * 128 + j * 16 + fq * 4;
        const float4 xv = *(const float4*)(xin_p + (size_t)m * D + n);
        float4 o;
        o.x = xv.x + acc[i][j][0]; o.y = xv.y + acc[i][j][1]; o.z = xv.z + acc[i][j][2]; o.w = xv.w + acc[i][j][3];
        *(float4*)(xout + (size_t)m * D + n) = o;
        if ((j & 1) == 1) __builtin_amdgcn_sched_barrier(0);
      }
  }
  {
    PF_DECL;
    bool first = true;
    for (int t = vcu; t < 32; t += gridDim.x) {
      const int mt = (MP / 128) + (t >> 3), nt = t & 7;
      const int m0 = mt * 128, n0 = nt * 128;
      const GemmOp cur{A + (size_t)m0 * lda, wt + (size_t)n0 * ldb, lda, ldb, K, koff_of(mt, nt)};
      f32x4 acc[2][4];
      zero_acc(acc);
      gemm_core<2, 4>(cur, cur, !first, PF_ARGS, acc, smem);
      const int tid_ = otid(); const int lane = tid_ & 63, w = tid_ >> 6, wm = w >> 1, wn = w & 1, fr = lane & 15, fq = lane >> 4;
      first = false;
#pragma unroll
      for (int i = 0; i < 2; ++i)
#pragma unroll
        for (int j = 0; j < 4; ++j) {
          const int m = m0 + wm * 32 + i * 16 + fr, n = n0 + wn * 64 + j * 16 + fq * 4;
          const float4 xv = *(const float4*)(xin_s + (size_t)(m - MP) * D + n);
          float4 o;
          o.x = xv.x + acc[i][j][0]; o.y = xv.y + acc[i][j][1]; o.z = xv.z + acc[i][j][2]; o.w = xv.w + acc[i][j][3];
          *(float4*)(xout + (size_t)m * D + n) = o;
        }
    }
  }
}

DEVI void unpack8(const uint4 u, float (&f)[8]) {
  f[0] = bflo(u.x); f[1] = bfhi(u.x); f[2] = bflo(u.y); f[3] = bfhi(u.y);
  f[4] = bflo(u.z); f[5] = bfhi(u.z); f[6] = bflo(u.w); f[7] = bfhi(u.w);
}
DEVI uint4 pack8(const float (&f)[8]) {
  uint4 r;
  r.x = pk2(f[0], f[1]); r.y = pk2(f[2], f[3]); r.z = pk2(f[4], f[5]); r.w = pk2(f[6], f[7]);
  return r;
}
DEVI void load8f(const float* p, float (&f)[8]) {
  const float4 a = *(const float4*)p, b = *(const float4*)(p + 4);
  f[0] = a.x; f[1] = a.y; f[2] = a.z; f[3] = a.w; f[4] = b.x; f[5] = b.y; f[6] = b.z; f[7] = b.w;
}
DEVI void phase_prep(const Params& p, int l) {
  const int tid_ = otid(); const int lane = tid_ & 63, gw = blockIdx.x * 8 + (tid_ >> 6), nw = gridDim.x * 8;
  u16* proj = (u16*)(p.ws + WS_PROJ);
  u16* conv = (u16*)(p.ws + WS_CONV);
  const float* small = (const float*)(p.ws + WS_SMALL);
  float* gates = (float*)(p.ws + WS_GATES);
  constexpr int NTASK = (M / 4) * 6;
  for (int task = gw; task < NTASK; task += nw) {
    const int tg = task / 6, k = task - tg * 6;
    const int m0 = tg * 4;
    const bool samp = m0 >= MP;
    int b, t0;
    if (!samp) { b = m0 >> 11; t0 = m0 & 2047; } else { b = (m0 - MP) >> 2; t0 = 0; }
    if (k < 3) {
      const int pp = k;
      const int ch = pp * 512 + lane * 8;
      const u16* src = proj + 2048 + ch;
      float r[7][8], cw[4][8];
#pragma unroll
      for (int j = 0; j < 7; ++j) {
        const int t = t0 - 3 + j;
        if (t >= 0) {
          unpack8(*(const uint4*)(src + (size_t)(m0 - 3 + j) * NPROJ), r[j]);
        } else if (samp) {
          load8f(p.st_gconv + ((size_t)(l * 128 + b) * 3 + j) * 1536 + ch, r[j]);
        } else {
#pragma unroll
          for (int c = 0; c < 8; ++c) r[j][c] = 0.f;
        }
      }
#pragma unroll
      for (int j = 0; j < 4; ++j) load8f(p.gd_conv_w + (size_t)(l * 4 + j) * 1536 + ch, cw[j]);
#pragma unroll
      for (int tt = 0; tt < 4; ++tt) {
        float a[8];
        float ss = 0.f;
#pragma unroll
        for (int c = 0; c < 8; ++c) {
          float sx = 0.f;
#pragma unroll
          for (int j = 0; j < 4; ++j) sx += cw[j][c] * r[tt + j][c];
          a[c] = silu(sx);
          ss += a[c] * a[c];
        }
        if (pp < 2) {
          ss = row16_sum(ss);
          float sc = rsqrtf(ss + 1e-6f);
          if (pp == 0) sc *= 0.08838834764831845f;
#pragma unroll
          for (int c = 0; c < 8; ++c) a[c] *= sc;
        }
        *(uint4*)(conv + (size_t)(m0 + tt) * 1536 + ch) = pack8(a);
      }
      const bool last = samp || (t0 == 2044);
      if (last) {
        float* co = p.out + (samp ? OFF_S_GC + (size_t)(l * 128 + b) * 3 * 1536 : OFF_P_GC + (size_t)(l * 8 + b) * 3 * 1536) + ch;
#pragma unroll
        for (int j = 0; j < 3; ++j) {
          *(float4*)(co + j * 1536) = float4{r[4 + j][0], r[4 + j][1], r[4 + j][2], r[4 + j][3]};
          *(float4*)(co + j * 1536 + 4) = float4{r[4 + j][4], r[4 + j][5], r[4 + j][6], r[4 + j][7]};
        }
      }
    } else if (k < 5) {
      const int part = k - 3;
      const int wch = lane * 8;
      u16* col = proj + 4096 + part * 512 + wch;
      float lb[8];
#pragma unroll
      for (int c = 0; c < 8; ++c) lb[c] = 0.f;
      if (part == 1 && l == 1) {
        float l0[8], l1[8];
        load8f(p.hg_lb_logits + wch, l0);
        load8f(p.hg_lb_logits + 512 + wch, l1);
#pragma unroll
        for (int c = 0; c < 8; ++c) lb[c] = sigm(l1[c] - l0[c]);
      }
      uint4 u[4];
#pragma unroll
      for (int tt = 0; tt < 4; ++tt) u[tt] = *(const uint4*)(col + (size_t)(m0 + tt) * NPROJ);
#pragma unroll
      for (int tt = 0; tt < 4; ++tt) {
        float f[8];
        unpack8(u[tt], f);
#pragma unroll
        for (int c = 0; c < 8; ++c) f[c] = (part == 0) ? silu(f[c]) : (1.f - lb[c]) * sigm(-f[c]);
        *(uint4*)(col + (size_t)(m0 + tt) * NPROJ) = pack8(f);
      }
    } else {
      const int tt = lane >> 4, g = lane & 15, hh = g & 3;
      const float v = small[(size_t)(m0 + tt) * 16 + g];
      float r;
      if (g < 4) r = v + p.ml_i_bias[l * 4 + hh];
      else if (g < 8) { const float x = v + p.ml_f_bias[l * 4 + hh]; r = -softplus(-x); }
      else if (g < 12) r = sigm(v);
      else { const float x = v + p.gd_dt_bias[l * 4 + hh]; r = __expf(-__expf(p.gd_A_log[l * 4 + hh]) * softplus(x)); }
      gates[(size_t)(m0 + tt) * 16 + g] = r;
    }
  }
}

template <int KIND>
DEVI void scan_unit(const Params& p, int l, bool samp, int b, int h, int colbase, float* smem) {
  constexpr int CPL = (KIND == 1) ? 1 : 2;
  constexpr int UC = 32 * CPL;
  constexpr int VCH = UC / 8;
  const int tid = otid(), lane = tid & 63, w = tid >> 6, kg = lane & 15, cl = lane >> 4;
  const int T = samp ? 4 : 2048;
  const int rowbase = samp ? (MP + b * 4) : b * 2048;
  const int NB = samp ? 128 : 8;
  const u16* proj = (const u16*)(p.ws + WS_PROJ);
  const u16* conv = (const u16*)(p.ws + WS_CONV);
  u16* obuf = (u16*)(p.ws + WS_OBUF);
  const float* gates = (const float*)(p.ws + WS_GATES);
  float* dm = (float*)(p.ws + WS_DM);
  const u16 *qsrc, *ksrc, *vsrc;
  int ld, ocol;
  const float* Sin;
  float* Sout;
  const size_t sidx_in = ((size_t)(l * 128 + b) * 4 + h) * 16384;
  const size_t sidx_out = ((size_t)(l * NB + b) * 4 + h) * 16384;
  if (KIND == 0) {
    qsrc = proj + h * 128; ksrc = proj + 512 + h * 128; vsrc = proj + 1024 + h * 128 + colbase; ld = NPROJ; ocol = 0;
    Sin = p.st_mC + sidx_in; Sout = p.out + (samp ? OFF_S_MC : OFF_P_MC) + sidx_out;
  } else if (KIND == 1) {
    qsrc = conv + h * 128; ksrc = conv + 512 + h * 128; vsrc = conv + 1024 + h * 128 + colbase; ld = 1536; ocol = 512;
    Sin = p.st_gS + sidx_in; Sout = p.out + (samp ? OFF_S_GS : OFF_P_GS) + sidx_out;
  } else {
    qsrc = proj + 4096 + h * 128; ksrc = proj + 4608 + h * 128; vsrc = proj + 5120 + h * 128 + colbase; ld = NPROJ; ocol = 1024;
    Sin = p.st_hS + sidx_in; Sout = p.out + (samp ? OFF_S_HS : OFF_P_HS) + sidx_out;
  }
  float* qk = smem;
  float* vl = smem + 2 * 32 * 256;
  float* gl = vl + 2 * 32 * 64;

  const int wc = w * 4 * CPL + cl * CPL;
  const int col0 = colbase + wc;
  v2f S[CPL][4];
  v2f nv[4];
#pragma unroll
  for (int c = 0; c < CPL; ++c)
#pragma unroll
    for (int i = 0; i < 4; ++i) {
      if (samp) { S[c][i].x = Sin[(size_t)(kg * 8 + 2 * i) * 128 + col0 + c]; S[c][i].y = Sin[(size_t)(kg * 8 + 2 * i + 1) * 128 + col0 + c]; }
      else { S[c][i].x = 0.f; S[c][i].y = 0.f; }
    }
  float mstart = 0.f;
  if (KIND == 0) {
    const size_t nidx = ((size_t)(l * 128 + b) * 4 + h) * 128;
#pragma unroll
    for (int i = 0; i < 4; ++i) {
      if (samp) { nv[i].x = p.st_mn[nidx + kg * 8 + 2 * i]; nv[i].y = p.st_mn[nidx + kg * 8 + 2 * i + 1]; }
      else { nv[i].x = 0.f; nv[i].y = 0.f; }
    }
    if (samp) mstart = p.st_mm[(size_t)(l * 128 + b) * 4 + h];
  }

  uint4 rq, rk, rv;
  float g0 = 0.f, g1 = 0.f;
  const int sr = tid >> 4, sc = tid & 15;
  const int vr = tid / VCH, vc = tid % VCH;
  auto prefetch = [&](int j) {
    const int t = j * 32 + sr;
    rq = uint4{0, 0, 0, 0}; rk = uint4{0, 0, 0, 0}; rv = uint4{0, 0, 0, 0};
    if (t < T) {
      rq = *(const uint4*)(qsrc + (size_t)(rowbase + t) * ld + sc * 8);
      rk = *(const uint4*)(ksrc + (size_t)(rowbase + t) * ld + sc * 8);
    }
    if (tid < 32 * VCH) {
      const int tv = j * 32 + vr;
      if (tv < T) rv = *(const uint4*)(vsrc + (size_t)(rowbase + tv) * ld + vc * 8);
    }
    if (KIND != 2) {
      g0 = (KIND == 0) ? -1e30f : 0.f; g1 = 0.f;
      if (tid < 32) {
        const int tg = j * 32 + tid;
        if (tg < T) {
          if (KIND == 0) { g0 = gates[(size_t)(rowbase + tg) * 16 + h]; g1 = gates[(size_t)(rowbase + tg) * 16 + 4 + h]; }
          else { g0 = gates[(size_t)(rowbase + tg) * 16 + 8 + h]; g1 = gates[(size_t)(rowbase + tg) * 16 + 12 + h]; }
        }
      }
    }
  };
  auto stage = [&](int j, int buf) {
    float* qd = qk + (buf * 32 + sr) * 256 + sc * 8;
    *(float4*)(qd) = float4{bflo(rq.x), bfhi(rq.x), bflo(rq.y), bfhi(rq.y)};
    *(float4*)(qd + 4) = float4{bflo(rq.z), bfhi(rq.z), bflo(rq.w), bfhi(rq.w)};
    *(float4*)(qd + 128) = float4{bflo(rk.x), bfhi(rk.x), bflo(rk.y), bfhi(rk.y)};
    *(float4*)(qd + 132) = float4{bflo(rk.z), bfhi(rk.z), bflo(rk.w), bfhi(rk.w)};
    if (tid < 32 * VCH) {
      float* vd = vl + (buf * 32 + vr) * 64 + vc * 8;
      *(float4*)(vd) = float4{bflo(rv.x), bfhi(rv.x), bflo(rv.y), bfhi(rv.y)};
      *(float4*)(vd + 4) = float4{bflo(rv.z), bfhi(rv.z), bflo(rv.w), bfhi(rv.w)};
    }
    if (KIND == 0) {
      if (w == 0) {
        float bs = g1;
#pragma unroll
        for (int d = 1; d < 32; d <<= 1) { const float o = __shfl_up(bs, d); if (lane >= d) bs += o; }
        float R = g0 - bs;
#pragma unroll
        for (int d = 1; d < 32; d <<= 1) { const float o = __shfl_up(R, d); if (lane >= d) R = fmaxf(R, o); }
        const float mt = bs + fmaxf(mstart, R);
        float mprev = __shfl_up(mt, 1);
        if (lane == 0) mprev = mstart;
        const float fw = __expf(g1 + mprev - mt);
        const float iw = __expf(g0 - mt) * 0.08838834764831845f;
        if (lane < 32) {
          float* gd = gl + (buf * 32 + lane) * 4;
          gd[0] = fw; gd[1] = iw; gd[2] = mt;
        }
        int lastv = T - j * 32 - 1;
        if (lastv > 31) lastv = 31;
        mstart = __shfl(mt, lastv);
      }
    } else if (KIND == 1) {
      if (tid < 32) {
        float* gd = gl + (buf * 32 + tid) * 4;
        gd[0] = g0; gd[1] = g1;
      }
    }
  };

  const bool do_n = (KIND == 0) && (colbase == 0) && (w == 0);
  const int nblk = (T + 31) >> 5;
  prefetch(0);
  stage(0, 0);
  __syncthreads();
  for (int j = 0; j < nblk; ++j) {
    const int buf = j & 1;
    if (j + 1 < nblk) prefetch(j + 1);
    int steps = T - j * 32;
    if (steps > 32) steps = 32;
    u16* const obase = obuf + (size_t)(rowbase + j * 32) * LDY + ocol + h * 128 + col0;
    float* const dmbase = dm + (size_t)(rowbase + j * 32) * 8 + h;
    for (int t0 = 0; t0 < steps; t0 += 16) {
      int ns = steps - t0;
      if (ns > 16) ns = 16;
      float keep0 = 0.f, keep1 = 0.f, keepd = 0.f, keepm = 0.f;
#pragma unroll 4
      for (int tt = 0; tt < ns; ++tt) {
        const int t = t0 + tt;
        const float* qp = qk + (buf * 32 + t) * 256 + kg * 8;
        const float4 qa = *(const float4*)(qp), qb = *(const float4*)(qp + 4);
        const float4 ka = *(const float4*)(qp + 128), kb = *(const float4*)(qp + 132);
        const v2f q2[4] = {v2f{qa.x, qa.y}, v2f{qa.z, qa.w}, v2f{qb.x, qb.y}, v2f{qb.z, qb.w}};
        const v2f k2[4] = {v2f{ka.x, ka.y}, v2f{ka.z, ka.w}, v2f{kb.x, kb.y}, v2f{kb.z, kb.w}};
        const float* vp = vl + (buf * 32 + t) * 64 + wc;
        const float* gp = gl + (buf * 32 + t) * 4;
        const bool mine = (kg == tt);
        if (KIND == 0) {
          const float fw = gp[0], iw = gp[1];
          const v2f fw2 = v2f{fw, fw};
          const float2 vv = *(const float2*)vp;
          const float va[2] = {vv.x * iw, vv.y * iw};
          float num[2];
#pragma unroll
          for (int c = 0; c < 2; ++c) {
            const v2f vc2 = v2f{va[c], va[c]};
            v2f a = v2f{0.f, 0.f};
#pragma unroll
            for (int i = 0; i < 4; ++i) {
              S[c][i] = fw2 * S[c][i] + k2[i] * vc2;
              a += q2[i] * S[c][i];
            }
            num[c] = row16_sum(a.x + a.y);
          }
          keep0 = mine ? num[0] : keep0;
          keep1 = mine ? num[1] : keep1;
          if (do_n) {
            const v2f iw2 = v2f{iw, iw};
            v2f a = v2f{0.f, 0.f};
#pragma unroll
            for (int i = 0; i < 4; ++i) {
              nv[i] = fw2 * nv[i] + k2[i] * iw2;
              a += q2[i] * nv[i];
            }
            const float den = row16_sum(a.x + a.y);
            keepd = mine ? den : keepd;
            keepm = mine ? gp[2] : keepm;
          }
        } else if (KIND == 1) {
          const float beta = gp[0], g = gp[1];
          const float v = vp[0];
          v2f a = v2f{0.f, 0.f};
#pragma unroll
          for (int i = 0; i < 4; ++i) a += k2[i] * S[0][i];
          const float kS = row16_sum(a.x + a.y);
          const float vn = beta * (v - g * kS);
          const v2f g2 = v2f{g, g}, vn2 = v2f{vn, vn};
          v2f o2 = v2f{0.f, 0.f};
#pragma unroll
          for (int i = 0; i < 4; ++i) {
            S[0][i] = g2 * S[0][i] + k2[i] * vn2;
            o2 += q2[i] * S[0][i];
          }
          const float o = row16_sum(o2.x + o2.y);
          keep0 = mine ? o : keep0;
        } else {
          const float2 vv = *(const float2*)vp;
          const float va[2] = {vv.x, vv.y};
          float num[2];
#pragma unroll
          for (int c = 0; c < 2; ++c) {
            const v2f vc2 = v2f{va[c], va[c]};
            v2f a = v2f{0.f, 0.f};
#pragma unroll
            for (int i = 0; i < 4; ++i) {
              S[c][i] = S[c][i] + k2[i] * (vc2 - S[c][i]);
              a += q2[i] * S[c][i];
            }
            num[c] = row16_sum(a.x + a.y);
          }
          keep0 = mine ? num[0] : keep0;
          keep1 = mine ? num[1] : keep1;
        }
      }
      if (kg < ns) {
        if (KIND == 1) obase[(size_t)(t0 + kg) * LDY] = f2bf(keep0);
        else *(unsigned*)(obase + (size_t)(t0 + kg) * LDY) = pk2(keep0, keep1);
        if (do_n && cl == 0) { dmbase[(t0 + kg) * 8] = keepd; dmbase[(t0 + kg) * 8 + 4] = keepm; }
      }
    }
    if (j + 1 < nblk) stage(j + 1, buf ^ 1);
    __syncthreads();
  }
#pragma unroll
  for (int c = 0; c < CPL; ++c)
#pragma unroll
    for (int i = 0; i < 4; ++i) {
      Sout[(size_t)(kg * 8 + 2 * i) * 128 + col0 + c] = S[c][i].x;
      Sout[(size_t)(kg * 8 + 2 * i + 1) * 128 + col0 + c] = S[c][i].y;
    }
  if (KIND == 0 && colbase == 0 && w == 0) {
    if (cl == 0) {
      float* no = p.out + (samp ? OFF_S_MN : OFF_P_MN) + ((size_t)(l * NB + b) * 4 + h) * 128 + kg * 8;
#pragma unroll
      for (int i = 0; i < 4; ++i) { no[2 * i] = nv[i].x; no[2 * i + 1] = nv[i].y; }
    }
    if (lane == 0) p.out[(samp ? OFF_S_MM : OFF_P_MM) + (size_t)(l * NB + b) * 4 + h] = mstart;
  }
  __syncthreads();
}

DEVI void scan_sample_unit(const Params& p, int l, int s, float* smem) {
  const int s4 = s & 3;
  if (s4 < 2) {
    const int idx = (s >> 2) * 2 + (s & 1), seq = idx >> 2;
    scan_unit<1>(p, l, true, seq >> 2, seq & 3, (idx & 3) * 32, smem);
  } else {
    const int idx = s >> 2, seq = idx >> 1;
    if (s4 == 2) scan_unit<0>(p, l, true, seq >> 2, seq & 3, (idx & 1) * 64, smem);
    else scan_unit<2>(p, l, true, seq >> 2, seq & 3, (idx & 1) * 64, smem);
  }
}

DEVI void phase_scan(const Params& p, int l, float* smem) {
  for (int u = blockIdx.x; u < 256; u += gridDim.x) {
    if (u < 128) {
      const int seq = u >> 2;
      scan_unit<1>(p, l, false, seq >> 2, seq & 3, (u & 3) * 32, smem);
    } else if (u < 192) {
      const int uu = u - 128, seq = uu >> 1;
      scan_unit<0>(p, l, false, seq >> 2, seq & 3, (uu & 1) * 64, smem);
    } else {
      const int uu = u - 192, seq = uu >> 1;
      scan_unit<2>(p, l, false, seq >> 2, seq & 3, (uu & 1) * 64, smem);
    }
  }
  if (gridDim.x == 256) {
    const int b = blockIdx.x;
    int s0, cnt;
    if (b < 128) { s0 = b * 26; cnt = 26; }
    else if (b < 192) {
      if (((b - 128) & 1) == 0) { s0 = 0; cnt = 0; }
      else { s0 = 3328 + ((b - 128) >> 1) * 8; cnt = 8; }
    } else { s0 = 3328 + (32 + (b - 192)) * 8; cnt = 8; }
    for (int i = 0; i < cnt; ++i) scan_sample_unit(p, l, s0 + i, smem);
  } else {
    for (int s = blockIdx.x; s < 4096; s += gridDim.x) scan_sample_unit(p, l, s, smem);
  }
}

DEVI void phase_post(const Params& p, int l) {
  const int tid_ = otid(); const int lane = tid_ & 63, gw = blockIdx.x * 8 + (tid_ >> 6), nw = gridDim.x * 8;
  const u16* proj = (const u16*)(p.ws + WS_PROJ);
  u16* obuf = (u16*)(p.ws + WS_OBUF);
  const float* dm = (const float*)(p.ws + WS_DM);
  constexpr int NTASK = (M / 4) * 3;
  for (int task = gw; task < NTASK; task += nw) {
    const int tg = task / 3, k = task - tg * 3;
    const int m0 = tg * 4;
    const int c = lane * 8, hh = lane >> 4;
    float wv[8];
    if (k == 0) load8f(p.ml_norm_w + l * 512 + c, wv);
    else if (k == 1) load8f(p.gd_norm_w + l * 128 + (c & 127), wv);
    else load8f(p.hg_norm_w + l * 512 + c, wv);
    const int gcol = (k == 0) ? 1536 : (k == 1 ? 3584 : 5632);
    uint4 ov[4], gv[4];
#pragma unroll
    for (int tt = 0; tt < 4; ++tt) {
      ov[tt] = *(const uint4*)(obuf + (size_t)(m0 + tt) * LDY + k * 512 + c);
      gv[tt] = *(const uint4*)(proj + (size_t)(m0 + tt) * NPROJ + gcol + c);
    }
#pragma unroll
    for (int tt = 0; tt < 4; ++tt) {
      const size_t m = m0 + tt;
      float o[8], g[8];
      unpack8(ov[tt], o);
      unpack8(gv[tt], g);
      if (k == 0) {
        const float den = dm[m * 8 + hh], mt = dm[m * 8 + 4 + hh];
        const float inv = 1.f / fmaxf(fabsf(den), __expf(-mt));
#pragma unroll
        for (int i = 0; i < 8; ++i) o[i] *= inv;
      }
      float ss = 0.f;
#pragma unroll
      for (int i = 0; i < 8; ++i) ss += o[i] * o[i];
      float sc;
      if (k == 2) { ss = wave_sum(ss); sc = rsqrtf(ss * (1.f / 512.f) + 1e-6f); }
      else { ss = row16_sum(ss); sc = rsqrtf(ss * (1.f / 128.f) + 1e-6f); }
#pragma unroll
      for (int i = 0; i < 8; ++i) o[i] = o[i] * sc * wv[i] * ((k == 0) ? sigm(g[i]) : silu(g[i]));
      *(uint4*)(obuf + m * LDY + k * 512 + c) = pack8(o);
    }
  }
}

#define LAS __attribute__((address_space(3)))
#define XB_TMO      128
#define XB_XCNT(j)  (256  + 64 * (j))
#define XB_XSUB(j)  (1280 + 64 * (j))
#define XB_XGEN(j)  (2304 + 64 * (j))
#define XB_TOP      3328
#define XB_TOPGEN   3392
#define XCD_BAR_WORDS 3456
#define XB_SPIN_CAP (1u << 18)

__device__ __forceinline__ unsigned xb_ld(unsigned* p)              { return __hip_atomic_load(p, __ATOMIC_RELAXED, __HIP_MEMORY_SCOPE_AGENT); }
__device__ __forceinline__ unsigned xb_add(unsigned* p, unsigned v) { return __hip_atomic_fetch_add(p, v, __ATOMIC_RELAXED, __HIP_MEMORY_SCOPE_AGENT); }
__device__ __forceinline__ unsigned xb_xcc_id() { return (unsigned)__builtin_amdgcn_s_getreg((3 << 11) | 20) & 0xFu; }
#define XB_SPIN(cond, bar) do { unsigned _sp = 0; while (cond) { __builtin_amdgcn_s_sleep(1); \
    if ((++_sp & 255u) == 0u) { if (xb_ld(&(bar)[XB_TMO])) break; if (_sp > XB_SPIN_CAP) { atomicAdd(&(bar)[XB_TMO], 1u); break; } } } } while (0)

struct XcdBarrier {
    unsigned* bar; unsigned x;
    volatile LAS unsigned* st;
};

__device__ __forceinline__ XcdBarrier xcd_barrier_post(unsigned* bar, volatile LAS unsigned* st) {
    XcdBarrier b; b.bar = bar; b.x = xb_xcc_id(); b.st = st;
    if (threadIdx.x == 0) (void)xb_add(&bar[XB_XCNT(b.x)], 1u);
    return b;
}
__device__ __forceinline__ void xcd_barrier_complete(unsigned* bar, unsigned x, unsigned& nloc, unsigned& nx) {
    const unsigned G = gridDim.x * gridDim.y * gridDim.z;
    unsigned sum, cnt, mine, sp = 0u;
    for (;;) {
        sum = 0u; cnt = 0u; mine = 0u;
#pragma unroll
        for (unsigned j = 0; j < 16; ++j) { const unsigned c = xb_ld(&bar[XB_XCNT(j)]); sum += c; cnt += (c > 0u) ? 1u : 0u; mine = (j == x) ? c : mine; }
        if (sum == G) break;
        __builtin_amdgcn_s_sleep(1);
        if ((++sp & 255u) == 0u) { if (xb_ld(&bar[XB_TMO])) break; if (sp > XB_SPIN_CAP) { atomicAdd(&bar[XB_TMO], 1u); break; } }
    }
    nloc = mine > 0u ? mine : 1u; nx = cnt > 0u ? cnt : 1u;
}

__device__ __forceinline__ void xcd_barrier(const XcdBarrier& b) {
    asm volatile("s_waitcnt vmcnt(0)" ::: "memory");
    __syncthreads();
    if (threadIdx.x == 0) {
        unsigned* bar = b.bar;
        __builtin_amdgcn_s_waitcnt(0);
        unsigned nloc = b.st[0], nx = b.st[1];
        if (nloc == 0u) { xcd_barrier_complete(bar, b.x, nloc, nx); b.st[0] = nloc; b.st[1] = nx; }
        const unsigned old = xb_add(&bar[XB_XSUB(b.x)], 1u);
        const unsigned gen = old / nloc;
        if (old + 1u == (gen + 1u) * nloc) {
            __builtin_amdgcn_fence(__ATOMIC_RELEASE, "agent");
            asm volatile("s_waitcnt vmcnt(0)" ::: "memory");
            const unsigned og = xb_add(&bar[XB_TOP], 1u);
            const unsigned tg = og / nx;
            if (og + 1u == (tg + 1u) * nx) xb_add(&bar[XB_TOPGEN], 1u);
            else XB_SPIN(xb_ld(&bar[XB_TOPGEN]) == tg, bar);
            __builtin_amdgcn_fence(__ATOMIC_ACQUIRE, "agent");
            xb_add(&bar[XB_XGEN(b.x)], 1u);
            asm volatile("s_waitcnt vmcnt(0)" ::: "memory");
        } else {
            XB_SPIN(xb_ld(&bar[XB_XGEN(b.x)]) == gen, bar);
            __builtin_amdgcn_fence(__ATOMIC_ACQUIRE, "agent");
            asm volatile("s_waitcnt vmcnt(0)" ::: "memory");
        }
    }
    __syncthreads();
}


__global__ void __launch_bounds__(NTHREADS) mega_fwd(Params p) {
  extern __shared__ __attribute__((aligned(16))) unsigned char smem_raw[];
  cg::grid_group grid = cg::this_grid();
  float* smf = (float*)smem_raw;
  u16* smh = (u16*)smem_raw;
  u16* xn = (u16*)(p.ws + WS_XN);
  float* x = p.out;

  volatile LAS unsigned* bst = (volatile LAS unsigned*)(smem_raw + LDS_BYTES - 16);
  if (threadIdx.x < 2) bst[threadIdx.x] = 0u;
  __syncthreads();
  XcdBarrier xbar; xbar.bar = (unsigned*)(p.ws + WS_BAR); xbar.x = xb_xcc_id(); xbar.st = bst;
  if (threadIdx.x == 0) bst[2] = xb_add(&xbar.bar[XB_XCNT(xbar.x)], 1u);
  phase_wprep(p, smf);
  phase_norm(p.x_prompt, p.x_sample, p.norm1_w, xn);
  grid.sync();
  if (threadIdx.x == 0) {
    const unsigned per = gridDim.x >> 3;
    bool ok = (gridDim.x & 7u) == 0u && xbar.x < 8u;
    for (unsigned j = 0; j < 8; ++j) ok = ok && (xb_ld(&xbar.bar[XB_XCNT(j)]) == per);
    const unsigned rank = bst[2];
    bst[3] = (ok && rank < per) ? xbar.x * per + rank : (blockIdx.x & 7u) * per + (blockIdx.x >> 3);
  }
  __syncthreads();
  const int vcu = __builtin_amdgcn_readfirstlane((int)bst[3]);
#pragma unroll 1
  for (int l = 0; l < 2; ++l) {
    phase_proj(p, l, vcu, smh);
    xcd_barrier(xbar);
    phase_prep(p, l);
    xcd_barrier(xbar);
    phase_scan(p, l, smf);
    xcd_barrier(xbar);
    phase_post(p, l);
    xcd_barrier(xbar);
    phase_merge(p, l, vcu, smh);
    xcd_barrier(xbar);
    if (l == 0)
      phase_resid((const u16*)(p.ws + WS_CONV), LDX, 1024, (const u16*)(p.ws + WS_WT_OUT), LDW1, p.x_prompt, p.x_sample, x, vcu, smh);
    else
      phase_resid((const u16*)(p.ws + WS_CONV), LDX, 1024, (const u16*)(p.ws + WS_WT_OUT) + (size_t)1024 * LDW1, LDW1, x, x + (size_t)MP * D, x, vcu, smh);
    xcd_barrier(xbar);
    phase_norm(x, x + (size_t)MP * D, p.norm2_w + l * D, xn);
    xcd_barrier(xbar);
    phase_up(p, l, vcu, smh);
    xcd_barrier(xbar);
    phase_resid((const u16*)(p.ws + WS_PROJ), LDH, 4096, (const u16*)(p.ws + WS_WT_DN) + (size_t)l * 1024 * LDWD, LDWD, x, x + (size_t)MP * D, x, vcu, smh);
    xcd_barrier(xbar);
    if (l == 0) {
      phase_norm(x, x + (size_t)MP * D, p.norm1_w + D, xn);
      xcd_barrier(xbar);
    }
  }
  phase_final_norm(x, p.final_norm_w);
}

extern "C" void kernel_launch(void* const* d_in, const int* in_sizes, int n_in, void* d_out, int out_size, void* d_ws,
                              size_t ws_size, hipStream_t stream) {
  static int grid_blocks = 0;
  if (!grid_blocks) {
    int dev = 0, cus = 0, per_cu = 0;
    hipGetDevice(&dev);
    hipDeviceGetAttribute(&cus, hipDeviceAttributeMultiprocessorCount, dev);
    hipFuncSetAttribute((const void*)mega_fwd, hipFuncAttributeMaxDynamicSharedMemorySize, LDS_BYTES);
    hipOccupancyMaxActiveBlocksPerMultiprocessor(&per_cu, (const void*)mega_fwd, NTHREADS, LDS_BYTES);
    if (per_cu < 1) { fprintf(stderr, "occupancy query returned %d\n", per_cu); per_cu = 1; }
    grid_blocks = cus;
    if (ws_size < WS_END) fprintf(stderr, "workspace too small: %zu < %zu\n", ws_size, (size_t)WS_END);
  }
  Params p{};
  p.x_prompt = (const float*)d_in[0]; p.x_sample = (const float*)d_in[1];
  p.st_mC = (const float*)d_in[2]; p.st_mn = (const float*)d_in[3]; p.st_mm = (const float*)d_in[4];
  p.st_gS = (const float*)d_in[5]; p.st_gconv = (const float*)d_in[6]; p.st_hS = (const float*)d_in[7];
  p.norm1_w = (const float*)d_in[8]; p.w_in = (const float*)d_in[9]; p.ml_i_bias = (const float*)d_in[10];
  p.ml_f_bias = (const float*)d_in[11]; p.ml_norm_w = (const float*)d_in[12]; p.gd_conv_w = (const float*)d_in[13];
  p.gd_A_log = (const float*)d_in[14]; p.gd_dt_bias = (const float*)d_in[15]; p.gd_norm_w = (const float*)d_in[16];
  p.hg_lb_logits = (const float*)d_in[17]; p.hg_norm_w = (const float*)d_in[18]; p.w_branch = (const float*)d_in[19];
  p.w_out = (const float*)d_in[20]; p.norm2_w = (const float*)d_in[21]; p.w_up = (const float*)d_in[22];
  p.w_down = (const float*)d_in[23]; p.final_norm_w = (const float*)d_in[24];
  p.out = (float*)d_out;
  p.ws = (unsigned char*)d_ws;
  hipMemsetAsync((char*)d_ws + WS_BAR, 0, WS_BAR_BYTES, stream);
  void* args[] = {&p};
  hipError_t e = hipLaunchCooperativeKernel((const void*)mega_fwd, dim3(grid_blocks), dim3(NTHREADS), args, LDS_BYTES, stream);
  if (e != hipSuccess) fprintf(stderr, "cooperative launch failed: %s (grid %d)\n", hipGetErrorString(e), grid_blocks);
}
```

```cpp
#include <hip/hip_runtime.h>
#include <hip/hip_cooperative_groups.h>
#include <cstdio>
namespace cg = cooperative_groups;

typedef unsigned short u16;
using bf16x8 = __attribute__((ext_vector_type(8))) short;
using f32x4 = __attribute__((ext_vector_type(4))) float;
typedef float v2f __attribute__((ext_vector_type(2)));

#define DEVI __device__ __forceinline__

constexpr int D = 1024;
constexpr int MP = 16384, MS = 512, M = MP + MS;
constexpr int NPROJ = 6144, NPROJ_PAD = 6272;
constexpr int INC = 9232;
constexpr int DFF = 4096;
constexpr int NTHREADS = 512;
constexpr int LDS_BYTES = 132 * 1024;
constexpr int LDX = 1088, LDH = 4160, LDY = 1600, LDW1 = 1088, LDWB = 576, LDWD = 4160;

constexpr size_t OFF_Y = 0;
constexpr size_t OFF_P_MC = (size_t)M * D;
constexpr size_t OFF_P_MN = OFF_P_MC + 2ull * 8 * 4 * 128 * 128;
constexpr size_t OFF_P_MM = OFF_P_MN + 2ull * 8 * 4 * 128;
constexpr size_t OFF_P_GS = OFF_P_MM + 2ull * 8 * 4;
constexpr size_t OFF_P_GC = OFF_P_GS + 2ull * 8 * 4 * 128 * 128;
constexpr size_t OFF_P_HS = OFF_P_GC + 2ull * 8 * 3 * 1536;
constexpr size_t OFF_S_MC = OFF_P_HS + 2ull * 8 * 4 * 128 * 128;
constexpr size_t OFF_S_MN = OFF_S_MC + 2ull * 128 * 4 * 128 * 128;
constexpr size_t OFF_S_MM = OFF_S_MN + 2ull * 128 * 4 * 128;
constexpr size_t OFF_S_GS = OFF_S_MM + 2ull * 128 * 4;
constexpr size_t OFF_S_GC = OFF_S_GS + 2ull * 128 * 4 * 128 * 128;
constexpr size_t OFF_S_HS = OFF_S_GC + 2ull * 128 * 3 * 1536;
static_assert(OFF_S_HS + 2ull * 128 * 4 * 128 * 128 == 72172608ull, "output size");

constexpr size_t WS_WT_IN = 0;
constexpr size_t WS_WT_GATE = WS_WT_IN + 2ull * NPROJ_PAD * LDW1 * 2;
constexpr size_t WS_WT_BR = WS_WT_GATE + 2ull * 3072 * LDW1 * 2;
constexpr size_t WS_WT_OUT = WS_WT_BR + 2ull * 3 * 1024 * LDWB * 2;
constexpr size_t WS_WT_UP = WS_WT_OUT + 2ull * 1024 * LDW1 * 2;
constexpr size_t WS_WT_DN = WS_WT_UP + 2ull * 4096 * LDW1 * 2;
constexpr size_t WS_PROJ = WS_WT_DN + 2ull * 1024 * LDWD * 2;
constexpr size_t WS_CONV = WS_PROJ + (size_t)M * NPROJ * 2;
constexpr size_t WS_OBUF = WS_CONV + (size_t)M * 1536 * 2;
constexpr size_t WS_XN = WS_OBUF + (size_t)M * LDY * 2;
constexpr size_t WS_SMALL = WS_XN + (size_t)M * LDX * 2;
constexpr size_t WS_GATES = WS_SMALL;
constexpr size_t WS_DM = WS_GATES + (size_t)M * 16 * 4;
constexpr size_t WS_BAR = WS_DM + (size_t)M * 8 * 4;
constexpr size_t WS_BAR_BYTES = 16384;
constexpr size_t WS_END = WS_BAR + WS_BAR_BYTES;
static_assert(WS_END <= 439571584ull, "workspace budget");
static_assert((size_t)M * LDH * 2 <= (size_t)M * NPROJ * 2 && (size_t)M * LDX * 2 <= (size_t)M * 1536 * 2, "aliases fit");

struct Params {
  const float *x_prompt, *x_sample, *st_mC, *st_mn, *st_mm, *st_gS, *st_gconv, *st_hS;
  const float *norm1_w, *w_in, *ml_i_bias, *ml_f_bias, *ml_norm_w, *gd_conv_w, *gd_A_log, *gd_dt_bias,
      *gd_norm_w, *hg_lb_logits, *hg_norm_w, *w_branch, *w_out, *norm2_w, *w_up, *w_down, *final_norm_w;
  float* out;
  unsigned char* ws;
};

DEVI u16 f2bf(float f) { unsigned u = __float_as_uint(f); return (u16)((u + 0x7fffu + ((u >> 16) & 1u)) >> 16); }
DEVI unsigned pk2(float lo, float hi) { return (unsigned)f2bf(lo) | ((unsigned)f2bf(hi) << 16); }
DEVI float bflo(unsigned u) { return __uint_as_float(u << 16); }
DEVI float bfhi(unsigned u) { return __uint_as_float(u & 0xffff0000u); }
DEVI float sigm(float x) { return __builtin_amdgcn_rcpf(1.f + __expf(-x)); }
DEVI float silu(float x) { return x * sigm(x); }
DEVI float softplus(float x) { return fmaxf(x, 0.f) + __logf(1.f + __expf(-fabsf(x))); }
DEVI int otid() { int t = threadIdx.x; asm volatile("" : "+v"(t)); return t; }
DEVI float wave_sum(float v) {
#pragma unroll
  for (int o = 32; o > 0; o >>= 1) v += __shfl_xor(v, o);
  return v;
}
template <int CTRL> DEVI float dpp_f(float v) {
  return __int_as_float(__builtin_amdgcn_update_dpp(0, __float_as_int(v), CTRL, 0xf, 0xf, false));
}
DEVI float row16_sum(float v) {
  float r;
  asm("s_nop 1\n\tv_add_f32_dpp %0, %1, %1 row_ror:8 row_mask:0xf bank_mask:0xf" : "=v"(r) : "v"(v));
  asm("s_nop 1\n\tv_add_f32_dpp %0, %1, %1 row_ror:4 row_mask:0xf bank_mask:0xf" : "=v"(v) : "v"(r));
  asm("s_nop 1\n\tv_add_f32_dpp %0, %1, %1 row_ror:2 row_mask:0xf bank_mask:0xf" : "=v"(r) : "v"(v));
  asm("s_nop 1\n\tv_add_f32_dpp %0, %1, %1 row_ror:1 row_mask:0xf bank_mask:0xf" : "=v"(v) : "v"(r));
  return v;
}

DEVI void tr_seg(const float* __restrict__ src, int ld, int K, int ncols, u16* __restrict__ dst, int dld, float* tile, int& off) {
  const int tid_ = otid();
  const int lane = tid_ & 63, gw = blockIdx.x * 8 + (tid_ >> 6), nw = gridDim.x * 8;
  const int nkb = K >> 4, nnb = ncols >> 6, nt = nkb * nnb;
  const int start = (int)(((long)gw + (long)nw * 4096 - off) % nw);
  for (int t = start; t < nt; t += nw) {
    const int kb = t % nkb, nb = t / nkb;
    const float* sp = src + (size_t)(kb * 16) * ld + nb * 64 + lane;
    float v[16];
#pragma unroll
    for (int i = 0; i < 16; ++i) v[i] = sp[(size_t)i * ld];
    uint4 o0, o1;
    o0.x = pk2(v[0], v[1]); o0.y = pk2(v[2], v[3]); o0.z = pk2(v[4], v[5]); o0.w = pk2(v[6], v[7]);
    o1.x = pk2(v[8], v[9]); o1.y = pk2(v[10], v[11]); o1.z = pk2(v[12], v[13]); o1.w = pk2(v[14], v[15]);
    u16* dp = dst + (size_t)(nb * 64 + lane) * dld + kb * 16;
    *(uint4*)dp = o0;
    *(uint4*)(dp + 8) = o1;
  }
  off += nt;
}

DEVI void phase_wprep(const Params& p, float* tile) {
  int off = 0;
  u16* wt_in = (u16*)(p.ws + WS_WT_IN);
  u16* wt_gate = (u16*)(p.ws + WS_WT_GATE);
  u16* wt_br = (u16*)(p.ws + WS_WT_BR);
  u16* wt_out = (u16*)(p.ws + WS_WT_OUT);
  u16* wt_up = (u16*)(p.ws + WS_WT_UP);
  u16* wt_dn = (u16*)(p.ws + WS_WT_DN);
  for (int l = 0; l < 2; ++l) {
    const float* win = p.w_in + (size_t)l * 1024 * INC;
    for (int s = 0; s < 12; ++s) {
      const int srccol = (s < 4) ? s * 512 : (s < 8 ? 2056 + (s - 4) * 512 : 4112 + (s - 8) * 512);
      tr_seg(win + srccol, INC, 1024, 512, wt_in + ((size_t)l * NPROJ_PAD + s * 512) * LDW1, LDW1, tile, off);
    }
    tr_seg(win + 6160, INC, 1024, 3072, wt_gate + (size_t)l * 3072 * LDW1, LDW1, tile, off);
    for (int b = 0; b < 3; ++b)
      tr_seg(p.w_branch + (size_t)(l * 3 + b) * 512 * 1024, 1024, 512, 1024, wt_br + (size_t)(l * 3 + b) * 1024 * LDWB, LDWB, tile, off);
    tr_seg(p.w_out + (size_t)l * 1024 * 1024, 1024, 1024, 1024, wt_out + (size_t)l * 1024 * LDW1, LDW1, tile, off);
    tr_seg(p.w_up + (size_t)l * 1024 * 4096, 4096, 1024, 4096, wt_up + (size_t)l * 4096 * LDW1, LDW1, tile, off);
    tr_seg(p.w_down + (size_t)l * 4096 * 1024, 1024, 4096, 1024, wt_dn + (size_t)l * 1024 * LDWD, LDWD, tile, off);
  }
  for (int idx = blockIdx.x * NTHREADS + otid(); idx < 2 * 128 * 1024; idx += gridDim.x * NTHREADS) {
    const int l = idx >> 17, rem = idx & 131071, r = rem >> 10, k = rem & 1023;
    float v = 0.f;
    if (r < 16) {
      const int sc = (r < 8) ? 2048 + r : 4104 + (r - 8);
      v = p.w_in[(size_t)l * 1024 * INC + (size_t)k * INC + sc];
    }
    wt_in[((size_t)l * NPROJ_PAD + 6144 + r) * LDW1 + k] = f2bf(v);
  }
}

DEVI void phase_norm(const float* xp, const float* xs, const float* __restrict__ w, u16* __restrict__ xn) {
  const int tid_ = otid(); const int lane = tid_ & 63, gw = blockIdx.x * 8 + (tid_ >> 6), nw = gridDim.x * 8;
  for (int m = gw; m < M; m += nw) {
    const float* xr = (m < MP) ? xp + (size_t)m * D : xs + (size_t)(m - MP) * D;
    float4 v[4];
    float ss = 0.f;
#pragma unroll
    for (int i = 0; i < 4; ++i) {
      v[i] = ((const float4*)xr)[lane + 64 * i];
      ss += v[i].x * v[i].x + v[i].y * v[i].y + v[i].z * v[i].z + v[i].w * v[i].w;
    }
    ss = wave_sum(ss);
    const float rstd = rsqrtf(ss * (1.f / 1024.f) + 1e-6f);
#pragma unroll
    for (int i = 0; i < 4; ++i) {
      const float4 wv = ((const float4*)w)[lane + 64 * i];
      uint2 o;
      o.x = pk2(v[i].x * rstd * wv.x, v[i].y * rstd * wv.y);
      o.y = pk2(v[i].z * rstd * wv.z, v[i].w * rstd * wv.w);
      ((uint2*)(xn + (size_t)m * LDX))[lane + 64 * i] = o;
    }
  }
}

DEVI void phase_final_norm(float* x, const float* __restrict__ w) {
  const int tid_ = otid(); const int lane = tid_ & 63, gw = blockIdx.x * 8 + (tid_ >> 6), nw = gridDim.x * 8;
  for (int m = gw; m < M; m += nw) {
    float* xr = x + (size_t)m * D;
    float4 v[4];
    float ss = 0.f;
#pragma unroll
    for (int i = 0; i < 4; ++i) {
      v[i] = ((const float4*)xr)[lane + 64 * i];
      ss += v[i].x * v[i].x + v[i].y * v[i].y + v[i].z * v[i].z + v[i].w * v[i].w;
    }
    ss = wave_sum(ss);
    const float rstd = rsqrtf(ss * (1.f / 1024.f) + 1e-6f);
#pragma unroll
    for (int i = 0; i < 4; ++i) {
      const float4 wv = ((const float4*)w)[lane + 64 * i];
      float4 o;
      o.x = v[i].x * rstd * wv.x; o.y = v[i].y * rstd * wv.y; o.z = v[i].z * rstd * wv.z; o.w = v[i].w * rstd * wv.w;
      ((float4*)xr)[lane + 64 * i] = o;
    }
  }
}

constexpr int LDS_S = 64;

struct GemmOp { const u16* A; const u16* B; int lda, ldb, K, koff; };

DEVI bool tile_map(int it, int vcu, int MT, int NT, int& mt, int& nt) {
  const int G = gridDim.x;
  const int t = it * G + vcu;
  if (t >= MT * NT) return false;
  constexpr int GM = 4;
  const int gsize = GM * NT;
  const int g = t / gsize, tl = t - g * gsize;
  int gsz = MT - g * GM;
  if (gsz > GM) gsz = GM;
  mt = g * GM + (tl % gsz);
  nt = tl / gsz;
  return true;
}
DEVI int koff_of(int mt, int nt) { return 0; }

template <int WMT, int WNT>
DEVI void zero_acc(f32x4 (&acc)[WMT][WNT]) {
#pragma unroll
  for (int i = 0; i < WMT; ++i)
#pragma unroll
    for (int j = 0; j < WNT; ++j) acc[i][j] = f32x4{0.f, 0.f, 0.f, 0.f};
}

#define PF_PARAMS uint4 &pa0, uint4 &pa1, uint4 &pa2, uint4 &pa3, uint4 &pb0, uint4 &pb1, uint4 &qa0, uint4 &qa1, uint4 &qa2, uint4 &qa3, uint4 &qb0, uint4 &qb1
#define PF_ARGS pa0, pa1, pa2, pa3, pb0, pb1, qa0, qa1, qa2, qa3, qb0, qb1
#define PF_DECL uint4 pa0 = uint4{0, 0, 0, 0}, pa1 = pa0, pa2 = pa0, pa3 = pa0, pb0 = pa0, pb1 = pa0, qa0 = pa0, qa1 = pa0, qa2 = pa0, qa3 = pa0, qb0 = pa0, qb1 = pa0
template <int WMT, int WNT>
DEVI void gemm_core(const GemmOp cur, const GemmOp nxt, bool primed, PF_PARAMS, f32x4 (&acc)[WMT][WNT], u16* smem) {
  constexpr int BM = 64 * WMT, BN = 32 * WNT;
  constexpr int ACH = BM * 8 / NTHREADS, BCH = BN * 8 / NTHREADS;
  static_assert(BCH == 2 && (ACH == 2 || ACH == 4), "chunk counts");
  u16* sA = smem;
  u16* sB = smem + 2 * BM * LDS_S;
  const int tid = otid(), lane = tid & 63, w = tid >> 6, wm = w >> 1, wn = w & 1;
  const int fr = lane & 15, fq = lane >> 4;
  const int crow = tid >> 3, ckc = tid & 7;
  const int wsw = (ckc ^ (crow & 7)) * 8;
  const int rsw0 = (fq ^ (fr & 7)) * 8;
  const u16* Ag = cur.A + (size_t)crow * cur.lda + ckc * 8;
  const u16* Bg = cur.B + (size_t)crow * cur.ldb + ckc * 8;
  const int nk = cur.K >> 6, km = nk - 1, kmn = (nxt.K >> 6) - 1;
#define GLOADX(S, AP, BP, LA, LB, KO)                                                 \
  do {                                                                                \
    S##a0 = *(const uint4*)((AP) + (KO));                                           \
    S##a1 = *(const uint4*)((AP) + (size_t)64 * (LA) + (KO));                       \
    if (ACH == 4) {                                                                   \
      S##a2 = *(const uint4*)((AP) + (size_t)128 * (LA) + (KO));                    \
      S##a3 = *(const uint4*)((AP) + (size_t)192 * (LA) + (KO));                    \
    }                                                                                 \
    S##b0 = *(const uint4*)((BP) + (KO));                                           \
    S##b1 = *(const uint4*)((BP) + (size_t)64 * (LB) + (KO));                       \
  } while (0)
#define GLOADC(S, T) GLOADX(S, Ag, Bg, cur.lda, cur.ldb, ((((T) + cur.koff) & km) * 64))
#define GLOADN(S, T) GLOADX(S, An, Bn, nxt.lda, nxt.ldb, ((((T) + nxt.koff) & kmn) * 64))
#define SSTORE(S, NB)                                                                 \
  do {                                                                                \
    u16* dA = sA + ((NB) * BM + crow) * LDS_S + wsw;                                  \
    u16* dB = sB + ((NB) * BN + crow) * LDS_S + wsw;                                  \
    *(uint4*)(dA) = S##a0;                                                          \
    *(uint4*)(dA + 64 * LDS_S) = S##a1;                                             \
    if (ACH == 4) {                                                                   \
      *(uint4*)(dA + 128 * LDS_S) = S##a2;                                          \
      *(uint4*)(dA + 192 * LDS_S) = S##a3;                                          \
    }                                                                                 \
    *(uint4*)(dB) = S##b0;                                                          \
    *(uint4*)(dB + 64 * LDS_S) = S##b1;                                             \
  } while (0)
#define LOADFR(BUF)                                                                   \
  do {                                                                                \
    const u16* cA = sA + ((BUF) * BM + wm * 16 * WMT + fr) * LDS_S;                   \
    const u16* cB = sB + ((BUF) * BN + wn * 16 * WNT + fr) * LDS_S;                   \
    _Pragma("unroll") for (int ks = 0; ks < 2; ++ks) {                                \
      const int so = rsw0 ^ (ks * 32);                                                \
      _Pragma("unroll") for (int i = 0; i < WMT; ++i) af[ks][i] = *(const bf16x8*)(cA + i * 16 * LDS_S + so);  \
      _Pragma("unroll") for (int j = 0; j < WNT; ++j) bfr[ks][j] = *(const bf16x8*)(cB + j * 16 * LDS_S + so); \
    }                                                                                 \
  } while (0)
#define MFMAS()                                                                       \
  do {                                                                                \
    _Pragma("unroll") for (int ks = 0; ks < 2; ++ks)                                  \
      _Pragma("unroll") for (int i = 0; i < WMT; ++i)                                 \
        _Pragma("unroll") for (int j = 0; j < WNT; ++j)                               \
          acc[i][j] = __builtin_amdgcn_mfma_f32_16x16x32_bf16(bfr[ks][j], af[ks][i], acc[i][j], 0, 0, 0);  \
  } while (0)
#define HALF(BUF, SS, LOADSTMT)                                                       \
  do {                                                                                \
    LOADFR(BUF);                                                                      \
    __builtin_amdgcn_sched_barrier(0);                                                \
    SSTORE(SS, (BUF) ^ 1);                                                            \
    LOADSTMT;                                                                         \
    __builtin_amdgcn_sched_barrier(0);                                                \
    MFMAS();                                                                          \
    __builtin_amdgcn_sched_barrier(0);                                                \
    __syncthreads();                                                                  \
  } while (0)
  bf16x8 af[2][WMT], bfr[2][WNT];
  if (!primed) {
    GLOADC(p, 0);
    SSTORE(p, 0);
    __builtin_amdgcn_sched_barrier(0);
    GLOADC(q, 1);
    __builtin_amdgcn_sched_barrier(0);
    GLOADC(p, 2);
    __builtin_amdgcn_sched_barrier(0);
    __syncthreads();
  }
#pragma unroll 1
  for (int kt = 0; kt + 4 < nk; kt += 2) {
    HALF(0, q, GLOADC(q, kt + 3));
    HALF(1, p, GLOADC(p, kt + 4));
  }
  HALF(0, q, GLOADC(q, nk - 1));
  const u16* An = nxt.A + (size_t)crow * nxt.lda + ckc * 8;
  const u16* Bn = nxt.B + (size_t)crow * nxt.ldb + ckc * 8;
  HALF(1, p, GLOADN(p, 0));
  HALF(0, q, GLOADN(q, 1));
  HALF(1, p, GLOADN(p, 2));
#undef GLOADX
#undef GLOADC
#undef GLOADN
#undef SSTORE
#undef LOADFR
#undef MFMAS
#undef HALF
}

#define PFB_PARAMS uint4 &pa0, uint4 &pa1, uint4 &pa2, uint4 &pa3, uint4 &pb0, uint4 &pb1, uint4 &pb2, uint4 &pb3
#define PFB_ARGS pa0, pa1, pa2, pa3, pb0, pb1, pb2, pb3
#define PFB_DECL uint4 pa0 = uint4{0, 0, 0, 0}, pa1 = pa0, pa2 = pa0, pa3 = pa0, pb0 = pa0, pb1 = pa0, pb2 = pa0, pb3 = pa0
template <int NBH>
DEVI void gemm_core_bigT(const GemmOp cur, const GemmOp nxt, bool primed, PFB_PARAMS, f32x4 (&acc)[4][4 * NBH], u16* smem) {
  constexpr int BNT = 128 * NBH;
  u16* sA = smem;
  u16* sB = smem + 2 * 256 * LDS_S;
  const int tid = otid(), lane = tid & 63, w = tid >> 6, wm = w >> 1, wn = w & 1;
  const int fr = lane & 15, fq = lane >> 4;
  const int crow = tid >> 3, ckc = tid & 7;
  const int wsw = (ckc ^ (crow & 7)) * 8;
  const int rsw0 = (fq ^ (fr & 7)) * 8;
  const u16* Ag = cur.A + (size_t)crow * cur.lda + ckc * 8;
  const u16* Bg = cur.B + (size_t)crow * cur.ldb + ckc * 8;
  const int nk = cur.K >> 6, km = nk - 1, kmn = (nxt.K >> 6) - 1;
#define BGLOADX(AP, BP, LA, LB, KO)                                                   \
  do {                                                                                \
    pa0 = *(const uint4*)((AP) + (KO));                                             \
    pa1 = *(const uint4*)((AP) + (size_t)64 * (LA) + (KO));                         \
    pa2 = *(const uint4*)((AP) + (size_t)128 * (LA) + (KO));                        \
    pa3 = *(const uint4*)((AP) + (size_t)192 * (LA) + (KO));                        \
    pb0 = *(const uint4*)((BP) + (KO));                                             \
    pb1 = *(const uint4*)((BP) + (size_t)64 * (LB) + (KO));                         \
    if (NBH == 2) {                                                                   \
      pb2 = *(const uint4*)((BP) + (size_t)128 * (LB) + (KO));                      \
      pb3 = *(const uint4*)((BP) + (size_t)192 * (LB) + (KO));                      \
    }                                                                                 \
  } while (0)
#define BGLOADC(T) BGLOADX(Ag, Bg, cur.lda, cur.ldb, ((((T) + cur.koff) & km) * 64))
#define BGLOADN(T) BGLOADX(An, Bn, nxt.lda, nxt.ldb, ((((T) + nxt.koff) & kmn) * 64))
#define BSSTORE(NB)                                                                   \
  do {                                                                                \
    u16* dA = sA + ((NB) * 256 + crow) * LDS_S + wsw;                                 \
    u16* dB = sB + ((NB) * BNT + crow) * LDS_S + wsw;                                 \
    *(uint4*)(dA) = pa0;                                                            \
    *(uint4*)(dA + 64 * LDS_S) = pa1;                                               \
    *(uint4*)(dA + 128 * LDS_S) = pa2;                                              \
    *(uint4*)(dA + 192 * LDS_S) = pa3;                                              \
    *(uint4*)(dB) = pb0;                                                            \
    *(uint4*)(dB + 64 * LDS_S) = pb1;                                               \
    if (NBH == 2) {                                                                   \
      *(uint4*)(dB + 128 * LDS_S) = pb2;                                            \
      *(uint4*)(dB + 192 * LDS_S) = pb3;                                            \
    }                                                                                 \
  } while (0)
#define BLOADFR(BUF, KS)                                                              \
  do {                                                                                \
    const u16* cA = sA + ((BUF) * 256 + wm * 64 + fr) * LDS_S + (rsw0 ^ ((KS) * 32)); \
    const u16* cB = sB + ((BUF) * BNT + wn * (64 * NBH) + fr) * LDS_S + (rsw0 ^ ((KS) * 32)); \
    _Pragma("unroll") for (int i = 0; i < 4; ++i) af[i] = *(const bf16x8*)(cA + i * 16 * LDS_S);  \
    _Pragma("unroll") for (int j = 0; j < 4; ++j) bfr[j] = *(const bf16x8*)(cB + j * 16 * LDS_S); \
  } while (0)
#define BLOADB2(BUF, KS)                                                              \
  do {                                                                                \
    const u16* cB = sB + ((BUF) * BNT + wn * (64 * NBH) + 64 + fr) * LDS_S + (rsw0 ^ ((KS) * 32)); \
    _Pragma("unroll") for (int j = 0; j < 4; ++j) bfr[j] = *(const bf16x8*)(cB + j * 16 * LDS_S); \
  } while (0)
#define BMFMAS(JO)                                                                    \
  do {                                                                                \
    _Pragma("unroll") for (int i = 0; i < 4; ++i)                                     \
      _Pragma("unroll") for (int j = 0; j < 4; ++j)                                   \
        acc[i][(JO) + j] = __builtin_amdgcn_mfma_f32_16x16x32_bf16(bfr[j], af[i], acc[i][(JO) + j], 0, 0, 0);  \
  } while (0)
#define BHALF(BUF, LOADSTMT)                                                          \
  do {                                                                                \
    BLOADFR(BUF, 0);                                                                  \
    __builtin_amdgcn_sched_barrier(0);                                                \
    BSSTORE((BUF) ^ 1);                                                               \
    LOADSTMT;                                                                         \
    __builtin_amdgcn_sched_barrier(0);                                                \
    BMFMAS(0);                                                                        \
    __builtin_amdgcn_sched_barrier(0);                                                \
    if (NBH == 2) {                                                                   \
      BLOADB2(BUF, 0);                                                                \
      __builtin_amdgcn_sched_barrier(0);                                              \
      BMFMAS(4 * (NBH - 1));                                                          \
      __builtin_amdgcn_sched_barrier(0);                                              \
    }                                                                                 \
    BLOADFR(BUF, 1);                                                                  \
    __builtin_amdgcn_sched_barrier(0);                                                \
    BMFMAS(0);                                                                        \
    __builtin_amdgcn_sched_barrier(0);                                                \
    if (NBH == 2) {                                                                   \
      BLOADB2(BUF, 1);                                                                \
      __builtin_amdgcn_sched_barrier(0);                                              \
      BMFMAS(4 * (NBH - 1));                                                          \
      __builtin_amdgcn_sched_barrier(0);                                              \
    }                                                                                 \
    __syncthreads();                                                                  \
  } while (0)
  bf16x8 af[4], bfr[4];
  if (!primed) {
    BGLOADC(0);
    BSSTORE(0);
    __builtin_amdgcn_sched_barrier(0);
    BGLOADC(1);
    __builtin_amdgcn_sched_barrier(0);
    __syncthreads();
  }
#pragma unroll 1
  for (int kt = 0; kt + 2 < nk; kt += 2) {
    BHALF(0, BGLOADC(kt + 2));
    BHALF(1, BGLOADC(kt + 3));
  }
  const u16* An = nxt.A + (size_t)crow * nxt.lda + ckc * 8;
  const u16* Bn = nxt.B + (size_t)crow * nxt.ldb + ckc * 8;
  BHALF(0, BGLOADN(0));
  BHALF(1, BGLOADN(1));
#undef BGLOADX
#undef BGLOADC
#undef BGLOADN
#undef BSSTORE
#undef BLOADFR
#undef BLOADB2
#undef BMFMAS
#undef BHALF
}
DEVI void gemm_core_big(const GemmOp cur, const GemmOp nxt, bool primed, PFB_PARAMS, f32x4 (&acc)[4][8], u16* smem) {
  gemm_core_bigT<2>(cur, nxt, primed, PFB_ARGS, acc, smem);
}

DEVI void phase_proj(const Params& p, int l, int vcu, u16* smem) {
  const u16* xn = (const u16*)(p.ws + WS_XN);
  const u16* wt = (const u16*)(p.ws + WS_WT_IN) + (size_t)l * NPROJ_PAD * LDW1;
  u16* proj = (u16*)(p.ws + WS_PROJ);
  float* small = (float*)(p.ws + WS_SMALL);
  constexpr int NT = 25, MT = M / 256;
  PFB_DECL;
  int mt, nt;
  bool have = tile_map(0, vcu, MT, NT, mt, nt);
  for (int it = 0; have; ++it) {
    const int m0 = mt * 256, n0 = nt * 256;
    const GemmOp cur{xn + (size_t)m0 * LDX, wt + (size_t)n0 * LDW1, LDX, LDW1, 1024, koff_of(mt, nt)};
    int mtn, ntn;
    const bool haven = tile_map(it + 1, vcu, MT, NT, mtn, ntn);
    GemmOp nxt = cur;
    if (haven) { nxt.A = xn + (size_t)(mtn * 256) * LDX; nxt.B = wt + (size_t)(ntn * 256) * LDW1; nxt.koff = koff_of(mtn, ntn); }
    f32x4 acc[4][8];
    zero_acc(acc);
    gemm_core_big(cur, nxt, it > 0, PFB_ARGS, acc, smem);
    const int tid_ = otid(); const int lane = tid_ & 63, w = tid_ >> 6, wm = w >> 1, wn = w & 1, fr = lane & 15, fq = lane >> 4;
#pragma unroll
    for (int i = 0; i < 4; ++i)
#pragma unroll
      for (int j = 0; j < 8; ++j) {
        const int m = m0 + wm * 64 + i * 16 + fr, n = n0 + wn * 128 + j * 16 + fq * 4;
        if (n < NPROJ) {
          uint2 o;
          o.x = pk2(acc[i][j][0], acc[i][j][1]);
          o.y = pk2(acc[i][j][2], acc[i][j][3]);
          *(uint2*)(proj + (size_t)m * NPROJ + n) = o;
        } else if (n < NPROJ + 16) {
          *(float4*)(small + (size_t)m * 16 + (n - NPROJ)) = float4{acc[i][j][0], acc[i][j][1], acc[i][j][2], acc[i][j][3]};
        }
      }
    have = haven; mt = mtn; nt = ntn;
  }
}

DEVI void phase_up(const Params& p, int l, int vcu, u16* smem) {
  const u16* xn = (const u16*)(p.ws + WS_XN);
  const u16* wt = (const u16*)(p.ws + WS_WT_UP) + (size_t)l * 4096 * LDW1;
  u16* hid = (u16*)(p.ws + WS_PROJ);
  constexpr int NT = DFF / 256, MT = M / 256;
  PFB_DECL;
  int mt, nt;
  bool have = tile_map(0, vcu, MT, NT, mt, nt);
  for (int it = 0; have; ++it) {
    const int m0 = mt * 256, n0 = nt * 256;
    const GemmOp cur{xn + (size_t)m0 * LDX, wt + (size_t)n0 * LDW1, LDX, LDW1, 1024, koff_of(mt, nt)};
    int mtn, ntn;
    const bool haven = tile_map(it + 1, vcu, MT, NT, mtn, ntn);
    GemmOp nxt = cur;
    if (haven) { nxt.A = xn + (size_t)(mtn * 256) * LDX; nxt.B = wt + (size_t)(ntn * 256) * LDW1; nxt.koff = koff_of(mtn, ntn); }
    f32x4 acc[4][8];
    zero_acc(acc);
    gemm_core_big(cur, nxt, it > 0, PFB_ARGS, acc, smem);
    const int tid_ = otid(); const int lane = tid_ & 63, w = tid_ >> 6, wm = w >> 1, wn = w & 1, fr = lane & 15, fq = lane >> 4;
#pragma unroll
    for (int i = 0; i < 4; ++i)
#pragma unroll
      for (int j = 0; j < 8; ++j) {
        const int m = m0 + wm * 64 + i * 16 + fr, n = n0 + wn * 128 + j * 16 + fq * 4;
        float r0 = fmaxf(acc[i][j][0], 0.f), r1 = fmaxf(acc[i][j][1], 0.f), r2 = fmaxf(acc[i][j][2], 0.f), r3 = fmaxf(acc[i][j][3], 0.f);
        uint2 o;
        o.x = pk2(r0 * r0, r1 * r1);
        o.y = pk2(r2 * r2, r3 * r3);
        *(uint2*)(hid + (size_t)m * LDH + n) = o;
      }
    have = haven; mt = mtn; nt = ntn;
  }
}

DEVI void merge_sample_rows(const Params& p, int l, int vcu, u16* smem) {
  const u16* xn = (const u16*)(p.ws + WS_XN);
  const u16* y = (const u16*)(p.ws + WS_OBUF);
  const u16* wg = (const u16*)(p.ws + WS_WT_GATE) + (size_t)l * 3072 * LDW1;
  const u16* wb = (const u16*)(p.ws + WS_WT_BR) + (size_t)l * 3 * 1024 * LDWB;
  u16* merged = (u16*)(p.ws + WS_CONV);
  const int tid_ = otid(); const int lane = tid_ & 63, w = tid_ >> 6, wm = w >> 1, wn = w & 1, fr = lane & 15, fq = lane >> 4;
  constexpr int NT = D / 128, MT = MS / 128;
  PF_DECL;
  int mt, nt;
  bool have = tile_map(0, vcu, MT, NT, mt, nt);
  for (int it = 0; have; ++it) {
    const int m0 = MP + mt * 128, n0 = nt * 128;
    const int ko = koff_of(mt, nt);
    int mtn, ntn;
    const bool haven = tile_map(it + 1, vcu, MT, NT, mtn, ntn);
    f32x4 accM[2][4];
    zero_acc(accM);
#pragma unroll 1
    for (int b = 0; b < 3; ++b) {
      f32x4 accG[2][4], accB[2][4];
      zero_acc(accG);
      const GemmOp gate{xn + (size_t)m0 * LDX, wg + ((size_t)b * 1024 + n0) * LDW1, LDX, LDW1, 1024, ko};
      const GemmOp br{y + (size_t)m0 * LDY + b * 512, wb + ((size_t)b * 1024 + n0) * LDWB, LDY, LDWB, 512, ko};
      GemmOp after = gate;
      if (b < 2) {
        after.B = wg + ((size_t)(b + 1) * 1024 + n0) * LDW1;
      } else if (haven) {
        after.A = xn + (size_t)(MP + mtn * 128) * LDX;
        after.B = wg + (size_t)(ntn * 128) * LDW1;
        after.koff = koff_of(mtn, ntn);
      }
      gemm_core<2, 4>(gate, br, (it > 0) || (b > 0), PF_ARGS, accG, smem);
      unsigned gpk[2][4][2];
#pragma unroll
      for (int i = 0; i < 2; ++i)
#pragma unroll
        for (int j = 0; j < 4; ++j) {
          gpk[i][j][0] = pk2(sigm(accG[i][j][0]), sigm(accG[i][j][1]));
          gpk[i][j][1] = pk2(sigm(accG[i][j][2]), sigm(accG[i][j][3]));
        }
      zero_acc(accB);
      gemm_core<2, 4>(br, after, true, PF_ARGS, accB, smem);
#pragma unroll
      for (int i = 0; i < 2; ++i)
#pragma unroll
        for (int j = 0; j < 4; ++j) {
          accM[i][j][0] += bflo(gpk[i][j][0]) * accB[i][j][0];
          accM[i][j][1] += bfhi(gpk[i][j][0]) * accB[i][j][1];
          accM[i][j][2] += bflo(gpk[i][j][1]) * accB[i][j][2];
          accM[i][j][3] += bfhi(gpk[i][j][1]) * accB[i][j][3];
        }
    }
#pragma unroll
    for (int i = 0; i < 2; ++i)
#pragma unroll
      for (int j = 0; j < 4; ++j) {
        const int m = m0 + wm * 32 + i * 16 + fr, n = n0 + wn * 64 + j * 16 + fq * 4;
        uint2 o;
        o.x = pk2(accM[i][j][0], accM[i][j][1]);
        o.y = pk2(accM[i][j][2], accM[i][j][3]);
        *(uint2*)(merged + (size_t)m * LDX + n) = o;
      }
    have = haven; mt = mtn; nt = ntn;
  }
}

DEVI void phase_merge(const Params& p, int l, int vcu, u16* smem) {
  const u16* xn = (const u16*)(p.ws + WS_XN);
  const u16* y = (const u16*)(p.ws + WS_OBUF);
  const u16* wg = (const u16*)(p.ws + WS_WT_GATE) + (size_t)l * 3072 * LDW1;
  const u16* wb = (const u16*)(p.ws + WS_WT_BR) + (size_t)l * 3 * 1024 * LDWB;
  u16* merged = (u16*)(p.ws + WS_CONV);
  constexpr int NT = D / 128, MT = MP / 256;
  PFB_DECL;
  int mt, nt;
  bool have = tile_map(0, vcu, MT, NT, mt, nt);
  for (int it = 0; have; ++it) {
    const int m0 = mt * 256, n0 = nt * 128;
    const int ko = koff_of(mt, nt);
    int mtn, ntn;
    const bool haven = tile_map(it + 1, vcu, MT, NT, mtn, ntn);
    unsigned mpk[4][4][2];
#pragma unroll
    for (int i = 0; i < 4; ++i)
#pragma unroll
      for (int j = 0; j < 4; ++j) { mpk[i][j][0] = 0u; mpk[i][j][1] = 0u; }
#pragma unroll 1
    for (int b = 0; b < 3; ++b) {
      const GemmOp gate{xn + (size_t)m0 * LDX, wg + ((size_t)b * 1024 + n0) * LDW1, LDX, LDW1, 1024, ko};
      const GemmOp br{y + (size_t)m0 * LDY + b * 512, wb + ((size_t)b * 1024 + n0) * LDWB, LDY, LDWB, 512, ko};
      GemmOp after = gate;
      if (b < 2) {
        after.B = wg + ((size_t)(b + 1) * 1024 + n0) * LDW1;
      } else if (haven) {
        after.A = xn + (size_t)(mtn * 256) * LDX;
        after.B = wg + (size_t)(ntn * 128) * LDW1;
        after.koff = koff_of(mtn, ntn);
      }
      unsigned gpk[4][4][2];
      {
        f32x4 accG[4][4];
        zero_acc(accG);
        gemm_core_bigT<1>(gate, br, (it > 0) || (b > 0), PFB_ARGS, accG, smem);
#pragma unroll
        for (int i = 0; i < 4; ++i)
#pragma unroll
          for (int j = 0; j < 4; ++j) {
            gpk[i][j][0] = pk2(sigm(accG[i][j][0]), sigm(accG[i][j][1]));
            gpk[i][j][1] = pk2(sigm(accG[i][j][2]), sigm(accG[i][j][3]));
            asm volatile("" : "+v"(gpk[i][j][0]), "+v"(gpk[i][j][1]));
          }
      }
      {
        f32x4 accB[4][4];
        zero_acc(accB);
        gemm_core_bigT<1>(br, after, true, PFB_ARGS, accB, smem);
#pragma unroll
        for (int i = 0; i < 4; ++i)
#pragma unroll
          for (int j = 0; j < 4; ++j) {
            mpk[i][j][0] = pk2(bflo(mpk[i][j][0]) + bflo(gpk[i][j][0]) * accB[i][j][0], bfhi(mpk[i][j][0]) + bfhi(gpk[i][j][0]) * accB[i][j][1]);
            mpk[i][j][1] = pk2(bflo(mpk[i][j][1]) + bflo(gpk[i][j][1]) * accB[i][j][2], bfhi(mpk[i][j][1]) + bfhi(gpk[i][j][1]) * accB[i][j][3]);
            asm volatile("" : "+v"(mpk[i][j][0]), "+v"(mpk[i][j][1]));
          }
      }
    }
    const int tid_ = otid(); const int lane = tid_ & 63, w = tid_ >> 6, wm = w >> 1, wn = w & 1, fr = lane & 15, fq = lane >> 4;
#pragma unroll
    for (int i = 0; i < 4; ++i)
#pragma unroll
      for (int j = 0; j < 4; ++j) {
        const int m = m0 + wm * 64 + i * 16 + fr, n = n0 + wn * 64 + j * 16 + fq * 4;
        *(uint2*)(merged + (size_t)m * LDX + n) = uint2{mpk[i][j][0], mpk[i][j][1]};
      }
    have = haven; mt = mtn; nt = ntn;
  }
  merge_sample_rows(p, l, vcu, smem);
}

DEVI void phase_resid(const u16* A, int lda, int K, const u16* wt, int ldb, const float* xin_p, const float* xin_s, float* xout, int vcu, u16* smem) {
  for (int t = vcu; t < 256; t += gridDim.x) {
    PFB_DECL;
    int mt, nt;
    tile_map(0, t, 64, 4, mt, nt);
    const int m0 = mt * 256, n0 = nt * 256;
    const GemmOp cur{A + (size_t)m0 * lda, wt + (size_t)n0 * ldb, lda, ldb, K, koff_of(mt, nt)};
    f32x4 acc[4][8];
    zero_acc(acc);
    gemm_core_big(cur, cur, false, PFB_ARGS, acc, smem);
    const int tid_ = otid(); const int lane = tid_ & 63, w = tid_ >> 6, wm = w >> 1, wn = w & 1, fr = lane & 15, fq = lane >> 4;
#pragma unroll
    for (int i = 0; i < 4; ++i)
#pragma unroll
      for (int j = 0; j < 8; ++j) {
        const int m = m0 + wm * 64 + i * 16 + fr, n = n0 + wn * 128 + j * 16 + fq * 4;
        const float4 xv = *(const float4*)(xin_p + (size_t)m * D + n);
        float4 o;
        o.x = xv.x + acc[i][j][0]; o.y = xv.y + acc[i][j][1]; o.z = xv.z + acc[i][j][2]; o.w = xv.w + acc[i][j][3];
        *(float4*)(xout + (size_t)m * D + n) = o;
        if ((j & 1) == 1) __builtin_amdgcn_sched_barrier(0);
      }
  }
  {
    PF_DECL;
    bool first = true;
    for (int t = vcu; t < 32; t += gridDim.x) {
      const int mt = (MP / 128) + (t >> 3), nt = t & 7;
      const int m0 = mt * 128, n0 = nt * 128;
      const GemmOp cur{A + (size_t)m0 * lda, wt + (size_t)n0 * ldb, lda, ldb, K, koff_of(mt, nt)};
      f32x4 acc[2][4];
      zero_acc(acc);
      gemm_core<2, 4>(cur, cur, !first, PF_ARGS, acc, smem);
      const int tid_ = otid(); const int lane = tid_ & 63, w = tid_ >> 6, wm = w >> 1, wn = w & 1, fr = lane & 15, fq = lane >> 4;
      first = false;
#pragma unroll
      for (int i = 0; i < 2; ++i)
#pragma unroll
        for (int j = 0; j < 4; ++j) {
          const int m = m0 + wm * 32 + i * 16 + fr, n = n0 + wn * 64 + j * 16 + fq * 4;
          const float4 xv = *(const float4*)(xin_s + (size_t)(m - MP) * D + n);
          float4 o;
          o.x = xv.x + acc[i][j][0]; o.y = xv.y + acc[i][j][1]; o.z = xv.z + acc[i][j][2]; o.w = xv.w + acc[i][j][3];
          *(float4*)(xout + (size_t)m * D + n) = o;
        }
    }
  }
}

DEVI void unpack8(const uint4 u, float (&f)[8]) {
  f[0] = bflo(u.x); f[1] = bfhi(u.x); f[2] = bflo(u.y); f[3] = bfhi(u.y);
  f[4] = bflo(u.z); f[5] = bfhi(u.z); f[6] = bflo(u.w); f[7] = bfhi(u.w);
}
DEVI uint4 pack8(const float (&f)[8]) {
  uint4 r;
  r.x = pk2(f[0], f[1]); r.y = pk2(f[2], f[3]); r.z = pk2(f[4], f[5]); r.w = pk2(f[6], f[7]);
  return r;
}
DEVI void load8f(const float* p, float (&f)[8]) {
  const float4 a = *(const float4*)p, b = *(const float4*)(p + 4);
  f[0] = a.x; f[1] = a.y; f[2] = a.z; f[3] = a.w; f[4] = b.x; f[5] = b.y; f[6] = b.z; f[7] = b.w;
}
DEVI void phase_prep(const Params& p, int l) {
  const int tid_ = otid(); const int lane = tid_ & 63, gw = blockIdx.x * 8 + (tid_ >> 6), nw = gridDim.x * 8;
  u16* proj = (u16*)(p.ws + WS_PROJ);
  u16* conv = (u16*)(p.ws + WS_CONV);
  const float* small = (const float*)(p.ws + WS_SMALL);
  float* gates = (float*)(p.ws + WS_GATES);
  constexpr int NTASK = (M / 4) * 6;
  for (int task = gw; task < NTASK; task += nw) {
    const int tg = task / 6, k = task - tg * 6;
    const int m0 = tg * 4;
    const bool samp = m0 >= MP;
    int b, t0;
    if (!samp) { b = m0 >> 11; t0 = m0 & 2047; } else { b = (m0 - MP) >> 2; t0 = 0; }
    if (k < 3) {
      const int pp = k;
      const int ch = pp * 512 + lane * 8;
      const u16* src = proj + 2048 + ch;
      float r[7][8], cw[4][8];
#pragma unroll
      for (int j = 0; j < 7; ++j) {
        const int t = t0 - 3 + j;
        if (t >= 0) {
          unpack8(*(const uint4*)(src + (size_t)(m0 - 3 + j) * NPROJ), r[j]);
        } else if (samp) {
          load8f(p.st_gconv + ((size_t)(l * 128 + b) * 3 + j) * 1536 + ch, r[j]);
        } else {
#pragma unroll
          for (int c = 0; c < 8; ++c) r[j][c] = 0.f;
        }
      }
#pragma unroll
      for (int j = 0; j < 4; ++j) load8f(p.gd_conv_w + (size_t)(l * 4 + j) * 1536 + ch, cw[j]);
#pragma unroll
      for (int tt = 0; tt < 4; ++tt) {
        float a[8];
        float ss = 0.f;
#pragma unroll
        for (int c = 0; c < 8; ++c) {
          float sx = 0.f;
#pragma unroll
          for (int j = 0; j < 4; ++j) sx += cw[j][c] * r[tt + j][c];
          a[c] = silu(sx);
          ss += a[c] * a[c];
        }
        if (pp < 2) {
          ss = row16_sum(ss);
          float sc = rsqrtf(ss + 1e-6f);
          if (pp == 0) sc *= 0.08838834764831845f;
#pragma unroll
          for (int c = 0; c < 8; ++c) a[c] *= sc;
        }
        *(uint4*)(conv + (size_t)(m0 + tt) * 1536 + ch) = pack8(a);
      }
      const bool last = samp || (t0 == 2044);
      if (last) {
        float* co = p.out + (samp ? OFF_S_GC + (size_t)(l * 128 + b) * 3 * 1536 : OFF_P_GC + (size_t)(l * 8 + b) * 3 * 1536) + ch;
#pragma unroll
        for (int j = 0; j < 3; ++j) {
          *(float4*)(co + j * 1536) = float4{r[4 + j][0], r[4 + j][1], r[4 + j][2], r[4 + j][3]};
          *(float4*)(co + j * 1536 + 4) = float4{r[4 + j][4], r[4 + j][5], r[4 + j][6], r[4 + j][7]};
        }
      }
    } else if (k < 5) {
      const int part = k - 3;
      const int wch = lane * 8;
      u16* col = proj + 4096 + part * 512 + wch;
      float lb[8];
#pragma unroll
      for (int c = 0; c < 8; ++c) lb[c] = 0.f;
      if (part == 1 && l == 1) {
        float l0[8], l1[8];
        load8f(p.hg_lb_logits + wch, l0);
        load8f(p.hg_lb_logits + 512 + wch, l1);
#pragma unroll
        for (int c = 0; c < 8; ++c) lb[c] = sigm(l1[c] - l0[c]);
      }
      uint4 u[4];
#pragma unroll
      for (int tt = 0; tt < 4; ++tt) u[tt] = *(const uint4*)(col + (size_t)(m0 + tt) * NPROJ);
#pragma unroll
      for (int tt = 0; tt < 4; ++tt) {
        float f[8];
        unpack8(u[tt], f);
#pragma unroll
        for (int c = 0; c < 8; ++c) f[c] = (part == 0) ? silu(f[c]) : (1.f - lb[c]) * sigm(-f[c]);
        *(uint4*)(col + (size_t)(m0 + tt) * NPROJ) = pack8(f);
      }
    } else {
      const int tt = lane >> 4, g = lane & 15, hh = g & 3;
      const float v = small[(size_t)(m0 + tt) * 16 + g];
      float r;
      if (g < 4) r = v + p.ml_i_bias[l * 4 + hh];
      else if (g < 8) { const float x = v + p.ml_f_bias[l * 4 + hh]; r = -softplus(-x); }
      else if (g < 12) r = sigm(v);
      else { const float x = v + p.gd_dt_bias[l * 4 + hh]; r = __expf(-__expf(p.gd_A_log[l * 4 + hh]) * softplus(x)); }
      gates[(size_t)(m0 + tt) * 16 + g] = r;
    }
  }
}

template <int KIND>
DEVI void scan_unit(const Params& p, int l, bool samp, int b, int h, int colbase, float* smem) {
  constexpr int CPL = (KIND == 1) ? 1 : 2;
  constexpr int UC = 32 * CPL;
  constexpr int VCH = UC / 8;
  const int tid = otid(), lane = tid & 63, w = tid >> 6, kg = lane & 15, cl = lane >> 4;
  const int T = samp ? 4 : 2048;
  const int rowbase = samp ? (MP + b * 4) : b * 2048;
  const int NB = samp ? 128 : 8;
  const u16* proj = (const u16*)(p.ws + WS_PROJ);
  const u16* conv = (const u16*)(p.ws + WS_CONV);
  u16* obuf = (u16*)(p.ws + WS_OBUF);
  const float* gates = (const float*)(p.ws + WS_GATES);
  float* dm = (float*)(p.ws + WS_DM);
  const u16 *qsrc, *ksrc, *vsrc;
  int ld, ocol;
  const float* Sin;
  float* Sout;
  const size_t sidx_in = ((size_t)(l * 128 + b) * 4 + h) * 16384;
  const size_t sidx_out = ((size_t)(l * NB + b) * 4 + h) * 16384;
  if (KIND == 0) {
    qsrc = proj + h * 128; ksrc = proj + 512 + h * 128; vsrc = proj + 1024 + h * 128 + colbase; ld = NPROJ; ocol = 0;
    Sin = p.st_mC + sidx_in; Sout = p.out + (samp ? OFF_S_MC : OFF_P_MC) + sidx_out;
  } else if (KIND == 1) {
    qsrc = conv + h * 128; ksrc = conv + 512 + h * 128; vsrc = conv + 1024 + h * 128 + colbase; ld = 1536; ocol = 512;
    Sin = p.st_gS + sidx_in; Sout = p.out + (samp ? OFF_S_GS : OFF_P_GS) + sidx_out;
  } else {
    qsrc = proj + 4096 + h * 128; ksrc = proj + 4608 + h * 128; vsrc = proj + 5120 + h * 128 + colbase; ld = NPROJ; ocol = 1024;
    Sin = p.st_hS + sidx_in; Sout = p.out + (samp ? OFF_S_HS : OFF_P_HS) + sidx_out;
  }
  float* qk = smem;
  float* vl = smem + 2 * 32 * 256;
  float* gl = vl + 2 * 32 * 64;

  const int wc = w * 4 * CPL + cl * CPL;
  const int col0 = colbase + wc;
  v2f S[CPL][4];
  v2f nv[4];
#pragma unroll
  for (int c = 0; c < CPL; ++c)
#pragma unroll
    for (int i = 0; i < 4; ++i) {
      if (samp) { S[c][i].x = Sin[(size_t)(kg * 8 + 2 * i) * 128 + col0 + c]; S[c][i].y = Sin[(size_t)(kg * 8 + 2 * i + 1) * 128 + col0 + c]; }
      else { S[c][i].x = 0.f; S[c][i].y = 0.f; }
    }
  float mstart = 0.f;
  if (KIND == 0) {
    const size_t nidx = ((size_t)(l * 128 + b) * 4 + h) * 128;
#pragma unroll
    for (int i = 0; i < 4; ++i) {
      if (samp) { nv[i].x = p.st_mn[nidx + kg * 8 + 2 * i]; nv[i].y = p.st_mn[nidx + kg * 8 + 2 * i + 1]; }
      else { nv[i].x = 0.f; nv[i].y = 0.f; }
    }
    if (samp) mstart = p.st_mm[(size_t)(l * 128 + b) * 4 + h];
  }

  uint4 rq, rk, rv;
  float g0 = 0.f, g1 = 0.f;
  const int sr = tid >> 4, sc = tid & 15;
  const int vr = tid / VCH, vc = tid % VCH;
  auto prefetch = [&](int j) {
    const int t = j * 32 + sr;
    rq = uint4{0, 0, 0, 0}; rk = uint4{0, 0, 0, 0}; rv = uint4{0, 0, 0, 0};
    if (t < T) {
      rq = *(const uint4*)(qsrc + (size_t)(rowbase + t) * ld + sc * 8);
      rk = *(const uint4*)(ksrc + (size_t)(rowbase + t) * ld + sc * 8);
    }
    if (tid < 32 * VCH) {
      const int tv = j * 32 + vr;
      if (tv < T) rv = *(const uint4*)(vsrc + (size_t)(rowbase + tv) * ld + vc * 8);
    }
    if (KIND != 2) {
      g0 = (KIND == 0) ? -1e30f : 0.f; g1 = 0.f;
      if (tid < 32) {
        const int tg = j * 32 + tid;
        if (tg < T) {
          if (KIND == 0) { g0 = gates[(size_t)(rowbase + tg) * 16 + h]; g1 = gates[(size_t)(rowbase + tg) * 16 + 4 + h]; }
          else { g0 = gates[(size_t)(rowbase + tg) * 16 + 8 + h]; g1 = gates[(size_t)(rowbase + tg) * 16 + 12 + h]; }
        }
      }
    }
  };
  auto stage = [&](int j, int buf) {
    float* qd = qk + (buf * 32 + sr) * 256 + sc * 8;
    *(float4*)(qd) = float4{bflo(rq.x), bfhi(rq.x), bflo(rq.y), bfhi(rq.y)};
    *(float4*)(qd + 4) = float4{bflo(rq.z), bfhi(rq.z), bflo(rq.w), bfhi(rq.w)};
    *(float4*)(qd + 128) = float4{bflo(rk.x), bfhi(rk.x), bflo(rk.y), bfhi(rk.y)};
    *(float4*)(qd + 132) = float4{bflo(rk.z), bfhi(rk.z), bflo(rk.w), bfhi(rk.w)};
    if (tid < 32 * VCH) {
      float* vd = vl + (buf * 32 + vr) * 64 + vc * 8;
      *(float4*)(vd) = float4{bflo(rv.x), bfhi(rv.x), bflo(rv.y), bfhi(rv.y)};
      *(float4*)(vd + 4) = float4{bflo(rv.z), bfhi(rv.z), bflo(rv.w), bfhi(rv.w)};
    }
    if (KIND == 0) {
      if (w == 0) {
        float bs = g1;
#pragma unroll
        for (int d = 1; d < 32; d <<= 1) { const float o = __shfl_up(bs, d); if (lane >= d) bs += o; }
        float R = g0 - bs;
#pragma unroll
        for (int d = 1; d < 32; d <<= 1) { const float o = __shfl_up(R, d); if (lane >= d) R = fmaxf(R, o); }
        const float mt = bs + fmaxf(mstart, R);
        float mprev = __shfl_up(mt, 1);
        if (lane == 0) mprev = mstart;
        const float fw = __expf(g1 + mprev - mt);
        const float iw = __expf(g0 - mt) * 0.08838834764831845f;
        if (lane < 32) {
          float* gd = gl + (buf * 32 + lane) * 4;
          gd[0] = fw; gd[1] = iw; gd[2] = mt;
        }
        int lastv = T - j * 32 - 1;
        if (lastv > 31) lastv = 31;
        mstart = __shfl(mt, lastv);
      }
    } else if (KIND == 1) {
      if (tid < 32) {
        float* gd = gl + (buf * 32 + tid) * 4;
        gd[0] = g0; gd[1] = g1;
      }
    }
  };

  const bool do_n = (KIND == 0) && (colbase == 0) && (w == 0);
  const int nblk = (T + 31) >> 5;
  prefetch(0);
  stage(0, 0);
  __syncthreads();
  for (int j = 0; j < nblk; ++j) {
    const int buf = j & 1;
    if (j + 1 < nblk) prefetch(j + 1);
    int steps = T - j * 32;
    if (steps > 32) steps = 32;
    u16* const obase = obuf + (size_t)(rowbase + j * 32) * LDY + ocol + h * 128 + col0;
    float* const dmbase = dm + (size_t)(rowbase + j * 32) * 8 + h;
    for (int t0 = 0; t0 < steps; t0 += 16) {
      int ns = steps - t0;
      if (ns > 16) ns = 16;
      float keep0 = 0.f, keep1 = 0.f, keepd = 0.f, keepm = 0.f;
#pragma unroll 4
      for (int tt = 0; tt < ns; ++tt) {
        const int t = t0 + tt;
        const float* qp = qk + (buf * 32 + t) * 256 + kg * 8;
        const float4 qa = *(const float4*)(qp), qb = *(const float4*)(qp + 4);
        const float4 ka = *(const float4*)(qp + 128), kb = *(const float4*)(qp + 132);
        const v2f q2[4] = {v2f{qa.x, qa.y}, v2f{qa.z, qa.w}, v2f{qb.x, qb.y}, v2f{qb.z, qb.w}};
        const v2f k2[4] = {v2f{ka.x, ka.y}, v2f{ka.z, ka.w}, v2f{kb.x, kb.y}, v2f{kb.z, kb.w}};
        const float* vp = vl + (buf * 32 + t) * 64 + wc;
        const float* gp = gl + (buf * 32 + t) * 4;
        const bool mine = (kg == tt);
        if (KIND == 0) {
          const float fw = gp[0], iw = gp[1];
          const v2f fw2 = v2f{fw, fw};
          const float2 vv = *(const float2*)vp;
          const float va[2] = {vv.x * iw, vv.y * iw};
          float num[2];
#pragma unroll
          for (int c = 0; c < 2; ++c) {
            const v2f vc2 = v2f{va[c], va[c]};
            v2f a = v2f{0.f, 0.f};
#pragma unroll
            for (int i = 0; i < 4; ++i) {
              S[c][i] = fw2 * S[c][i] + k2[i] * vc2;
              a += q2[i] * S[c][i];
            }
            num[c] = row16_sum(a.x + a.y);
          }
          keep0 = mine ? num[0] : keep0;
          keep1 = mine ? num[1] : keep1;
          if (do_n) {
            const v2f iw2 = v2f{iw, iw};
            v2f a = v2f{0.f, 0.f};
#pragma unroll
            for (int i = 0; i < 4; ++i) {
              nv[i] = fw2 * nv[i] + k2[i] * iw2;
              a += q2[i] * nv[i];
            }
            const float den = row16_sum(a.x + a.y);
            keepd = mine ? den : keepd;
            keepm = mine ? gp[2] : keepm;
          }
        } else if (KIND == 1) {
          const float beta = gp[0], g = gp[1];
          const float v = vp[0];
          v2f a = v2f{0.f, 0.f};
#pragma unroll
          for (int i = 0; i < 4; ++i) a += k2[i] * S[0][i];
          const float kS = row16_sum(a.x + a.y);
          const float vn = beta * (v - g * kS);
          const v2f g2 = v2f{g, g}, vn2 = v2f{vn, vn};
          v2f o2 = v2f{0.f, 0.f};
#pragma unroll
          for (int i = 0; i < 4; ++i) {
            S[0][i] = g2 * S[0][i] + k2[i] * vn2;
            o2 += q2[i] * S[0][i];
          }
          const float o = row16_sum(o2.x + o2.y);
          keep0 = mine ? o : keep0;
        } else {
          const float2 vv = *(const float2*)vp;
          const float va[2] = {vv.x, vv.y};
          float num[2];
#pragma unroll
          for (int c = 0; c < 2; ++c) {
            const v2f vc2 = v2f{va[c], va[c]};
            v2f a = v2f{0.f, 0.f};
#pragma unroll
            for (int i = 0; i < 4; ++i) {
              S[c][i] = S[c][i] + k2[i] * (vc2 - S[c][i]);
              a += q2[i] * S[c][i];
            }
            num[c] = row16_sum(a.x + a.y);
          }
          keep0 = mine ? num[0] : keep0;
          keep1 = mine ? num[1] : keep1;
        }
      }
      if (kg < ns) {
        if (KIND == 1) obase[(size_t)(t0 + kg) * LDY] = f2bf(keep0);
        else *(unsigned*)(obase + (size_t)(t0 + kg) * LDY) = pk2(keep0, keep1);
        if (do_n && cl == 0) { dmbase[(t0 + kg) * 8] = keepd; dmbase[(t0 + kg) * 8 + 4] = keepm; }
      }
    }
    if (j + 1 < nblk) stage(j + 1, buf ^ 1);
    __syncthreads();
  }
#pragma unroll
  for (int c = 0; c < CPL; ++c)
#pragma unroll
    for (int i = 0; i < 4; ++i) {
      Sout[(size_t)(kg * 8 + 2 * i) * 128 + col0 + c] = S[c][i].x;
      Sout[(size_t)(kg * 8 + 2 * i + 1) * 128 + col0 + c] = S[c][i].y;
    }
  if (KIND == 0 && colbase == 0 && w == 0) {
    if (cl == 0) {
      float* no = p.out + (samp ? OFF_S_MN : OFF_P_MN) + ((size_t)(l * NB + b) * 4 + h) * 128 + kg * 8;
#pragma unroll
      for (int i = 0; i < 4; ++i) { no[2 * i] = nv[i].x; no[2 * i + 1] = nv[i].y; }
    }
    if (lane == 0) p.out[(samp ? OFF_S_MM : OFF_P_MM) + (size_t)(l * NB + b) * 4 + h] = mstart;
  }
  __syncthreads();
}

DEVI void scan_sample_unit(const Params& p, int l, int s, float* smem) {
  const int s4 = s & 3;
  if (s4 < 2) {
    const int idx = (s >> 2) * 2 + (s & 1), seq = idx >> 2;
    scan_unit<1>(p, l, true, seq >> 2, seq & 3, (idx & 3) * 32, smem);
  } else {
    const int idx = s >> 2, seq = idx >> 1;
    if (s4 == 2) scan_unit<0>(p, l, true, seq >> 2, seq & 3, (idx & 1) * 64, smem);
    else scan_unit<2>(p, l, true, seq >> 2, seq & 3, (idx & 1) * 64, smem);
  }
}

DEVI void phase_scan(const Params& p, int l, float* smem) {
  for (int u = blockIdx.x; u < 256; u += gridDim.x) {
    if (u < 128) {
      const int seq = u >> 2;
      scan_unit<1>(p, l, false, seq >> 2, seq & 3, (u & 3) * 32, smem);
    } else if (u < 192) {
      const int uu = u - 128, seq = uu >> 1;
      scan_unit<0>(p, l, false, seq >> 2, seq & 3, (uu & 1) * 64, smem);
    } else {
      const int uu = u - 192, seq = uu >> 1;
      scan_unit<2>(p, l, false, seq >> 2, seq & 3, (uu & 1) * 64, smem);
    }
  }
  if (gridDim.x == 256) {
    const int b = blockIdx.x;
    int s0, cnt;
    if (b < 128) { s0 = b * 26; cnt = 26; }
    else if (b < 192) {
      if (((b - 128) & 1) == 0) { s0 = 0; cnt = 0; }
      else { s0 = 3328 + ((b - 128) >> 1) * 8; cnt = 8; }
    } else { s0 = 3328 + (32 + (b - 192)) * 8; cnt = 8; }
    for (int i = 0; i < cnt; ++i) scan_sample_unit(p, l, s0 + i, smem);
  } else {
    for (int s = blockIdx.x; s < 4096; s += gridDim.x) scan_sample_unit(p, l, s, smem);
  }
}

DEVI void phase_post(const Params& p, int l) {
  const int tid_ = otid(); const int lane = tid_ & 63, gw = blockIdx.x * 8 + (tid_ >> 6), nw = gridDim.x * 8;
  const u16* proj = (const u16*)(p.ws + WS_PROJ);
  u16* obuf = (u16*)(p.ws + WS_OBUF);
  const float* dm = (const float*)(p.ws + WS_DM);
  constexpr int NTASK = (M / 4) * 3;
  for (int task = gw; task < NTASK; task += nw) {
    const int tg = task / 3, k = task - tg * 3;
    const int m0 = tg * 4;
    const int c = lane * 8, hh = lane >> 4;
    float wv[8];
    if (k == 0) load8f(p.ml_norm_w + l * 512 + c, wv);
    else if (k == 1) load8f(p.gd_norm_w + l * 128 + (c & 127), wv);
    else load8f(p.hg_norm_w + l * 512 + c, wv);
    const int gcol = (k == 0) ? 1536 : (k == 1 ? 3584 : 5632);
    uint4 ov[4], gv[4];
#pragma unroll
    for (int tt = 0; tt < 4; ++tt) {
      ov[tt] = *(const uint4*)(obuf + (size_t)(m0 + tt) * LDY + k * 512 + c);
      gv[tt] = *(const uint4*)(proj + (size_t)(m0 + tt) * NPROJ + gcol + c);
    }
#pragma unroll
    for (int tt = 0; tt < 4; ++tt) {
      const size_t m = m0 + tt;
      float o[8], g[8];
      unpack8(ov[tt], o);
      unpack8(gv[tt], g);
      if (k == 0) {
        const float den = dm[m * 8 + hh], mt = dm[m * 8 + 4 + hh];
        const float inv = 1.f / fmaxf(fabsf(den), __expf(-mt));
#pragma unroll
        for (int i = 0; i < 8; ++i) o[i] *= inv;
      }
      float ss = 0.f;
#pragma unroll
      for (int i = 0; i < 8; ++i) ss += o[i] * o[i];
      float sc;
      if (k == 2) { ss = wave_sum(ss); sc = rsqrtf(ss * (1.f / 512.f) + 1e-6f); }
      else { ss = row16_sum(ss); sc = rsqrtf(ss * (1.f / 128.f) + 1e-6f); }
#pragma unroll
      for (int i = 0; i < 8; ++i) o[i] = o[i] * sc * wv[i] * ((k == 0) ? sigm(g[i]) : silu(g[i]));
      *(uint4*)(obuf + m * LDY + k * 512 + c) = pack8(o);
    }
  }
}

#define LAS __attribute__((address_space(3)))
#define XB_TMO      128
#define XB_XCNT(j)  (256  + 64 * (j))
#define XB_XSUB(j)  (1280 + 64 * (j))
#define XB_XGEN(j)  (2304 + 64 * (j))
#define XB_TOP      3328
#define XB_TOPGEN   3392
#define XCD_BAR_WORDS 3456
#define XB_SPIN_CAP (1u << 18)

__device__ __forceinline__ unsigned xb_ld(unsigned* p)              { return __hip_atomic_load(p, __ATOMIC_RELAXED, __HIP_MEMORY_SCOPE_AGENT); }
__device__ __forceinline__ unsigned xb_add(unsigned* p, unsigned v) { return __hip_atomic_fetch_add(p, v, __ATOMIC_RELAXED, __HIP_MEMORY_SCOPE_AGENT); }
__device__ __forceinline__ unsigned xb_xcc_id() { return (unsigned)__builtin_amdgcn_s_getreg((3 << 11) | 20) & 0xFu; }
#define XB_SPIN(cond, bar) do { unsigned _sp = 0; while (cond) { __builtin_amdgcn_s_sleep(1); \
    if ((++_sp & 255u) == 0u) { if (xb_ld(&(bar)[XB_TMO])) break; if (_sp > XB_SPIN_CAP) { atomicAdd(&(bar)[XB_TMO], 1u); break; } } } } while (0)

struct XcdBarrier {
    unsigned* bar; unsigned x;
    volatile LAS unsigned* st;
};

__device__ __forceinline__ XcdBarrier xcd_barrier_post(unsigned* bar, volatile LAS unsigned* st) {
    XcdBarrier b; b.bar = bar; b.x = xb_xcc_id(); b.st = st;
    if (threadIdx.x == 0) (void)xb_add(&bar[XB_XCNT(b.x)], 1u);
    return b;
}
__device__ __forceinline__ void xcd_barrier_complete(unsigned* bar, unsigned x, unsigned& nloc, unsigned& nx) {
    const unsigned G = gridDim.x * gridDim.y * gridDim.z;
    unsigned sum, cnt, mine, sp = 0u;
    for (;;) {
        sum = 0u; cnt = 0u; mine = 0u;
#pragma unroll
        for (unsigned j = 0; j < 16; ++j) { const unsigned c = xb_ld(&bar[XB_XCNT(j)]); sum += c; cnt += (c > 0u) ? 1u : 0u; mine = (j == x) ? c : mine; }
        if (sum == G) break;
        __builtin_amdgcn_s_sleep(1);
        if ((++sp & 255u) == 0u) { if (xb_ld(&bar[XB_TMO])) break; if (sp > XB_SPIN_CAP) { atomicAdd(&bar[XB_TMO], 1u); break; } }
    }
    nloc = mine > 0u ? mine : 1u; nx = cnt > 0u ? cnt : 1u;
}

__device__ __forceinline__ void xcd_barrier(const XcdBarrier& b) {
    asm volatile("s_waitcnt vmcnt(0)" ::: "memory");
    __syncthreads();
    if (threadIdx.x == 0) {
        unsigned* bar = b.bar;
        __builtin_amdgcn_s_waitcnt(0);
        unsigned nloc = b.st[0], nx = b.st[1];
        if (nloc == 0u) { xcd_barrier_complete(bar, b.x, nloc, nx); b.st[0] = nloc; b.st[1] = nx; }
        const unsigned old = xb_add(&bar[XB_XSUB(b.x)], 1u);
        const unsigned gen = old / nloc;
        if (old + 1u == (gen + 1u) * nloc) {
            __builtin_amdgcn_fence(__ATOMIC_RELEASE, "agent");
            asm volatile("s_waitcnt vmcnt(0)" ::: "memory");
            const unsigned og = xb_add(&bar[XB_TOP], 1u);
            const unsigned tg = og / nx;
            if (og + 1u == (tg + 1u) * nx) xb_add(&bar[XB_TOPGEN], 1u);
            else XB_SPIN(xb_ld(&bar[XB_TOPGEN]) == tg, bar);
            __builtin_amdgcn_fence(__ATOMIC_ACQUIRE, "agent");
            xb_add(&bar[XB_XGEN(b.x)], 1u);
            asm volatile("s_waitcnt vmcnt(0)" ::: "memory");
        } else {
            XB_SPIN(xb_ld(&bar[XB_XGEN(b.x)]) == gen, bar);
            __builtin_amdgcn_fence(__ATOMIC_ACQUIRE, "agent");
            asm volatile("s_waitcnt vmcnt(0)" ::: "memory");
        }
    }
    __syncthreads();
}


__global__ void __launch_bounds__(NTHREADS) mega_fwd(Params p) {
  extern __shared__ __attribute__((aligned(16))) unsigned char smem_raw[];
  cg::grid_group grid = cg::this_grid();
  float* smf = (float*)smem_raw;
  u16* smh = (u16*)smem_raw;
  u16* xn = (u16*)(p.ws + WS_XN);
  float* x = p.out;

  volatile LAS unsigned* bst = (volatile LAS unsigned*)(smem_raw + LDS_BYTES - 16);
  if (threadIdx.x < 2) bst[threadIdx.x] = 0u;
  __syncthreads();
  XcdBarrier xbar; xbar.bar = (unsigned*)(p.ws + WS_BAR); xbar.x = xb_xcc_id(); xbar.st = bst;
  if (threadIdx.x == 0) bst[2] = xb_add(&xbar.bar[XB_XCNT(xbar.x)], 1u);
  phase_wprep(p, smf);
  phase_norm(p.x_prompt, p.x_sample, p.norm1_w, xn);
  grid.sync();
  if (threadIdx.x == 0) {
    const unsigned per = gridDim.x >> 3;
    bool ok = (gridDim.x & 7u) == 0u && xbar.x < 8u;
    for (unsigned j = 0; j < 8; ++j) ok = ok && (xb_ld(&xbar.bar[XB_XCNT(j)]) == per);
    const unsigned rank = bst[2];
    bst[3] = (ok && rank < per) ? xbar.x * per + rank : (blockIdx.x & 7u) * per + (blockIdx.x >> 3);
  }
  __syncthreads();
  const int vcu = __builtin_amdgcn_readfirstlane((int)bst[3]);
#pragma unroll 1
  for (int l = 0; l < 2; ++l) {
    phase_proj(p, l, vcu, smh);
    xcd_barrier(xbar);
    phase_prep(p, l);
    xcd_barrier(xbar);
    phase_scan(p, l, smf);
    xcd_barrier(xbar);
    phase_post(p, l);
    xcd_barrier(xbar);
    phase_merge(p, l, vcu, smh);
    xcd_barrier(xbar);
    if (l == 0)
      phase_resid((const u16*)(p.ws + WS_CONV), LDX, 1024, (const u16*)(p.ws + WS_WT_OUT), LDW1, p.x_prompt, p.x_sample, x, vcu, smh);
    else
      phase_resid((const u16*)(p.ws + WS_CONV), LDX, 1024, (const u16*)(p.ws + WS_WT_OUT) + (size_t)1024 * LDW1, LDW1, x, x + (size_t)MP * D, x, vcu, smh);
    xcd_barrier(xbar);
    phase_norm(x, x + (size_t)MP * D, p.norm2_w + l * D, xn);
    xcd_barrier(xbar);
    phase_up(p, l, vcu, smh);
    xcd_barrier(xbar);
    phase_resid((const u16*)(p.ws + WS_PROJ), LDH, 4096, (const u16*)(p.ws + WS_WT_DN) + (size_t)l * 1024 * LDWD, LDWD, x, x + (size_t)MP * D, x, vcu, smh);
    xcd_barrier(xbar);
    if (l == 0) {
      phase_norm(x, x + (size_t)MP * D, p.norm1_w + D, xn);
      xcd_barrier(xbar);
    }
  }
  phase_final_norm(x, p.final_norm_w);
}

extern "C" void kernel_launch(void* const* d_in, const int* in_sizes, int n_in, void* d_out, int out_size, void* d_ws,
                              size_t ws_size, hipStream_t stream) {
  static int grid_blocks = 0;
  if (!grid_blocks) {
    int dev = 0, cus = 0, per_cu = 0;
    hipGetDevice(&dev);
    hipDeviceGetAttribute(&cus, hipDeviceAttributeMultiprocessorCount, dev);
    hipFuncSetAttribute((const void*)mega_fwd, hipFuncAttributeMaxDynamicSharedMemorySize, LDS_BYTES);
    hipOccupancyMaxActiveBlocksPerMultiprocessor(&per_cu, (const void*)mega_fwd, NTHREADS, LDS_BYTES);
    if (per_cu < 1) { fprintf(stderr, "occupancy query returned %d\n", per_cu); per_cu = 1; }
    grid_blocks = cus;
    if (ws_size < WS_END) fprintf(stderr, "workspace too small: %zu < %zu\n", ws_size, (size_t)WS_END);
  }
  Params p{};
  p.x_prompt = (const float*)d_in[0]; p.x_sample = (const float*)d_in[1];
  p.st_mC = (const float*)d_in[2]; p.st_mn = (const float*)d_in[3]; p.st_mm = (const float*)d_in[4];
  p.st_gS = (const float*)d_in[5]; p.st_gconv = (const float*)d_in[6]; p.st_hS = (const float*)d_in[7];
  p.norm1_w = (const float*)d_in[8]; p.w_in = (const float*)d_in[9]; p.ml_i_bias = (const float*)d_in[10];
  p.ml_f_bias = (const float*)d_in[11]; p.ml_norm_w = (const float*)d_in[12]; p.gd_conv_w = (const float*)d_in[13];
  p.gd_A_log = (const float*)d_in[14]; p.gd_dt_bias = (const float*)d_in[15]; p.gd_norm_w = (const float*)d_in[16];
  p.hg_lb_logits = (const float*)d_in[17]; p.hg_norm_w = (const float*)d_in[18]; p.w_branch = (const float*)d_in[19];
  p.w_out = (const float*)d_in[20]; p.norm2_w = (const float*)d_in[21]; p.w_up = (const float*)d_in[22];
  p.w_down = (const float*)d_in[23]; p.final_norm_w = (const float*)d_in[24];
  p.out = (float*)d_out;
  p.ws = (unsigned char*)d_ws;
  hipMemsetAsync((char*)d_ws + WS_BAR, 0, WS_BAR_BYTES, stream);
  void* args[] = {&p};
  hipError_t e = hipLaunchCooperativeKernel((const void*)mega_fwd, dim3(grid_blocks), dim3(NTHREADS), args, LDS_BYTES, stream);
  if (e != hipSuccess) fprintf(stderr, "cooperative launch failed: %s (grid %d)\n", hipGetErrorString(e), grid_blocks);
}
```

```cpp
#include <hip/hip_runtime.h>
#include <hip/hip_cooperative_groups.h>
#include <cstdio>
namespace cg = cooperative_groups;

typedef unsigned short u16;
using bf16x8 = __attribute__((ext_vector_type(8))) short;
using f32x4 = __attribute__((ext_vector_type(4))) float;
typedef float v2f __attribute__((ext_vector_type(2)));

#define DEVI __device__ __forceinline__

constexpr int D = 1024;
constexpr int MP = 16384, MS = 512, M = MP + MS;
constexpr int NPROJ = 6144, NPROJ_PAD = 6272;
constexpr int INC = 9232;
constexpr int DFF = 4096;
constexpr int NTHREADS = 512;
constexpr int LDS_BYTES = 132 * 1024;
constexpr int LDX = 1088, LDH = 4160, LDY = 1600, LDW1 = 1088, LDWB = 576, LDWD = 4160;

constexpr size_t OFF_Y = 0;
constexpr size_t OFF_P_MC = (size_t)M * D;
constexpr size_t OFF_P_MN = OFF_P_MC + 2ull * 8 * 4 * 128 * 128;
constexpr size_t OFF_P_MM = OFF_P_MN + 2ull * 8 * 4 * 128;
constexpr size_t OFF_P_GS = OFF_P_MM + 2ull * 8 * 4;
constexpr size_t OFF_P_GC = OFF_P_GS + 2ull * 8 * 4 * 128 * 128;
constexpr size_t OFF_P_HS = OFF_P_GC + 2ull * 8 * 3 * 1536;
constexpr size_t OFF_S_MC = OFF_P_HS + 2ull * 8 * 4 * 128 * 128;
constexpr size_t OFF_S_MN = OFF_S_MC + 2ull * 128 * 4 * 128 * 128;
constexpr size_t OFF_S_MM = OFF_S_MN + 2ull * 128 * 4 * 128;
constexpr size_t OFF_S_GS = OFF_S_MM + 2ull * 128 * 4;
constexpr size_t OFF_S_GC = OFF_S_GS + 2ull * 128 * 4 * 128 * 128;
constexpr size_t OFF_S_HS = OFF_S_GC + 2ull * 128 * 3 * 1536;
static_assert(OFF_S_HS + 2ull * 128 * 4 * 128 * 128 == 72172608ull, "output size");

constexpr size_t WS_WT_IN = 0;
constexpr size_t WS_WT_GATE = WS_WT_IN + 2ull * NPROJ_PAD * LDW1 * 2;
constexpr size_t WS_WT_BR = WS_WT_GATE + 2ull * 3072 * LDW1 * 2;
constexpr size_t WS_WT_OUT = WS_WT_BR + 2ull * 3 * 1024 * LDWB * 2;
constexpr size_t WS_WT_UP = WS_WT_OUT + 2ull * 1024 * LDW1 * 2;
constexpr size_t WS_WT_DN = WS_WT_UP + 2ull * 4096 * LDW1 * 2;
constexpr size_t WS_PROJ = WS_WT_DN + 2ull * 1024 * LDWD * 2;
constexpr size_t WS_CONV = WS_PROJ + (size_t)M * NPROJ * 2;
constexpr size_t WS_OBUF = WS_CONV + (size_t)M * 1536 * 2;
constexpr size_t WS_XN = WS_OBUF + (size_t)M * LDY * 2;
constexpr size_t WS_SMALL = WS_XN + (size_t)M * LDX * 2;
constexpr size_t WS_GATES = WS_SMALL;
constexpr size_t WS_DM = WS_GATES + (size_t)M * 16 * 4;
constexpr size_t WS_BAR = WS_DM + (size_t)M * 8 * 4;
constexpr size_t WS_BAR_BYTES = 16384;
constexpr size_t WS_END = WS_BAR + WS_BAR_BYTES;
static_assert(WS_END <= 439571584ull, "workspace budget");
static_assert((size_t)M * LDH * 2 <= (size_t)M * NPROJ * 2 && (size_t)M * LDX * 2 <= (size_t)M * 1536 * 2, "aliases fit");

struct Params {
  const float *x_prompt, *x_sample, *st_mC, *st_mn, *st_mm, *st_gS, *st_gconv, *st_hS;
  const float *norm1_w, *w_in, *ml_i_bias, *ml_f_bias, *ml_norm_w, *gd_conv_w, *gd_A_log, *gd_dt_bias,
      *gd_norm_w, *hg_lb_logits, *hg_norm_w, *w_branch, *w_out, *norm2_w, *w_up, *w_down, *final_norm_w;
  float* out;
  unsigned char* ws;
};

DEVI u16 f2bf(float f) { unsigned u = __float_as_uint(f); return (u16)((u + 0x7fffu + ((u >> 16) & 1u)) >> 16); }
DEVI unsigned pk2(float lo, float hi) { return (unsigned)f2bf(lo) | ((unsigned)f2bf(hi) << 16); }
DEVI float bflo(unsigned u) { return __uint_as_float(u << 16); }
DEVI float bfhi(unsigned u) { return __uint_as_float(u & 0xffff0000u); }
DEVI float sigm(float x) { return __builtin_amdgcn_rcpf(1.f + __expf(-x)); }
DEVI float silu(float x) { return x * sigm(x); }
DEVI float softplus(float x) { return fmaxf(x, 0.f) + __logf(1.f + __expf(-fabsf(x))); }
DEVI int otid() { int t = threadIdx.x; asm volatile("" : "+v"(t)); return t; }
DEVI float wave_sum(float v) {
#pragma unroll
  for (int o = 32; o > 0; o >>= 1) v += __shfl_xor(v, o);
  return v;
}
template <int CTRL> DEVI float dpp_f(float v) {
  return __int_as_float(__builtin_amdgcn_update_dpp(0, __float_as_int(v), CTRL, 0xf, 0xf, false));
}
DEVI float row16_sum(float v) {
  float r;
  asm("s_nop 1\n\tv_add_f32_dpp %0, %1, %1 row_ror:8 row_mask:0xf bank_mask:0xf" : "=v"(r) : "v"(v));
  asm("s_nop 1\n\tv_add_f32_dpp %0, %1, %1 row_ror:4 row_mask:0xf bank_mask:0xf" : "=v"(v) : "v"(r));
  asm("s_nop 1\n\tv_add_f32_dpp %0, %1, %1 row_ror:2 row_mask:0xf bank_mask:0xf" : "=v"(r) : "v"(v));
  asm("s_nop 1\n\tv_add_f32_dpp %0, %1, %1 row_ror:1 row_mask:0xf bank_mask:0xf" : "=v"(v) : "v"(r));
  return v;
}

DEVI void tr_seg(const float* __restrict__ src, int ld, int K, int ncols, u16* __restrict__ dst, int dld, float* tile, int& off) {
  const int tid_ = otid();
  const int lane = tid_ & 63, gw = blockIdx.x * 8 + (tid_ >> 6), nw = gridDim.x * 8;
  const int nkb = K >> 4, nnb = ncols >> 6, nt = nkb * nnb;
  const int start = (int)(((long)gw + (long)nw * 4096 - off) % nw);
  for (int t = start; t < nt; t += nw) {
    const int kb = t % nkb, nb = t / nkb;
    const float* sp = src + (size_t)(kb * 16) * ld + nb * 64 + lane;
    float v[16];
#pragma unroll
    for (int i = 0; i < 16; ++i) v[i] = sp[(size_t)i * ld];
    uint4 o0, o1;
    o0.x = pk2(v[0], v[1]); o0.y = pk2(v[2], v[3]); o0.z = pk2(v[4], v[5]); o0.w = pk2(v[6], v[7]);
    o1.x = pk2(v[8], v[9]); o1.y = pk2(v[10], v[11]); o1.z = pk2(v[12], v[13]); o1.w = pk2(v[14], v[15]);
    u16* dp = dst + (size_t)(nb * 64 + lane) * dld + kb * 16;
    *(uint4*)dp = o0;
    *(uint4*)(dp + 8) = o1;
  }
  off += nt;
}

DEVI void phase_wprep(const Params& p, float* tile) {
  int off = 0;
  u16* wt_in = (u16*)(p.ws + WS_WT_IN);
  u16* wt_gate = (u16*)(p.ws + WS_WT_GATE);
  u16* wt_br = (u16*)(p.ws + WS_WT_BR);
  u16* wt_out = (u16*)(p.ws + WS_WT_OUT);
  u16* wt_up = (u16*)(p.ws + WS_WT_UP);
  u16* wt_dn = (u16*)(p.ws + WS_WT_DN);
  for (int l = 0; l < 2; ++l) {
    const float* win = p.w_in + (size_t)l * 1024 * INC;
    for (int s = 0; s < 12; ++s) {
      const int srccol = (s < 4) ? s * 512 : (s < 8 ? 2056 + (s - 4) * 512 : 4112 + (s - 8) * 512);
      tr_seg(win + srccol, INC, 1024, 512, wt_in + ((size_t)l * NPROJ_PAD + s * 512) * LDW1, LDW1, tile, off);
    }
    tr_seg(win + 6160, INC, 1024, 3072, wt_gate + (size_t)l * 3072 * LDW1, LDW1, tile, off);
    for (int b = 0; b < 3; ++b)
      tr_seg(p.w_branch + (size_t)(l * 3 + b) * 512 * 1024, 1024, 512, 1024, wt_br + (size_t)(l * 3 + b) * 1024 * LDWB, LDWB, tile, off);
    tr_seg(p.w_out + (size_t)l * 1024 * 1024, 1024, 1024, 1024, wt_out + (size_t)l * 1024 * LDW1, LDW1, tile, off);
    tr_seg(p.w_up + (size_t)l * 1024 * 4096, 4096, 1024, 4096, wt_up + (size_t)l * 4096 * LDW1, LDW1, tile, off);
    tr_seg(p.w_down + (size_t)l * 4096 * 1024, 1024, 4096, 1024, wt_dn + (size_t)l * 1024 * LDWD, LDWD, tile, off);
  }
  for (int idx = blockIdx.x * NTHREADS + otid(); idx < 2 * 128 * 1024; idx += gridDim.x * NTHREADS) {
    const int l = idx >> 17, rem = idx & 131071, r = rem >> 10, k = rem & 1023;
    float v = 0.f;
    if (r < 16) {
      const int sc = (r < 8) ? 2048 + r : 4104 + (r - 8);
      v = p.w_in[(size_t)l * 1024 * INC + (size_t)k * INC + sc];
    }
    wt_in[((size_t)l * NPROJ_PAD + 6144 + r) * LDW1 + k] = f2bf(v);
  }
}

DEVI void phase_norm(const float* xp, const float* xs, const float* __restrict__ w, u16* __restrict__ xn) {
  const int tid_ = otid(); const int lane = tid_ & 63, gw = blockIdx.x * 8 + (tid_ >> 6), nw = gridDim.x * 8;
  for (int m = gw; m < M; m += nw) {
    const float* xr = (m < MP) ? xp + (size_t)m * D : xs + (size_t)(m - MP) * D;
    float4 v[4];
    float ss = 0.f;
#pragma unroll
    for (int i = 0; i < 4; ++i) {
      v[i] = ((const float4*)xr)[lane + 64 * i];
      ss += v[i].x * v[i].x + v[i].y * v[i].y + v[i].z * v[i].z + v[i].w * v[i].w;
    }
    ss = wave_sum(ss);
    const float rstd = rsqrtf(ss * (1.f / 1024.f) + 1e-6f);
#pragma unroll
    for (int i = 0; i < 4; ++i) {
      const float4 wv = ((const float4*)w)[lane + 64 * i];
      uint2 o;
      o.x = pk2(v[i].x * rstd * wv.x, v[i].y * rstd * wv.y);
      o.y = pk2(v[i].z * rstd * wv.z, v[i].w * rstd * wv.w);
      ((uint2*)(xn + (size_t)m * LDX))[lane + 64 * i] = o;
    }
  }
}

DEVI void phase_final_norm(float* x, const float* __restrict__ w) {
  const int tid_ = otid(); const int lane = tid_ & 63, gw = blockIdx.x * 8 + (tid_ >> 6), nw = gridDim.x * 8;
  for (int m = gw; m < M; m += nw) {
    float* xr = x + (size_t)m * D;
    float4 v[4];
    float ss = 0.f;
#pragma unroll
    for (int i = 0; i < 4; ++i) {
      v[i] = ((const float4*)xr)[lane + 64 * i];
      ss += v[i].x * v[i].x + v[i].y * v[i].y + v[i].z * v[i].z + v[i].w * v[i].w;
    }
    ss = wave_sum(ss);
    const float rstd = rsqrtf(ss * (1.f / 1024.f) + 1e-6f);
#pragma unroll
    for (int i = 0; i < 4; ++i) {
      const float4 wv = ((const float4*)w)[lane + 64 * i];
      float4 o;
      o.x = v[i].x * rstd * wv.x; o.y = v[i].y * rstd * wv.y; o.z = v[i].z * rstd * wv.z; o.w = v[i].w * rstd * wv.w;
      ((float4*)xr)[lane + 64 * i] = o;
    }
  }
}

constexpr int LDS_S = 64;

struct GemmOp { const u16* A; const u16* B; int lda, ldb, K, koff; };

DEVI bool tile_map(int it, int vcu, int MT, int NT, int& mt, int& nt) {
  const int G = gridDim.x;
  const int t = it * G + vcu;
  if (t >= MT * NT) return false;
  constexpr int GM = 4;
  const int gsize = GM * NT;
  const int g = t / gsize, tl = t - g * gsize;
  int gsz = MT - g * GM;
  if (gsz > GM) gsz = GM;
  mt = g * GM + (tl % gsz);
  nt = tl / gsz;
  return true;
}
DEVI int koff_of(int mt, int nt) { return 0; }

template <int WMT, int WNT>
DEVI void zero_acc(f32x4 (&acc)[WMT][WNT]) {
#pragma unroll
  for (int i = 0; i < WMT; ++i)
#pragma unroll
    for (int j = 0; j < WNT; ++j) acc[i][j] = f32x4{0.f, 0.f, 0.f, 0.f};
}

#define PF_PARAMS uint4 &pa0, uint4 &pa1, uint4 &pa2, uint4 &pa3, uint4 &pb0, uint4 &pb1, uint4 &qa0, uint4 &qa1, uint4 &qa2, uint4 &qa3, uint4 &qb0, uint4 &qb1
#define PF_ARGS pa0, pa1, pa2, pa3, pb0, pb1, qa0, qa1, qa2, qa3, qb0, qb1
#define PF_DECL uint4 pa0 = uint4{0, 0, 0, 0}, pa1 = pa0, pa2 = pa0, pa3 = pa0, pb0 = pa0, pb1 = pa0, qa0 = pa0, qa1 = pa0, qa2 = pa0, qa3 = pa0, qb0 = pa0, qb1 = pa0
template <int WMT, int WNT>
DEVI void gemm_core(const GemmOp cur, const GemmOp nxt, bool primed, PF_PARAMS, f32x4 (&acc)[WMT][WNT], u16* smem) {
  constexpr int BM = 64 * WMT, BN = 32 * WNT;
  constexpr int ACH = BM * 8 / NTHREADS, BCH = BN * 8 / NTHREADS;
  static_assert(BCH == 2 && (ACH == 2 || ACH == 4), "chunk counts");
  u16* sA = smem;
  u16* sB = smem + 2 * BM * LDS_S;
  const int tid = otid(), lane = tid & 63, w = tid >> 6, wm = w >> 1, wn = w & 1;
  const int fr = lane & 15, fq = lane >> 4;
  const int crow = tid >> 3, ckc = tid & 7;
  const int wsw = (ckc ^ (crow & 7)) * 8;
  const int rsw0 = (fq ^ (fr & 7)) * 8;
  const u16* Ag = cur.A + (size_t)crow * cur.lda + ckc * 8;
  const u16* Bg = cur.B + (size_t)crow * cur.ldb + ckc * 8;
  const int nk = cur.K >> 6, km = nk - 1, kmn = (nxt.K >> 6) - 1;
#define GLOADX(S, AP, BP, LA, LB, KO)                                                 \
  do {                                                                                \
    S##a0 = *(const uint4*)((AP) + (KO));                                           \
    S##a1 = *(const uint4*)((AP) + (size_t)64 * (LA) + (KO));                       \
    if (ACH == 4) {                                                                   \
      S##a2 = *(const uint4*)((AP) + (size_t)128 * (LA) + (KO));                    \
      S##a3 = *(const uint4*)((AP) + (size_t)192 * (LA) + (KO));                    \
    }                                                                                 \
    S##b0 = *(const uint4*)((BP) + (KO));                                           \
    S##b1 = *(const uint4*)((BP) + (size_t)64 * (LB) + (KO));                       \
  } while (0)
#define GLOADC(S, T) GLOADX(S, Ag, Bg, cur.lda, cur.ldb, ((((T) + cur.koff) & km) * 64))
#define GLOADN(S, T) GLOADX(S, An, Bn, nxt.lda, nxt.ldb, ((((T) + nxt.koff) & kmn) * 64))
#define SSTORE(S, NB)                                                                 \
  do {                                                                                \
    u16* dA = sA + ((NB) * BM + crow) * LDS_S + wsw;                                  \
    u16* dB = sB + ((NB) * BN + crow) * LDS_S + wsw;                                  \
    *(uint4*)(dA) = S##a0;                                                          \
    *(uint4*)(dA + 64 * LDS_S) = S##a1;                                             \
    if (ACH == 4) {                                                                   \
      *(uint4*)(dA + 128 * LDS_S) = S##a2;                                          \
      *(uint4*)(dA + 192 * LDS_S) = S##a3;                                          \
    }                                                                                 \
    *(uint4*)(dB) = S##b0;                                                          \
    *(uint4*)(dB + 64 * LDS_S) = S##b1;                                             \
  } while (0)
#define LOADFR(BUF)                                                                   \
  do {                                                                                \
    const u16* cA = sA + ((BUF) * BM + wm * 16 * WMT + fr) * LDS_S;                   \
    const u16* cB = sB + ((BUF) * BN + wn * 16 * WNT + fr) * LDS_S;                   \
    _Pragma("unroll") for (int ks = 0; ks < 2; ++ks) {                                \
      const int so = rsw0 ^ (ks * 32);                                                \
      _Pragma("unroll") for (int i = 0; i < WMT; ++i) af[ks][i] = *(const bf16x8*)(cA + i * 16 * LDS_S + so);  \
      _Pragma("unroll") for (int j = 0; j < WNT; ++j) bfr[ks][j] = *(const bf16x8*)(cB + j * 16 * LDS_S + so); \
    }                                                                                 \
  } while (0)
#define MFMAS()                                                                       \
  do {                                                                                \
    _Pragma("unroll") for (int ks = 0; ks < 2; ++ks)                                  \
      _Pragma("unroll") for (int i = 0; i < WMT; ++i)                                 \
        _Pragma("unroll") for (int j = 0; j < WNT; ++j)                               \
          acc[i][j] = __builtin_amdgcn_mfma_f32_16x16x32_bf16(bfr[ks][j], af[ks][i], acc[i][j], 0, 0, 0);  \
  } while (0)
#define HALF(BUF, SS, LOADSTMT)                                                       \
  do {                                                                                \
    LOADFR(BUF);                                                                      \
    __builtin_amdgcn_sched_barrier(0);                                                \
    SSTORE(SS, (BUF) ^ 1);                                                            \
    LOADSTMT;                                                                         \
    __builtin_amdgcn_sched_barrier(0);                                                \
    MFMAS();                                                                          \
    __builtin_amdgcn_sched_barrier(0);                                                \
    __syncthreads();                                                                  \
  } while (0)
  bf16x8 af[2][WMT], bfr[2][WNT];
  if (!primed) {
    GLOADC(p, 0);
    SSTORE(p, 0);
    __builtin_amdgcn_sched_barrier(0);
    GLOADC(q, 1);
    __builtin_amdgcn_sched_barrier(0);
    GLOADC(p, 2);
    __builtin_amdgcn_sched_barrier(0);
    __syncthreads();
  }
#pragma unroll 1
  for (int kt = 0; kt + 4 < nk; kt += 2) {
    HALF(0, q, GLOADC(q, kt + 3));
    HALF(1, p, GLOADC(p, kt + 4));
  }
  HALF(0, q, GLOADC(q, nk - 1));
  const u16* An = nxt.A + (size_t)crow * nxt.lda + ckc * 8;
  const u16* Bn = nxt.B + (size_t)crow * nxt.ldb + ckc * 8;
  HALF(1, p, GLOADN(p, 0));
  HALF(0, q, GLOADN(q, 1));
  HALF(1, p, GLOADN(p, 2));
#undef GLOADX
#undef GLOADC
#undef GLOADN
#undef SSTORE
#undef LOADFR
#undef MFMAS
#undef HALF
}

#define PFB_PARAMS uint4 &pa0, uint4 &pa1, uint4 &pa2, uint4 &pa3, uint4 &pb0, uint4 &pb1, uint4 &pb2, uint4 &pb3
#define PFB_ARGS pa0, pa1, pa2, pa3, pb0, pb1, pb2, pb3
#define PFB_DECL uint4 pa0 = uint4{0, 0, 0, 0}, pa1 = pa0, pa2 = pa0, pa3 = pa0, pb0 = pa0, pb1 = pa0, pb2 = pa0, pb3 = pa0
template <int NBH>
DEVI void gemm_core_bigT(const GemmOp cur, const GemmOp nxt, bool primed, PFB_PARAMS, f32x4 (&acc)[4][4 * NBH], u16* smem) {
  constexpr int BNT = 128 * NBH;
  u16* sA = smem;
  u16* sB = smem + 2 * 256 * LDS_S;
  const int tid = otid(), lane = tid & 63, w = tid >> 6, wm = w >> 1, wn = w & 1;
  const int fr = lane & 15, fq = lane >> 4;
  const int crow = tid >> 3, ckc = tid & 7;
  const int wsw = (ckc ^ (crow & 7)) * 8;
  const int rsw0 = (fq ^ (fr & 7)) * 8;
  const u16* Ag = cur.A + (size_t)crow * cur.lda + ckc * 8;
  const u16* Bg = cur.B + (size_t)crow * cur.ldb + ckc * 8;
  const int nk = cur.K >> 6, km = nk - 1, kmn = (nxt.K >> 6) - 1;
#define BGLOADX(AP, BP, LA, LB, KO)                                                   \
  do {                                                                                \
    pa0 = *(const uint4*)((AP) + (KO));                                             \
    pa1 = *(const uint4*)((AP) + (size_t)64 * (LA) + (KO));                         \
    pa2 = *(const uint4*)((AP) + (size_t)128 * (LA) + (KO));                        \
    pa3 = *(const uint4*)((AP) + (size_t)192 * (LA) + (KO));                        \
    pb0 = *(const uint4*)((BP) + (KO));                                             \
    pb1 = *(const uint4*)((BP) + (size_t)64 * (LB) + (KO));                         \
    if (NBH == 2) {                                                                   \
      pb2 = *(const uint4*)((BP) + (size_t)128 * (LB) + (KO));                      \
      pb3 = *(const uint4*)((BP) + (size_t)192 * (LB) + (KO));                      \
    }                                                                                 \
  } while (0)
#define BGLOADC(T) BGLOADX(Ag, Bg, cur.lda, cur.ldb, ((((T) + cur.koff) & km) * 64))
#define BGLOADN(T) BGLOADX(An, Bn, nxt.lda, nxt.ldb, ((((T) + nxt.koff) & kmn) * 64))
#define BSSTORE(NB)                                                                   \
  do {                                                                                \
    u16* dA = sA + ((NB) * 256 + crow) * LDS_S + wsw;                                 \
    u16* dB = sB + ((NB) * BNT + crow) * LDS_S + wsw;                                 \
    *(uint4*)(dA) = pa0;                                                            \
    *(uint4*)(dA + 64 * LDS_S) = pa1;                                               \
    *(uint4*)(dA + 128 * LDS_S) = pa2;                                              \
    *(uint4*)(dA + 192 * LDS_S) = pa3;                                              \
    *(uint4*)(dB) = pb0;                                                            \
    *(uint4*)(dB + 64 * LDS_S) = pb1;                                               \
    if (NBH == 2) {                                                                   \
      *(uint4*)(dB + 128 * LDS_S) = pb2;                                            \
      *(uint4*)(dB + 192 * LDS_S) = pb3;                                            \
    }                                                                                 \
  } while (0)
#define BLOADFR(BUF, KS)                                                              \
  do {                                                                                \
    const u16* cA = sA + ((BUF) * 256 + wm * 64 + fr) * LDS_S + (rsw0 ^ ((KS) * 32)); \
    const u16* cB = sB + ((BUF) * BNT + wn * (64 * NBH) + fr) * LDS_S + (rsw0 ^ ((KS) * 32)); \
    _Pragma("unroll") for (int i = 0; i < 4; ++i) af[i] = *(const bf16x8*)(cA + i * 16 * LDS_S);  \
    _Pragma("unroll") for (int j = 0; j < 4; ++j) bfr[j] = *(const bf16x8*)(cB + j * 16 * LDS_S); \
  } while (0)
#define BLOADB2(BUF, KS)                                                              \
  do {                                                                                \
    const u16* cB = sB + ((BUF) * BNT + wn * (64 * NBH) + 64 + fr) * LDS_S + (rsw0 ^ ((KS) * 32)); \
    _Pragma("unroll") for (int j = 0; j < 4; ++j) bfr[j] = *(const bf16x8*)(cB + j * 16 * LDS_S); \
  } while (0)
#define BMFMAS(JO)                                                                    \
  do {                                                                                \
    _Pragma("unroll") for (int i = 0; i < 4; ++i)                                     \
      _Pragma("unroll") for (int j = 0; j < 4; ++j)                                   \
        acc[i][(JO) + j] = __builtin_amdgcn_mfma_f32_16x16x32_bf16(bfr[j], af[i], acc[i][(JO) + j], 0, 0, 0);  \
  } while (0)
#define BHALF(BUF, LOADSTMT)                                                          \
  do {                                                                                \
    BLOADFR(BUF, 0);                                                                  \
    __builtin_amdgcn_sched_barrier(0);                                                \
    BSSTORE((BUF) ^ 1);                                                               \
    LOADSTMT;                                                                         \
    __builtin_amdgcn_sched_barrier(0);                                                \
    BMFMAS(0);                                                                        \
    __builtin_amdgcn_sched_barrier(0);                                                \
    if (NBH == 2) {                                                                   \
      BLOADB2(BUF, 0);                                                                \
      __builtin_amdgcn_sched_barrier(0);                                              \
      BMFMAS(4 * (NBH - 1));                                                          \
      __builtin_amdgcn_sched_barrier(0);                                              \
    }                                                                                 \
    BLOADFR(BUF, 1);                                                                  \
    __builtin_amdgcn_sched_barrier(0);                                                \
    BMFMAS(0);                                                                        \
    __builtin_amdgcn_sched_barrier(0);                                                \
    if (NBH == 2) {                                                                   \
      BLOADB2(BUF, 1);                                                                \
      __builtin_amdgcn_sched_barrier(0);                                              \
      BMFMAS(4 * (NBH - 1));                                                          \
      __builtin_amdgcn_sched_barrier(0);                                              \
    }                                                                                 \
    __syncthreads();                                                                  \
  } while (0)
  bf16x8 af[4], bfr[4];
  if (!primed) {
    BGLOADC(0);
    BSSTORE(0);
    __builtin_amdgcn_sched_barrier(0);
    BGLOADC(1);
    __builtin_amdgcn_sched_barrier(0);
    __syncthreads();
  }
#pragma unroll 1
  for (int kt = 0; kt + 2 < nk; kt += 2) {
    BHALF(0, BGLOADC(kt + 2));
    BHALF(1, BGLOADC(kt + 3));
  }
  const u16* An = nxt.A + (size_t)crow * nxt.lda + ckc * 8;
  const u16* Bn = nxt.B + (size_t)crow * nxt.ldb + ckc * 8;
  BHALF(0, BGLOADN(0));
  BHALF(1, BGLOADN(1));
#undef BGLOADX
#undef BGLOADC
#undef BGLOADN
#undef BSSTORE
#undef BLOADFR
#undef BLOADB2
#undef BMFMAS
#undef BHALF
}
DEVI void gemm_core_big(const GemmOp cur, const GemmOp nxt, bool primed, PFB_PARAMS, f32x4 (&acc)[4][8], u16* smem) {
  gemm_core_bigT<2>(cur, nxt, primed, PFB_ARGS, acc, smem);
}

DEVI void phase_proj(const Params& p, int l, int vcu, u16* smem) {
  const u16* xn = (const u16*)(p.ws + WS_XN);
  const u16* wt = (const u16*)(p.ws + WS_WT_IN) + (size_t)l * NPROJ_PAD * LDW1;
  u16* proj = (u16*)(p.ws + WS_PROJ);
  float* small = (float*)(p.ws + WS_SMALL);
  constexpr int NT = 25, MT = M / 256;
  PFB_DECL;
  int mt, nt;
  bool have = tile_map(0, vcu, MT, NT, mt, nt);
  for (int it = 0; have; ++it) {
    const int m0 = mt * 256, n0 = nt * 256;
    const GemmOp cur{xn + (size_t)m0 * LDX, wt + (size_t)n0 * LDW1, LDX, LDW1, 1024, koff_of(mt, nt)};
    int mtn, ntn;
    const bool haven = tile_map(it + 1, vcu, MT, NT, mtn, ntn);
    GemmOp nxt = cur;
    if (haven) { nxt.A = xn + (size_t)(mtn * 256) * LDX; nxt.B = wt + (size_t)(ntn * 256) * LDW1; nxt.koff = koff_of(mtn, ntn); }
    f32x4 acc[4][8];
    zero_acc(acc);
    gemm_core_big(cur, nxt, it > 0, PFB_ARGS, acc, smem);
    const int tid_ = otid(); const int lane = tid_ & 63, w = tid_ >> 6, wm = w >> 1, wn = w & 1, fr = lane & 15, fq = lane >> 4;
#pragma unroll
    for (int i = 0; i < 4; ++i)
#pragma unroll
      for (int j = 0; j < 8; ++j) {
        const int m = m0 + wm * 64 + i * 16 + fr, n = n0 + wn * 128 + j * 16 + fq * 4;
        if (n < NPROJ) {
          uint2 o;
          o.x = pk2(acc[i][j][0], acc[i][j][1]);
          o.y = pk2(acc[i][j][2], acc[i][j][3]);
          *(uint2*)(proj + (size_t)m * NPROJ + n) = o;
        } else if (n < NPROJ + 16) {
          *(float4*)(small + (size_t)m * 16 + (n - NPROJ)) = float4{acc[i][j][0], acc[i][j][1], acc[i][j][2], acc[i][j][3]};
        }
      }
    have = haven; mt = mtn; nt = ntn;
  }
}

DEVI void phase_up(const Params& p, int l, int vcu, u16* smem) {
  const u16* xn = (const u16*)(p.ws + WS_XN);
  const u16* wt = (const u16*)(p.ws + WS_WT_UP) + (size_t)l * 4096 * LDW1;
  u16* hid = (u16*)(p.ws + WS_PROJ);
  constexpr int NT = DFF / 256, MT = MP / 256;
  PFB_DECL;
  int mt, nt;
  bool have = tile_map(0, vcu, MT, NT, mt, nt);
  for (int it = 0; have; ++it) {
    const int m0 = mt * 256, n0 = nt * 256;
    const GemmOp cur{xn + (size_t)m0 * LDX, wt + (size_t)n0 * LDW1, LDX, LDW1, 1024, koff_of(mt, nt)};
    int mtn, ntn;
    const bool haven = tile_map(it + 1, vcu, MT, NT, mtn, ntn);
    GemmOp nxt = cur;
    if (haven) { nxt.A = xn + (size_t)(mtn * 256) * LDX; nxt.B = wt + (size_t)(ntn * 256) * LDW1; nxt.koff = koff_of(mtn, ntn); }
    f32x4 acc[4][8];
    zero_acc(acc);
    gemm_core_big(cur, nxt, it > 0, PFB_ARGS, acc, smem);
    const int tid_ = otid(); const int lane = tid_ & 63, w = tid_ >> 6, wm = w >> 1, wn = w & 1, fr = lane & 15, fq = lane >> 4;
#pragma unroll
    for (int i = 0; i < 4; ++i)
#pragma unroll
      for (int j = 0; j < 8; ++j) {
        const int m = m0 + wm * 64 + i * 16 + fr, n = n0 + wn * 128 + j * 16 + fq * 4;
        float r0 = fmaxf(acc[i][j][0], 0.f), r1 = fmaxf(acc[i][j][1], 0.f), r2 = fmaxf(acc[i][j][2], 0.f), r3 = fmaxf(acc[i][j][3], 0.f);
        uint2 o;
        o.x = pk2(r0 * r0, r1 * r1);
        o.y = pk2(r2 * r2, r3 * r3);
        *(uint2*)(hid + (size_t)m * LDH + n) = o;
      }
    have = haven; mt = mtn; nt = ntn;
  }
  {
    PF_DECL;
    bool first = true;
    for (int t = vcu; t < 128; t += gridDim.x) {
      const int mt = (MP / 128) + (t >> 5), nt = t & 31;
      const int m0 = mt * 128, n0 = nt * 128;
      const GemmOp cur{xn + (size_t)m0 * LDX, wt + (size_t)n0 * LDW1, LDX, LDW1, 1024, koff_of(mt, nt)};
      f32x4 acc[2][4];
      zero_acc(acc);
      gemm_core<2, 4>(cur, cur, !first, PF_ARGS, acc, smem);
      first = false;
      const int tid_ = otid(); const int lane = tid_ & 63, w = tid_ >> 6, wm = w >> 1, wn = w & 1, fr = lane & 15, fq = lane >> 4;
#pragma unroll
      for (int i = 0; i < 2; ++i)
#pragma unroll
        for (int j = 0; j < 4; ++j) {
          const int m = m0 + wm * 32 + i * 16 + fr, n = n0 + wn * 64 + j * 16 + fq * 4;
          float r0 = fmaxf(acc[i][j][0], 0.f), r1 = fmaxf(acc[i][j][1], 0.f), r2 = fmaxf(acc[i][j][2], 0.f), r3 = fmaxf(acc[i][j][3], 0.f);
          uint2 o;
          o.x = pk2(r0 * r0, r1 * r1);
          o.y = pk2(r2 * r2, r3 * r3);
          *(uint2*)(hid + (size_t)m * LDH + n) = o;
        }
    }
  }
}

DEVI void merge_sample_rows(const Params& p, int l, int vcu, u16* smem) {
  const u16* xn = (const u16*)(p.ws + WS_XN);
  const u16* y = (const u16*)(p.ws + WS_OBUF);
  const u16* wg = (const u16*)(p.ws + WS_WT_GATE) + (size_t)l * 3072 * LDW1;
  const u16* wb = (const u16*)(p.ws + WS_WT_BR) + (size_t)l * 3 * 1024 * LDWB;
  u16* merged = (u16*)(p.ws + WS_CONV);
  const int tid_ = otid(); const int lane = tid_ & 63, w = tid_ >> 6, wm = w >> 1, wn = w & 1, fr = lane & 15, fq = lane >> 4;
  constexpr int NT = D / 128, MT = MS / 128;
  PF_DECL;
  int mt, nt;
  bool have = tile_map(0, vcu, MT, NT, mt, nt);
  for (int it = 0; have; ++it) {
    const int m0 = MP + mt * 128, n0 = nt * 128;
    const int ko = koff_of(mt, nt);
    int mtn, ntn;
    const bool haven = tile_map(it + 1, vcu, MT, NT, mtn, ntn);
    f32x4 accM[2][4];
    zero_acc(accM);
#pragma unroll 1
    for (int b = 0; b < 3; ++b) {
      f32x4 accG[2][4], accB[2][4];
      zero_acc(accG);
      const GemmOp gate{xn + (size_t)m0 * LDX, wg + ((size_t)b * 1024 + n0) * LDW1, LDX, LDW1, 1024, ko};
      const GemmOp br{y + (size_t)m0 * LDY + b * 512, wb + ((size_t)b * 1024 + n0) * LDWB, LDY, LDWB, 512, ko};
      GemmOp after = gate;
      if (b < 2) {
        after.B = wg + ((size_t)(b + 1) * 1024 + n0) * LDW1;
      } else if (haven) {
        after.A = xn + (size_t)(MP + mtn * 128) * LDX;
        after.B = wg + (size_t)(ntn * 128) * LDW1;
        after.koff = koff_of(mtn, ntn);
      }
      gemm_core<2, 4>(gate, br, (it > 0) || (b > 0), PF_ARGS, accG, smem);
      unsigned gpk[2][4][2];
#pragma unroll
      for (int i = 0; i < 2; ++i)
#pragma unroll
        for (int j = 0; j < 4; ++j) {
          gpk[i][j][0] = pk2(sigm(accG[i][j][0]), sigm(accG[i][j][1]));
          gpk[i][j][1] = pk2(sigm(accG[i][j][2]), sigm(accG[i][j][3]));
        }
      zero_acc(accB);
      gemm_core<2, 4>(br, after, true, PF_ARGS, accB, smem);
#pragma unroll
      for (int i = 0; i < 2; ++i)
#pragma unroll
        for (int j = 0; j < 4; ++j) {
          accM[i][j][0] += bflo(gpk[i][j][0]) * accB[i][j][0];
          accM[i][j][1] += bfhi(gpk[i][j][0]) * accB[i][j][1];
          accM[i][j][2] += bflo(gpk[i][j][1]) * accB[i][j][2];
          accM[i][j][3] += bfhi(gpk[i][j][1]) * accB[i][j][3];
        }
    }
#pragma unroll
    for (int i = 0; i < 2; ++i)
#pragma unroll
      for (int j = 0; j < 4; ++j) {
        const int m = m0 + wm * 32 + i * 16 + fr, n = n0 + wn * 64 + j * 16 + fq * 4;
        uint2 o;
        o.x = pk2(accM[i][j][0], accM[i][j][1]);
        o.y = pk2(accM[i][j][2], accM[i][j][3]);
        *(uint2*)(merged + (size_t)m * LDX + n) = o;
      }
    have = haven; mt = mtn; nt = ntn;
  }
}

DEVI void phase_merge(const Params& p, int l, int vcu, u16* smem) {
  const u16* xn = (const u16*)(p.ws + WS_XN);
  const u16* y = (const u16*)(p.ws + WS_OBUF);
  const u16* wg = (const u16*)(p.ws + WS_WT_GATE) + (size_t)l * 3072 * LDW1;
  const u16* wb = (const u16*)(p.ws + WS_WT_BR) + (size_t)l * 3 * 1024 * LDWB;
  u16* merged = (u16*)(p.ws + WS_CONV);
  constexpr int NT = D / 128, MT = MP / 256;
  PFB_DECL;
  int mt, nt;
  bool have = tile_map(0, vcu, MT, NT, mt, nt);
  for (int it = 0; have; ++it) {
    const int m0 = mt * 256, n0 = nt * 128;
    const int ko = koff_of(mt, nt);
    int mtn, ntn;
    const bool haven = tile_map(it + 1, vcu, MT, NT, mtn, ntn);
    unsigned mpk[4][4][2];
#pragma unroll
    for (int i = 0; i < 4; ++i)
#pragma unroll
      for (int j = 0; j < 4; ++j) { mpk[i][j][0] = 0u; mpk[i][j][1] = 0u; }
#pragma unroll 1
    for (int b = 0; b < 3; ++b) {
      const GemmOp gate{xn + (size_t)m0 * LDX, wg + ((size_t)b * 1024 + n0) * LDW1, LDX, LDW1, 1024, ko};
      const GemmOp br{y + (size_t)m0 * LDY + b * 512, wb + ((size_t)b * 1024 + n0) * LDWB, LDY, LDWB, 512, ko};
      GemmOp after = gate;
      if (b < 2) {
        after.B = wg + ((size_t)(b + 1) * 1024 + n0) * LDW1;
      } else if (haven) {
        after.A = xn + (size_t)(mtn * 256) * LDX;
        after.B = wg + (size_t)(ntn * 128) * LDW1;
        after.koff = koff_of(mtn, ntn);
      }
      unsigned gpk[4][4][2];
      {
        f32x4 accG[4][4];
        zero_acc(accG);
        gemm_core_bigT<1>(gate, br, (it > 0) || (b > 0), PFB_ARGS, accG, smem);
#pragma unroll
        for (int i = 0; i < 4; ++i)
#pragma unroll
          for (int j = 0; j < 4; ++j) {
            gpk[i][j][0] = pk2(sigm(accG[i][j][0]), sigm(accG[i][j][1]));
            gpk[i][j][1] = pk2(sigm(accG[i][j][2]), sigm(accG[i][j][3]));
            asm volatile("" : "+v"(gpk[i][j][0]), "+v"(gpk[i][j][1]));
          }
      }
      {
        f32x4 accB[4][4];
        zero_acc(accB);
        gemm_core_bigT<1>(br, after, true, PFB_ARGS, accB, smem);
#pragma unroll
        for (int i = 0; i < 4; ++i)
#pragma unroll
          for (int j = 0; j < 4; ++j) {
            mpk[i][j][0] = pk2(bflo(mpk[i][j][0]) + bflo(gpk[i][j][0]) * accB[i][j][0], bfhi(mpk[i][j][0]) + bfhi(gpk[i][j][0]) * accB[i][j][1]);
            mpk[i][j][1] = pk2(bflo(mpk[i][j][1]) + bflo(gpk[i][j][1]) * accB[i][j][2], bfhi(mpk[i][j][1]) + bfhi(gpk[i][j][1]) * accB[i][j][3]);
            asm volatile("" : "+v"(mpk[i][j][0]), "+v"(mpk[i][j][1]));
          }
      }
    }
    const int tid_ = otid(); const int lane = tid_ & 63, w = tid_ >> 6, wm = w >> 1, wn = w & 1, fr = lane & 15, fq = lane >> 4;
#pragma unroll
    for (int i = 0; i < 4; ++i)
#pragma unroll
      for (int j = 0; j < 4; ++j) {
        const int m = m0 + wm * 64 + i * 16 + fr, n = n0 + wn * 64 + j * 16 + fq * 4;
        *(uint2*)(merged + (size_t)m * LDX + n) = uint2{mpk[i][j][0], mpk[i][j][1]};
      }
    have = haven; mt = mtn; nt = ntn;
  }
  merge_sample_rows(p, l, vcu, smem);
}

DEVI void phase_resid(const u16* A, int lda, int K, const u16* wt, int ldb, const float* xin_p, const float* xin_s, float* xout, int vcu, u16* smem) {
  for (int t = vcu; t < 256; t += gridDim.x) {
    PFB_DECL;
    int mt, nt;
    tile_map(0, t, 64, 4, mt, nt);
    const int m0 = mt * 256, n0 = nt * 256;
    const GemmOp cur{A + (size_t)m0 * lda, wt + (size_t)n0 * ldb, lda, ldb, K, koff_of(mt, nt)};
    f32x4 acc[4][8];
    zero_acc(acc);
    gemm_core_big(cur, cur, false, PFB_ARGS, acc, smem);
    const int tid_ = otid(); const int lane = tid_ & 63, w = tid_ >> 6, wm = w >> 1, wn = w & 1, fr = lane & 15, fq = lane >> 4;
#pragma unroll
    for (int i = 0; i < 4; ++i)
#pragma unroll
      for (int j = 0; j < 8; ++j) {
        const int m = m0 + wm * 64 + i * 16 + fr, n = n0 + wn * 128 + j * 16 + fq * 4;
        const float4 xv = *(const float4*)(xin_p + (size_t)m * D + n);
        float4 o;
        o.x = xv.x + acc[i][j][0]; o.y = xv.y + acc[i][j][1]; o.z = xv.z + acc[i][j][2]; o.w = xv.w + acc[i][j][3];
        *(float4*)(xout + (size_t)m * D + n) = o;
        if ((j & 1) == 1) __builtin_amdgcn_sched_barrier(0);
      }
  }
  {
    PF_DECL;
    bool first = true;
    for (int t = vcu; t < 32; t += gridDim.x) {
      const int mt = (MP / 128) + (t >> 3), nt = t & 7;
      const int m0 = mt * 128, n0 = nt * 128;
      const GemmOp cur{A + (size_t)m0 * lda, wt + (size_t)n0 * ldb, lda, ldb, K, koff_of(mt, nt)};
      f32x4 acc[2][4];
      zero_acc(acc);
      gemm_core<2, 4>(cur, cur, !first, PF_ARGS, acc, smem);
      const int tid_ = otid(); const int lane = tid_ & 63, w = tid_ >> 6, wm = w >> 1, wn = w & 1, fr = lane & 15, fq = lane >> 4;
      first = false;
#pragma unroll
      for (int i = 0; i < 2; ++i)
#pragma unroll
        for (int j = 0; j < 4; ++j) {
          const int m = m0 + wm * 32 + i * 16 + fr, n = n0 + wn * 64 + j * 16 + fq * 4;
          const float4 xv = *(const float4*)(xin_s + (size_t)(m - MP) * D + n);
          float4 o;
          o.x = xv.x + acc[i][j][0]; o.y = xv.y + acc[i][j][1]; o.z = xv.z + acc[i][j][2]; o.w = xv.w + acc[i][j][3];
          *(float4*)(xout + (size_t)m * D + n) = o;
        }
    }
  }
}

DEVI void unpack8(const uint4 u, float (&f)[8]) {
  f[0] = bflo(u.x); f[1] = bfhi(u.x); f[2] = bflo(u.y); f[3] = bfhi(u.y);
  f[4] = bflo(u.z); f[5] = bfhi(u.z); f[6] = bflo(u.w); f[7] = bfhi(u.w);
}
DEVI uint4 pack8(const float (&f)[8]) {
  uint4 r;
  r.x = pk2(f[0], f[1]); r.y = pk2(f[2], f[3]); r.z = pk2(f[4], f[5]); r.w = pk2(f[6], f[7]);
  return r;
}
DEVI void load8f(const float* p, float (&f)[8]) {
  const float4 a = *(const float4*)p, b = *(const float4*)(p + 4);
  f[0] = a.x; f[1] = a.y; f[2] = a.z; f[3] = a.w; f[4] = b.x; f[5] = b.y; f[6] = b.z; f[7] = b.w;
}
DEVI void phase_prep(const Params& p, int l) {
  const int tid_ = otid(); const int lane = tid_ & 63, gw = blockIdx.x * 8 + (tid_ >> 6), nw = gridDim.x * 8;
  u16* proj = (u16*)(p.ws + WS_PROJ);
  u16* conv = (u16*)(p.ws + WS_CONV);
  const float* small = (const float*)(p.ws + WS_SMALL);
  float* gates = (float*)(p.ws + WS_GATES);
  constexpr int NTASK = (M / 4) * 6;
  for (int task = gw; task < NTASK; task += nw) {
    const int tg = task / 6, k = task - tg * 6;
    const int m0 = tg * 4;
    const bool samp = m0 >= MP;
    int b, t0;
    if (!samp) { b = m0 >> 11; t0 = m0 & 2047; } else { b = (m0 - MP) >> 2; t0 = 0; }
    if (k < 3) {
      const int pp = k;
      const int ch = pp * 512 + lane * 8;
      const u16* src = proj + 2048 + ch;
      float r[7][8], cw[4][8];
#pragma unroll
      for (int j = 0; j < 7; ++j) {
        const int t = t0 - 3 + j;
        if (t >= 0) {
          unpack8(*(const uint4*)(src + (size_t)(m0 - 3 + j) * NPROJ), r[j]);
        } else if (samp) {
          load8f(p.st_gconv + ((size_t)(l * 128 + b) * 3 + j) * 1536 + ch, r[j]);
        } else {
#pragma unroll
          for (int c = 0; c < 8; ++c) r[j][c] = 0.f;
        }
      }
#pragma unroll
      for (int j = 0; j < 4; ++j) load8f(p.gd_conv_w + (size_t)(l * 4 + j) * 1536 + ch, cw[j]);
#pragma unroll
      for (int tt = 0; tt < 4; ++tt) {
        float a[8];
        float ss = 0.f;
#pragma unroll
        for (int c = 0; c < 8; ++c) {
          float sx = 0.f;
#pragma unroll
          for (int j = 0; j < 4; ++j) sx += cw[j][c] * r[tt + j][c];
          a[c] = silu(sx);
          ss += a[c] * a[c];
        }
        if (pp < 2) {
          ss = row16_sum(ss);
          float sc = rsqrtf(ss + 1e-6f);
          if (pp == 0) sc *= 0.08838834764831845f;
#pragma unroll
          for (int c = 0; c < 8; ++c) a[c] *= sc;
        }
        *(uint4*)(conv + (size_t)(m0 + tt) * 1536 + ch) = pack8(a);
      }
      const bool last = samp || (t0 == 2044);
      if (last) {
        float* co = p.out + (samp ? OFF_S_GC + (size_t)(l * 128 + b) * 3 * 1536 : OFF_P_GC + (size_t)(l * 8 + b) * 3 * 1536) + ch;
#pragma unroll
        for (int j = 0; j < 3; ++j) {
          *(float4*)(co + j * 1536) = float4{r[4 + j][0], r[4 + j][1], r[4 + j][2], r[4 + j][3]};
          *(float4*)(co + j * 1536 + 4) = float4{r[4 + j][4], r[4 + j][5], r[4 + j][6], r[4 + j][7]};
        }
      }
    } else if (k < 5) {
      const int part = k - 3;
      const int wch = lane * 8;
      u16* col = proj + 4096 + part * 512 + wch;
      float lb[8];
#pragma unroll
      for (int c = 0; c < 8; ++c) lb[c] = 0.f;
      if (part == 1 && l == 1) {
        float l0[8], l1[8];
        load8f(p.hg_lb_logits + wch, l0);
        load8f(p.hg_lb_logits + 512 + wch, l1);
#pragma unroll
        for (int c = 0; c < 8; ++c) lb[c] = sigm(l1[c] - l0[c]);
      }
      uint4 u[4];
#pragma unroll
      for (int tt = 0; tt < 4; ++tt) u[tt] = *(const uint4*)(col + (size_t)(m0 + tt) * NPROJ);
#pragma unroll
      for (int tt = 0; tt < 4; ++tt) {
        float f[8];
        unpack8(u[tt], f);
#pragma unroll
        for (int c = 0; c < 8; ++c) f[c] = (part == 0) ? silu(f[c]) : (1.f - lb[c]) * sigm(-f[c]);
        *(uint4*)(col + (size_t)(m0 + tt) * NPROJ) = pack8(f);
      }
    } else {
      const int tt = lane >> 4, g = lane & 15, hh = g & 3;
      const float v = small[(size_t)(m0 + tt) * 16 + g];
      float r;
      if (g < 4) r = v + p.ml_i_bias[l * 4 + hh];
      else if (g < 8) { const float x = v + p.ml_f_bias[l * 4 + hh]; r = -softplus(-x); }
      else if (g < 12) r = sigm(v);
      else { const float x = v + p.gd_dt_bias[l * 4 + hh]; r = __expf(-__expf(p.gd_A_log[l * 4 + hh]) * softplus(x)); }
      gates[(size_t)(m0 + tt) * 16 + g] = r;
    }
  }
}

template <int KIND>
DEVI void scan_unit(const Params& p, int l, bool samp, int b, int h, int colbase, float* smem) {
  constexpr int CPL = (KIND == 1) ? 1 : 2;
  constexpr int UC = 32 * CPL;
  constexpr int VCH = UC / 8;
  const int tid = otid(), lane = tid & 63, w = tid >> 6, kg = lane & 15, cl = lane >> 4;
  const int T = samp ? 4 : 2048;
  const int rowbase = samp ? (MP + b * 4) : b * 2048;
  const int NB = samp ? 128 : 8;
  const u16* proj = (const u16*)(p.ws + WS_PROJ);
  const u16* conv = (const u16*)(p.ws + WS_CONV);
  u16* obuf = (u16*)(p.ws + WS_OBUF);
  const float* gates = (const float*)(p.ws + WS_GATES);
  float* dm = (float*)(p.ws + WS_DM);
  const u16 *qsrc, *ksrc, *vsrc;
  int ld, ocol;
  const float* Sin;
  float* Sout;
  const size_t sidx_in = ((size_t)(l * 128 + b) * 4 + h) * 16384;
  const size_t sidx_out = ((size_t)(l * NB + b) * 4 + h) * 16384;
  if (KIND == 0) {
    qsrc = proj + h * 128; ksrc = proj + 512 + h * 128; vsrc = proj + 1024 + h * 128 + colbase; ld = NPROJ; ocol = 0;
    Sin = p.st_mC + sidx_in; Sout = p.out + (samp ? OFF_S_MC : OFF_P_MC) + sidx_out;
  } else if (KIND == 1) {
    qsrc = conv + h * 128; ksrc = conv + 512 + h * 128; vsrc = conv + 1024 + h * 128 + colbase; ld = 1536; ocol = 512;
    Sin = p.st_gS + sidx_in; Sout = p.out + (samp ? OFF_S_GS : OFF_P_GS) + sidx_out;
  } else {
    qsrc = proj + 4096 + h * 128; ksrc = proj + 4608 + h * 128; vsrc = proj + 5120 + h * 128 + colbase; ld = NPROJ; ocol = 1024;
    Sin = p.st_hS + sidx_in; Sout = p.out + (samp ? OFF_S_HS : OFF_P_HS) + sidx_out;
  }
  float* qk = smem;
  float* vl = smem + 2 * 32 * 256;
  float* gl = vl + 2 * 32 * 64;

  const int wc = w * 4 * CPL + cl * CPL;
  const int col0 = colbase + wc;
  v2f S[CPL][4];
  v2f nv[4];
#pragma unroll
  for (int c = 0; c < CPL; ++c)
#pragma unroll
    for (int i = 0; i < 4; ++i) {
      if (samp) { S[c][i].x = Sin[(size_t)(kg * 8 + 2 * i) * 128 + col0 + c]; S[c][i].y = Sin[(size_t)(kg * 8 + 2 * i + 1) * 128 + col0 + c]; }
      else { S[c][i].x = 0.f; S[c][i].y = 0.f; }
    }
  float mstart = 0.f;
  if (KIND == 0) {
    const size_t nidx = ((size_t)(l * 128 + b) * 4 + h) * 128;
#pragma unroll
    for (int i = 0; i < 4; ++i) {
      if (samp) { nv[i].x = p.st_mn[nidx + kg * 8 + 2 * i]; nv[i].y = p.st_mn[nidx + kg * 8 + 2 * i + 1]; }
      else { nv[i].x = 0.f; nv[i].y = 0.f; }
    }
    if (samp) mstart = p.st_mm[(size_t)(l * 128 + b) * 4 + h];
  }

  uint4 rq, rk, rv;
  float g0 = 0.f, g1 = 0.f;
  const int sr = tid >> 4, sc = tid & 15;
  const int vr = tid / VCH, vc = tid % VCH;
  auto prefetch = [&](int j) {
    const int t = j * 32 + sr;
    rq = uint4{0, 0, 0, 0}; rk = uint4{0, 0, 0, 0}; rv = uint4{0, 0, 0, 0};
    if (t < T) {
      rq = *(const uint4*)(qsrc + (size_t)(rowbase + t) * ld + sc * 8);
      rk = *(const uint4*)(ksrc + (size_t)(rowbase + t) * ld + sc * 8);
    }
    if (tid < 32 * VCH) {
      const int tv = j * 32 + vr;
      if (tv < T) rv = *(const uint4*)(vsrc + (size_t)(rowbase + tv) * ld + vc * 8);
    }
    if (KIND != 2) {
      g0 = (KIND == 0) ? -1e30f : 0.f; g1 = 0.f;
      if (tid < 32) {
        const int tg = j * 32 + tid;
        if (tg < T) {
          if (KIND == 0) { g0 = gates[(size_t)(rowbase + tg) * 16 + h]; g1 = gates[(size_t)(rowbase + tg) * 16 + 4 + h]; }
          else { g0 = gates[(size_t)(rowbase + tg) * 16 + 8 + h]; g1 = gates[(size_t)(rowbase + tg) * 16 + 12 + h]; }
        }
      }
    }
  };
  auto stage = [&](int j, int buf) {
    float* qd = qk + (buf * 32 + sr) * 256 + sc * 8;
    *(float4*)(qd) = float4{bflo(rq.x), bfhi(rq.x), bflo(rq.y), bfhi(rq.y)};
    *(float4*)(qd + 4) = float4{bflo(rq.z), bfhi(rq.z), bflo(rq.w), bfhi(rq.w)};
    *(float4*)(qd + 128) = float4{bflo(rk.x), bfhi(rk.x), bflo(rk.y), bfhi(rk.y)};
    *(float4*)(qd + 132) = float4{bflo(rk.z), bfhi(rk.z), bflo(rk.w), bfhi(rk.w)};
    if (tid < 32 * VCH) {
      float* vd = vl + (buf * 32 + vr) * 64 + vc * 8;
      *(float4*)(vd) = float4{bflo(rv.x), bfhi(rv.x), bflo(rv.y), bfhi(rv.y)};
      *(float4*)(vd + 4) = float4{bflo(rv.z), bfhi(rv.z), bflo(rv.w), bfhi(rv.w)};
    }
    if (KIND == 0) {
      if (w == 0) {
        float bs = g1;
#pragma unroll
        for (int d = 1; d < 32; d <<= 1) { const float o = __shfl_up(bs, d); if (lane >= d) bs += o; }
        float R = g0 - bs;
#pragma unroll
        for (int d = 1; d < 32; d <<= 1) { const float o = __shfl_up(R, d); if (lane >= d) R = fmaxf(R, o); }
        const float mt = bs + fmaxf(mstart, R);
        float mprev = __shfl_up(mt, 1);
        if (lane == 0) mprev = mstart;
        const float fw = __expf(g1 + mprev - mt);
        const float iw = __expf(g0 - mt) * 0.08838834764831845f;
        if (lane < 32) {
          float* gd = gl + (buf * 32 + lane) * 4;
          gd[0] = fw; gd[1] = iw; gd[2] = mt;
        }
        int lastv = T - j * 32 - 1;
        if (lastv > 31) lastv = 31;
        mstart = __shfl(mt, lastv);
      }
    } else if (KIND == 1) {
      if (tid < 32) {
        float* gd = gl + (buf * 32 + tid) * 4;
        gd[0] = g0; gd[1] = g1;
      }
    }
  };

  const bool do_n = (KIND == 0) && (colbase == 0) && (w == 0);
  const int nblk = (T + 31) >> 5;
  prefetch(0);
  stage(0, 0);
  __syncthreads();
  for (int j = 0; j < nblk; ++j) {
    const int buf = j & 1;
    if (j + 1 < nblk) prefetch(j + 1);
    int steps = T - j * 32;
    if (steps > 32) steps = 32;
    u16* const obase = obuf + (size_t)(rowbase + j * 32) * LDY + ocol + h * 128 + col0;
    float* const dmbase = dm + (size_t)(rowbase + j * 32) * 8 + h;
    for (int t0 = 0; t0 < steps; t0 += 16) {
      int ns = steps - t0;
      if (ns > 16) ns = 16;
      float keep0 = 0.f, keep1 = 0.f, keepd = 0.f, keepm = 0.f;
#pragma unroll 4
      for (int tt = 0; tt < ns; ++tt) {
        const int t = t0 + tt;
        const float* qp = qk + (buf * 32 + t) * 256 + kg * 8;
        const float4 qa = *(const float4*)(qp), qb = *(const float4*)(qp + 4);
        const float4 ka = *(const float4*)(qp + 128), kb = *(const float4*)(qp + 132);
        const v2f q2[4] = {v2f{qa.x, qa.y}, v2f{qa.z, qa.w}, v2f{qb.x, qb.y}, v2f{qb.z, qb.w}};
        const v2f k2[4] = {v2f{ka.x, ka.y}, v2f{ka.z, ka.w}, v2f{kb.x, kb.y}, v2f{kb.z, kb.w}};
        const float* vp = vl + (buf * 32 + t) * 64 + wc;
        const float* gp = gl + (buf * 32 + t) * 4;
        const bool mine = (kg == tt);
        if (KIND == 0) {
          const float fw = gp[0], iw = gp[1];
          const v2f fw2 = v2f{fw, fw};
          const float2 vv = *(const float2*)vp;
          const float va[2] = {vv.x * iw, vv.y * iw};
          float num[2];
#pragma unroll
          for (int c = 0; c < 2; ++c) {
            const v2f vc2 = v2f{va[c], va[c]};
            v2f a = v2f{0.f, 0.f};
#pragma unroll
            for (int i = 0; i < 4; ++i) {
              S[c][i] = fw2 * S[c][i] + k2[i] * vc2;
              a += q2[i] * S[c][i];
            }
            num[c] = row16_sum(a.x + a.y);
          }
          keep0 = mine ? num[0] : keep0;
          keep1 = mine ? num[1] : keep1;
          if (do_n) {
            const v2f iw2 = v2f{iw, iw};
            v2f a = v2f{0.f, 0.f};
#pragma unroll
            for (int i = 0; i < 4; ++i) {
              nv[i] = fw2 * nv[i] + k2[i] * iw2;
              a += q2[i] * nv[i];
            }
            const float den = row16_sum(a.x + a.y);
            keepd = mine ? den : keepd;
            keepm = mine ? gp[2] : keepm;
          }
        } else if (KIND == 1) {
          const float beta = gp[0], g = gp[1];
          const float v = vp[0];
          v2f a = v2f{0.f, 0.f};
#pragma unroll
          for (int i = 0; i < 4; ++i) a += k2[i] * S[0][i];
          const float kS = row16_sum(a.x + a.y);
          const float vn = beta * (v - g * kS);
          const v2f g2 = v2f{g, g}, vn2 = v2f{vn, vn};
          v2f o2 = v2f{0.f, 0.f};
#pragma unroll
          for (int i = 0; i < 4; ++i) {
            S[0][i] = g2 * S[0][i] + k2[i] * vn2;
            o2 += q2[i] * S[0][i];
          }
          const float o = row16_sum(o2.x + o2.y);
          keep0 = mine ? o : keep0;
        } else {
          const float2 vv = *(const float2*)vp;
          const float va[2] = {vv.x, vv.y};
          float num[2];
#pragma unroll
          for (int c = 0; c < 2; ++c) {
            const v2f vc2 = v2f{va[c], va[c]};
            v2f a = v2f{0.f, 0.f};
#pragma unroll
            for (int i = 0; i < 4; ++i) {
              S[c][i] = S[c][i] + k2[i] * (vc2 - S[c][i]);
              a += q2[i] * S[c][i];
            }
            num[c] = row16_sum(a.x + a.y);
          }
          keep0 = mine ? num[0] : keep0;
          keep1 = mine ? num[1] : keep1;
        }
      }
      if (kg < ns) {
        if (KIND == 1) obase[(size_t)(t0 + kg) * LDY] = f2bf(keep0);
        else *(unsigned*)(obase + (size_t)(t0 + kg) * LDY) = pk2(keep0, keep1);
        if (do_n && cl == 0) { dmbase[(t0 + kg) * 8] = keepd; dmbase[(t0 + kg) * 8 + 4] = keepm; }
      }
    }
    if (j + 1 < nblk) stage(j + 1, buf ^ 1);
    __syncthreads();
  }
#pragma unroll
  for (int c = 0; c < CPL; ++c)
#pragma unroll
    for (int i = 0; i < 4; ++i) {
      Sout[(size_t)(kg * 8 + 2 * i) * 128 + col0 + c] = S[c][i].x;
      Sout[(size_t)(kg * 8 + 2 * i + 1) * 128 + col0 + c] = S[c][i].y;
    }
  if (KIND == 0 && colbase == 0 && w == 0) {
    if (cl == 0) {
      float* no = p.out + (samp ? OFF_S_MN : OFF_P_MN) + ((size_t)(l * NB + b) * 4 + h) * 128 + kg * 8;
#pragma unroll
      for (int i = 0; i < 4; ++i) { no[2 * i] = nv[i].x; no[2 * i + 1] = nv[i].y; }
    }
    if (lane == 0) p.out[(samp ? OFF_S_MM : OFF_P_MM) + (size_t)(l * NB + b) * 4 + h] = mstart;
  }
  __syncthreads();
}

DEVI void scan_sample_unit(const Params& p, int l, int s, float* smem) {
  const int s4 = s & 3;
  if (s4 < 2) {
    const int idx = (s >> 2) * 2 + (s & 1), seq = idx >> 2;
    scan_unit<1>(p, l, true, seq >> 2, seq & 3, (idx & 3) * 32, smem);
  } else {
    const int idx = s >> 2, seq = idx >> 1;
    if (s4 == 2) scan_unit<0>(p, l, true, seq >> 2, seq & 3, (idx & 1) * 64, smem);
    else scan_unit<2>(p, l, true, seq >> 2, seq & 3, (idx & 1) * 64, smem);
  }
}

DEVI void phase_scan(const Params& p, int l, float* smem) {
  for (int u = blockIdx.x; u < 256; u += gridDim.x) {
    if (u < 128) {
      const int seq = u >> 2;
      scan_unit<1>(p, l, false, seq >> 2, seq & 3, (u & 3) * 32, smem);
    } else if (u < 192) {
      const int uu = u - 128, seq = uu >> 1;
      scan_unit<0>(p, l, false, seq >> 2, seq & 3, (uu & 1) * 64, smem);
    } else {
      const int uu = u - 192, seq = uu >> 1;
      scan_unit<2>(p, l, false, seq >> 2, seq & 3, (uu & 1) * 64, smem);
    }
  }
  if (gridDim.x == 256) {
    const int b = blockIdx.x;
    int s0, cnt;
    if (b < 128) { s0 = b * 26; cnt = 26; }
    else if (b < 192) {
      if (((b - 128) & 1) == 0) { s0 = 0; cnt = 0; }
      else { s0 = 3328 + ((b - 128) >> 1) * 8; cnt = 8; }
    } else { s0 = 3328 + (32 + (b - 192)) * 8; cnt = 8; }
    for (int i = 0; i < cnt; ++i) scan_sample_unit(p, l, s0 + i, smem);
  } else {
    for (int s = blockIdx.x; s < 4096; s += gridDim.x) scan_sample_unit(p, l, s, smem);
  }
}

DEVI void phase_post(const Params& p, int l) {
  const int tid_ = otid(); const int lane = tid_ & 63, gw = blockIdx.x * 8 + (tid_ >> 6), nw = gridDim.x * 8;
  const u16* proj = (const u16*)(p.ws + WS_PROJ);
  u16* obuf = (u16*)(p.ws + WS_OBUF);
  const float* dm = (const float*)(p.ws + WS_DM);
  constexpr int NTASK = (M / 4) * 3;
  for (int task = gw; task < NTASK; task += nw) {
    const int tg = task / 3, k = task - tg * 3;
    const int m0 = tg * 4;
    const int c = lane * 8, hh = lane >> 4;
    float wv[8];
    if (k == 0) load8f(p.ml_norm_w + l * 512 + c, wv);
    else if (k == 1) load8f(p.gd_norm_w + l * 128 + (c & 127), wv);
    else load8f(p.hg_norm_w + l * 512 + c, wv);
    const int gcol = (k == 0) ? 1536 : (k == 1 ? 3584 : 5632);
    uint4 ov[4], gv[4];
#pragma unroll
    for (int tt = 0; tt < 4; ++tt) {
      ov[tt] = *(const uint4*)(obuf + (size_t)(m0 + tt) * LDY + k * 512 + c);
      gv[tt] = *(const uint4*)(proj + (size_t)(m0 + tt) * NPROJ + gcol + c);
    }
#pragma unroll
    for (int tt = 0; tt < 4; ++tt) {
      const size_t m = m0 + tt;
      float o[8], g[8];
      unpack8(ov[tt], o);
      unpack8(gv[tt], g);
      if (k == 0) {
        const float den = dm[m * 8 + hh], mt = dm[m * 8 + 4 + hh];
        const float inv = 1.f / fmaxf(fabsf(den), __expf(-mt));
#pragma unroll
        for (int i = 0; i < 8; ++i) o[i] *= inv;
      }
      float ss = 0.f;
#pragma unroll
      for (int i = 0; i < 8; ++i) ss += o[i] * o[i];
      float sc;
      if (k == 2) { ss = wave_sum(ss); sc = rsqrtf(ss * (1.f / 512.f) + 1e-6f); }
      else { ss = row16_sum(ss); sc = rsqrtf(ss * (1.f / 128.f) + 1e-6f); }
#pragma unroll
      for (int i = 0; i < 8; ++i) o[i] = o[i] * sc * wv[i] * ((k == 0) ? sigm(g[i]) : silu(g[i]));
      *(uint4*)(obuf + m * LDY + k * 512 + c) = pack8(o);
    }
  }
}

#define LAS __attribute__((address_space(3)))
#define XB_TMO      128
#define XB_XCNT(j)  (256  + 64 * (j))
#define XB_XSUB(j)  (1280 + 64 * (j))
#define XB_XGEN(j)  (2304 + 64 * (j))
#define XB_TOP      3328
#define XB_TOPGEN   3392
#define XCD_BAR_WORDS 3456
#define XB_SPIN_CAP (1u << 18)

__device__ __forceinline__ unsigned xb_ld(unsigned* p)              { return __hip_atomic_load(p, __ATOMIC_RELAXED, __HIP_MEMORY_SCOPE_AGENT); }
__device__ __forceinline__ unsigned xb_add(unsigned* p, unsigned v) { return __hip_atomic_fetch_add(p, v, __ATOMIC_RELAXED, __HIP_MEMORY_SCOPE_AGENT); }
__device__ __forceinline__ unsigned xb_xcc_id() { return (unsigned)__builtin_amdgcn_s_getreg((3 << 11) | 20) & 0xFu; }
#define XB_SPIN(cond, bar) do { unsigned _sp = 0; while (cond) { __builtin_amdgcn_s_sleep(1); \
    if ((++_sp & 255u) == 0u) { if (xb_ld(&(bar)[XB_TMO])) break; if (_sp > XB_SPIN_CAP) { atomicAdd(&(bar)[XB_TMO], 1u); break; } } } } while (0)

struct XcdBarrier {
    unsigned* bar; unsigned x;
    volatile LAS unsigned* st;
};

__device__ __forceinline__ XcdBarrier xcd_barrier_post(unsigned* bar, volatile LAS unsigned* st) {
    XcdBarrier b; b.bar = bar; b.x = xb_xcc_id(); b.st = st;
    if (threadIdx.x == 0) (void)xb_add(&bar[XB_XCNT(b.x)], 1u);
    return b;
}
__device__ __forceinline__ void xcd_barrier_complete(unsigned* bar, unsigned x, unsigned& nloc, unsigned& nx) {
    const unsigned G = gridDim.x * gridDim.y * gridDim.z;
    unsigned sum, cnt, mine, sp = 0u;
    for (;;) {
        sum = 0u; cnt = 0u; mine = 0u;
#pragma unroll
        for (unsigned j = 0; j < 16; ++j) { const unsigned c = xb_ld(&bar[XB_XCNT(j)]); sum += c; cnt += (c > 0u) ? 1u : 0u; mine = (j == x) ? c : mine; }
        if (sum == G) break;
        __builtin_amdgcn_s_sleep(1);
        if ((++sp & 255u) == 0u) { if (xb_ld(&bar[XB_TMO])) break; if (sp > XB_SPIN_CAP) { atomicAdd(&bar[XB_TMO], 1u); break; } }
    }
    nloc = mine > 0u ? mine : 1u; nx = cnt > 0u ? cnt : 1u;
}

__device__ __forceinline__ void xcd_barrier(const XcdBarrier& b) {
    asm volatile("s_waitcnt vmcnt(0)" ::: "memory");
    __syncthreads();
    if (threadIdx.x == 0) {
        unsigned* bar = b.bar;
        __builtin_amdgcn_s_waitcnt(0);
        unsigned nloc = b.st[0], nx = b.st[1];
        if (nloc == 0u) { xcd_barrier_complete(bar, b.x, nloc, nx); b.st[0] = nloc; b.st[1] = nx; }
        const unsigned old = xb_add(&bar[XB_XSUB(b.x)], 1u);
        const unsigned gen = old / nloc;
        if (old + 1u == (gen + 1u) * nloc) {
            __builtin_amdgcn_fence(__ATOMIC_RELEASE, "agent");
            asm volatile("s_waitcnt vmcnt(0)" ::: "memory");
            const unsigned og = xb_add(&bar[XB_TOP], 1u);
            const unsigned tg = og / nx;
            if (og + 1u == (tg + 1u) * nx) xb_add(&bar[XB_TOPGEN], 1u);
            else XB_SPIN(xb_ld(&bar[XB_TOPGEN]) == tg, bar);
            __builtin_amdgcn_fence(__ATOMIC_ACQUIRE, "agent");
            xb_add(&bar[XB_XGEN(b.x)], 1u);
            asm volatile("s_waitcnt vmcnt(0)" ::: "memory");
        } else {
            XB_SPIN(xb_ld(&bar[XB_XGEN(b.x)]) == gen, bar);
            __builtin_amdgcn_fence(__ATOMIC_ACQUIRE, "agent");
            asm volatile("s_waitcnt vmcnt(0)" ::: "memory");
        }
    }
    __syncthreads();
}


__global__ void __launch_bounds__(NTHREADS) mega_fwd(Params p) {
  extern __shared__ __attribute__((aligned(16))) unsigned char smem_raw[];
  cg::grid_group grid = cg::this_grid();
  float* smf = (float*)smem_raw;
  u16* smh = (u16*)smem_raw;
  u16* xn = (u16*)(p.ws + WS_XN);
  float* x = p.out;

  volatile LAS unsigned* bst = (volatile LAS unsigned*)(smem_raw + LDS_BYTES - 16);
  if (threadIdx.x < 2) bst[threadIdx.x] = 0u;
  __syncthreads();
  XcdBarrier xbar; xbar.bar = (unsigned*)(p.ws + WS_BAR); xbar.x = xb_xcc_id(); xbar.st = bst;
  if (threadIdx.x == 0) bst[2] = xb_add(&xbar.bar[XB_XCNT(xbar.x)], 1u);
  phase_wprep(p, smf);
  phase_norm(p.x_prompt, p.x_sample, p.norm1_w, xn);
  grid.sync();
  if (threadIdx.x == 0) {
    const unsigned per = gridDim.x >> 3;
    bool ok = (gridDim.x & 7u) == 0u && xbar.x < 8u;
    for (unsigned j = 0; j < 8; ++j) ok = ok && (xb_ld(&xbar.bar[XB_XCNT(j)]) == per);
    const unsigned rank = bst[2];
    bst[3] = (ok && rank < per) ? xbar.x * per + rank : (blockIdx.x & 7u) * per + (blockIdx.x >> 3);
  }
  __syncthreads();
  const int vcu = __builtin_amdgcn_readfirstlane((int)bst[3]);
#pragma unroll 1
  for (int l = 0; l < 2; ++l) {
    phase_proj(p, l, vcu, smh);
    xcd_barrier(xbar);
    phase_prep(p, l);
    xcd_barrier(xbar);
    phase_scan(p, l, smf);
    xcd_barrier(xbar);
    phase_post(p, l);
    xcd_barrier(xbar);
    phase_merge(p, l, vcu, smh);
    xcd_barrier(xbar);
    if (l == 0)
      phase_resid((const u16*)(p.ws + WS_CONV), LDX, 1024, (const u16*)(p.ws + WS_WT_OUT), LDW1, p.x_prompt, p.x_sample, x, vcu, smh);
    else
      phase_resid((const u16*)(p.ws + WS_CONV), LDX, 1024, (const u16*)(p.ws + WS_WT_OUT) + (size_t)1024 * LDW1, LDW1, x, x + (size_t)MP * D, x, vcu, smh);
    xcd_barrier(xbar);
    phase_norm(x, x + (size_t)MP * D, p.norm2_w + l * D, xn);
    xcd_barrier(xbar);
    phase_up(p, l, vcu, smh);
    xcd_barrier(xbar);
    phase_resid((const u16*)(p.ws + WS_PROJ), LDH, 4096, (const u16*)(p.ws + WS_WT_DN) + (size_t)l * 1024 * LDWD, LDWD, x, x + (size_t)MP * D, x, vcu, smh);
    xcd_barrier(xbar);
    if (l == 0) {
      phase_norm(x, x + (size_t)MP * D, p.norm1_w + D, xn);
      xcd_barrier(xbar);
    }
  }
  phase_final_norm(x, p.final_norm_w);
}

extern "C" void kernel_launch(void* const* d_in, const int* in_sizes, int n_in, void* d_out, int out_size, void* d_ws,
                              size_t ws_size, hipStream_t stream) {
  static int grid_blocks = 0;
  if (!grid_blocks) {
    int dev = 0, cus = 0, per_cu = 0;
    hipGetDevice(&dev);
    hipDeviceGetAttribute(&cus, hipDeviceAttributeMultiprocessorCount, dev);
    hipFuncSetAttribute((const void*)mega_fwd, hipFuncAttributeMaxDynamicSharedMemorySize, LDS_BYTES);
    hipOccupancyMaxActiveBlocksPerMultiprocessor(&per_cu, (const void*)mega_fwd, NTHREADS, LDS_BYTES);
    if (per_cu < 1) { fprintf(stderr, "occupancy query returned %d\n", per_cu); per_cu = 1; }
    grid_blocks = cus;
    if (ws_size < WS_END) fprintf(stderr, "workspace too small: %zu < %zu\n", ws_size, (size_t)WS_END);
  }
  Params p{};
  p.x_prompt = (const float*)d_in[0]; p.x_sample = (const float*)d_in[1];
  p.st_mC = (const float*)d_in[2]; p.st_mn = (const float*)d_in[3]; p.st_mm = (const float*)d_in[4];
  p.st_gS = (const float*)d_in[5]; p.st_gconv = (const float*)d_in[6]; p.st_hS = (const float*)d_in[7];
  p.norm1_w = (const float*)d_in[8]; p.w_in = (const float*)d_in[9]; p.ml_i_bias = (const float*)d_in[10];
  p.ml_f_bias = (const float*)d_in[11]; p.ml_norm_w = (const float*)d_in[12]; p.gd_conv_w = (const float*)d_in[13];
  p.gd_A_log = (const float*)d_in[14]; p.gd_dt_bias = (const float*)d_in[15]; p.gd_norm_w = (const float*)d_in[16];
  p.hg_lb_logits = (const float*)d_in[17]; p.hg_norm_w = (const float*)d_in[18]; p.w_branch = (const float*)d_in[19];
  p.w_out = (const float*)d_in[20]; p.norm2_w = (const float*)d_in[21]; p.w_up = (const float*)d_in[22];
  p.w_down = (const float*)d_in[23]; p.final_norm_w = (const float*)d_in[24];
  p.out = (float*)d_out;
  p.ws = (unsigned char*)d_ws;
  hipMemsetAsync((char*)d_ws + WS_BAR, 0, WS_BAR_BYTES, stream);
  void* args[] = {&p};
  hipError_t e = hipLaunchCooperativeKernel((const void*)mega_fwd, dim3(grid_blocks), dim3(NTHREADS), args, LDS_BYTES, stream);
  if (e != hipSuccess) fprintf(stderr, "cooperative launch failed: %s (grid %d)\n", hipGetErrorString(e), grid_blocks);
}
```
